# Optimizing an MI355X kernel written in HIP

```python
import jax, jax.numpy as jnp
from jax import lax
import numpy as np

D_MODEL = 2048
BATCH = 2
SEQ = 4096
DEPTH = 1

ROPE_THETA = 500000.0
EPS = 1e-6
A_GROUPS = 8
A_GROUP_DIM = 128
A_WIDTH = A_GROUPS * A_GROUP_DIM
CHUNK = 128
B_HEADS = 8
B_KV_HEADS = 2
B_HEAD_DIM = 128
B_WIDTH = B_HEADS * B_HEAD_DIM
IDX_HEADS = 16
IDX_DIM = 64
TOPK_MAX = 256
Q_BLOCK = 128
M_HEADS = 4
M_HEAD_DIM = 256
M_WIDTH = M_HEADS * M_HEAD_DIM
MEM_LEN = 256

SPLIT_SIZES = (
    A_WIDTH, A_WIDTH, A_WIDTH,
    B_WIDTH, B_KV_HEADS * B_HEAD_DIM, B_KV_HEADS * B_HEAD_DIM,
    B_WIDTH,
    IDX_HEADS * IDX_DIM, IDX_DIM, IDX_HEADS,
    M_WIDTH, M_WIDTH,
    D_MODEL, D_MODEL, D_MODEL,
)
D_IN = sum(SPLIT_SIZES)
SPLIT_OFFSETS = tuple(int(o) for o in np.cumsum(SPLIT_SIZES)[:-1])

kernel_name = 'hybrid_gmlp_dsa_memxattn_gated_block'


def rms_norm(x, g):
    xf = x.astype(jnp.float32)
    y = xf * lax.rsqrt(jnp.mean(xf * xf, axis=-1, keepdims=True) + EPS)
    return (y * g.astype(jnp.float32)).astype(x.dtype)


def layer_norm(x, g, b):
    xf = x.astype(jnp.float32)
    mu = jnp.mean(xf, axis=-1, keepdims=True)
    var = jnp.mean(jnp.square(xf - mu), axis=-1, keepdims=True)
    y = (xf - mu) * lax.rsqrt(var + EPS)
    return (y * g.astype(jnp.float32) + b.astype(jnp.float32)).astype(x.dtype)


def partial_rope(x, pos):
    rot = x.shape[-1] // 4
    half = rot // 2
    inv_freq = ROPE_THETA ** (-jnp.arange(half, dtype=jnp.float32) / half)
    ang = pos.astype(jnp.float32)[..., None] * inv_freq
    cos = jnp.cos(ang)[:, :, None, :]
    sin = jnp.sin(ang)[:, :, None, :]
    x1 = x[..., :half].astype(jnp.float32)
    x2 = x[..., half:rot].astype(jnp.float32)
    r1 = (x1 * cos - x2 * sin).astype(x.dtype)
    r2 = (x2 * cos + x1 * sin).astype(x.dtype)
    return jnp.concatenate([r1, r2, x[..., rot:]], axis=-1)


def gmlp_branch(a_u, a_v, a_z, ln_g, ln_b, spatial_w, spatial_b):
    bsz, s, _ = a_u.shape
    u = jax.nn.gelu(a_u)
    v = layer_norm(jax.nn.gelu(a_v), ln_g, ln_b)
    vr = v.reshape(bsz, s // CHUNK, CHUNK, A_GROUPS, A_GROUP_DIM)
    mask = jnp.tril(jnp.ones((CHUNK, CHUNK), dtype=bool))
    ws = jnp.where(mask[None], spatial_w, jnp.zeros_like(spatial_w))
    sg = jnp.einsum('gts,bcsgd->bctgd', ws, vr) + spatial_b.T[None, None, :, :, None]
    return u * sg.reshape(bsz, s, A_WIDTH) * jax.nn.silu(a_z)


def dsa_branch(b_q, b_k, b_v, b_z, i_q, i_k, i_w, positions,
               q_norm_gain, k_norm_gain, idx_k_ln_gain, idx_k_ln_bias):
    bsz, s, _ = b_q.shape
    grp = B_HEADS // B_KV_HEADS
    q = partial_rope(rms_norm(b_q.reshape(bsz, s, B_HEADS, B_HEAD_DIM), q_norm_gain), positions)
    k = partial_rope(rms_norm(b_k.reshape(bsz, s, B_KV_HEADS, B_HEAD_DIM), k_norm_gain), positions)
    v = b_v.reshape(bsz, s, B_KV_HEADS, B_HEAD_DIM)
    kv = jnp.stack([k, v], axis=2)
    iq = partial_rope(i_q.reshape(bsz, s, IDX_HEADS, IDX_DIM), positions)
    ik = partial_rope(layer_norm(i_k, idx_k_ln_gain, idx_k_ln_bias)[:, :, None, :], positions)[:, :, 0]
    iw = i_w * (IDX_HEADS ** -0.5)
    topk = min(TOPK_MAX, s // 4)
    nb = s // Q_BLOCK
    key_pos = jnp.arange(s)

    def to_blocks(t):
        return t.reshape((bsz, nb, Q_BLOCK) + t.shape[2:]).swapaxes(0, 1)

    def block(args):
        qb, iqb, iwb, bid = args
        t_idx = bid * Q_BLOCK + jnp.arange(Q_BLOCK)
        rel = jax.nn.relu(jnp.einsum('bthd,bsd->bths', iqb, ik).astype(jnp.float32) * (IDX_DIM ** -0.5))
        score = jnp.einsum('bth,bths->bts', iwb.astype(jnp.float32), rel)
        causal = key_pos[None, :] <= t_idx[:, None]
        score = jnp.where(causal[None], score, -jnp.inf)
        _, sel = lax.top_k(score, topk)
        valid = sel <= t_idx[None, :, None]
        kv_sel = jax.vmap(lambda kvb, ib: kvb[ib])(kv, sel)
        k_sel = kv_sel[:, :, :, 0]
        v_sel = kv_sel[:, :, :, 1]
        qg = qb.reshape(bsz, Q_BLOCK, B_KV_HEADS, grp, B_HEAD_DIM)
        logits = jnp.einsum('btngd,btsnd->btngs', qg, k_sel).astype(jnp.float32) * (B_HEAD_DIM ** -0.5)
        logits = jnp.where(valid[:, :, None, None, :], logits, -jnp.inf)
        p = jax.nn.softmax(logits, axis=-1).astype(v_sel.dtype)
        o = jnp.einsum('btngs,btsnd->btngd', p, v_sel)
        return o.reshape(bsz, Q_BLOCK, B_WIDTH)

    out = lax.map(block, (to_blocks(q), to_blocks(iq), to_blocks(iw), jnp.arange(nb)))
    out = out.swapaxes(0, 1).reshape(bsz, s, B_WIDTH)
    return out * jax.nn.silu(b_z)


def memory_branch(m_q, m_z, mem, mem_norm_gain, w_mem_kv, mem_q_norm_gain, mem_k_norm_gain):
    bsz, s, _ = m_q.shape
    qm = rms_norm(m_q.reshape(bsz, s, M_HEADS, M_HEAD_DIM), mem_q_norm_gain)
    memn = rms_norm(mem, mem_norm_gain)
    kvm = (memn @ w_mem_kv).reshape(bsz, mem.shape[1], 2, M_HEADS, M_HEAD_DIM)
    km = rms_norm(kvm[:, :, 0], mem_k_norm_gain)
    vm = kvm[:, :, 1]
    logits = jnp.einsum('bshd,bmhd->bhsm', qm, km).astype(jnp.float32) * (M_HEAD_DIM ** -0.5)
    p = jax.nn.softmax(logits, axis=-1).astype(vm.dtype)
    o = jnp.einsum('bhsm,bmhd->bshd', p, vm).reshape(bsz, s, M_WIDTH)
    return o * jax.nn.silu(m_z)


def setup_inputs(seed: int = 0) -> dict:
    key = jax.random.key(seed)
    ks = jax.random.split(key, 24)
    f32 = jnp.float32
    nrm = lambda k, shape, scale: jax.random.normal(k, shape, f32) * scale
    L = DEPTH
    return {
        'x': jax.random.normal(ks[0], (BATCH, SEQ, D_MODEL), f32),
        'mem': jax.random.normal(ks[1], (BATCH, MEM_LEN, D_MODEL), f32),
        'positions': jnp.arange(SEQ, dtype=jnp.int32)[None, :]
                     + jax.random.randint(ks[2], (BATCH, 1), 0, 1024, dtype=jnp.int32),
        'norm_gain': 1.0 + nrm(ks[3], (L, D_MODEL), 0.01),
        'w_in': nrm(ks[4], (L, D_MODEL, D_IN), D_MODEL ** -0.5),
        'gmlp_ln_gain': 1.0 + nrm(ks[5], (L, A_WIDTH), 0.01),
        'gmlp_ln_bias': nrm(ks[6], (L, A_WIDTH), 0.01),
        'spatial_w': nrm(ks[7], (L, A_GROUPS, CHUNK, CHUNK), CHUNK ** -0.5),
        'spatial_b': 1.0 + nrm(ks[8], (L, A_GROUPS, CHUNK), 0.1),
        'w_branch_a': nrm(ks[9], (L, A_WIDTH, D_MODEL), A_WIDTH ** -0.5),
        'q_norm_gain': 1.0 + nrm(ks[10], (L, B_HEAD_DIM), 0.01),
        'k_norm_gain': 1.0 + nrm(ks[11], (L, B_HEAD_DIM), 0.01),
        'idx_k_ln_gain': 1.0 + nrm(ks[12], (L, IDX_DIM), 0.01),
        'idx_k_ln_bias': nrm(ks[13], (L, IDX_DIM), 0.01),
        'w_branch_b': nrm(ks[14], (L, B_WIDTH, D_MODEL), B_WIDTH ** -0.5),
        'mem_norm_gain': 1.0 + nrm(ks[15], (L, D_MODEL), 0.01),
        'w_mem_kv': nrm(ks[16], (L, D_MODEL, 2 * M_WIDTH), D_MODEL ** -0.5),
        'mem_q_norm_gain': 1.0 + nrm(ks[17], (L, M_HEAD_DIM), 0.01),
        'mem_k_norm_gain': 1.0 + nrm(ks[18], (L, M_HEAD_DIM), 0.01),
        'w_branch_m': nrm(ks[19], (L, M_WIDTH, D_MODEL), M_WIDTH ** -0.5),
        'w_out': nrm(ks[20], (L, D_MODEL, D_MODEL), D_MODEL ** -0.5),
    }


def reference(x, mem, positions, norm_gain, w_in, gmlp_ln_gain, gmlp_ln_bias, spatial_w,
              spatial_b, w_branch_a, q_norm_gain, k_norm_gain, idx_k_ln_gain, idx_k_ln_bias,
              w_branch_b, mem_norm_gain, w_mem_kv, mem_q_norm_gain, mem_k_norm_gain,
              w_branch_m, w_out):
    for l in range(DEPTH):
        h = rms_norm(x, norm_gain[l])
        proj = h @ w_in[l]
        (a_u, a_v, a_z, b_q, b_k, b_v, b_z, i_q, i_k, i_w,
         m_q, m_z, g_a, g_b, g_m) = jnp.split(proj, SPLIT_OFFSETS, axis=-1)
        y_a = gmlp_branch(a_u, a_v, a_z, gmlp_ln_gain[l], gmlp_ln_bias[l],
                          spatial_w[l], spatial_b[l]) @ w_branch_a[l]
        y_b = dsa_branch(b_q, b_k, b_v, b_z, i_q, i_k, i_w, positions,
                         q_norm_gain[l], k_norm_gain[l], idx_k_ln_gain[l],
                         idx_k_ln_bias[l]) @ w_branch_b[l]
        y_m = memory_branch(m_q, m_z, mem, mem_norm_gain[l], w_mem_kv[l],
                            mem_q_norm_gain[l], mem_k_norm_gain[l]) @ w_branch_m[l]
        merged = (jax.nn.sigmoid(g_a) * y_a + jax.nn.sigmoid(g_b) * y_b
                  + jax.nn.sigmoid(g_m) * y_m)
        x = x + merged @ w_out[l]
    return x
```

```cpp
#include <hip/hip_runtime.h>
#include <hip/hip_cooperative_groups.h>
#include <cstdio>
#include <cstdint>
namespace cg = cooperative_groups;

#define LAS __attribute__((address_space(3)))
typedef unsigned short bf16_t;
typedef short bf16x8 __attribute__((ext_vector_type(8)));
typedef short s16x4 __attribute__((ext_vector_type(4)));
typedef float f32x2 __attribute__((ext_vector_type(2)));
typedef float f32x4 __attribute__((ext_vector_type(4)));
typedef float f32x16 __attribute__((ext_vector_type(16)));
typedef unsigned u32x2 __attribute__((ext_vector_type(2)));
typedef unsigned u32x4 __attribute__((ext_vector_type(4)));

constexpr int NB = 2, SEQ = 4096, T = NB * SEQ, DM = 2048, DIN = 14928, NPAD = 15104, MEML = 256;
constexpr int NTHREADS = 512, NWAVES = 8;
constexpr int LDS_BYTES = 147456;
constexpr float EPS = 1e-6f;
constexpr float LOG2E = 1.4426950408889634f;

constexpr size_t MiB = (size_t)1 << 20;
constexpr size_t WS_WIN = 0, WS_WBR = 60 * MiB, WS_WOUT = 72 * MiB, WS_WMKV = 80 * MiB, WS_H = 88 * MiB, WS_MEMN = 120 * MiB;
constexpr size_t WS_AU = 122 * MiB, WS_AV = 138 * MiB, WS_AZ = 154 * MiB, WS_QR = 170 * MiB, WS_BZ = 186 * MiB, WS_MQ = 202 * MiB, WS_MZ = 218 * MiB;
constexpr size_t WS_IQ = 234 * MiB, WS_KR = 250 * MiB, WS_VV = 254 * MiB, WS_SA = 258 * MiB, WS_SB = 290 * MiB, WS_SM = 322 * MiB;
constexpr size_t WS_QN = 354 * MiB, WS_KN = 370 * MiB, WS_XA = 374 * MiB, WS_XM = 390 * MiB, WS_MASK = 406 * MiB, WS_IK = 410 * MiB, WS_IW = 411 * MiB;
constexpr size_t WS_KM = 412 * MiB, WS_VT = 413 * MiB, WS_CSB = 414 * MiB, WS_CSI = 415 * MiB, WS_END = 416 * MiB;
constexpr size_t WS_RKP = WS_IW + 524288;
constexpr size_t WS_CTL = WS_END, CTL_BYTES = 65536, WS_TOTAL = WS_END + CTL_BYTES;
constexpr int CW_BAR = 0;
constexpr int MISC_OFF = 147200;
constexpr size_t WS_XB = WS_QR;
constexpr size_t WS_MERGED = WS_H;

__device__ __forceinline__ unsigned cvt_pk_bf16(float lo, float hi) { unsigned r; asm volatile("v_cvt_pk_bf16_f32 %0, %1, %2" : "=v"(r) : "v"(lo), "v"(hi)); return r; }
__device__ __forceinline__ bf16_t f2bf(float f) { return (bf16_t)(cvt_pk_bf16(f, 0.f) & 0xffffu); }
__device__ __forceinline__ float bf2f(unsigned short b) { return __uint_as_float(((unsigned)b) << 16); }
__device__ __forceinline__ float bflo(unsigned w) { return __uint_as_float(w << 16); }
__device__ __forceinline__ float bfhi(unsigned w) { return __uint_as_float(w & 0xffff0000u); }
__device__ __forceinline__ float sigm(float x) { return __builtin_amdgcn_rcpf(1.f + __builtin_amdgcn_exp2f(-LOG2E * x)); }
__device__ __forceinline__ float silu_f(float x) { return x * sigm(x); }
__device__ __forceinline__ float gelu_f(float x) { const float u = 0.7978845608028654f * (x + 0.044715f * x * x * x); return x * sigm(2.f * u); }
__device__ __forceinline__ float wave_sum(float v) {
#pragma unroll
    for (int o = 1; o < 64; o <<= 1) v += __shfl_xor(v, o);
    return v;
}
__device__ __forceinline__ unsigned wave_sum_u(unsigned v) {
#pragma unroll
    for (int o = 1; o < 64; o <<= 1) v += (unsigned)__shfl_xor((int)v, o);
    return v;
}
__device__ __forceinline__ bf16x8 pack8(f32x4 a, f32x4 b) {
    u32x4 w = {cvt_pk_bf16(a[0], a[1]), cvt_pk_bf16(a[2], a[3]), cvt_pk_bf16(b[0], b[1]), cvt_pk_bf16(b[2], b[3])};
    return *reinterpret_cast<bf16x8*>(&w);
}
#define LDS_WAIT() asm volatile("s_waitcnt lgkmcnt(0)" ::: "memory")
__device__ __forceinline__ int opaque_tid() { int t = threadIdx.x; asm volatile("" : "+v"(t)); return t; }

namespace pg8 {
constexpr int BM = 256, BK = 64, HALF = 128, HTB = HALF * BK * 2, STAGE_BYTES = 8 * HTB, NXCD = 8, WGM = 8;
__host__ __device__ __forceinline__ int lds_byte(int r, int c) { const int st = (r >> 4) * 2 + (c >> 5), rr = r & 15, cc = c & 31, ob = rr * 64 + cc * 2; return st * 1024 + (ob ^ (((ob >> 9) & 1) << 5)); }
__host__ __device__ __forceinline__ void stage_rc(int b, int& R, int& C) { const int st = b / 1024, sb = b % 1024, swz = sb ^ (((sb >> 9) & 1) << 5); R = (st >> 1) * 16 + swz / 64; C = (st & 1) * 32 + (swz % 64) / 2; }
__host__ __device__ __forceinline__ int perm32(int rho) { const int n = rho >> 4, i = rho & 15; return 8 * (i >> 2) + 4 * n + (i & 3); }

struct Unit { int pm, pn, kind; };

__device__ __forceinline__ void tile_order(int wgid, int nM, int nN, int& pm, int& pn) {
    const int nwg = nM * nN;
    { const int q = nwg / NXCD, r = nwg % NXCD, xcd = wgid % NXCD, off = wgid / NXCD; wgid = (xcd < r ? xcd * (q + 1) : r * (q + 1) + (xcd - r) * q) + off; }
    const int nig = WGM * nN, gid = wgid / nig, fm = gid * WGM, gsz = (nM - fm) < WGM ? (nM - fm) : WGM;
    pm = fm + ((wgid % nig) % gsz); pn = (wgid % nig) / gsz;
}

template <class Epi, class Sched, bool ALIGN_EPI, bool SP2>
__device__ __forceinline__ void gemm_phase(LAS unsigned char* lds, const int K, const Sched& S, const Epi& E) {
    const int tid = opaque_tid(), wid = __builtin_amdgcn_readfirstlane(tid >> 6), lane = tid & 63, wr = wid >> 2, wc = wid & 3, fr = lane & 15, fq = lane >> 4;
    const int nt = K / BK;
    unsigned voffA[2], voffB[2];
#pragma unroll
    for (int i = 0; i < 2; ++i) { int R, C; stage_rc(tid * 16 + i * 8192, R, C); const int Rb = Epi::PERM ? ((R & ~31) + perm32(R & 31)) : R;
        voffA[i] = (unsigned)(R * K + C) * 2u; voffB[i] = (unsigned)(Rb * K + C) * 2u; }
    const size_t kstep = (size_t)(BK * 2);
    const size_t hstep = (size_t)HALF * K * 2;
    const unsigned ldsw = (unsigned)wid * 1024u;
    const int aoff = lds_byte(wr * 64 + fr, fq * 8), boff = lds_byte(wc * 32 + fr, fq * 8);
#define PG8_SA(b, h) (((b) * 2 + (h)) * HTB)
#define PG8_SB(b, h) ((4 + (b) * 2 + (h)) * HTB)
#define PG8_STAGE(bufoff, gbase, voff) do { _Pragma("unroll") for (int _i = 0; _i < 2; ++_i) \
        __builtin_amdgcn_global_load_lds((const unsigned*)((const char*)(gbase) + (voff)[_i]), (LAS unsigned*)(lds + (bufoff) + ldsw + _i * 8192), 16, 0, 0); } while (0)
#define PG8_LDA(dst, b, h) do { _Pragma("unroll") for (int m = 0; m < 4; ++m) _Pragma("unroll") for (int k = 0; k < 2; ++k) dst[m][k] = *(const LAS bf16x8*)(lds + PG8_SA(b, h) + aoff + m * 2048 + k * 1024); } while (0)
#define PG8_LDB(dst, b, h) do { _Pragma("unroll") for (int n = 0; n < 2; ++n) _Pragma("unroll") for (int k = 0; k < 2; ++k) dst[n][k] = *(const LAS bf16x8*)(lds + PG8_SB(b, h) + boff + n * 2048 + k * 1024); } while (0)
#define PG8_MMA(ai, bj, At, Bt) do { __builtin_amdgcn_s_setprio(1); _Pragma("unroll") for (int m = 0; m < 4; ++m) _Pragma("unroll") for (int n = 0; n < 2; ++n) _Pragma("unroll") for (int k = 0; k < 2; ++k) \
        acc[ai][bj][m][n] = __builtin_amdgcn_mfma_f32_16x16x32_bf16(Bt[n][k], At[m][k], acc[ai][bj][m][n], 0, 0, 0); __builtin_amdgcn_s_setprio(0); } while (0)
#define PG8_WAIT_V(n) asm volatile("s_waitcnt vmcnt(" #n ")" ::: "memory")
#define PG8_WAIT_L(n) asm volatile("s_waitcnt lgkmcnt(" #n ")" ::: "memory")
#define PG8_BAR __builtin_amdgcn_s_barrier()
#define PG8_SCHED __builtin_amdgcn_sched_barrier(0)
    Unit cur, nxt; int ui = 0;
    if (!S.next(0, cur)) return;
    f32x4 acc[2][2][4][2];
#pragma unroll
    for (int a = 0; a < 2; ++a)
#pragma unroll
        for (int b = 0; b < 2; ++b)
#pragma unroll
            for (int m = 0; m < 4; ++m)
#pragma unroll
                for (int n = 0; n < 2; ++n) acc[a][b][m][n] = (f32x4){0.f, 0.f, 0.f, 0.f};
    bf16x8 At[4][2], B0[2][2], B1[2][2];
    const char* cA = S.a_base(cur); const char* cB = S.b_base(cur);
    if constexpr (SP2) {
        PG8_STAGE(PG8_SB(0, 0), cB, voffB); PG8_STAGE(PG8_SB(0, 1), cB + hstep, voffB); PG8_STAGE(PG8_SA(0, 0), cA, voffA); PG8_STAGE(PG8_SA(0, 1), cA + hstep, voffA);
        if (wr == 1) PG8_BAR;
        PG8_WAIT_V(2); PG8_BAR;
        PG8_STAGE(PG8_SB(1, 0), cB + kstep, voffB); PG8_STAGE(PG8_SA(1, 0), cA + kstep, voffA); PG8_STAGE(PG8_SB(1, 1), cB + hstep + kstep, voffB);
        PG8_WAIT_V(6); PG8_BAR;
    } else {
        PG8_STAGE(PG8_SB(0, 0), cB, voffB); PG8_STAGE(PG8_SA(0, 0), cA, voffA); PG8_STAGE(PG8_SB(0, 1), cB + hstep, voffB); PG8_STAGE(PG8_SA(0, 1), cA + hstep, voffA);
        if (wr == 1) PG8_BAR;
        PG8_WAIT_V(4); PG8_BAR;
        PG8_STAGE(PG8_SB(1, 0), cB + kstep, voffB); PG8_STAGE(PG8_SA(1, 0), cA + kstep, voffA); PG8_STAGE(PG8_SB(1, 1), cB + hstep + kstep, voffB);
        PG8_WAIT_V(6); PG8_BAR;
    }
    for (;;) {
        const bool has_next = S.next(ui + 1, nxt);
        const char* nA = has_next ? S.a_base(nxt) : cA; const char* nB = has_next ? S.b_base(nxt) : cB;
        for (int t = 0; t < nt; t += 2) {
            const bool last = (t == nt - 2);
            const char* a1 = cA + (size_t)(t + 1) * kstep;
            const char* a2 = last ? nA : cA + (size_t)(t + 2) * kstep; const char* b2 = last ? nB : cB + (size_t)(t + 2) * kstep;
            const char* a3 = a2 + kstep; const char* b3 = b2 + kstep;
            if constexpr (SP2) {
            PG8_LDB(B0, 0, 0); PG8_LDB(B1, 0, 1); PG8_SCHED; PG8_LDA(At, 0, 0); PG8_STAGE(PG8_SA(1, 1), a1 + hstep, voffA);
            PG8_WAIT_V(8); PG8_WAIT_L(0); PG8_BAR; PG8_MMA(0, 0, At, B0); PG8_MMA(0, 1, At, B1); PG8_BAR; PG8_SCHED;
            PG8_LDA(At, 0, 1); PG8_STAGE(PG8_SB(0, 0), b2, voffB); PG8_STAGE(PG8_SB(0, 1), b2 + hstep, voffB); PG8_STAGE(PG8_SA(0, 0), a2, voffA);
            PG8_WAIT_V(8); PG8_WAIT_L(0); PG8_BAR; PG8_MMA(1, 0, At, B0); PG8_MMA(1, 1, At, B1); PG8_BAR; PG8_SCHED;
            PG8_LDB(B0, 1, 0); PG8_LDB(B1, 1, 1); PG8_SCHED; PG8_LDA(At, 1, 0); PG8_STAGE(PG8_SA(0, 1), a2 + hstep, voffA);
            PG8_WAIT_V(8); PG8_WAIT_L(0); PG8_BAR; PG8_MMA(0, 0, At, B0); PG8_MMA(0, 1, At, B1); PG8_BAR; PG8_SCHED;
            PG8_LDA(At, 1, 1); PG8_STAGE(PG8_SB(1, 0), b3, voffB); PG8_STAGE(PG8_SB(1, 1), b3 + hstep, voffB); PG8_STAGE(PG8_SA(1, 0), a3, voffA);
            PG8_WAIT_V(8); PG8_WAIT_L(0); PG8_BAR; PG8_MMA(1, 0, At, B0); PG8_MMA(1, 1, At, B1); PG8_BAR; PG8_SCHED;
            } else {
            PG8_LDB(B0, 0, 0); PG8_SCHED; PG8_LDA(At, 0, 0); PG8_STAGE(PG8_SA(1, 1), a1 + hstep, voffA);
            PG8_WAIT_L(8); PG8_BAR; PG8_WAIT_L(0); PG8_MMA(0, 0, At, B0); PG8_BAR; PG8_SCHED;
            PG8_LDB(B1, 0, 1); PG8_STAGE(PG8_SB(0, 0), b2, voffB);
            PG8_BAR; PG8_WAIT_L(0); PG8_MMA(0, 1, At, B1); PG8_BAR;
            PG8_LDA(At, 0, 1); PG8_STAGE(PG8_SA(0, 0), a2, voffA);
            PG8_BAR; PG8_WAIT_L(0); PG8_MMA(1, 0, At, B0); PG8_BAR; PG8_SCHED;
            PG8_STAGE(PG8_SB(0, 1), b2 + hstep, voffB);
            PG8_WAIT_V(6); PG8_BAR; PG8_MMA(1, 1, At, B1); PG8_BAR;
            PG8_LDB(B0, 1, 0); PG8_SCHED; PG8_LDA(At, 1, 0); PG8_STAGE(PG8_SA(0, 1), a2 + hstep, voffA);
            PG8_WAIT_L(8); PG8_BAR; PG8_WAIT_L(0); PG8_MMA(0, 0, At, B0); PG8_BAR; PG8_SCHED;
            PG8_LDB(B1, 1, 1); PG8_STAGE(PG8_SB(1, 0), b3, voffB);
            PG8_BAR; PG8_WAIT_L(0); PG8_MMA(0, 1, At, B1); PG8_BAR;
            PG8_LDA(At, 1, 1); PG8_STAGE(PG8_SA(1, 0), a3, voffA);
            PG8_BAR; PG8_WAIT_L(0); PG8_MMA(1, 0, At, B0); PG8_BAR; PG8_SCHED;
            PG8_STAGE(PG8_SB(1, 1), b3 + hstep, voffB);
            PG8_WAIT_V(6); PG8_BAR; PG8_MMA(1, 1, At, B1); PG8_BAR;
            }
        }
        if constexpr (ALIGN_EPI) { if (wr == 0) PG8_BAR; }
        const bool zero = E(acc, cur, wr, wc, fr, fq);
        if (!has_next) break;
        if (zero) {
#pragma unroll
        for (int a = 0; a < 2; ++a)
#pragma unroll
            for (int b = 0; b < 2; ++b)
#pragma unroll
                for (int m = 0; m < 4; ++m)
#pragma unroll
                    for (int n = 0; n < 2; ++n) acc[a][b][m][n] = (f32x4){0.f, 0.f, 0.f, 0.f};
        }
        cur = nxt; cA = nA; cB = nB; ++ui;
        if constexpr (ALIGN_EPI) { if (wr == 1) PG8_BAR; }
    }
    PG8_WAIT_V(0);
    if constexpr (!ALIGN_EPI) { if (wr == 0) PG8_BAR; }
    PG8_BAR;
#undef PG8_SA
#undef PG8_SB
#undef PG8_STAGE
#undef PG8_LDA
#undef PG8_LDB
#undef PG8_MMA
#undef PG8_WAIT_V
#undef PG8_WAIT_L
#undef PG8_BAR
#undef PG8_SCHED
}
}

struct Params {
    const float* x; const float* mem; const int* pos; const float* norm_gain; const float* w_in; const float* gmlp_g; const float* gmlp_b;
    const float* spatial_w; const float* spatial_b; const float* w_a; const float* q_gain; const float* k_gain; const float* ik_g; const float* ik_b;
    const float* w_b; const float* mem_gain; const float* w_mkv; const float* mq_gain; const float* mk_gain; const float* w_m; const float* w_out;
    float* out; unsigned char* ws;
};

__device__ __forceinline__ int win_src_col(int np) {
    const int tile = np >> 8, c = np & 255;
    if (tile < 22) return np;
    const int bj = c >> 7, wc = (c >> 5) & 3, fq = (c >> 3) & 3, j = c & 7;
    if (tile < 26) return 5632 + (tile - 22) * 256 + wc * 64 + 8 * (2 * fq + bj) + j;
    if (tile == 26) {
        if (wc == 0) return 6656 + 8 * (2 * fq + bj) + j;
        if (wc == 1 && fq == 0) return 6720 + 8 * bj + j;
        return -1;
    }
    return np - 176;
}
__device__ __forceinline__ void transpose_item(const float* W, int K, int N, bf16_t* WT, int kb, int nb, bool is_win, LAS float* scr, int lane) {
    const int k0 = 64 * kb, n0 = 32 * nb, nl = lane & 31;
    const int src = is_win ? win_src_col(n0 + nl) : (n0 + nl);
    const float* wp = W + (size_t)(k0 + (lane >> 5)) * N + (src >= 0 ? src : 0);
#pragma unroll 8
    for (int i = 0; i < 32; ++i) { const int kk = 2 * i + (lane >> 5); const float v = wp[(size_t)(2 * i) * N]; scr[kk * 33 + nl] = src >= 0 ? v : 0.f; }
    LDS_WAIT(); asm volatile("" ::: "memory");
    const int c = lane & 7;
#pragma unroll
    for (int j = 0; j < 4; ++j) { const int n = (lane >> 3) + 8 * j; const LAS float* s = scr + (8 * c) * 33 + n;
        u32x4 o; o.x = cvt_pk_bf16(s[0 * 33], s[1 * 33]); o.y = cvt_pk_bf16(s[2 * 33], s[3 * 33]); o.z = cvt_pk_bf16(s[4 * 33], s[5 * 33]); o.w = cvt_pk_bf16(s[6 * 33], s[7 * 33]);
        *(u32x4*)(WT + (size_t)(n0 + n) * K + k0 + 8 * c) = o; }
    LDS_WAIT(); asm volatile("" ::: "memory");
}
__device__ __forceinline__ void rms_row(const float* xrow, const float* gain, bf16_t* orow, int lane) {
    f32x4 v[8]; float s = 0.f;
#pragma unroll
    for (int j = 0; j < 8; ++j) { v[j] = ((const f32x4*)xrow)[lane + 64 * j]; s += (v[j][0] * v[j][0] + v[j][1] * v[j][1]) + (v[j][2] * v[j][2] + v[j][3] * v[j][3]); }
    s = wave_sum(s);
    const float r = 1.0f / sqrtf(s * (1.0f / DM) + EPS);
#pragma unroll
    for (int j = 0; j < 8; ++j) { const f32x4 g = ((const f32x4*)gain)[lane + 64 * j]; const f32x4 o = v[j] * r * g;
        u32x2 w; w.x = cvt_pk_bf16(o[0], o[1]); w.y = cvt_pk_bf16(o[2], o[3]); ((u32x2*)orow)[lane + 64 * j] = w; }
}
__device__ __forceinline__ void p0_prep(const Params& p, LAS unsigned char* lds, int vcu, int G) {
    const int tid = opaque_tid(), lane = tid & 63, wave = tid >> 6;
    LAS float* scr = (LAS float*)(lds + wave * 16384);
    const int gw = vcu * NWAVES + wave, NGW = G * NWAVES;
    unsigned char* ws = p.ws;
    constexpr int I_WIN = 32 * (NPAD / 32), I_BR = 16 * 64, I_SQ = 32 * 64;
    constexpr int NITEMS = I_WIN + 3 * I_BR + 2 * I_SQ;
    for (int it = gw; it < NITEMS; it += NGW) {
        int r = it;
        if (r < I_WIN) { const int nb = r % (NPAD / 32), kb = r / (NPAD / 32); transpose_item(p.w_in, DM, DIN, (bf16_t*)(ws + WS_WIN), kb, nb, true, scr, lane); continue; } r -= I_WIN;
        if (r < 3 * I_BR) { const int br = r / I_BR, q = r % I_BR; const float* W = br == 0 ? p.w_a : (br == 1 ? p.w_b : p.w_m);
            transpose_item(W, 1024, DM, (bf16_t*)(ws + WS_WBR) + (size_t)br * DM * 1024, q / 64, q % 64, false, scr, lane); continue; } r -= 3 * I_BR;
        if (r < I_SQ) { transpose_item(p.w_out, DM, DM, (bf16_t*)(ws + WS_WOUT), r / 64, r % 64, false, scr, lane); continue; } r -= I_SQ;
        transpose_item(p.w_mkv, DM, DM, (bf16_t*)(ws + WS_WMKV), r / 64, r % 64, false, scr, lane);
    }
    for (int m = gw; m < T + NB * MEML; m += NGW) {
        if (m < T) rms_row(p.x + (size_t)m * DM, p.norm_gain, (bf16_t*)(ws + WS_H) + (size_t)m * DM, lane);
        else rms_row(p.mem + (size_t)(m - T) * DM, p.mem_gain, (bf16_t*)(ws + WS_MEMN) + (size_t)(m - T) * DM, lane);
    }
    for (int i = vcu * NTHREADS + tid; i < T * 24; i += G * NTHREADS) {
        const int t = i / 24, j = i % 24; const float ps = (float)p.pos[t];
        float inv; if (j < 16) inv = powf(500000.0f, -(float)j / 16.0f); else inv = powf(500000.0f, -(float)(j - 16) / 8.0f);
        float sn, cs; sincosf(ps * inv, &sn, &cs);
        if (j < 16) ((f32x2*)(ws + WS_CSB))[t * 16 + j] = (f32x2){cs, sn}; else ((f32x2*)(ws + WS_CSI))[t * 8 + (j - 16)] = (f32x2){cs, sn};
    }
}

struct Sched1 {
    int G, c; const char* ws;
    __device__ __forceinline__ bool next(int i, pg8::Unit& u) const {
        int L = i * G + c;
        if (L < 32 * 59) { pg8::tile_order(L, 32, 59, u.pm, u.pn); u.kind = 0; return true; }
        L -= 32 * 59;
        if (L < 8) { u.pm = L & 1; u.pn = L >> 1; u.kind = 1; return true; }
        L -= 8;
        if (L < 8) { u.pm = L & 3; u.pn = L >> 2; u.kind = 2; return true; }
        return false;
    }
    __device__ __forceinline__ const char* a_base(const pg8::Unit& u) const {
        const size_t off = u.kind == 0 ? WS_H : (u.kind == 1 ? WS_MEMN : WS_WMKV + (size_t)1024 * DM * 2);
        return ws + off + (size_t)u.pm * (256 * DM * 2); }
    __device__ __forceinline__ const char* b_base(const pg8::Unit& u) const {
        const size_t off = u.kind == 0 ? WS_WIN : (u.kind == 1 ? WS_WMKV : WS_MEMN);
        return ws + off + (size_t)u.pn * (256 * DM * 2); }
};
struct Epi1 {
    static constexpr bool PERM = true;
    unsigned char* ws; const float* ikg; const float* ikb;
    __device__ __forceinline__ bool operator()(f32x4 (&acc)[2][2][4][2], const pg8::Unit& u, int wr, int wc, int fr, int fq) const {
        const int rowb = u.pm * 256 + wr * 64 + fr, cl = wc * 32 + 8 * fq, pn = u.pn;
#ifndef EX_NOIQ
        if (u.kind == 0 && pn >= 22 && pn < 26) {
            const int head = 4 * (pn - 22) + wc;
#pragma unroll
            for (int ai = 0; ai < 2; ++ai)
#pragma unroll
                for (int m = 0; m < 4; ++m) { const int row = rowb + ai * 128 + m * 16;
                    f32x4 x1a = acc[ai][0][m][0], x1b = acc[ai][0][m][1], x2a = acc[ai][1][m][0], x2b = acc[ai][1][m][1];
                    if (fq == 0) { const f32x4* cs = (const f32x4*)(ws + WS_CSI) + row * 4;
                        const f32x4 c0 = cs[0], c1 = cs[1], c2 = cs[2], c3 = cs[3];
                        const f32x4 co_a = {c0[0], c0[2], c1[0], c1[2]}, si_a = {c0[1], c0[3], c1[1], c1[3]}, co_b = {c2[0], c2[2], c3[0], c3[2]}, si_b = {c2[1], c2[3], c3[1], c3[3]};
                        const f32x4 r1a = x1a * co_a - x2a * si_a, r1b = x1b * co_b - x2b * si_b, r2a = x2a * co_a + x1a * si_a, r2b = x2b * co_b + x1b * si_b;
                        x1a = r1a; x1b = r1b; x2a = r2a; x2b = r2b; }
                    bf16_t* dst = (bf16_t*)(ws + WS_IQ) + (size_t)row * 1024 + head * 64 + 16 * fq;
                    *(bf16x8*)(dst) = pack8(x1a, x1b); *(bf16x8*)(dst + 8) = pack8(x2a, x2b); }
            return true;
        }
#endif
#ifndef EX_NOIK
        if (u.kind == 0 && pn == 26) {
            if (wc == 0) {
                const f32x4 g0 = *(const f32x4*)(ikg + 16 * fq), g1 = *(const f32x4*)(ikg + 16 * fq + 4), g2 = *(const f32x4*)(ikg + 16 * fq + 8), g3 = *(const f32x4*)(ikg + 16 * fq + 12);
                const f32x4 e0 = *(const f32x4*)(ikb + 16 * fq), e1 = *(const f32x4*)(ikb + 16 * fq + 4), e2 = *(const f32x4*)(ikb + 16 * fq + 8), e3 = *(const f32x4*)(ikb + 16 * fq + 12);
#pragma unroll
                for (int ai = 0; ai < 2; ++ai)
#pragma unroll
                    for (int m = 0; m < 4; ++m) { const int row = rowb + ai * 128 + m * 16;
                        f32x4 v0 = acc[ai][0][m][0], v1 = acc[ai][0][m][1], v2 = acc[ai][1][m][0], v3 = acc[ai][1][m][1];
                        const f32x4 sv = (v0 + v1) + (v2 + v3);
                        float sm = (sv[0] + sv[1]) + (sv[2] + sv[3]);
                        sm += __shfl_xor(sm, 16); sm += __shfl_xor(sm, 32);
                        const float mean = sm * (1.f / 64.f);
                        v0 = v0 - mean; v1 = v1 - mean; v2 = v2 - mean; v3 = v3 - mean;
                        const f32x4 qv = (v0 * v0 + v1 * v1) + (v2 * v2 + v3 * v3);
                        float q2 = (qv[0] + qv[1]) + (qv[2] + qv[3]);
                        q2 += __shfl_xor(q2, 16); q2 += __shfl_xor(q2, 32);
                        const float rstd = 1.0f / sqrtf(q2 * (1.f / 64.f) + EPS);
                        v0 = v0 * rstd * g0 + e0; v1 = v1 * rstd * g1 + e1; v2 = v2 * rstd * g2 + e2; v3 = v3 * rstd * g3 + e3;
                        if (fq == 0) { const f32x4* cs = (const f32x4*)(ws + WS_CSI) + row * 4;
                            const f32x4 c0 = cs[0], c1 = cs[1], c2 = cs[2], c3 = cs[3];
                            const f32x4 co_a = {c0[0], c0[2], c1[0], c1[2]}, si_a = {c0[1], c0[3], c1[1], c1[3]}, co_b = {c2[0], c2[2], c3[0], c3[2]}, si_b = {c2[1], c2[3], c3[1], c3[3]};
                            const f32x4 r1a = v0 * co_a - v2 * si_a, r1b = v1 * co_b - v3 * si_b, r2a = v2 * co_a + v0 * si_a, r2b = v3 * co_b + v1 * si_b;
                            v0 = r1a; v1 = r1b; v2 = r2a; v3 = r2b; }
                        bf16_t* dst = (bf16_t*)(ws + WS_IK) + (size_t)row * 64 + 16 * fq;
                        *(bf16x8*)(dst) = pack8(v0, v1); *(bf16x8*)(dst + 8) = pack8(v2, v3); }
            } else if (wc == 1 && fq == 0) {
#pragma unroll
                for (int ai = 0; ai < 2; ++ai)
#pragma unroll
                    for (int m = 0; m < 4; ++m) { const int row = rowb + ai * 128 + m * 16; float* dst = (float*)(ws + WS_IW) + (size_t)row * 16;
                        *(f32x4*)(dst) = acc[ai][0][m][0] * 0.03125f; *(f32x4*)(dst + 4) = acc[ai][0][m][1] * 0.03125f;
                        *(f32x4*)(dst + 8) = acc[ai][1][m][0] * 0.03125f; *(f32x4*)(dst + 12) = acc[ai][1][m][1] * 0.03125f; }
            }
            return true;
        }
#endif
        int act = 0, ld = 1024, co = 0, bjs = 128; size_t off = 0, bex = 0;
        if (u.kind == 1) { off = WS_KM; co = pn * 256; }
        else if (u.kind == 2) { off = WS_VT; ld = 512; co = pn * 256; }
        else if (pn < 4) { act = 1; off = WS_AU; co = pn * 256; }
        else if (pn < 8) { act = 1; off = WS_AV; co = (pn - 4) * 256; }
        else if (pn < 12) { act = 2; off = WS_AZ; co = (pn - 8) * 256; }
        else if (pn < 16) { off = WS_QR; co = (pn - 12) * 256; }
        else if (pn == 16) { off = WS_KR; ld = 256; }
        else if (pn == 17) { off = WS_VV; ld = 128; bjs = SEQ * 128; bex = (size_t)SEQ * 128; }
        else if (pn < 22) { act = 2; off = WS_BZ; co = (pn - 18) * 256; }
        else if (pn < 31) { off = WS_MQ; co = (pn - 27) * 256; }
        else if (pn < 35) { act = 2; off = WS_MZ; co = (pn - 31) * 256; }
        else if (pn < 43) { act = 3; off = WS_SA; ld = 2048; co = (pn - 35) * 256; }
        else if (pn < 51) { act = 3; off = WS_SB; ld = 2048; co = (pn - 43) * 256; }
        else { act = 3; off = WS_SM; ld = 2048; co = (pn - 51) * 256; }
        bf16_t* dst = (bf16_t*)(ws + off) + co + cl;
#pragma unroll
        for (int ai = 0; ai < 2; ++ai)
#pragma unroll
            for (int m = 0; m < 4; ++m) { const int row = rowb + ai * 128 + m * 16; bf16_t* rp = dst + (size_t)row * ld + (size_t)(row >> 12) * bex;
#pragma unroll
                for (int bj = 0; bj < 2; ++bj) { f32x4 v0 = acc[ai][bj][m][0], v1 = acc[ai][bj][m][1];
                    if (act == 1) {
#pragma unroll
                        for (int e = 0; e < 4; ++e) { v0[e] = gelu_f(v0[e]); v1[e] = gelu_f(v1[e]); } }
                    else if (act == 2) {
#pragma unroll
                        for (int e = 0; e < 4; ++e) { v0[e] = silu_f(v0[e]); v1[e] = silu_f(v1[e]); } }
                    else if (act == 3) {
#pragma unroll
                        for (int e = 0; e < 4; ++e) { v0[e] = sigm(v0[e]); v1[e] = sigm(v1[e]); } }
                    *(bf16x8*)(rp + (size_t)bj * bjs) = pack8(v0, v1); }
                if (u.kind == 1) {
                    const f32x4 q = (acc[ai][0][m][0] * acc[ai][0][m][0] + acc[ai][0][m][1] * acc[ai][0][m][1]) + (acc[ai][1][m][0] * acc[ai][1][m][0] + acc[ai][1][m][1] * acc[ai][1][m][1]);
                    float ss = (q[0] + q[1]) + (q[2] + q[3]);
                    ss += __shfl_xor(ss, 16); ss += __shfl_xor(ss, 32);
                    if (fq == 0) ((float*)(ws + WS_RKP))[(size_t)row * 16 + pn * 4 + wc] = ss; } }
        return true;
    }
};

struct Sched2 {
    int G, c; const char* ws;
    __device__ __forceinline__ bool next(int i, pg8::Unit& u) const {
        const int L = (i / 3) * G + c; if (L >= 256) return false;
        pg8::tile_order(L, 32, 8, u.pm, u.pn); u.kind = i % 3; return true;
    }
    __device__ __forceinline__ const char* a_base(const pg8::Unit& u) const {
        const size_t off = WS_XA + (u.kind == 1 ? (WS_XB - WS_XA) : (size_t)0) + (u.kind == 2 ? (WS_XM - WS_XA) : (size_t)0);
        return ws + off + (size_t)u.pm * (256 * 1024 * 2); }
    __device__ __forceinline__ const char* b_base(const pg8::Unit& u) const { return ws + WS_WBR + (size_t)u.kind * ((size_t)DM * 1024 * 2) + (size_t)u.pn * (256 * 1024 * 2); }
};
struct Epi2 {
    static constexpr bool PERM = true;
    unsigned char* ws;
    __device__ __forceinline__ bool operator()(f32x4 (&acc)[2][2][4][2], const pg8::Unit& u, int wr, int wc, int fr, int fq) const {
        const int rowb = u.pm * 256 + wr * 64 + fr, colb = u.pn * 256 + wc * 32 + 8 * fq, seg = u.kind;
        constexpr size_t GST = WS_SB - WS_SA;
        static_assert(WS_SM - WS_SB == GST, "gate spacing");
        const bf16_t* NUM = (const bf16_t*)(ws + WS_SA + (size_t)seg * GST);
        const bf16_t* DEN = (const bf16_t*)(ws + WS_SA + (size_t)(seg < 2 ? seg + 1 : 2) * GST);
        bf16_t* MG = (bf16_t*)(ws + WS_MERGED);
#pragma unroll
        for (int ai = 0; ai < 2; ++ai)
#pragma unroll
            for (int m = 0; m < 4; ++m) { const size_t ro = (size_t)(rowb + ai * 128 + m * 16) * DM + colb;
#pragma unroll
                for (int bj = 0; bj < 2; ++bj) {
                    const u32x4 nu = *(const u32x4*)(NUM + ro + bj * 128);
                    f32x4 f0 = {bflo(nu[0]), bfhi(nu[0]), bflo(nu[1]), bfhi(nu[1])}, f1 = {bflo(nu[2]), bfhi(nu[2]), bflo(nu[3]), bfhi(nu[3])};
                    if (seg < 2) { const u32x4 de = *(const u32x4*)(DEN + ro + bj * 128);
                        const f32x4 d0 = {bflo(de[0]), bfhi(de[0]), bflo(de[1]), bfhi(de[1])}, d1 = {bflo(de[2]), bfhi(de[2]), bflo(de[3]), bfhi(de[3])};
#pragma unroll
                        for (int e = 0; e < 4; ++e) { f0[e] *= __builtin_amdgcn_rcpf(d0[e]); f1[e] *= __builtin_amdgcn_rcpf(d1[e]); }
                        acc[ai][bj][m][0] *= f0; acc[ai][bj][m][1] *= f1;
                    } else { *(bf16x8*)(MG + ro + bj * 128) = pack8(acc[ai][bj][m][0] * f0, acc[ai][bj][m][1] * f1); }
                } }
        return seg == 2;
    }
};
struct Sched3 {
    int G, c; const char* A; const char* B;
    __device__ __forceinline__ bool next(int i, pg8::Unit& u) const { const int L = i * G + c; if (L >= 256) return false; pg8::tile_order(L, 32, 8, u.pm, u.pn); u.kind = 0; return true; }
    __device__ __forceinline__ const char* a_base(const pg8::Unit& u) const { return A + (size_t)u.pm * (256 * DM * 2); }
    __device__ __forceinline__ const char* b_base(const pg8::Unit& u) const { return B + (size_t)u.pn * (256 * DM * 2); }
};
struct Epi3 {
    static constexpr bool PERM = false;
    const float* x; float* out;
    __device__ __forceinline__ bool operator()(f32x4 (&acc)[2][2][4][2], const pg8::Unit& u, int wr, int wc, int fr, int fq) const {
        const int rowb = u.pm * 256 + wr * 64 + fr, colb = u.pn * 256 + wc * 32 + 4 * fq;
#pragma unroll
        for (int ai = 0; ai < 2; ++ai)
#pragma unroll
            for (int m = 0; m < 4; ++m) { const size_t ro = (size_t)(rowb + ai * 128 + m * 16) * DM + colb;
#pragma unroll
                for (int bj = 0; bj < 2; ++bj)
#pragma unroll
                    for (int n = 0; n < 2; ++n) { const size_t o = ro + bj * 128 + n * 16; *(f32x4*)(out + o) = *(const f32x4*)(x + o) + acc[ai][bj][m][n]; } }
        return true;
    }
};

__device__ __forceinline__ void p2_qkprep(const Params& p, int vcu, int G) {
    const int tid = opaque_tid(), lane = tid & 63, wave = tid >> 6;
    unsigned char* ws = p.ws;
    const bf16_t* QR = (const bf16_t*)(ws + WS_QR); const bf16_t* KR = (const bf16_t*)(ws + WS_KR);
    bf16_t* QN = (bf16_t*)(ws + WS_QN); bf16_t* KN = (bf16_t*)(ws + WS_KN);
    const f32x2* CSB = (const f32x2*)(ws + WS_CSB);
    const float gq0 = p.q_gain[lane], gq1 = p.q_gain[lane + 64], gk0 = p.k_gain[lane], gk1 = p.k_gain[lane + 64];
    for (int t = vcu * NWAVES + wave; t < T; t += G * NWAVES) {
        const int b = t >> 12, s = t & (SEQ - 1);
        const f32x2 cs = CSB[t * 16 + (lane & 15)];
#pragma unroll
        for (int r = 0; r < 10; ++r) {
            const bf16_t* src = r < 8 ? QR + (size_t)t * 1024 + r * 128 : KR + (size_t)t * 256 + (r - 8) * 128;
            const float x0 = bf2f(src[lane]), x1 = bf2f(src[lane + 64]);
            const float ss = wave_sum(x0 * x0 + x1 * x1);
            const float rs = 1.0f / sqrtf(ss * (1.f / 128.f) + EPS);
            float y0 = x0 * rs * (r < 8 ? gq0 : gk0); const float y1 = x1 * rs * (r < 8 ? gq1 : gk1);
            const float pr = __shfl_xor(y0, 16);
            if (lane < 16) y0 = y0 * cs[0] - pr * cs[1]; else if (lane < 32) y0 = y0 * cs[0] + pr * cs[1];
            bf16_t* dst = r < 8 ? QN + ((size_t)(b * 8 + r) * SEQ + s) * 128 : KN + ((size_t)(b * 2 + (r - 8)) * SEQ + s) * 128;
            dst[lane] = f2bf(y0); dst[lane + 64] = f2bf(y1);
        }
    }
}

constexpr int GM_VSTR = 136;
__device__ __forceinline__ void p2_gmlp_unit(const Params& p, LAS unsigned char* lds, int unit) {
    const int tid = opaque_tid(), lane = tid & 63, wave = __builtin_amdgcn_readfirstlane(tid >> 6), r32 = lane & 31, hi = lane >> 5;
    unsigned char* ws = p.ws;
    const int g = unit & 7, ch = unit >> 3, tok0 = ch * 128;
    const bf16_t* AV = (const bf16_t*)(ws + WS_AV); const bf16_t* AU = (const bf16_t*)(ws + WS_AU); const bf16_t* AZ = (const bf16_t*)(ws + WS_AZ);
    bf16_t* XA = (bf16_t*)(ws + WS_XA);
    LAS float* stat = (LAS float*)lds;
    LAS bf16_t* vT = (LAS bf16_t*)(lds + 1024);
    const int tb = wave >> 1, dh = wave & 1, trow = tb * 32 + r32;
    const float* wsp = p.spatial_w + ((size_t)g * 128 + trow) * 128 + 8 * hi;
    f32x4 wf[8][2];
#pragma unroll
    for (int ks = 0; ks < 8; ++ks) { wf[ks][0] = *(const f32x4*)(wsp + 16 * ks); wf[ks][1] = *(const f32x4*)(wsp + 16 * ks + 4); }
#pragma unroll 1
    for (int hf = 0; hf < 2; ++hf) {
        u32x4 ra[8], rb[8];
#pragma unroll
        for (int i = 0; i < 8; ++i) { const bf16_t* row = AV + (size_t)(tok0 + wave * 16 + hf * 8 + i) * 1024 + lane * 16; ra[i] = *(const u32x4*)row; rb[i] = *(const u32x4*)(row + 8); }
        float sm[8];
#pragma unroll
        for (int i = 0; i < 8; ++i) { float a = 0.f;
#pragma unroll
            for (int e = 0; e < 4; ++e) a += (bflo(ra[i][e]) + bfhi(ra[i][e])) + (bflo(rb[i][e]) + bfhi(rb[i][e]));
            sm[i] = a; }
#pragma unroll
        for (int o = 1; o < 64; o <<= 1)
#pragma unroll
            for (int i = 0; i < 8; ++i) sm[i] += __shfl_xor(sm[i], o);
        float qv[8];
#pragma unroll
        for (int i = 0; i < 8; ++i) { const float mean = sm[i] * (1.f / 1024.f); sm[i] = mean; float a = 0.f;
#pragma unroll
            for (int e = 0; e < 4; ++e) { const float d0 = bflo(ra[i][e]) - mean, d1 = bfhi(ra[i][e]) - mean, d2 = bflo(rb[i][e]) - mean, d3 = bfhi(rb[i][e]) - mean; a += (d0 * d0 + d1 * d1) + (d2 * d2 + d3 * d3); }
            qv[i] = a; }
#pragma unroll
        for (int o = 1; o < 64; o <<= 1)
#pragma unroll
            for (int i = 0; i < 8; ++i) qv[i] += __shfl_xor(qv[i], o);
        if (lane < 8) { float mm = sm[0], qq = qv[0];
#pragma unroll
            for (int i = 1; i < 8; ++i) { if (lane == i) { mm = sm[i]; qq = qv[i]; } }
            const int tk = wave * 16 + hf * 8 + lane; stat[2 * tk] = mm; stat[2 * tk + 1] = 1.0f / sqrtf(qq * (1.f / 1024.f) + EPS); }
    }
    __syncthreads();
    {
        u32x4 va[4];
#pragma unroll
        for (int i = 0; i < 4; ++i) { const int it = tid + i * NTHREADS, s_ = it >> 4, d8 = (it & 15) * 8; va[i] = *(const u32x4*)(AV + (size_t)(tok0 + s_) * 1024 + g * 128 + d8); }
        const int d8 = (tid & 15) * 8;
        const f32x4 g0 = *(const f32x4*)(p.gmlp_g + g * 128 + d8), g1 = *(const f32x4*)(p.gmlp_g + g * 128 + d8 + 4), b0 = *(const f32x4*)(p.gmlp_b + g * 128 + d8), b1 = *(const f32x4*)(p.gmlp_b + g * 128 + d8 + 4);
#pragma unroll
        for (int i = 0; i < 4; ++i) { const int it = tid + i * NTHREADS, s_ = it >> 4; const u32x4 a = va[i];
            const float mean = stat[2 * s_], rstd = stat[2 * s_ + 1];
            float f[8] = {bflo(a[0]), bfhi(a[0]), bflo(a[1]), bfhi(a[1]), bflo(a[2]), bfhi(a[2]), bflo(a[3]), bfhi(a[3])};
#pragma unroll
            for (int e = 0; e < 8; ++e) { const float y = (f[e] - mean) * rstd * (e < 4 ? g0[e & 3] : g1[e & 3]) + (e < 4 ? b0[e & 3] : b1[e & 3]); vT[(d8 + e) * GM_VSTR + s_] = f2bf(y); } }
    }
    unsigned short gu[16][2], gz[16][2];
#pragma unroll
    for (int r = 0; r < 16; ++r) { const int tl = tb * 32 + (r & 3) + 8 * (r >> 2) + 4 * hi; const size_t o = (size_t)(tok0 + tl) * 1024 + g * 128 + dh * 64 + r32;
        gu[r][0] = AU[o]; gu[r][1] = AU[o + 32]; gz[r][0] = AZ[o]; gz[r][1] = AZ[o + 32]; }
    __syncthreads();
    f32x16 acc0 = {}, acc1 = {};
#pragma unroll
    for (int ks = 0; ks < 8; ++ks) {
        const int s0 = 16 * ks + 8 * hi;
        f32x4 w0 = wf[ks][0], w1 = wf[ks][1];
#pragma unroll
        for (int e = 0; e < 4; ++e) { if (s0 + e > trow) w0[e] = 0.f; if (s0 + 4 + e > trow) w1[e] = 0.f; }
        const bf16x8 a = pack8(w0, w1);
        const bf16x8 b0 = *(const LAS bf16x8*)(vT + (dh * 64 + r32) * GM_VSTR + s0), b1 = *(const LAS bf16x8*)(vT + (dh * 64 + 32 + r32) * GM_VSTR + s0);
        acc0 = __builtin_amdgcn_mfma_f32_32x32x16_bf16(a, b0, acc0, 0, 0, 0);
        acc1 = __builtin_amdgcn_mfma_f32_32x32x16_bf16(a, b1, acc1, 0, 0, 0);
    }
#pragma unroll
    for (int r = 0; r < 16; ++r) { const int tl = tb * 32 + (r & 3) + 8 * (r >> 2) + 4 * hi; const float bias = p.spatial_b[g * 128 + tl];
        const size_t o = (size_t)(tok0 + tl) * 1024 + g * 128 + dh * 64 + r32;
        XA[o] = f2bf(bf2f(gu[r][0]) * (acc0[r] + bias) * bf2f(gz[r][0]));
        XA[o + 32] = f2bf(bf2f(gu[r][1]) * (acc1[r] + bias) * bf2f(gz[r][1])); }
    __syncthreads();
}

constexpr int MA_KST = 32 * 512, MA_VROW = 72, MA_VST = 256 * MA_VROW;
constexpr int MA_K0 = 2048, MA_V0 = MA_K0 + 2 * MA_KST;
static_assert(MA_V0 + 2 * MA_VST <= MISC_OFF, "mem-attn LDS map");
__device__ __forceinline__ void p2_mem_unit(const Params& p, LAS unsigned char* lds, int unit) {
    const int tid = opaque_tid(), lane = tid & 63, wave = __builtin_amdgcn_readfirstlane(tid >> 6), r32 = lane & 31, hi = lane >> 5;
    unsigned char* ws = p.ws;
    const int qb = unit & 31, h = (unit >> 5) & 3, b = unit >> 7, qg = wave & 3, dhf = wave >> 2;
    const bf16_t* MQ = (const bf16_t*)(ws + WS_MQ); const bf16_t* MZ = (const bf16_t*)(ws + WS_MZ);
    const bf16_t* KM = (const bf16_t*)(ws + WS_KM) + (size_t)(b * 256) * 1024 + h * 256;
    const bf16_t* VT = (const bf16_t*)(ws + WS_VT) + (size_t)(h * 256) * 512 + b * 256;
    bf16_t* XM = (bf16_t*)(ws + WS_XM);
    LAS float* rk = (LAS float*)lds;
    LAS float* gqk = (LAS float*)(lds + 1024);
    u32x4 sk[2], sv[2];
#define MA_LOAD(st) do { _Pragma("unroll") for (int i = 0; i < 2; ++i) { const int q = tid + i * NTHREADS; \
        sk[i] = *(const u32x4*)(KM + (size_t)((st) * 32 + (q >> 5)) * 1024 + (q & 31) * 8); \
        sv[i] = *(const u32x4*)(VT + (size_t)(q >> 2) * 512 + (st) * 32 + (q & 3) * 8); } } while (0)
#define MA_WRITE(bf) do { _Pragma("unroll") for (int i = 0; i < 2; ++i) { const int q = tid + i * NTHREADS; const int key = q >> 5, c = q & 31; \
        *(LAS u32x4*)(lds + MA_K0 + (bf) * MA_KST + key * 512 + ((c ^ (key & 15)) << 4)) = sk[i]; \
        LAS unsigned char* vd = lds + MA_V0 + (bf) * MA_VST + (q >> 2) * MA_VROW + (q & 3) * 16; \
        *(LAS u32x2*)vd = (u32x2){sv[i][0], sv[i][1]}; *(LAS u32x2*)(vd + 8) = (u32x2){sv[i][2], sv[i][3]}; } } while (0)
    if (tid < 256) { const f32x4 pr = *(const f32x4*)((const float*)(ws + WS_RKP) + (size_t)(b * 256 + tid) * 16 + h * 4);
        rk[tid] = 1.0f / sqrtf(((pr[0] + pr[1]) + (pr[2] + pr[3])) * (1.f / 256.f) + EPS); gqk[tid] = p.mq_gain[tid] * p.mk_gain[tid]; }
    __syncthreads();
    const int tq = b * SEQ + qb * 128 + qg * 32 + r32;
    bf16x8 qf[16]; float ssq = 0.f;
#pragma unroll
    for (int ks = 0; ks < 16; ++ks) { const int d0 = 16 * ks + 8 * hi; const u32x4 a = *(const u32x4*)(MQ + (size_t)tq * 1024 + h * 256 + d0);
        f32x4 f0 = {bflo(a[0]), bfhi(a[0]), bflo(a[1]), bfhi(a[1])}, f1 = {bflo(a[2]), bfhi(a[2]), bflo(a[3]), bfhi(a[3])};
        ssq += (f0[0] * f0[0] + f0[1] * f0[1]) + (f0[2] * f0[2] + f0[3] * f0[3]) + (f1[0] * f1[0] + f1[1] * f1[1]) + (f1[2] * f1[2] + f1[3] * f1[3]);
        const f32x4 g0 = *(const LAS f32x4*)(gqk + d0), g1 = *(const LAS f32x4*)(gqk + d0 + 4);
        qf[ks] = pack8(f0 * g0, f1 * g1); }
    ssq += __shfl_xor(ssq, 32);
    const float qs = (1.0f / sqrtf(ssq * (1.f / 256.f) + EPS)) * (0.0625f * LOG2E);
    MA_LOAD(0);
    MA_WRITE(0);
    __syncthreads();
    f32x16 o[4];
#pragma unroll
    for (int db = 0; db < 4; ++db) o[db] = (f32x16){};
    float mrun = -1e30f, l = 0.f;
    const int kx = r32 & 15;
#pragma unroll 1
    for (int st = 0; st < 8; ++st) {
        const int bf = st & 1;
        if (st + 1 < 8) MA_LOAD(st + 1);
        {
            f32x16 a = {};
            const LAS unsigned char* kp = lds + MA_K0 + bf * MA_KST + r32 * 512;
#pragma unroll
            for (int ks = 0; ks < 16; ++ks) { if ((ks & 3) == 0) __builtin_amdgcn_sched_barrier(0); const bf16x8 kf = *(const LAS bf16x8*)(kp + (((2 * ks + hi) ^ kx) << 4)); a = __builtin_amdgcn_mfma_f32_32x32x16_bf16(kf, qf[ks], a, 0, 0, 0); }
            __builtin_amdgcn_sched_barrier(0);
#pragma unroll
            for (int g4 = 0; g4 < 4; ++g4) { const f32x4 rr = *(const LAS f32x4*)(rk + st * 32 + 8 * g4 + 4 * hi);
#pragma unroll
                for (int e = 0; e < 4; ++e) a[4 * g4 + e] *= rr[e] * qs; }
            float bm = a[0];
#pragma unroll
            for (int r = 1; r < 16; ++r) bm = fmaxf(bm, a[r]);
            bm = fmaxf(bm, __shfl_xor(bm, 32));
            if (!__all(bm - mrun <= 8.f)) { const float mn = fmaxf(mrun, bm), al = __builtin_amdgcn_exp2f(mrun - mn); mrun = mn; l *= al;
#pragma unroll
                for (int db = 0; db < 4; ++db) o[db] *= al; }
#pragma unroll
            for (int r = 0; r < 16; ++r) { a[r] = __builtin_amdgcn_exp2f(a[r] - mrun); l += a[r]; }
            u32x4 w0 = {cvt_pk_bf16(a[0], a[1]), cvt_pk_bf16(a[2], a[3]), cvt_pk_bf16(a[4], a[5]), cvt_pk_bf16(a[6], a[7])};
            u32x4 w1 = {cvt_pk_bf16(a[8], a[9]), cvt_pk_bf16(a[10], a[11]), cvt_pk_bf16(a[12], a[13]), cvt_pk_bf16(a[14], a[15])};
            const bf16x8 pf0 = *reinterpret_cast<bf16x8*>(&w0), pf1 = *reinterpret_cast<bf16x8*>(&w1);
            const LAS unsigned char* vp = lds + MA_V0 + bf * MA_VST + (dhf * 128 + r32) * MA_VROW + 8 * hi;
#pragma unroll
            for (int db = 0; db < 4; ++db) {
                const u32x2 lo0 = *(const LAS u32x2*)(vp + db * 32 * MA_VROW), hi0 = *(const LAS u32x2*)(vp + db * 32 * MA_VROW + 16);
                const u32x2 lo1 = *(const LAS u32x2*)(vp + db * 32 * MA_VROW + 32), hi1 = *(const LAS u32x2*)(vp + db * 32 * MA_VROW + 48);
                u32x4 v0 = {lo0[0], lo0[1], hi0[0], hi0[1]}, v1 = {lo1[0], lo1[1], hi1[0], hi1[1]};
                o[db] = __builtin_amdgcn_mfma_f32_32x32x16_bf16(*reinterpret_cast<bf16x8*>(&v0), pf0, o[db], 0, 0, 0);
                o[db] = __builtin_amdgcn_mfma_f32_32x32x16_bf16(*reinterpret_cast<bf16x8*>(&v1), pf1, o[db], 0, 0, 0); }
        }
        if (st + 1 < 8) MA_WRITE(bf ^ 1);
        __syncthreads();
    }
#undef MA_LOAD
#undef MA_WRITE
    l += __shfl_xor(l, 32);
    const float il = __builtin_amdgcn_rcpf(l);
#pragma unroll
    for (int db = 0; db < 4; ++db)
#pragma unroll
        for (int g4 = 0; g4 < 4; ++g4) { const size_t oo = (size_t)tq * 1024 + h * 256 + dhf * 128 + db * 32 + 8 * g4 + 4 * hi;
            const u32x2 z = *(const u32x2*)(MZ + oo);
            u32x2 w; w[0] = cvt_pk_bf16(o[db][4 * g4] * il * bflo(z[0]), o[db][4 * g4 + 1] * il * bfhi(z[0])); w[1] = cvt_pk_bf16(o[db][4 * g4 + 2] * il * bflo(z[1]), o[db][4 * g4 + 3] * il * bfhi(z[1]));
            *(u32x2*)(XM + oo) = w; }
}

__device__ __forceinline__ unsigned sortable(float f) { const unsigned u = __float_as_uint(f); return u ^ ((unsigned)((int)u >> 31) | 0x80000000u); }
__device__ __forceinline__ void p2_idx_unit(const Params& p, LAS unsigned char* lds, int b, int ublk) {
    const int tid = opaque_tid(), lane = tid & 63, wave = __builtin_amdgcn_readfirstlane(tid >> 6), r32 = lane & 31, hi = lane >> 5;
    unsigned char* ws = p.ws;
    const int s0 = ublk * 8, t0 = b * SEQ + s0;
    const bf16_t* IQ = (const bf16_t*)(ws + WS_IQ); const bf16_t* IK = (const bf16_t*)(ws + WS_IK) + (size_t)(b * SEQ) * 64; const float* IW = (const float*)(ws + WS_IW);
    LAS unsigned* sc = (LAS unsigned*)lds;
    LAS float* iwl = (LAS float*)(lds + 131072);
    if (tid < 128) iwl[tid] = IW[(size_t)t0 * 16 + tid];
    bf16x8 af[4][4];
#pragma unroll
    for (int at = 0; at < 4; ++at)
#pragma unroll
        for (int ks = 0; ks < 4; ++ks) af[at][ks] = *(const bf16x8*)(IQ + (size_t)(t0 + 2 * at + (r32 >> 4)) * 1024 + (r32 & 15) * 64 + 16 * ks + 8 * hi);
    __syncthreads();
    const int ntiles = (s0 + 8 + 31) >> 5;
    bf16x8 bfr[4], bnx[4];
    {
        const int jc = wave < ntiles ? wave : 0;
#pragma unroll
        for (int ks = 0; ks < 4; ++ks) bfr[ks] = *(const bf16x8*)(IK + (size_t)(32 * jc + r32) * 64 + 16 * ks + 8 * hi);
    }
#pragma unroll 1
    for (int j = wave; j < ntiles; j += NWAVES) {
        const int k0 = 32 * j;
        {
            const int jn = (j + NWAVES < ntiles) ? j + NWAVES : j;
#pragma unroll
            for (int ks = 0; ks < 4; ++ks) bnx[ks] = *(const bf16x8*)(IK + (size_t)(32 * jn + r32) * 64 + 16 * ks + 8 * hi);
        }
#pragma unroll
        for (int at = 0; at < 4; ++at) {
            f32x16 a = {};
#pragma unroll
            for (int ks = 0; ks < 4; ++ks) a = __builtin_amdgcn_mfma_f32_32x32x16_bf16(af[at][ks], bfr[ks], a, 0, 0, 0);
            const f32x4 wa0 = *(const LAS f32x4*)(iwl + (2 * at) * 16 + 4 * hi), wa1 = *(const LAS f32x4*)(iwl + (2 * at) * 16 + 8 + 4 * hi);
            const f32x4 wb0 = *(const LAS f32x4*)(iwl + (2 * at + 1) * 16 + 4 * hi), wb1 = *(const LAS f32x4*)(iwl + (2 * at + 1) * 16 + 8 + 4 * hi);
            float pa = 0.f, pb = 0.f;
#pragma unroll
            for (int e = 0; e < 4; ++e) { pa += wa0[e] * fmaxf(a[e], 0.f); pa += wa1[e] * fmaxf(a[4 + e], 0.f); pb += wb0[e] * fmaxf(a[8 + e], 0.f); pb += wb1[e] * fmaxf(a[12 + e], 0.f); }
            auto rr = __builtin_amdgcn_permlane32_swap(__float_as_uint(pa), __float_as_uint(pb), false, false);
            const float score = __uint_as_float(rr[0]) + __uint_as_float(rr[1]);
            const int qi = 2 * at + hi, key = k0 + r32;
            sc[qi * 4096 + key] = (key <= s0 + qi) ? sortable(score) : 0u;
        }
#pragma unroll
        for (int ks = 0; ks < 4; ++ks) bfr[ks] = bnx[ks];
    }
    __syncthreads();
    {
        const int s = s0 + wave, n = s + 1;
        unsigned kv[64];
#pragma unroll
        for (int i = 0; i < 64; ++i) { const int key = 64 * i + lane; kv[i] = (key <= s) ? sc[wave * 4096 + key] : 0u; }
        unsigned Tt = 1u; bool exact = true;
        if (n > 256) {
            Tt = 0u; exact = false;
            for (int bit = 31; bit >= 0; --bit) {
                const unsigned cand = Tt | (1u << bit); unsigned c = 0;
#pragma unroll
                for (int i = 0; i < 64; ++i) c += (kv[i] >= cand) ? 1u : 0u;
                c = wave_sum_u(c);
                if (c >= 256u) { Tt = cand; if (c == 256u) { exact = true; break; } }
            }
        }
        LAS unsigned long long* lm = (LAS unsigned long long*)(lds + 131072 + 512) + wave * 64;
        if (exact) {
#pragma unroll
            for (int i = 0; i < 64; ++i) { const unsigned long long bal = __ballot(kv[i] >= Tt); if (lane == 0) lm[i] = bal; }
        } else {
            unsigned cg_ = 0;
#pragma unroll
            for (int i = 0; i < 64; ++i) cg_ += (kv[i] > Tt) ? 1u : 0u;
            cg_ = wave_sum_u(cg_);
            unsigned need = 256u - cg_, seen = 0u;
#pragma unroll 1
            for (int i = 0; i < 64; ++i) {
                const unsigned kk = (64 * i + lane <= s) ? sc[wave * 4096 + 64 * i + lane] : 0u;
                const unsigned long long eq = __ballot(kk == Tt), gt = __ballot(kk > Tt);
                const unsigned below = (unsigned)__popcll(eq & ((1ull << lane) - 1ull));
                const bool take = (kk == Tt) && (seen + below < need);
                const unsigned long long bal = gt | __ballot(take);
                seen += (unsigned)__popcll(eq);
                if (lane == 0) lm[i] = bal;
            }
        }
        LDS_WAIT(); asm volatile("" ::: "memory");
        const unsigned long long mine = lm[lane];
        ((unsigned long long*)(ws + WS_MASK))[(size_t)(t0 + wave) * 64 + lane] = mine;
    }
    __syncthreads();
}

namespace att {
constexpr int D = 128, NW = 8, QBLK = 32, KVBLK = 64, QB = 256;
constexpr int SHM_V = KVBLK * D * 2, SHM_K = KVBLK * D * 2;
constexpr int LDS_NEED = 2 * SHM_V + 2 * SHM_K + NW * 64 * 4;
constexpr float SCALE = 0.08838834764831845f, THR = 8.f;
#define KSWZ(row, colB) ((row) * 256 + ((colB) ^ (((row) & 7) << 4)))
#define SBAR() __builtin_amdgcn_sched_barrier(0)
__device__ __forceinline__ int v_st(int k, int c) { const int kk = (k & ~0xC) | ((k & 4) << 1) | ((k & 8) >> 1); return ((kk >> 3) * 4 + (c >> 5)) * 512 + ((kk & 7) * 32 + (c & 31)) * 2; }
__device__ __forceinline__ int v_rd_base(int lane) { return ((lane & 3) << 3) | (((lane >> 2) & 3) << 6) | (((lane >> 4) & 1) << 5) | (((lane >> 5) & 1) << 8); }
constexpr int v_rd_off(int d0, int ks, int half) { return d0 * 512 + ks * 4096 + half * 2048; }
__device__ __forceinline__ int crow(int r, int hi) { return (r & 3) + 8 * (r >> 2) + 4 * hi; }
__device__ __forceinline__ bf16x8 load8(const bf16_t* p) { return *reinterpret_cast<const bf16x8*>(p); }
__device__ __forceinline__ void mask_bits(f32x16& p0, f32x16& p1, unsigned w0, unsigned w1, int hi) {
    const float NEG = -__builtin_inff();
    w0 >>= 4 * hi; w1 >>= 4 * hi;
#pragma unroll
    for (int r = 0; r < 16; ++r) { const int c = (r & 3) + 8 * (r >> 2);
        if (!((w0 >> c) & 1u)) p0[r] = NEG;
        if (!((w1 >> c) & 1u)) p1[r] = NEG; }
}
__device__ __forceinline__ void partialSM(f32x16& p0, f32x16& p1, float& m_reg, float& mn, float& alpha) {
    float pmax = p0[0];
#pragma unroll
    for (int r = 1; r < 16; ++r) pmax = fmaxf(pmax, p0[r]);
#pragma unroll
    for (int r = 0; r < 16; ++r) pmax = fmaxf(pmax, p1[r]);
    { auto rr = __builtin_amdgcn_permlane32_swap(__float_as_uint(pmax), __float_as_uint(pmax), false, false);
      pmax = fmaxf(__uint_as_float(rr[0]), __uint_as_float(rr[1])); }
    constexpr float C2 = 1.4426950408889634f * SCALE;
    if (__builtin_expect(__all((pmax - m_reg) * SCALE <= THR), 1)) { mn = m_reg; alpha = 1.f; }
    else { mn = fmaxf(m_reg, pmax); alpha = __builtin_amdgcn_exp2f((m_reg - mn) * C2); m_reg = mn; }
    const float mnL = -mn * C2;
#pragma unroll
    for (int r = 0; r < 16; ++r) p0[r] = fmaf(p0[r], C2, mnL);
#pragma unroll
    for (int r = 0; r < 16; ++r) p1[r] = fmaf(p1[r], C2, mnL);
#pragma unroll
    for (int r = 0; r < 16; ++r) p0[r] = __builtin_amdgcn_exp2f(p0[r]);
}
__device__ __forceinline__ void finishSM(f32x16& p0, f32x16& p1, float alpha, float& l_reg, bf16x8& pa0, bf16x8& pa1, bf16x8& pa2, bf16x8& pa3) {
#pragma unroll
    for (int r = 0; r < 16; ++r) p1[r] = __builtin_amdgcn_exp2f(p1[r]);
    float ps = 0;
#pragma unroll
    for (int r = 0; r < 16; ++r) ps += p0[r];
#pragma unroll
    for (int r = 0; r < 16; ++r) ps += p1[r];
    { auto rr = __builtin_amdgcn_permlane32_swap(__float_as_uint(ps), __float_as_uint(ps), false, false);
      ps = __uint_as_float(rr[0]) + __uint_as_float(rr[1]); }
    l_reg = l_reg * alpha + ps;
#define PK4(P, B_, OUT) do { unsigned a0 = cvt_pk_bf16(P[B_+0], P[B_+1]), a1 = cvt_pk_bf16(P[B_+2], P[B_+3]);                          \
        unsigned b0 = cvt_pk_bf16(P[B_+4], P[B_+5]), b1 = cvt_pk_bf16(P[B_+6], P[B_+7]);                                             \
        auto r0 = __builtin_amdgcn_permlane32_swap(a0, b0, false, false); auto r1 = __builtin_amdgcn_permlane32_swap(a1, b1, false, false); \
        u32x4 w = {r0[0], r1[0], r0[1], r1[1]}; OUT = *reinterpret_cast<bf16x8*>(&w); } while (0)
    PK4(p0, 0, pa0); PK4(p0, 8, pa1); PK4(p1, 0, pa2); PK4(p1, 8, pa3);
#undef PK4
}
template <int KB>
__device__ __forceinline__ void qkt(f32x16& p0, f32x16& p1, const char* K_lds, int r32, int hi, const bf16x8* qr) {
    p0 = f32x16{}; p1 = f32x16{};
    const char* kb[4];
#pragma unroll
    for (int dd = 0; dd < 4; ++dd) kb[dd] = K_lds + KB * SHM_K + KSWZ(r32, (dd * 16 + hi * 8) * 2);
#pragma unroll
    for (int d0 = 0; d0 < 8; ++d0) { const char* a = kb[d0 & 3] + (d0 >> 2) * 128;
        bf16x8 b0 = *reinterpret_cast<const bf16x8*>(a);
        bf16x8 b1 = *reinterpret_cast<const bf16x8*>(a + 32 * 256);
        p0 = __builtin_amdgcn_mfma_f32_32x32x16_bf16(b0, qr[d0], p0, 0, 0, 0);
        p1 = __builtin_amdgcn_mfma_f32_32x32x16_bf16(b1, qr[d0], p1, 0, 0, 0); }
}
template <int VB>
__device__ __forceinline__ void pv_tile(f32x16* o, int vb0, bf16x8 pa0, bf16x8 pa1, bf16x8 pa2, bf16x8 pa3) {
#define TRRD(dst, off) asm volatile("ds_read_b64_tr_b16 %0, %1 offset:%2" : "=&v"(dst) : "v"(vb0), "i"(off) : "memory")
#define PV_D0(d0) do { s16x4 l0, l1, l2, l3, h0, h1, h2, h3; constexpr int b_ = VB * SHM_V + v_rd_off(d0, 0, 0); \
        TRRD(l0, b_); TRRD(h0, b_ + 2048); TRRD(l1, b_ + 4096); TRRD(h1, b_ + 6144); TRRD(l2, b_ + 8192); TRRD(h2, b_ + 10240); TRRD(l3, b_ + 12288); TRRD(h3, b_ + 14336); \
        asm volatile("s_waitcnt lgkmcnt(0)" ::: "memory"); SBAR();   \
        o[d0] = __builtin_amdgcn_mfma_f32_32x32x16_bf16(pa0, (bf16x8){l0[0], l0[1], l0[2], l0[3], h0[0], h0[1], h0[2], h0[3]}, o[d0], 0, 0, 0);   \
        o[d0] = __builtin_amdgcn_mfma_f32_32x32x16_bf16(pa1, (bf16x8){l1[0], l1[1], l1[2], l1[3], h1[0], h1[1], h1[2], h1[3]}, o[d0], 0, 0, 0);   \
        o[d0] = __builtin_amdgcn_mfma_f32_32x32x16_bf16(pa2, (bf16x8){l2[0], l2[1], l2[2], l2[3], h2[0], h2[1], h2[2], h2[3]}, o[d0], 0, 0, 0);   \
        o[d0] = __builtin_amdgcn_mfma_f32_32x32x16_bf16(pa3, (bf16x8){l3[0], l3[1], l3[2], l3[3], h3[0], h3[1], h3[2], h3[3]}, o[d0], 0, 0, 0); } while (0)
    PV_D0(0); PV_D0(1); PV_D0(2); PV_D0(3);
#undef PV_D0
#undef TRRD
}
struct BlockRef { const bf16_t* Q; const bf16_t* K; const bf16_t* V; const unsigned* M; bf16_t* O; const bf16_t* Z; int P0; };
struct Seam { bf16x8 qr[8]; bf16x8 st_v0, st_v1, st_k0, st_k1; };
#define ROW(p, k0, rr) ((p) + (size_t)((k0) + (rr)) * D + sc)
#define VMW() asm volatile("s_waitcnt vmcnt(0)" ::: "memory")
#define VMWN(n) asm volatile("s_waitcnt vmcnt(%0)" :: "i"(n) : "memory")
#define SLOAD_H(Kp, Vp, k0) do { S.st_v0 = load8(ROW(Vp, k0, sr)); S.st_v1 = load8(ROW(Vp, k0, 32 + sr));              \
                         S.st_k0 = load8(ROW(Kp, k0, sr)); S.st_k1 = load8(ROW(Kp, k0, 32 + sr)); } while (0)
#define SWRITE_HK(bf) do { *(bf16x8*)(K_lds + (bf) * SHM_K + kws) = S.st_k0; *(bf16x8*)(K_lds + (bf) * SHM_K + kws + 32 * 256) = S.st_k1; } while (0)
#define SWRITE_HV(bf) do { *(bf16x8*)(V_lds + (bf) * SHM_V + vst0) = S.st_v0; *(bf16x8*)(V_lds + (bf) * SHM_V + vst1) = S.st_v1; } while (0)
#define SWRITE_H(bf) do { SWRITE_HV(bf); SWRITE_HK(bf); } while (0)
__device__ __forceinline__ void attn_prime(const BlockRef& cur, char* lds, Seam& S) {
    const int tid = opaque_tid(), wid = __builtin_amdgcn_readfirstlane(tid >> 6), lane = tid & 63, r32 = lane & 31, hi = lane >> 5;
    const int sr = tid >> 4, sc = (tid & 15) * 8, kws = KSWZ(sr, sc * 2); char* K_lds = lds + 2 * SHM_V;
#pragma unroll
    for (int d0 = 0; d0 < 8; ++d0) S.qr[d0] = load8(cur.Q + (size_t)(wid * QBLK + r32) * D + d0 * 16 + hi * 8);
    SLOAD_H(cur.K, cur.V, 0); VMW(); SWRITE_HK(0);
    __syncthreads();
}
__device__ __forceinline__ void attn_block(const BlockRef& cur, const BlockRef& nxt, char* lds, Seam& S) {
    const int tid = opaque_tid(), wid = __builtin_amdgcn_readfirstlane(tid >> 6), lane = tid & 63, r32 = lane & 31, hi = lane >> 5;
    const int NT = (cur.P0 + QB - 1) / KVBLK + 1;
    char* V_lds = lds; char* K_lds = lds + 2 * SHM_V;
    float* wsl = (float*)(lds + 2 * SHM_V + 2 * SHM_K) + wid * 64; float* li_l = wsl, * al_l = wsl + 32;
    float m_reg = -1e30f, l_reg = 0; f32x16 o[4] = {};
    const int sr = tid >> 4, sc = (tid & 15) * 8, vst0 = v_st(sr, sc), vst1 = v_st(32 + sr, sc), kws = KSWZ(sr, sc * 2);
    const int vb0 = (int)(uintptr_t)V_lds + v_rd_base(lane);
    const bf16_t* Kh = cur.K; const bf16_t* Vh = cur.V;
    const unsigned* mrow = cur.M + (size_t)(wid * QBLK + r32) * 128;
#define RESC(a) do { if (__any((a) < 1.f)) { if (hi == 0) al_l[r32] = (a); asm volatile("s_waitcnt lgkmcnt(0)" ::: "memory");              \
                     for (int d_ = 0; d_ < 4; ++d_) for (int r = 0; r < 16; ++r) o[d_][r] *= al_l[crow(r, hi)]; } } while (0)
#define KBASE(t) ((t) * KVBLK)
#define MLOAD(t) (*(const u32x2*)(mrow + 2 * (t)))
#define SEAM_K0() do { VMWN(8); SWRITE_HK(0); SBAR(); } while (0)
    f32x16 pA0, pA1, pB0, pB1; float mnA, mnB, alA, alB; bf16x8 pa0, pa1, pa2, pa3;
    u32x2 mwA, mwB;
    SWRITE_HV(0); SBAR();
    mwA = MLOAD(0);
    SLOAD_H(Kh, Vh, KBASE(1));
    SBAR(); qkt<0>(pA0, pA1, K_lds, r32, hi, S.qr);
    mask_bits(pA0, pA1, mwA[0], mwA[1], hi); partialSM(pA0, pA1, m_reg, mnA, alA);
    VMW(); SWRITE_H(1);
    __syncthreads();
#define HALF_STEP(PX0, PX1, mnX, alX, mwX, PY0, PY1, alY, t, KB, VB, SB) do {                                                   \
        SBAR(); mwX = MLOAD(t); qkt<KB>(PX0, PX1, K_lds, r32, hi, S.qr);                                                      \
        finishSM(PY0, PY1, alY, l_reg, pa0, pa1, pa2, pa3); SBAR();                                                           \
        if ((t) + 1 < NT) { SLOAD_H(Kh, Vh, KBASE((t) + 1)); SBAR(); }                                                        \
        pv_tile<VB>(o, vb0, pa0, pa1, pa2, pa3); mask_bits(PX0, PX1, mwX[0], mwX[1], hi); partialSM(PX0, PX1, m_reg, mnX, alX); \
        __syncthreads();                                                                                                      \
        if ((t) + 1 < NT) { VMW(); SWRITE_H(SB); }                                                                            \
        RESC(alX); __syncthreads(); } while (0)
    for (int t = 1; t + 1 < NT; t += 2) {
        HALF_STEP(pB0, pB1, mnB, alB, mwB, pA0, pA1, alA, t, 1, 0, 0);
        HALF_STEP(pA0, pA1, mnA, alA, mwA, pB0, pB1, alB, t + 1, 0, 1, 1);
    }
    SBAR(); mwB = MLOAD(NT - 1); qkt<1>(pB0, pB1, K_lds, r32, hi, S.qr); SBAR();
    SLOAD_H(nxt.K, nxt.V, 0); SBAR();
#pragma unroll
    for (int d0 = 0; d0 < 8; ++d0) S.qr[d0] = load8(nxt.Q + (size_t)(wid * QBLK + r32) * D + d0 * 16 + hi * 8);
    SBAR();
    finishSM(pA0, pA1, alA, l_reg, pa0, pa1, pa2, pa3); SBAR();
    pv_tile<0>(o, vb0, pa0, pa1, pa2, pa3);
    mask_bits(pB0, pB1, mwB[0], mwB[1], hi); partialSM(pB0, pB1, m_reg, mnB, alB); __syncthreads(); RESC(alB);
    finishSM(pB0, pB1, alB, l_reg, pa0, pa1, pa2, pa3); SBAR(); pv_tile<1>(o, vb0, pa0, pa1, pa2, pa3);
    SBAR(); SEAM_K0();
    if (hi == 0) li_l[r32] = l_reg; asm volatile("s_waitcnt lgkmcnt(0)" ::: "memory");
    float rli[16];
#pragma unroll
    for (int r = 0; r < 16; ++r) rli[r] = __builtin_amdgcn_rcpf(li_l[crow(r, hi)]);
#pragma unroll
    for (int r = 0; r < 16; ++r) { const size_t ro = (size_t)(wid * QBLK + crow(r, hi)) * 1024;
#pragma unroll
        for (int d0 = 0; d0 < 4; ++d0) { const float v = o[d0][r] * rli[r];
            const float vn = __shfl_xor(v, 1);
            if ((r32 & 1) == 0) { const unsigned z = *(const unsigned*)(cur.Z + ro + d0 * 32 + r32);
                *(unsigned*)(cur.O + ro + d0 * 32 + r32) = cvt_pk_bf16(v * bflo(z), vn * bfhi(z)); } } }
    __syncthreads();
#undef RESC
#undef KBASE
#undef MLOAD
#undef SEAM_K0
#undef HALF_STEP
}
#undef ROW
#undef VMW
#undef VMWN
#undef SLOAD_H
#undef SWRITE_HK
#undef SWRITE_HV
#undef SWRITE_H
__device__ __forceinline__ BlockRef make_ref(unsigned char* ws, int item) {
    const int qb = 15 - (item >> 4), bh = item & 15, b = bh >> 3, h = bh & 7, kvh = b * 2 + (h >> 2);
    BlockRef r;
    r.Q = (const bf16_t*)(ws + WS_QN) + ((size_t)bh * SEQ + qb * QB) * D;
    r.K = (const bf16_t*)(ws + WS_KN) + (size_t)kvh * SEQ * D; r.V = (const bf16_t*)(ws + WS_VV) + (size_t)kvh * SEQ * D;
    r.M = (const unsigned*)(ws + WS_MASK) + (size_t)(b * SEQ + qb * QB) * 128;
    r.O = (bf16_t*)(ws + WS_XB) + (size_t)(b * SEQ + qb * QB) * 1024 + h * 128;
    r.Z = (const bf16_t*)(ws + WS_BZ) + (size_t)(b * SEQ + qb * QB) * 1024 + h * 128;
    r.P0 = qb * QB; return r;
}
}


#define XB_TMO      128
#define XB_XCNT(j)  (256  + 64 * (j))
#define XB_XSUB(j)  (1280 + 64 * (j))
#define XB_XGEN(j)  (2304 + 64 * (j))
#define XB_TOP      3328
#define XB_TOPGEN   3392
#define XCD_BAR_WORDS 3456
#define XB_SPIN_CAP (1u << 22)
__device__ __forceinline__ unsigned xb_ld(unsigned* p)              { return __hip_atomic_load(p, __ATOMIC_RELAXED, __HIP_MEMORY_SCOPE_AGENT); }
__device__ __forceinline__ unsigned xb_add(unsigned* p, unsigned v) { return __hip_atomic_fetch_add(p, v, __ATOMIC_RELAXED, __HIP_MEMORY_SCOPE_AGENT); }
__device__ __forceinline__ unsigned xb_xcc_id() { return (unsigned)__builtin_amdgcn_s_getreg((3 << 11) | 20) & 0xFu; }
#define XB_SPIN(cond, bar) do { unsigned _sp = 0; while (cond) { __builtin_amdgcn_s_sleep(1); \
    if ((++_sp & 255u) == 0u) { if (xb_ld(&(bar)[XB_TMO])) break; if (_sp > XB_SPIN_CAP) { atomicAdd(&(bar)[XB_TMO], 1u); break; } } } } while (0)
struct XcdBarrier { unsigned* bar; unsigned x; volatile LAS unsigned* st; };
__device__ __forceinline__ XcdBarrier xcd_barrier_post(unsigned* bar, volatile LAS unsigned* st) {
    XcdBarrier b; b.bar = bar; b.x = xb_xcc_id(); b.st = st;
    if (threadIdx.x == 0) (void)xb_add(&bar[XB_XCNT(b.x)], 1u);
    return b;
}
__device__ __forceinline__ void xcd_barrier_complete(unsigned* bar, unsigned x, unsigned& nloc, unsigned& nx) {
    const unsigned G = gridDim.x * gridDim.y * gridDim.z;
    unsigned sum, cnt, mine, sp = 0u;
    for (;;) {
        sum = 0u; cnt = 0u; mine = 0u;
#pragma unroll
        for (unsigned j = 0; j < 16; ++j) { const unsigned c = xb_ld(&bar[XB_XCNT(j)]); sum += c; cnt += (c > 0u) ? 1u : 0u; mine = (j == x) ? c : mine; }
        if (sum == G) break;
        __builtin_amdgcn_s_sleep(1);
        if ((++sp & 255u) == 0u) { if (xb_ld(&bar[XB_TMO])) break; if (sp > XB_SPIN_CAP) { atomicAdd(&bar[XB_TMO], 1u); break; } }
    }
    nloc = mine > 0u ? mine : 1u; nx = cnt > 0u ? cnt : 1u;
}
__device__ __forceinline__ void xcd_barrier(const XcdBarrier& b) {
    asm volatile("s_waitcnt vmcnt(0)" ::: "memory");
    __syncthreads();
    if (threadIdx.x == 0) {
        unsigned* bar = b.bar;
        __builtin_amdgcn_s_waitcnt(0);
        unsigned nloc = b.st[0], nx = b.st[1];
        if (nloc == 0u) { xcd_barrier_complete(bar, b.x, nloc, nx); b.st[0] = nloc; b.st[1] = nx; }
        const unsigned old = xb_add(&bar[XB_XSUB(b.x)], 1u);
        const unsigned gen = old / nloc;
        if (old + 1u == (gen + 1u) * nloc) {
            __builtin_amdgcn_fence(__ATOMIC_RELEASE, "agent");
            asm volatile("s_waitcnt vmcnt(0)" ::: "memory");
            const unsigned og = xb_add(&bar[XB_TOP], 1u);
            const unsigned tg = og / nx;
            if (og + 1u == (tg + 1u) * nx) xb_add(&bar[XB_TOPGEN], 1u);
            else XB_SPIN(xb_ld(&bar[XB_TOPGEN]) == tg, bar);
            __builtin_amdgcn_fence(__ATOMIC_ACQUIRE, "agent");
            xb_add(&bar[XB_XGEN(b.x)], 1u);
            asm volatile("s_waitcnt vmcnt(0)" ::: "memory");
        } else {
            XB_SPIN(xb_ld(&bar[XB_XGEN(b.x)]) == gen, bar);
            __builtin_amdgcn_fence(__ATOMIC_ACQUIRE, "agent");
            asm volatile("s_waitcnt vmcnt(0)" ::: "memory");
        }
    }
    __syncthreads();
}

constexpr int CW_EXIT = XCD_BAR_WORDS, CW_WORDS = XCD_BAR_WORDS + 64;
__device__ unsigned g_ctl[CW_WORDS];

__global__ void __launch_bounds__(NTHREADS, 2) fwd_mega(Params p) {
    extern __shared__ __attribute__((aligned(16))) unsigned char lds_raw[];
    cg::grid_group grid = cg::this_grid();
    LAS unsigned char* lds = (LAS unsigned char*)lds_raw;
    const int G = gridDim.x, bx = blockIdx.x;
    const int vcu = (G % 8 == 0) ? (bx % 8) * (G / 8) + bx / 8 : bx;
    unsigned char* ws = p.ws;
    volatile LAS unsigned* misc = (volatile LAS unsigned*)(lds + MISC_OFF);
    if (threadIdx.x < 2) misc[threadIdx.x] = 0u;
    __syncthreads();
    if (p.out == nullptr) grid.sync();
    const XcdBarrier gbar = xcd_barrier_post(g_ctl, misc);
#define GRID_SYNC() xcd_barrier(gbar)

#ifndef PHASES
#define PHASES 0xffff
#endif
#ifndef REPMASK
#define REPMASK 0
#endif
#define NREP(bit) ((REPMASK & (bit)) ? 2 : 1)
    for (int rep = 0; rep < NREP(1); ++rep) if (PHASES & 1) p0_prep(p, lds, vcu, G);
    GRID_SYNC();
    for (int rep = 0; rep < NREP(2); ++rep) if (PHASES & 2) {
        Sched1 S{G, bx, (const char*)ws};
        Epi1 E{ws, p.ik_g, p.ik_b};
        pg8::gemm_phase<Epi1, Sched1, true, true>(lds, DM, S, E);
    }
    GRID_SYNC();
    for (int rep = 0; rep < NREP(4); ++rep) if (PHASES & 4) p2_qkprep(p, vcu, G);
    for (int rep = 0; rep < NREP(8); ++rep) if (PHASES & 8) for (int u = bx; u < 512; u += G) p2_gmlp_unit(p, lds, u);
    for (int rep = 0; rep < NREP(16); ++rep) if (PHASES & 16) for (int u = bx; u < 256; u += G) p2_mem_unit(p, lds, u);
    for (int rep = 0; rep < NREP(32); ++rep) if (PHASES & 32) for (int pr = bx; pr < 512; pr += G) { const int b = pr >> 8, idx = pr & 255; p2_idx_unit(p, lds, b, 511 - idx); p2_idx_unit(p, lds, b, idx); }
    GRID_SYNC();
    for (int rep = 0; rep < NREP(64); ++rep) if (PHASES & 64) {
        int L = bx;
        if (L < 256) {
            att::Seam S; att::BlockRef cur = att::make_ref(ws, L);
            att::attn_prime(cur, (char*)lds_raw, S);
            for (;;) {
                const bool more = L + G < 256; const int Ln = more ? L + G : L;
                const att::BlockRef nxt = more ? att::make_ref(ws, Ln) : cur;
                att::attn_block(cur, nxt, (char*)lds_raw, S);
                if (!more) break;
                cur = nxt; L = Ln;
            }
        }
    }
    GRID_SYNC();
    for (int rep = 0; rep < NREP(128); ++rep) if (PHASES & 128) {
        Sched2 S{G, bx, (const char*)ws};
        Epi2 E{ws};
        pg8::gemm_phase<Epi2, Sched2, true, true>(lds, 1024, S, E);
    }
    GRID_SYNC();
    if (REPMASK & 512) { for (int i = 0; i < 10; ++i) GRID_SYNC(); }
    for (int rep = 0; rep < NREP(256); ++rep) if (PHASES & 256) {
        Sched3 S{G, bx, (const char*)(ws + WS_MERGED), (const char*)(ws + WS_WOUT)};
        Epi3 E{p.x, p.out};
        pg8::gemm_phase<Epi3, Sched3, true, true>(lds, DM, S, E);
    }
    __syncthreads();
    if (threadIdx.x == 0) misc[0] = (xb_add(&g_ctl[CW_EXIT], 1u) == (unsigned)G - 1u) ? 1u : 0u;
    __syncthreads();
    if (misc[0]) { for (int i = threadIdx.x; i < CW_WORDS; i += NTHREADS) __hip_atomic_store(&g_ctl[i], 0u, __ATOMIC_RELAXED, __HIP_MEMORY_SCOPE_AGENT); }
}

extern "C" void kernel_launch(void* const* d_in, const int* in_sizes, int n_in, void* d_out, int out_size, void* d_ws, size_t ws_size, hipStream_t stream) {
    static int grid_blocks = 0;
    if (!grid_blocks) {
        if (n_in != 21 || out_size != T * DM || ws_size < WS_TOTAL) { fprintf(stderr, "kernel_launch: unexpected shapes (n_in %d out %d ws %zu)\n", n_in, out_size, ws_size); grid_blocks = -1; return; }
        int dev = 0, cus = 0, per_cu = 0;
        (void)hipGetDevice(&dev);
        (void)hipDeviceGetAttribute(&cus, hipDeviceAttributeMultiprocessorCount, dev);
        (void)hipFuncSetAttribute((const void*)fwd_mega, hipFuncAttributeMaxDynamicSharedMemorySize, LDS_BYTES);
        (void)hipOccupancyMaxActiveBlocksPerMultiprocessor(&per_cu, (const void*)fwd_mega, NTHREADS, LDS_BYTES);
        if (per_cu < 1) { fprintf(stderr, "kernel_launch: occupancy query returned %d\n", per_cu); grid_blocks = -1; return; }
        grid_blocks = cus;
        fprintf(stderr, "kernel_launch: cus %d per_cu %d grid %d\n", cus, per_cu, grid_blocks);
    }
    if (grid_blocks < 0) return;
    Params p{};
    p.x = (const float*)d_in[0]; p.mem = (const float*)d_in[1]; p.pos = (const int*)d_in[2]; p.norm_gain = (const float*)d_in[3]; p.w_in = (const float*)d_in[4];
    p.gmlp_g = (const float*)d_in[5]; p.gmlp_b = (const float*)d_in[6]; p.spatial_w = (const float*)d_in[7]; p.spatial_b = (const float*)d_in[8]; p.w_a = (const float*)d_in[9];
    p.q_gain = (const float*)d_in[10]; p.k_gain = (const float*)d_in[11]; p.ik_g = (const float*)d_in[12]; p.ik_b = (const float*)d_in[13]; p.w_b = (const float*)d_in[14];
    p.mem_gain = (const float*)d_in[15]; p.w_mkv = (const float*)d_in[16]; p.mq_gain = (const float*)d_in[17]; p.mk_gain = (const float*)d_in[18]; p.w_m = (const float*)d_in[19];
    p.w_out = (const float*)d_in[20]; p.out = (float*)d_out; p.ws = (unsigned char*)d_ws;
    void* args[] = {&p};
    hipError_t e = hipLaunchCooperativeKernel((const void*)fwd_mega, dim3(grid_blocks), dim3(NTHREADS), args, LDS_BYTES, stream);
    if (e != hipSuccess) fprintf(stderr, "cooperative launch failed: %s (grid %d)\n", hipGetErrorString(e), grid_blocks);
}
```

```cpp
#include <hip/hip_runtime.h>
#include <hip/hip_cooperative_groups.h>
#include <cstdio>
#include <cstdint>
namespace cg = cooperative_groups;

#define LAS __attribute__((address_space(3)))
typedef unsigned short bf16_t;
typedef short bf16x8 __attribute__((ext_vector_type(8)));
typedef short s16x4 __attribute__((ext_vector_type(4)));
typedef float f32x2 __attribute__((ext_vector_type(2)));
typedef float f32x4 __attribute__((ext_vector_type(4)));
typedef float f32x16 __attribute__((ext_vector_type(16)));
typedef unsigned u32x2 __attribute__((ext_vector_type(2)));
typedef unsigned u32x4 __attribute__((ext_vector_type(4)));

constexpr int NB = 2, SEQ = 4096, T = NB * SEQ, DM = 2048, DIN = 14928, NPAD = 15104, MEML = 256;
constexpr int NTHREADS = 512, NWAVES = 8;
constexpr int LDS_BYTES = 147456;
constexpr float EPS = 1e-6f;
constexpr float LOG2E = 1.4426950408889634f;

constexpr size_t MiB = (size_t)1 << 20;
constexpr size_t WS_WIN = 0, WS_WBR = 60 * MiB, WS_WOUT = 72 * MiB, WS_WMKV = 80 * MiB, WS_H = 88 * MiB, WS_MEMN = 120 * MiB;
constexpr size_t WS_AU = 122 * MiB, WS_AV = 138 * MiB, WS_AZ = 154 * MiB, WS_QR = 170 * MiB, WS_BZ = 186 * MiB, WS_MQ = 202 * MiB, WS_MZ = 218 * MiB;
constexpr size_t WS_IQ = 234 * MiB, WS_KR = 250 * MiB, WS_VV = 254 * MiB, WS_SA = 258 * MiB, WS_SB = 290 * MiB, WS_SM = 322 * MiB;
constexpr size_t WS_QN = 354 * MiB, WS_KN = 370 * MiB, WS_XA = 374 * MiB, WS_XM = 390 * MiB, WS_MASK = 406 * MiB, WS_IK = 410 * MiB, WS_IW = 411 * MiB;
constexpr size_t WS_KM = 412 * MiB, WS_VT = 413 * MiB, WS_CSB = 414 * MiB, WS_CSI = 415 * MiB, WS_END = 416 * MiB;
constexpr size_t WS_RKP = WS_IW + 524288;
constexpr size_t WS_CTL = WS_END, CTL_BYTES = 65536, WS_TOTAL = WS_END + CTL_BYTES;
constexpr int CW_BAR = 0;
constexpr int MISC_OFF = 147200;
constexpr size_t WS_XB = WS_QR;
constexpr size_t WS_MERGED = WS_H;

__device__ __forceinline__ unsigned cvt_pk_bf16(float lo, float hi) { unsigned r; asm volatile("v_cvt_pk_bf16_f32 %0, %1, %2" : "=v"(r) : "v"(lo), "v"(hi)); return r; }
__device__ __forceinline__ bf16_t f2bf(float f) { return (bf16_t)(cvt_pk_bf16(f, 0.f) & 0xffffu); }
__device__ __forceinline__ float bf2f(unsigned short b) { return __uint_as_float(((unsigned)b) << 16); }
__device__ __forceinline__ float bflo(unsigned w) { return __uint_as_float(w << 16); }
__device__ __forceinline__ float bfhi(unsigned w) { return __uint_as_float(w & 0xffff0000u); }
__device__ __forceinline__ float sigm(float x) { return __builtin_amdgcn_rcpf(1.f + __builtin_amdgcn_exp2f(-LOG2E * x)); }
__device__ __forceinline__ float silu_f(float x) { return x * sigm(x); }
__device__ __forceinline__ float gelu_f(float x) { const float u = 0.7978845608028654f * (x + 0.044715f * x * x * x); return x * sigm(2.f * u); }
__device__ __forceinline__ float wave_sum(float v) {
#pragma unroll
    for (int o = 1; o < 64; o <<= 1) v += __shfl_xor(v, o);
    return v;
}
__device__ __forceinline__ unsigned wave_sum_u(unsigned v) {
#pragma unroll
    for (int o = 1; o < 64; o <<= 1) v += (unsigned)__shfl_xor((int)v, o);
    return v;
}
__device__ __forceinline__ bf16x8 pack8(f32x4 a, f32x4 b) {
    u32x4 w = {cvt_pk_bf16(a[0], a[1]), cvt_pk_bf16(a[2], a[3]), cvt_pk_bf16(b[0], b[1]), cvt_pk_bf16(b[2], b[3])};
    return *reinterpret_cast<bf16x8*>(&w);
}
#define LDS_WAIT() asm volatile("s_waitcnt lgkmcnt(0)" ::: "memory")
__device__ __forceinline__ int opaque_tid() { int t = threadIdx.x; asm volatile("" : "+v"(t)); return t; }

namespace pg8 {
constexpr int BM = 256, BK = 64, HALF = 128, HTB = HALF * BK * 2, STAGE_BYTES = 8 * HTB, NXCD = 8, WGM = 8;
__host__ __device__ __forceinline__ int lds_byte(int r, int c) { const int st = (r >> 4) * 2 + (c >> 5), rr = r & 15, cc = c & 31, ob = rr * 64 + cc * 2; return st * 1024 + (ob ^ (((ob >> 9) & 1) << 5)); }
__host__ __device__ __forceinline__ void stage_rc(int b, int& R, int& C) { const int st = b / 1024, sb = b % 1024, swz = sb ^ (((sb >> 9) & 1) << 5); R = (st >> 1) * 16 + swz / 64; C = (st & 1) * 32 + (swz % 64) / 2; }
__host__ __device__ __forceinline__ int perm32(int rho) { const int n = rho >> 4, i = rho & 15; return 8 * (i >> 2) + 4 * n + (i & 3); }

struct Unit { int pm, pn, kind; };

__device__ __forceinline__ void tile_order(int wgid, int nM, int nN, int& pm, int& pn) {
    const int nwg = nM * nN;
    { const int q = nwg / NXCD, r = nwg % NXCD, xcd = wgid % NXCD, off = wgid / NXCD; wgid = (xcd < r ? xcd * (q + 1) : r * (q + 1) + (xcd - r) * q) + off; }
    const int nig = WGM * nN, gid = wgid / nig, fm = gid * WGM, gsz = (nM - fm) < WGM ? (nM - fm) : WGM;
    pm = fm + ((wgid % nig) % gsz); pn = (wgid % nig) / gsz;
}

template <class Epi, class Sched, bool ALIGN_EPI, bool SP2>
__device__ __forceinline__ void gemm_phase(LAS unsigned char* lds, const int K, const Sched& S, const Epi& E) {
    const int tid = opaque_tid(), wid = __builtin_amdgcn_readfirstlane(tid >> 6), lane = tid & 63, wr = wid >> 2, wc = wid & 3, fr = lane & 15, fq = lane >> 4;
    const int nt = K / BK;
    unsigned voffA[2], voffB[2];
#pragma unroll
    for (int i = 0; i < 2; ++i) { int R, C; stage_rc(tid * 16 + i * 8192, R, C); const int Rb = Epi::PERM ? ((R & ~31) + perm32(R & 31)) : R;
        voffA[i] = (unsigned)(R * K + C) * 2u; voffB[i] = (unsigned)(Rb * K + C) * 2u; }
    const size_t kstep = (size_t)(BK * 2);
    const size_t hstep = (size_t)HALF * K * 2;
    const unsigned ldsw = (unsigned)wid * 1024u;
    const int aoff = lds_byte(wr * 64 + fr, fq * 8), boff = lds_byte(wc * 32 + fr, fq * 8);
#define PG8_SA(b, h) (((b) * 2 + (h)) * HTB)
#define PG8_SB(b, h) ((4 + (b) * 2 + (h)) * HTB)
#define PG8_STAGE(bufoff, gbase, voff) do { _Pragma("unroll") for (int _i = 0; _i < 2; ++_i) \
        __builtin_amdgcn_global_load_lds((const unsigned*)((const char*)(gbase) + (voff)[_i]), (LAS unsigned*)(lds + (bufoff) + ldsw + _i * 8192), 16, 0, 0); } while (0)
#define PG8_LDA(dst, b, h) do { _Pragma("unroll") for (int m = 0; m < 4; ++m) _Pragma("unroll") for (int k = 0; k < 2; ++k) dst[m][k] = *(const LAS bf16x8*)(lds + PG8_SA(b, h) + aoff + m * 2048 + k * 1024); } while (0)
#define PG8_LDB(dst, b, h) do { _Pragma("unroll") for (int n = 0; n < 2; ++n) _Pragma("unroll") for (int k = 0; k < 2; ++k) dst[n][k] = *(const LAS bf16x8*)(lds + PG8_SB(b, h) + boff + n * 2048 + k * 1024); } while (0)
#define PG8_MMA(ai, bj, At, Bt) do { __builtin_amdgcn_s_setprio(1); _Pragma("unroll") for (int m = 0; m < 4; ++m) _Pragma("unroll") for (int n = 0; n < 2; ++n) _Pragma("unroll") for (int k = 0; k < 2; ++k) \
        acc[ai][bj][m][n] = __builtin_amdgcn_mfma_f32_16x16x32_bf16(Bt[n][k], At[m][k], acc[ai][bj][m][n], 0, 0, 0); __builtin_amdgcn_s_setprio(0); } while (0)
#define PG8_WAIT_V(n) asm volatile("s_waitcnt vmcnt(" #n ")" ::: "memory")
#define PG8_WAIT_L(n) asm volatile("s_waitcnt lgkmcnt(" #n ")" ::: "memory")
#define PG8_BAR __builtin_amdgcn_s_barrier()
#define PG8_SCHED __builtin_amdgcn_sched_barrier(0)
    Unit cur, nxt; int ui = 0;
    if (!S.next(0, cur)) return;
    f32x4 acc[2][2][4][2];
#pragma unroll
    for (int a = 0; a < 2; ++a)
#pragma unroll
        for (int b = 0; b < 2; ++b)
#pragma unroll
            for (int m = 0; m < 4; ++m)
#pragma unroll
                for (int n = 0; n < 2; ++n) acc[a][b][m][n] = (f32x4){0.f, 0.f, 0.f, 0.f};
    bf16x8 At[4][2], B0[2][2], B1[2][2];
    const char* cA = S.a_base(cur); const char* cB = S.b_base(cur);
    if constexpr (SP2) {
        PG8_STAGE(PG8_SB(0, 0), cB, voffB); PG8_STAGE(PG8_SB(0, 1), cB + hstep, voffB); PG8_STAGE(PG8_SA(0, 0), cA, voffA); PG8_STAGE(PG8_SA(0, 1), cA + hstep, voffA);
        if (wr == 1) PG8_BAR;
        PG8_WAIT_V(2); PG8_BAR;
        PG8_STAGE(PG8_SB(1, 0), cB + kstep, voffB); PG8_STAGE(PG8_SA(1, 0), cA + kstep, voffA); PG8_STAGE(PG8_SB(1, 1), cB + hstep + kstep, voffB);
        PG8_WAIT_V(6); PG8_BAR;
    } else {
        PG8_STAGE(PG8_SB(0, 0), cB, voffB); PG8_STAGE(PG8_SA(0, 0), cA, voffA); PG8_STAGE(PG8_SB(0, 1), cB + hstep, voffB); PG8_STAGE(PG8_SA(0, 1), cA + hstep, voffA);
        if (wr == 1) PG8_BAR;
        PG8_WAIT_V(4); PG8_BAR;
        PG8_STAGE(PG8_SB(1, 0), cB + kstep, voffB); PG8_STAGE(PG8_SA(1, 0), cA + kstep, voffA); PG8_STAGE(PG8_SB(1, 1), cB + hstep + kstep, voffB);
        PG8_WAIT_V(6); PG8_BAR;
    }
    for (;;) {
        const bool has_next = S.next(ui + 1, nxt);
        const char* nA = has_next ? S.a_base(nxt) : cA; const char* nB = has_next ? S.b_base(nxt) : cB;
        for (int t = 0; t < nt; t += 2) {
            const bool last = (t == nt - 2);
            const char* a1 = cA + (size_t)(t + 1) * kstep;
            const char* a2 = last ? nA : cA + (size_t)(t + 2) * kstep; const char* b2 = last ? nB : cB + (size_t)(t + 2) * kstep;
            const char* a3 = a2 + kstep; const char* b3 = b2 + kstep;
            if constexpr (SP2) {
            PG8_LDB(B0, 0, 0); PG8_LDB(B1, 0, 1); PG8_SCHED; PG8_LDA(At, 0, 0); PG8_STAGE(PG8_SA(1, 1), a1 + hstep, voffA);
            PG8_WAIT_V(8); PG8_WAIT_L(0); PG8_BAR; PG8_MMA(0, 0, At, B0); PG8_MMA(0, 1, At, B1); PG8_BAR; PG8_SCHED;
            PG8_LDA(At, 0, 1); PG8_STAGE(PG8_SB(0, 0), b2, voffB); PG8_STAGE(PG8_SB(0, 1), b2 + hstep, voffB); PG8_STAGE(PG8_SA(0, 0), a2, voffA);
            PG8_WAIT_V(8); PG8_WAIT_L(0); PG8_BAR; PG8_MMA(1, 0, At, B0); PG8_MMA(1, 1, At, B1); PG8_BAR; PG8_SCHED;
            PG8_LDB(B0, 1, 0); PG8_LDB(B1, 1, 1); PG8_SCHED; PG8_LDA(At, 1, 0); PG8_STAGE(PG8_SA(0, 1), a2 + hstep, voffA);
            PG8_WAIT_V(8); PG8_WAIT_L(0); PG8_BAR; PG8_MMA(0, 0, At, B0); PG8_MMA(0, 1, At, B1); PG8_BAR; PG8_SCHED;
            PG8_LDA(At, 1, 1); PG8_STAGE(PG8_SB(1, 0), b3, voffB); PG8_STAGE(PG8_SB(1, 1), b3 + hstep, voffB); PG8_STAGE(PG8_SA(1, 0), a3, voffA);
            PG8_WAIT_V(8); PG8_WAIT_L(0); PG8_BAR; PG8_MMA(1, 0, At, B0); PG8_MMA(1, 1, At, B1); PG8_BAR; PG8_SCHED;
            } else {
            PG8_LDB(B0, 0, 0); PG8_SCHED; PG8_LDA(At, 0, 0); PG8_STAGE(PG8_SA(1, 1), a1 + hstep, voffA);
            PG8_WAIT_L(8); PG8_BAR; PG8_WAIT_L(0); PG8_MMA(0, 0, At, B0); PG8_BAR; PG8_SCHED;
            PG8_LDB(B1, 0, 1); PG8_STAGE(PG8_SB(0, 0), b2, voffB);
            PG8_BAR; PG8_WAIT_L(0); PG8_MMA(0, 1, At, B1); PG8_BAR;
            PG8_LDA(At, 0, 1); PG8_STAGE(PG8_SA(0, 0), a2, voffA);
            PG8_BAR; PG8_WAIT_L(0); PG8_MMA(1, 0, At, B0); PG8_BAR; PG8_SCHED;
            PG8_STAGE(PG8_SB(0, 1), b2 + hstep, voffB);
            PG8_WAIT_V(6); PG8_BAR; PG8_MMA(1, 1, At, B1); PG8_BAR;
            PG8_LDB(B0, 1, 0); PG8_SCHED; PG8_LDA(At, 1, 0); PG8_STAGE(PG8_SA(0, 1), a2 + hstep, voffA);
            PG8_WAIT_L(8); PG8_BAR; PG8_WAIT_L(0); PG8_MMA(0, 0, At, B0); PG8_BAR; PG8_SCHED;
            PG8_LDB(B1, 1, 1); PG8_STAGE(PG8_SB(1, 0), b3, voffB);
            PG8_BAR; PG8_WAIT_L(0); PG8_MMA(0, 1, At, B1); PG8_BAR;
            PG8_LDA(At, 1, 1); PG8_STAGE(PG8_SA(1, 0), a3, voffA);
            PG8_BAR; PG8_WAIT_L(0); PG8_MMA(1, 0, At, B0); PG8_BAR; PG8_SCHED;
            PG8_STAGE(PG8_SB(1, 1), b3 + hstep, voffB);
            PG8_WAIT_V(6); PG8_BAR; PG8_MMA(1, 1, At, B1); PG8_BAR;
            }
        }
        if constexpr (ALIGN_EPI) { if (wr == 0) PG8_BAR; }
        const bool zero = E(acc, cur, wr, wc, fr, fq);
        if (!has_next) break;
        if (zero) {
#pragma unroll
        for (int a = 0; a < 2; ++a)
#pragma unroll
            for (int b = 0; b < 2; ++b)
#pragma unroll
                for (int m = 0; m < 4; ++m)
#pragma unroll
                    for (int n = 0; n < 2; ++n) acc[a][b][m][n] = (f32x4){0.f, 0.f, 0.f, 0.f};
        }
        cur = nxt; cA = nA; cB = nB; ++ui;
        if constexpr (ALIGN_EPI) { if (wr == 1) PG8_BAR; }
    }
    PG8_WAIT_V(0);
    if constexpr (!ALIGN_EPI) { if (wr == 0) PG8_BAR; }
    PG8_BAR;
#undef PG8_SA
#undef PG8_SB
#undef PG8_STAGE
#undef PG8_LDA
#undef PG8_LDB
#undef PG8_MMA
#undef PG8_WAIT_V
#undef PG8_WAIT_L
#undef PG8_BAR
#undef PG8_SCHED
}
}

struct Params {
    const float* x; const float* mem; const int* pos; const float* norm_gain; const float* w_in; const float* gmlp_g; const float* gmlp_b;
    const float* spatial_w; const float* spatial_b; const float* w_a; const float* q_gain; const float* k_gain; const float* ik_g; const float* ik_b;
    const float* w_b; const float* mem_gain; const float* w_mkv; const float* mq_gain; const float* mk_gain; const float* w_m; const float* w_out;
    float* out; unsigned char* ws;
};

__device__ __forceinline__ int win_src_col(int np) {
    const int tile = np >> 8, c = np & 255;
    if (tile < 22) return np;
    const int bj = c >> 7, wc = (c >> 5) & 3, fq = (c >> 3) & 3, j = c & 7;
    if (tile < 26) return 5632 + (tile - 22) * 256 + wc * 64 + 8 * (2 * fq + bj) + j;
    if (tile == 26) {
        if (wc == 0) return 6656 + 8 * (2 * fq + bj) + j;
        if (wc == 1 && fq == 0) return 6720 + 8 * bj + j;
        return -1;
    }
    return np - 176;
}
__device__ __forceinline__ void transpose_item(const float* W, int K, int N, bf16_t* WT, int kb, int nb, bool is_win, LAS float* scr, int lane) {
    const int k0 = 64 * kb, n0 = 32 * nb, nl = lane & 31;
    const int src = is_win ? win_src_col(n0 + nl) : (n0 + nl);
    const float* wp = W + (size_t)(k0 + (lane >> 5)) * N + (src >= 0 ? src : 0);
#pragma unroll 8
    for (int i = 0; i < 32; ++i) { const int kk = 2 * i + (lane >> 5); const float v = wp[(size_t)(2 * i) * N]; scr[kk * 33 + nl] = src >= 0 ? v : 0.f; }
    LDS_WAIT(); asm volatile("" ::: "memory");
    const int c = lane & 7;
#pragma unroll
    for (int j = 0; j < 4; ++j) { const int n = (lane >> 3) + 8 * j; const LAS float* s = scr + (8 * c) * 33 + n;
        u32x4 o; o.x = cvt_pk_bf16(s[0 * 33], s[1 * 33]); o.y = cvt_pk_bf16(s[2 * 33], s[3 * 33]); o.z = cvt_pk_bf16(s[4 * 33], s[5 * 33]); o.w = cvt_pk_bf16(s[6 * 33], s[7 * 33]);
        *(u32x4*)(WT + (size_t)(n0 + n) * K + k0 + 8 * c) = o; }
    LDS_WAIT(); asm volatile("" ::: "memory");
}
__device__ __forceinline__ void rms_row(const float* xrow, const float* gain, bf16_t* orow, int lane) {
    f32x4 v[8]; float s = 0.f;
#pragma unroll
    for (int j = 0; j < 8; ++j) { v[j] = ((const f32x4*)xrow)[lane + 64 * j]; s += (v[j][0] * v[j][0] + v[j][1] * v[j][1]) + (v[j][2] * v[j][2] + v[j][3] * v[j][3]); }
    s = wave_sum(s);
    const float r = 1.0f / sqrtf(s * (1.0f / DM) + EPS);
#pragma unroll
    for (int j = 0; j < 8; ++j) { const f32x4 g = ((const f32x4*)gain)[lane + 64 * j]; const f32x4 o = v[j] * r * g;
        u32x2 w; w.x = cvt_pk_bf16(o[0], o[1]); w.y = cvt_pk_bf16(o[2], o[3]); ((u32x2*)orow)[lane + 64 * j] = w; }
}
__device__ __forceinline__ void p0_prep(const Params& p, LAS unsigned char* lds, int vcu, int G) {
    const int tid = opaque_tid(), lane = tid & 63, wave = tid >> 6;
    LAS float* scr = (LAS float*)(lds + wave * 16384);
    const int gw = vcu * NWAVES + wave, NGW = G * NWAVES;
    unsigned char* ws = p.ws;
    constexpr int I_WIN = 32 * (NPAD / 32), I_BR = 16 * 64, I_SQ = 32 * 64;
    constexpr int NITEMS = I_WIN + 3 * I_BR + 2 * I_SQ;
    for (int it = gw; it < NITEMS; it += NGW) {
        int r = it;
        if (r < I_WIN) { const int nb = r % (NPAD / 32), kb = r / (NPAD / 32); transpose_item(p.w_in, DM, DIN, (bf16_t*)(ws + WS_WIN), kb, nb, true, scr, lane); continue; } r -= I_WIN;
        if (r < 3 * I_BR) { const int br = r / I_BR, q = r % I_BR; const float* W = br == 0 ? p.w_a : (br == 1 ? p.w_b : p.w_m);
            transpose_item(W, 1024, DM, (bf16_t*)(ws + WS_WBR) + (size_t)br * DM * 1024, q / 64, q % 64, false, scr, lane); continue; } r -= 3 * I_BR;
        if (r < I_SQ) { transpose_item(p.w_out, DM, DM, (bf16_t*)(ws + WS_WOUT), r / 64, r % 64, false, scr, lane); continue; } r -= I_SQ;
        transpose_item(p.w_mkv, DM, DM, (bf16_t*)(ws + WS_WMKV), r / 64, r % 64, false, scr, lane);
    }
    for (int m = gw; m < T + NB * MEML; m += NGW) {
        if (m < T) rms_row(p.x + (size_t)m * DM, p.norm_gain, (bf16_t*)(ws + WS_H) + (size_t)m * DM, lane);
        else rms_row(p.mem + (size_t)(m - T) * DM, p.mem_gain, (bf16_t*)(ws + WS_MEMN) + (size_t)(m - T) * DM, lane);
    }
    for (int i = vcu * NTHREADS + tid; i < T * 24; i += G * NTHREADS) {
        const int t = i / 24, j = i % 24; const float ps = (float)p.pos[t];
        float inv; if (j < 16) inv = powf(500000.0f, -(float)j / 16.0f); else inv = powf(500000.0f, -(float)(j - 16) / 8.0f);
        float sn, cs; sincosf(ps * inv, &sn, &cs);
        if (j < 16) ((f32x2*)(ws + WS_CSB))[t * 16 + j] = (f32x2){cs, sn}; else ((f32x2*)(ws + WS_CSI))[t * 8 + (j - 16)] = (f32x2){cs, sn};
    }
}

struct Sched1 {
    int G, c; const char* ws;
    __device__ __forceinline__ bool next(int i, pg8::Unit& u) const {
        int L = i * G + c;
        if (L < 32 * 59) { pg8::tile_order(L, 32, 59, u.pm, u.pn); u.kind = 0; return true; }
        L -= 32 * 59;
        if (L < 8) { u.pm = L & 1; u.pn = L >> 1; u.kind = 1; return true; }
        L -= 8;
        if (L < 8) { u.pm = L & 3; u.pn = L >> 2; u.kind = 2; return true; }
        return false;
    }
    __device__ __forceinline__ const char* a_base(const pg8::Unit& u) const {
        const size_t off = u.kind == 0 ? WS_H : (u.kind == 1 ? WS_MEMN : WS_WMKV + (size_t)1024 * DM * 2);
        return ws + off + (size_t)u.pm * (256 * DM * 2); }
    __device__ __forceinline__ const char* b_base(const pg8::Unit& u) const {
        const size_t off = u.kind == 0 ? WS_WIN : (u.kind == 1 ? WS_WMKV : WS_MEMN);
        return ws + off + (size_t)u.pn * (256 * DM * 2); }
};
struct Epi1 {
    static constexpr bool PERM = true;
    unsigned char* ws; const float* ikg; const float* ikb;
    __device__ __forceinline__ bool operator()(f32x4 (&acc)[2][2][4][2], const pg8::Unit& u, int wr, int wc, int fr, int fq) const {
        const int rowb = u.pm * 256 + wr * 64 + fr, cl = wc * 32 + 8 * fq, pn = u.pn;
#ifndef EX_NOIQ
        if (u.kind == 0 && pn >= 22 && pn < 26) {
            const int head = 4 * (pn - 22) + wc;
#pragma unroll
            for (int ai = 0; ai < 2; ++ai)
#pragma unroll
                for (int m = 0; m < 4; ++m) { const int row = rowb + ai * 128 + m * 16;
                    f32x4 x1a = acc[ai][0][m][0], x1b = acc[ai][0][m][1], x2a = acc[ai][1][m][0], x2b = acc[ai][1][m][1];
                    if (fq == 0) { const f32x4* cs = (const f32x4*)(ws + WS_CSI) + row * 4;
                        const f32x4 c0 = cs[0], c1 = cs[1], c2 = cs[2], c3 = cs[3];
                        const f32x4 co_a = {c0[0], c0[2], c1[0], c1[2]}, si_a = {c0[1], c0[3], c1[1], c1[3]}, co_b = {c2[0], c2[2], c3[0], c3[2]}, si_b = {c2[1], c2[3], c3[1], c3[3]};
                        const f32x4 r1a = x1a * co_a - x2a * si_a, r1b = x1b * co_b - x2b * si_b, r2a = x2a * co_a + x1a * si_a, r2b = x2b * co_b + x1b * si_b;
                        x1a = r1a; x1b = r1b; x2a = r2a; x2b = r2b; }
                    bf16_t* dst = (bf16_t*)(ws + WS_IQ) + (size_t)row * 1024 + head * 64 + 16 * fq;
                    *(bf16x8*)(dst) = pack8(x1a, x1b); *(bf16x8*)(dst + 8) = pack8(x2a, x2b); }
            return true;
        }
#endif
#ifndef EX_NOIK
        if (u.kind == 0 && pn == 26) {
            if (wc == 0) {
                const f32x4 g0 = *(const f32x4*)(ikg + 16 * fq), g1 = *(const f32x4*)(ikg + 16 * fq + 4), g2 = *(const f32x4*)(ikg + 16 * fq + 8), g3 = *(const f32x4*)(ikg + 16 * fq + 12);
                const f32x4 e0 = *(const f32x4*)(ikb + 16 * fq), e1 = *(const f32x4*)(ikb + 16 * fq + 4), e2 = *(const f32x4*)(ikb + 16 * fq + 8), e3 = *(const f32x4*)(ikb + 16 * fq + 12);
#pragma unroll
                for (int ai = 0; ai < 2; ++ai)
#pragma unroll
                    for (int m = 0; m < 4; ++m) { const int row = rowb + ai * 128 + m * 16;
                        f32x4 v0 = acc[ai][0][m][0], v1 = acc[ai][0][m][1], v2 = acc[ai][1][m][0], v3 = acc[ai][1][m][1];
                        const f32x4 sv = (v0 + v1) + (v2 + v3);
                        float sm = (sv[0] + sv[1]) + (sv[2] + sv[3]);
                        sm += __shfl_xor(sm, 16); sm += __shfl_xor(sm, 32);
                        const float mean = sm * (1.f / 64.f);
                        v0 = v0 - mean; v1 = v1 - mean; v2 = v2 - mean; v3 = v3 - mean;
                        const f32x4 qv = (v0 * v0 + v1 * v1) + (v2 * v2 + v3 * v3);
                        float q2 = (qv[0] + qv[1]) + (qv[2] + qv[3]);
                        q2 += __shfl_xor(q2, 16); q2 += __shfl_xor(q2, 32);
                        const float rstd = 1.0f / sqrtf(q2 * (1.f / 64.f) + EPS);
                        v0 = v0 * rstd * g0 + e0; v1 = v1 * rstd * g1 + e1; v2 = v2 * rstd * g2 + e2; v3 = v3 * rstd * g3 + e3;
                        if (fq == 0) { const f32x4* cs = (const f32x4*)(ws + WS_CSI) + row * 4;
                            const f32x4 c0 = cs[0], c1 = cs[1], c2 = cs[2], c3 = cs[3];
                            const f32x4 co_a = {c0[0], c0[2], c1[0], c1[2]}, si_a = {c0[1], c0[3], c1[1], c1[3]}, co_b = {c2[0], c2[2], c3[0], c3[2]}, si_b = {c2[1], c2[3], c3[1], c3[3]};
                            const f32x4 r1a = v0 * co_a - v2 * si_a, r1b = v1 * co_b - v3 * si_b, r2a = v2 * co_a + v0 * si_a, r2b = v3 * co_b + v1 * si_b;
                            v0 = r1a; v1 = r1b; v2 = r2a; v3 = r2b; }
                        bf16_t* dst = (bf16_t*)(ws + WS_IK) + (size_t)row * 64 + 16 * fq;
                        *(bf16x8*)(dst) = pack8(v0, v1); *(bf16x8*)(dst + 8) = pack8(v2, v3); }
            } else if (wc == 1 && fq == 0) {
#pragma unroll
                for (int ai = 0; ai < 2; ++ai)
#pragma unroll
                    for (int m = 0; m < 4; ++m) { const int row = rowb + ai * 128 + m * 16; float* dst = (float*)(ws + WS_IW) + (size_t)row * 16;
                        *(f32x4*)(dst) = acc[ai][0][m][0] * 0.03125f; *(f32x4*)(dst + 4) = acc[ai][0][m][1] * 0.03125f;
                        *(f32x4*)(dst + 8) = acc[ai][1][m][0] * 0.03125f; *(f32x4*)(dst + 12) = acc[ai][1][m][1] * 0.03125f; }
            }
            return true;
        }
#endif
        int act = 0, ld = 1024, co = 0, bjs = 128; size_t off = 0, bex = 0;
        if (u.kind == 1) { off = WS_KM; co = pn * 256; }
        else if (u.kind == 2) { off = WS_VT; ld = 512; co = pn * 256; }
        else if (pn < 4) { act = 1; off = WS_AU; co = pn * 256; }
        else if (pn < 8) { act = 1; off = WS_AV; co = (pn - 4) * 256; }
        else if (pn < 12) { act = 2; off = WS_AZ; co = (pn - 8) * 256; }
        else if (pn < 16) { off = WS_QR; co = (pn - 12) * 256; }
        else if (pn == 16) { off = WS_KR; ld = 256; }
        else if (pn == 17) { off = WS_VV; ld = 128; bjs = SEQ * 128; bex = (size_t)SEQ * 128; }
        else if (pn < 22) { act = 2; off = WS_BZ; co = (pn - 18) * 256; }
        else if (pn < 31) { off = WS_MQ; co = (pn - 27) * 256; }
        else if (pn < 35) { act = 2; off = WS_MZ; co = (pn - 31) * 256; }
        else if (pn < 43) { act = 3; off = WS_SA; ld = 2048; co = (pn - 35) * 256; }
        else if (pn < 51) { act = 3; off = WS_SB; ld = 2048; co = (pn - 43) * 256; }
        else { act = 3; off = WS_SM; ld = 2048; co = (pn - 51) * 256; }
        bf16_t* dst = (bf16_t*)(ws + off) + co + cl;
#pragma unroll
        for (int ai = 0; ai < 2; ++ai)
#pragma unroll
            for (int m = 0; m < 4; ++m) { const int row = rowb + ai * 128 + m * 16; bf16_t* rp = dst + (size_t)row * ld + (size_t)(row >> 12) * bex;
#pragma unroll
                for (int bj = 0; bj < 2; ++bj) { f32x4 v0 = acc[ai][bj][m][0], v1 = acc[ai][bj][m][1];
                    if (act == 1) {
#pragma unroll
                        for (int e = 0; e < 4; ++e) { v0[e] = gelu_f(v0[e]); v1[e] = gelu_f(v1[e]); } }
                    else if (act == 2) {
#pragma unroll
                        for (int e = 0; e < 4; ++e) { v0[e] = silu_f(v0[e]); v1[e] = silu_f(v1[e]); } }
                    else if (act == 3) {
#pragma unroll
                        for (int e = 0; e < 4; ++e) { v0[e] = sigm(v0[e]); v1[e] = sigm(v1[e]); } }
                    *(bf16x8*)(rp + (size_t)bj * bjs) = pack8(v0, v1); }
                if (u.kind == 1) {
                    const f32x4 q = (acc[ai][0][m][0] * acc[ai][0][m][0] + acc[ai][0][m][1] * acc[ai][0][m][1]) + (acc[ai][1][m][0] * acc[ai][1][m][0] + acc[ai][1][m][1] * acc[ai][1][m][1]);
                    float ss = (q[0] + q[1]) + (q[2] + q[3]);
                    ss += __shfl_xor(ss, 16); ss += __shfl_xor(ss, 32);
                    if (fq == 0) ((float*)(ws + WS_RKP))[(size_t)row * 16 + pn * 4 + wc] = ss; } }
        return true;
    }
};

struct Sched2 {
    int G, c; const char* ws;
    __device__ __forceinline__ bool next(int i, pg8::Unit& u) const {
        const int L = (i / 3) * G + c; if (L >= 256) return false;
        pg8::tile_order(L, 32, 8, u.pm, u.pn); u.kind = i % 3; return true;
    }
    __device__ __forceinline__ const char* a_base(const pg8::Unit& u) const {
        const size_t off = WS_XA + (u.kind == 1 ? (WS_XB - WS_XA) : (size_t)0) + (u.kind == 2 ? (WS_XM - WS_XA) : (size_t)0);
        return ws + off + (size_t)u.pm * (256 * 1024 * 2); }
    __device__ __forceinline__ const char* b_base(const pg8::Unit& u) const { return ws + WS_WBR + (size_t)u.kind * ((size_t)DM * 1024 * 2) + (size_t)u.pn * (256 * 1024 * 2); }
};
struct Epi2 {
    static constexpr bool PERM = true;
    unsigned char* ws;
    __device__ __forceinline__ bool operator()(f32x4 (&acc)[2][2][4][2], const pg8::Unit& u, int wr, int wc, int fr, int fq) const {
        const int rowb = u.pm * 256 + wr * 64 + fr, colb = u.pn * 256 + wc * 32 + 8 * fq, seg = u.kind;
        constexpr size_t GST = WS_SB - WS_SA;
        static_assert(WS_SM - WS_SB == GST, "gate spacing");
        const bf16_t* NUM = (const bf16_t*)(ws + WS_SA + (size_t)seg * GST);
        const bf16_t* DEN = (const bf16_t*)(ws + WS_SA + (size_t)(seg < 2 ? seg + 1 : 2) * GST);
        bf16_t* MG = (bf16_t*)(ws + WS_MERGED);
#pragma unroll
        for (int ai = 0; ai < 2; ++ai)
#pragma unroll
            for (int m = 0; m < 4; ++m) { const size_t ro = (size_t)(rowb + ai * 128 + m * 16) * DM + colb;
#pragma unroll
                for (int bj = 0; bj < 2; ++bj) {
                    const u32x4 nu = *(const u32x4*)(NUM + ro + bj * 128);
                    f32x4 f0 = {bflo(nu[0]), bfhi(nu[0]), bflo(nu[1]), bfhi(nu[1])}, f1 = {bflo(nu[2]), bfhi(nu[2]), bflo(nu[3]), bfhi(nu[3])};
                    if (seg < 2) { const u32x4 de = *(const u32x4*)(DEN + ro + bj * 128);
                        const f32x4 d0 = {bflo(de[0]), bfhi(de[0]), bflo(de[1]), bfhi(de[1])}, d1 = {bflo(de[2]), bfhi(de[2]), bflo(de[3]), bfhi(de[3])};
#pragma unroll
                        for (int e = 0; e < 4; ++e) { f0[e] *= __builtin_amdgcn_rcpf(d0[e]); f1[e] *= __builtin_amdgcn_rcpf(d1[e]); }
                        acc[ai][bj][m][0] *= f0; acc[ai][bj][m][1] *= f1;
                    } else { *(bf16x8*)(MG + ro + bj * 128) = pack8(acc[ai][bj][m][0] * f0, acc[ai][bj][m][1] * f1); }
                } }
        return seg == 2;
    }
};
struct Sched3 {
    int G, c; const char* A; const char* B;
    __device__ __forceinline__ bool next(int i, pg8::Unit& u) const { const int L = i * G + c; if (L >= 256) return false; pg8::tile_order(L, 32, 8, u.pm, u.pn); u.kind = 0; return true; }
    __device__ __forceinline__ const char* a_base(const pg8::Unit& u) const { return A + (size_t)u.pm * (256 * DM * 2); }
    __device__ __forceinline__ const char* b_base(const pg8::Unit& u) const { return B + (size_t)u.pn * (256 * DM * 2); }
};
struct Epi3 {
    static constexpr bool PERM = false;
    const float* x; float* out;
    __device__ __forceinline__ bool operator()(f32x4 (&acc)[2][2][4][2], const pg8::Unit& u, int wr, int wc, int fr, int fq) const {
        const int rowb = u.pm * 256 + wr * 64 + fr, colb = u.pn * 256 + wc * 32 + 4 * fq;
#pragma unroll
        for (int ai = 0; ai < 2; ++ai)
#pragma unroll
            for (int m = 0; m < 4; ++m) { const size_t ro = (size_t)(rowb + ai * 128 + m * 16) * DM + colb;
#pragma unroll
                for (int bj = 0; bj < 2; ++bj)
#pragma unroll
                    for (int n = 0; n < 2; ++n) { const size_t o = ro + bj * 128 + n * 16; *(f32x4*)(out + o) = *(const f32x4*)(x + o) + acc[ai][bj][m][n]; } }
        return true;
    }
};

__device__ __forceinline__ void p2_qkprep(const Params& p, int vcu, int G) {
    const int tid = opaque_tid(), lane = tid & 63, wave = tid >> 6;
    unsigned char* ws = p.ws;
    const bf16_t* QR = (const bf16_t*)(ws + WS_QR); const bf16_t* KR = (const bf16_t*)(ws + WS_KR);
    bf16_t* QN = (bf16_t*)(ws + WS_QN); bf16_t* KN = (bf16_t*)(ws + WS_KN);
    const f32x2* CSB = (const f32x2*)(ws + WS_CSB);
    const float gq0 = p.q_gain[lane], gq1 = p.q_gain[lane + 64], gk0 = p.k_gain[lane], gk1 = p.k_gain[lane + 64];
    for (int t = vcu * NWAVES + wave; t < T; t += G * NWAVES) {
        const int b = t >> 12, s = t & (SEQ - 1);
        const f32x2 cs = CSB[t * 16 + (lane & 15)];
#pragma unroll
        for (int r = 0; r < 10; ++r) {
            const bf16_t* src = r < 8 ? QR + (size_t)t * 1024 + r * 128 : KR + (size_t)t * 256 + (r - 8) * 128;
            const float x0 = bf2f(src[lane]), x1 = bf2f(src[lane + 64]);
            const float ss = wave_sum(x0 * x0 + x1 * x1);
            const float rs = 1.0f / sqrtf(ss * (1.f / 128.f) + EPS);
            float y0 = x0 * rs * (r < 8 ? gq0 : gk0); const float y1 = x1 * rs * (r < 8 ? gq1 : gk1);
            const float pr = __shfl_xor(y0, 16);
            if (lane < 16) y0 = y0 * cs[0] - pr * cs[1]; else if (lane < 32) y0 = y0 * cs[0] + pr * cs[1];
            bf16_t* dst = r < 8 ? QN + ((size_t)(b * 8 + r) * SEQ + s) * 128 : KN + ((size_t)(b * 2 + (r - 8)) * SEQ + s) * 128;
            dst[lane] = f2bf(y0); dst[lane + 64] = f2bf(y1);
        }
    }
}

constexpr int GM_VSTR = 136;
__device__ __forceinline__ void p2_gmlp_unit(const Params& p, LAS unsigned char* lds, int unit) {
    const int tid = opaque_tid(), lane = tid & 63, wave = __builtin_amdgcn_readfirstlane(tid >> 6), r32 = lane & 31, hi = lane >> 5;
    unsigned char* ws = p.ws;
    const int g = unit & 7, ch = unit >> 3, tok0 = ch * 128;
    const bf16_t* AV = (const bf16_t*)(ws + WS_AV); const bf16_t* AU = (const bf16_t*)(ws + WS_AU); const bf16_t* AZ = (const bf16_t*)(ws + WS_AZ);
    bf16_t* XA = (bf16_t*)(ws + WS_XA);
    LAS float* stat = (LAS float*)lds;
    LAS bf16_t* vT = (LAS bf16_t*)(lds + 1024);
    const int tb = wave >> 1, dh = wave & 1, trow = tb * 32 + r32;
    const float* wsp = p.spatial_w + ((size_t)g * 128 + trow) * 128 + 8 * hi;
    f32x4 wf[8][2];
#pragma unroll
    for (int ks = 0; ks < 8; ++ks) { wf[ks][0] = *(const f32x4*)(wsp + 16 * ks); wf[ks][1] = *(const f32x4*)(wsp + 16 * ks + 4); }
#pragma unroll 1
    for (int hf = 0; hf < 2; ++hf) {
        u32x4 ra[8], rb[8];
#pragma unroll
        for (int i = 0; i < 8; ++i) { const bf16_t* row = AV + (size_t)(tok0 + wave * 16 + hf * 8 + i) * 1024 + lane * 16; ra[i] = *(const u32x4*)row; rb[i] = *(const u32x4*)(row + 8); }
        float sm[8];
#pragma unroll
        for (int i = 0; i < 8; ++i) { float a = 0.f;
#pragma unroll
            for (int e = 0; e < 4; ++e) a += (bflo(ra[i][e]) + bfhi(ra[i][e])) + (bflo(rb[i][e]) + bfhi(rb[i][e]));
            sm[i] = a; }
#pragma unroll
        for (int o = 1; o < 64; o <<= 1)
#pragma unroll
            for (int i = 0; i < 8; ++i) sm[i] += __shfl_xor(sm[i], o);
        float qv[8];
#pragma unroll
        for (int i = 0; i < 8; ++i) { const float mean = sm[i] * (1.f / 1024.f); sm[i] = mean; float a = 0.f;
#pragma unroll
            for (int e = 0; e < 4; ++e) { const float d0 = bflo(ra[i][e]) - mean, d1 = bfhi(ra[i][e]) - mean, d2 = bflo(rb[i][e]) - mean, d3 = bfhi(rb[i][e]) - mean; a += (d0 * d0 + d1 * d1) + (d2 * d2 + d3 * d3); }
            qv[i] = a; }
#pragma unroll
        for (int o = 1; o < 64; o <<= 1)
#pragma unroll
            for (int i = 0; i < 8; ++i) qv[i] += __shfl_xor(qv[i], o);
        if (lane < 8) { float mm = sm[0], qq = qv[0];
#pragma unroll
            for (int i = 1; i < 8; ++i) { if (lane == i) { mm = sm[i]; qq = qv[i]; } }
            const int tk = wave * 16 + hf * 8 + lane; stat[2 * tk] = mm; stat[2 * tk + 1] = 1.0f / sqrtf(qq * (1.f / 1024.f) + EPS); }
    }
    __syncthreads();
    {
        u32x4 va[4];
#pragma unroll
        for (int i = 0; i < 4; ++i) { const int it = tid + i * NTHREADS, s_ = it >> 4, d8 = (it & 15) * 8; va[i] = *(const u32x4*)(AV + (size_t)(tok0 + s_) * 1024 + g * 128 + d8); }
        const int d8 = (tid & 15) * 8;
        const f32x4 g0 = *(const f32x4*)(p.gmlp_g + g * 128 + d8), g1 = *(const f32x4*)(p.gmlp_g + g * 128 + d8 + 4), b0 = *(const f32x4*)(p.gmlp_b + g * 128 + d8), b1 = *(const f32x4*)(p.gmlp_b + g * 128 + d8 + 4);
#pragma unroll
        for (int i = 0; i < 4; ++i) { const int it = tid + i * NTHREADS, s_ = it >> 4; const u32x4 a = va[i];
            const float mean = stat[2 * s_], rstd = stat[2 * s_ + 1];
            float f[8] = {bflo(a[0]), bfhi(a[0]), bflo(a[1]), bfhi(a[1]), bflo(a[2]), bfhi(a[2]), bflo(a[3]), bfhi(a[3])};
#pragma unroll
            for (int e = 0; e < 8; ++e) { const float y = (f[e] - mean) * rstd * (e < 4 ? g0[e & 3] : g1[e & 3]) + (e < 4 ? b0[e & 3] : b1[e & 3]); vT[(d8 + e) * GM_VSTR + s_] = f2bf(y); } }
    }
    unsigned short gu[16][2], gz[16][2];
#pragma unroll
    for (int r = 0; r < 16; ++r) { const int tl = tb * 32 + (r & 3) + 8 * (r >> 2) + 4 * hi; const size_t o = (size_t)(tok0 + tl) * 1024 + g * 128 + dh * 64 + r32;
        gu[r][0] = AU[o]; gu[r][1] = AU[o + 32]; gz[r][0] = AZ[o]; gz[r][1] = AZ[o + 32]; }
    __syncthreads();
    f32x16 acc0 = {}, acc1 = {};
#pragma unroll
    for (int ks = 0; ks < 8; ++ks) {
        const int s0 = 16 * ks + 8 * hi;
        f32x4 w0 = wf[ks][0], w1 = wf[ks][1];
#pragma unroll
        for (int e = 0; e < 4; ++e) { if (s0 + e > trow) w0[e] = 0.f; if (s0 + 4 + e > trow) w1[e] = 0.f; }
        const bf16x8 a = pack8(w0, w1);
        const bf16x8 b0 = *(const LAS bf16x8*)(vT + (dh * 64 + r32) * GM_VSTR + s0), b1 = *(const LAS bf16x8*)(vT + (dh * 64 + 32 + r32) * GM_VSTR + s0);
        acc0 = __builtin_amdgcn_mfma_f32_32x32x16_bf16(a, b0, acc0, 0, 0, 0);
        acc1 = __builtin_amdgcn_mfma_f32_32x32x16_bf16(a, b1, acc1, 0, 0, 0);
    }
#pragma unroll
    for (int r = 0; r < 16; ++r) { const int tl = tb * 32 + (r & 3) + 8 * (r >> 2) + 4 * hi; const float bias = p.spatial_b[g * 128 + tl];
        const size_t o = (size_t)(tok0 + tl) * 1024 + g * 128 + dh * 64 + r32;
        XA[o] = f2bf(bf2f(gu[r][0]) * (acc0[r] + bias) * bf2f(gz[r][0]));
        XA[o + 32] = f2bf(bf2f(gu[r][1]) * (acc1[r] + bias) * bf2f(gz[r][1])); }
    __syncthreads();
}

constexpr int MA_KST = 32 * 512, MA_VROW = 72, MA_VST = 256 * MA_VROW;
constexpr int MA_K0 = 2048, MA_V0 = MA_K0 + 2 * MA_KST;
static_assert(MA_V0 + 2 * MA_VST <= MISC_OFF, "mem-attn LDS map");
__device__ __forceinline__ void p2_mem_unit(const Params& p, LAS unsigned char* lds, int unit) {
    const int tid = opaque_tid(), lane = tid & 63, wave = __builtin_amdgcn_readfirstlane(tid >> 6), r32 = lane & 31, hi = lane >> 5;
    unsigned char* ws = p.ws;
    const int qb = unit & 31, h = (unit >> 5) & 3, b = unit >> 7, qg = wave & 3, dhf = wave >> 2;
    const bf16_t* MQ = (const bf16_t*)(ws + WS_MQ); const bf16_t* MZ = (const bf16_t*)(ws + WS_MZ);
    const bf16_t* KM = (const bf16_t*)(ws + WS_KM) + (size_t)(b * 256) * 1024 + h * 256;
    const bf16_t* VT = (const bf16_t*)(ws + WS_VT) + (size_t)(h * 256) * 512 + b * 256;
    bf16_t* XM = (bf16_t*)(ws + WS_XM);
    LAS float* rk = (LAS float*)lds;
    LAS float* gqk = (LAS float*)(lds + 1024);
    u32x4 sk[2], sv[2];
#define MA_LOAD(st) do { _Pragma("unroll") for (int i = 0; i < 2; ++i) { const int q = tid + i * NTHREADS; \
        sk[i] = *(const u32x4*)(KM + (size_t)((st) * 32 + (q >> 5)) * 1024 + (q & 31) * 8); \
        sv[i] = *(const u32x4*)(VT + (size_t)(q >> 2) * 512 + (st) * 32 + (q & 3) * 8); } } while (0)
#define MA_WRITE(bf) do { _Pragma("unroll") for (int i = 0; i < 2; ++i) { const int q = tid + i * NTHREADS; const int key = q >> 5, c = q & 31; \
        *(LAS u32x4*)(lds + MA_K0 + (bf) * MA_KST + key * 512 + ((c ^ (key & 15)) << 4)) = sk[i]; \
        LAS unsigned char* vd = lds + MA_V0 + (bf) * MA_VST + (q >> 2) * MA_VROW + (q & 3) * 16; \
        *(LAS u32x2*)vd = (u32x2){sv[i][0], sv[i][1]}; *(LAS u32x2*)(vd + 8) = (u32x2){sv[i][2], sv[i][3]}; } } while (0)
    if (tid < 256) { const f32x4 pr = *(const f32x4*)((const float*)(ws + WS_RKP) + (size_t)(b * 256 + tid) * 16 + h * 4);
        rk[tid] = 1.0f / sqrtf(((pr[0] + pr[1]) + (pr[2] + pr[3])) * (1.f / 256.f) + EPS); gqk[tid] = p.mq_gain[tid] * p.mk_gain[tid]; }
    __syncthreads();
    const int tq = b * SEQ + qb * 128 + qg * 32 + r32;
    bf16x8 qf[16]; float ssq = 0.f;
#pragma unroll
    for (int ks = 0; ks < 16; ++ks) { const int d0 = 16 * ks + 8 * hi; const u32x4 a = *(const u32x4*)(MQ + (size_t)tq * 1024 + h * 256 + d0);
        f32x4 f0 = {bflo(a[0]), bfhi(a[0]), bflo(a[1]), bfhi(a[1])}, f1 = {bflo(a[2]), bfhi(a[2]), bflo(a[3]), bfhi(a[3])};
        ssq += (f0[0] * f0[0] + f0[1] * f0[1]) + (f0[2] * f0[2] + f0[3] * f0[3]) + (f1[0] * f1[0] + f1[1] * f1[1]) + (f1[2] * f1[2] + f1[3] * f1[3]);
        const f32x4 g0 = *(const LAS f32x4*)(gqk + d0), g1 = *(const LAS f32x4*)(gqk + d0 + 4);
        qf[ks] = pack8(f0 * g0, f1 * g1); }
    ssq += __shfl_xor(ssq, 32);
    const float qs = (1.0f / sqrtf(ssq * (1.f / 256.f) + EPS)) * (0.0625f * LOG2E);
    MA_LOAD(0);
    MA_WRITE(0);
    __syncthreads();
    f32x16 o[4];
#pragma unroll
    for (int db = 0; db < 4; ++db) o[db] = (f32x16){};
    float mrun = -1e30f, l = 0.f;
    const int kx = r32 & 15;
#pragma unroll 1
    for (int st = 0; st < 8; ++st) {
        const int bf = st & 1;
        if (st + 1 < 8) MA_LOAD(st + 1);
        {
            f32x16 a = {};
            const LAS unsigned char* kp = lds + MA_K0 + bf * MA_KST + r32 * 512;
#pragma unroll
            for (int ks = 0; ks < 16; ++ks) { if ((ks & 3) == 0) __builtin_amdgcn_sched_barrier(0); const bf16x8 kf = *(const LAS bf16x8*)(kp + (((2 * ks + hi) ^ kx) << 4)); a = __builtin_amdgcn_mfma_f32_32x32x16_bf16(kf, qf[ks], a, 0, 0, 0); }
            __builtin_amdgcn_sched_barrier(0);
#pragma unroll
            for (int g4 = 0; g4 < 4; ++g4) { const f32x4 rr = *(const LAS f32x4*)(rk + st * 32 + 8 * g4 + 4 * hi);
#pragma unroll
                for (int e = 0; e < 4; ++e) a[4 * g4 + e] *= rr[e] * qs; }
            float bm = a[0];
#pragma unroll
            for (int r = 1; r < 16; ++r) bm = fmaxf(bm, a[r]);
            bm = fmaxf(bm, __shfl_xor(bm, 32));
            if (!__all(bm - mrun <= 8.f)) { const float mn = fmaxf(mrun, bm), al = __builtin_amdgcn_exp2f(mrun - mn); mrun = mn; l *= al;
#pragma unroll
                for (int db = 0; db < 4; ++db) o[db] *= al; }
#pragma unroll
            for (int r = 0; r < 16; ++r) { a[r] = __builtin_amdgcn_exp2f(a[r] - mrun); l += a[r]; }
            u32x4 w0 = {cvt_pk_bf16(a[0], a[1]), cvt_pk_bf16(a[2], a[3]), cvt_pk_bf16(a[4], a[5]), cvt_pk_bf16(a[6], a[7])};
            u32x4 w1 = {cvt_pk_bf16(a[8], a[9]), cvt_pk_bf16(a[10], a[11]), cvt_pk_bf16(a[12], a[13]), cvt_pk_bf16(a[14], a[15])};
            const bf16x8 pf0 = *reinterpret_cast<bf16x8*>(&w0), pf1 = *reinterpret_cast<bf16x8*>(&w1);
            const LAS unsigned char* vp = lds + MA_V0 + bf * MA_VST + (dhf * 128 + r32) * MA_VROW + 8 * hi;
#pragma unroll
            for (int db = 0; db < 4; ++db) {
                const u32x2 lo0 = *(const LAS u32x2*)(vp + db * 32 * MA_VROW), hi0 = *(const LAS u32x2*)(vp + db * 32 * MA_VROW + 16);
                const u32x2 lo1 = *(const LAS u32x2*)(vp + db * 32 * MA_VROW + 32), hi1 = *(const LAS u32x2*)(vp + db * 32 * MA_VROW + 48);
                u32x4 v0 = {lo0[0], lo0[1], hi0[0], hi0[1]}, v1 = {lo1[0], lo1[1], hi1[0], hi1[1]};
                o[db] = __builtin_amdgcn_mfma_f32_32x32x16_bf16(*reinterpret_cast<bf16x8*>(&v0), pf0, o[db], 0, 0, 0);
                o[db] = __builtin_amdgcn_mfma_f32_32x32x16_bf16(*reinterpret_cast<bf16x8*>(&v1), pf1, o[db], 0, 0, 0); }
        }
        if (st + 1 < 8) MA_WRITE(bf ^ 1);
        __syncthreads();
    }
#undef MA_LOAD
#undef MA_WRITE
    l += __shfl_xor(l, 32);
    const float il = __builtin_amdgcn_rcpf(l);
#pragma unroll
    for (int db = 0; db < 4; ++db)
#pragma unroll
        for (int g4 = 0; g4 < 4; ++g4) { const size_t oo = (size_t)tq * 1024 + h * 256 + dhf * 128 + db * 32 + 8 * g4 + 4 * hi;
            const u32x2 z = *(const u32x2*)(MZ + oo);
            u32x2 w; w[0] = cvt_pk_bf16(o[db][4 * g4] * il * bflo(z[0]), o[db][4 * g4 + 1] * il * bfhi(z[0])); w[1] = cvt_pk_bf16(o[db][4 * g4 + 2] * il * bflo(z[1]), o[db][4 * g4 + 3] * il * bfhi(z[1]));
            *(u32x2*)(XM + oo) = w; }
}


__device__ __forceinline__ unsigned wave_sum_dpp(unsigned c) {
    c += (unsigned)__builtin_amdgcn_update_dpp(0, (int)c, 0xB1, 0xF, 0xF, false);
    c += (unsigned)__builtin_amdgcn_update_dpp(0, (int)c, 0x4E, 0xF, 0xF, false);
    c += (unsigned)__builtin_amdgcn_update_dpp(0, (int)c, 0x141, 0xF, 0xF, false);
    c += (unsigned)__builtin_amdgcn_update_dpp(0, (int)c, 0x140, 0xF, 0xF, false);
    { auto r = __builtin_amdgcn_permlane16_swap(c, c, false, false); c = r[0] + r[1]; }
    { auto r = __builtin_amdgcn_permlane32_swap(c, c, false, false); c = r[0] + r[1]; }
    return c;
}
#define CNT4(c0, c1, c2, c3, a, b, c_, d, t) do { unsigned long long m0_, m1_, m2_, m3_; asm volatile( \
    "v_cmp_ge_u32_e64 %[m0], %[va], %[vt]\n\tv_cmp_ge_u32_e64 %[m1], %[vb], %[vt]\n\tv_cmp_ge_u32_e64 %[m2], %[vc], %[vt]\n\tv_cmp_ge_u32_e64 %[m3], %[vd], %[vt]\n\t" \
    "v_addc_co_u32_e64 %[k0], %[m0], %[k0], 0, %[m0]\n\tv_addc_co_u32_e64 %[k1], %[m1], %[k1], 0, %[m1]\n\tv_addc_co_u32_e64 %[k2], %[m2], %[k2], 0, %[m2]\n\tv_addc_co_u32_e64 %[k3], %[m3], %[k3], 0, %[m3]" \
    : [k0] "+v"(c0), [k1] "+v"(c1), [k2] "+v"(c2), [k3] "+v"(c3), [m0] "=&s"(m0_), [m1] "=&s"(m1_), [m2] "=&s"(m2_), [m3] "=&s"(m3_) \
    : [va] "v"(a), [vb] "v"(b), [vc] "v"(c_), [vd] "v"(d), [vt] "v"(t)); } while (0)

__device__ __forceinline__ unsigned sortable(float f) { const unsigned u = __float_as_uint(f); return u ^ ((unsigned)((int)u >> 31) | 0x80000000u); }
__device__ __forceinline__ void p2_idx_unit(const Params& p, LAS unsigned char* lds, int b, int ublk) {
    const int tid = opaque_tid(), lane = tid & 63, wave = __builtin_amdgcn_readfirstlane(tid >> 6), r32 = lane & 31, hi = lane >> 5;
    unsigned char* ws = p.ws;
    const int s0 = ublk * 8, t0 = b * SEQ + s0;
    const bf16_t* IQ = (const bf16_t*)(ws + WS_IQ); const bf16_t* IK = (const bf16_t*)(ws + WS_IK) + (size_t)(b * SEQ) * 64; const float* IW = (const float*)(ws + WS_IW);
    LAS unsigned* sc = (LAS unsigned*)lds;
    LAS float* iwl = (LAS float*)(lds + 131072);
    if (tid < 128) iwl[tid] = IW[(size_t)t0 * 16 + tid];
    bf16x8 af[4][4];
#pragma unroll
    for (int at = 0; at < 4; ++at)
#pragma unroll
        for (int ks = 0; ks < 4; ++ks) af[at][ks] = *(const bf16x8*)(IQ + (size_t)(t0 + 2 * at + (r32 >> 4)) * 1024 + (r32 & 15) * 64 + 16 * ks + 8 * hi);
    __syncthreads();
    const int ntiles = (s0 + 8 + 31) >> 5;
    bf16x8 bfr[4], bnx[4];
    {
        const int jc = wave < ntiles ? wave : 0;
#pragma unroll
        for (int ks = 0; ks < 4; ++ks) bfr[ks] = *(const bf16x8*)(IK + (size_t)(32 * jc + r32) * 64 + 16 * ks + 8 * hi);
    }
#pragma unroll 1
    for (int j = wave; j < ntiles; j += NWAVES) {
        const int k0 = 32 * j;
        {
            const int jn = (j + NWAVES < ntiles) ? j + NWAVES : j;
#pragma unroll
            for (int ks = 0; ks < 4; ++ks) bnx[ks] = *(const bf16x8*)(IK + (size_t)(32 * jn + r32) * 64 + 16 * ks + 8 * hi);
        }
#pragma unroll
        for (int at = 0; at < 4; ++at) {
            f32x16 a = {};
#pragma unroll
            for (int ks = 0; ks < 4; ++ks) a = __builtin_amdgcn_mfma_f32_32x32x16_bf16(af[at][ks], bfr[ks], a, 0, 0, 0);
            const f32x4 wa0 = *(const LAS f32x4*)(iwl + (2 * at) * 16 + 4 * hi), wa1 = *(const LAS f32x4*)(iwl + (2 * at) * 16 + 8 + 4 * hi);
            const f32x4 wb0 = *(const LAS f32x4*)(iwl + (2 * at + 1) * 16 + 4 * hi), wb1 = *(const LAS f32x4*)(iwl + (2 * at + 1) * 16 + 8 + 4 * hi);
            float pa = 0.f, pb = 0.f;
#pragma unroll
            for (int e = 0; e < 4; ++e) { pa += wa0[e] * fmaxf(a[e], 0.f); pa += wa1[e] * fmaxf(a[4 + e], 0.f); pb += wb0[e] * fmaxf(a[8 + e], 0.f); pb += wb1[e] * fmaxf(a[12 + e], 0.f); }
            auto rr = __builtin_amdgcn_permlane32_swap(__float_as_uint(pa), __float_as_uint(pb), false, false);
            const float score = __uint_as_float(rr[0]) + __uint_as_float(rr[1]);
            const int qi = 2 * at + hi, key = k0 + r32;
            sc[qi * 4096 + key] = (key <= s0 + qi) ? sortable(score) : 0u;
        }
#pragma unroll
        for (int ks = 0; ks < 4; ++ks) bfr[ks] = bnx[ks];
    }
    __syncthreads();
    {
        const int s = s0 + wave, n = s + 1;
        unsigned kv[64];
#pragma unroll
        for (int i = 0; i < 64; ++i) { const int key = 64 * i + lane; kv[i] = (key <= s) ? sc[wave * 4096 + key] : 0u; }
        unsigned Tt = 1u; bool exact = true;
        if (n > 256) {
            Tt = 0u; exact = false;
            for (int bit = 31; bit >= 0; --bit) {
                const unsigned cand = Tt | (1u << bit); unsigned c0 = 0, c1 = 0, c2 = 0, c3 = 0;
#pragma unroll
                for (int i = 0; i < 64; i += 4) CNT4(c0, c1, c2, c3, kv[i], kv[i + 1], kv[i + 2], kv[i + 3], cand);
                const unsigned c = wave_sum_dpp((c0 + c1) + (c2 + c3));
                if (c >= 256u) { Tt = cand; if (c == 256u) { exact = true; break; } }
            }
        }
        LAS unsigned long long* lm = (LAS unsigned long long*)(lds + 131072 + 512) + wave * 64;
        if (exact) {
#pragma unroll
            for (int i = 0; i < 64; ++i) { const unsigned long long bal = __ballot(kv[i] >= Tt); if (lane == 0) lm[i] = bal; }
        } else {
            unsigned cg_ = 0;
#pragma unroll
            for (int i = 0; i < 64; ++i) cg_ += (kv[i] > Tt) ? 1u : 0u;
            cg_ = wave_sum_u(cg_);
            unsigned need = 256u - cg_, seen = 0u;
#pragma unroll 1
            for (int i = 0; i < 64; ++i) {
                const unsigned kk = (64 * i + lane <= s) ? sc[wave * 4096 + 64 * i + lane] : 0u;
                const unsigned long long eq = __ballot(kk == Tt), gt = __ballot(kk > Tt);
                const unsigned below = (unsigned)__popcll(eq & ((1ull << lane) - 1ull));
                const bool take = (kk == Tt) && (seen + below < need);
                const unsigned long long bal = gt | __ballot(take);
                seen += (unsigned)__popcll(eq);
                if (lane == 0) lm[i] = bal;
            }
        }
        LDS_WAIT(); asm volatile("" ::: "memory");
        const unsigned long long mine = lm[lane];
        ((unsigned long long*)(ws + WS_MASK))[(size_t)(t0 + wave) * 64 + lane] = mine;
    }
    __syncthreads();
}

namespace att {
constexpr int D = 128, NW = 8, QBLK = 32, KVBLK = 64, QB = 256;
constexpr int SHM_V = KVBLK * D * 2, SHM_K = KVBLK * D * 2;
constexpr int LDS_NEED = 2 * SHM_V + 2 * SHM_K + NW * 64 * 4;
constexpr float SCALE = 0.08838834764831845f, THR = 8.f;
#define KSWZ(row, colB) ((row) * 256 + ((colB) ^ (((row) & 7) << 4)))
#define SBAR() __builtin_amdgcn_sched_barrier(0)
__device__ __forceinline__ int v_st(int k, int c) { const int kk = (k & ~0xC) | ((k & 4) << 1) | ((k & 8) >> 1); return ((kk >> 3) * 4 + (c >> 5)) * 512 + ((kk & 7) * 32 + (c & 31)) * 2; }
__device__ __forceinline__ int v_rd_base(int lane) { return ((lane & 3) << 3) | (((lane >> 2) & 3) << 6) | (((lane >> 4) & 1) << 5) | (((lane >> 5) & 1) << 8); }
constexpr int v_rd_off(int d0, int ks, int half) { return d0 * 512 + ks * 4096 + half * 2048; }
__device__ __forceinline__ int crow(int r, int hi) { return (r & 3) + 8 * (r >> 2) + 4 * hi; }
__device__ __forceinline__ bf16x8 load8(const bf16_t* p) { return *reinterpret_cast<const bf16x8*>(p); }
__device__ __forceinline__ void mask_bits(f32x16& p0, f32x16& p1, unsigned w0, unsigned w1, int hi) {
    const float NEG = -__builtin_inff();
    w0 >>= 4 * hi; w1 >>= 4 * hi;
#pragma unroll
    for (int r = 0; r < 16; ++r) { const int c = (r & 3) + 8 * (r >> 2);
        if (!((w0 >> c) & 1u)) p0[r] = NEG;
        if (!((w1 >> c) & 1u)) p1[r] = NEG; }
}
__device__ __forceinline__ void partialSM(f32x16& p0, f32x16& p1, float& m_reg, float& mn, float& alpha) {
    float pmax = p0[0];
#pragma unroll
    for (int r = 1; r < 16; ++r) pmax = fmaxf(pmax, p0[r]);
#pragma unroll
    for (int r = 0; r < 16; ++r) pmax = fmaxf(pmax, p1[r]);
    { auto rr = __builtin_amdgcn_permlane32_swap(__float_as_uint(pmax), __float_as_uint(pmax), false, false);
      pmax = fmaxf(__uint_as_float(rr[0]), __uint_as_float(rr[1])); }
    constexpr float C2 = 1.4426950408889634f * SCALE;
    if (__builtin_expect(__all((pmax - m_reg) * SCALE <= THR), 1)) { mn = m_reg; alpha = 1.f; }
    else { mn = fmaxf(m_reg, pmax); alpha = __builtin_amdgcn_exp2f((m_reg - mn) * C2); m_reg = mn; }
    const float mnL = -mn * C2;
#pragma unroll
    for (int r = 0; r < 16; ++r) p0[r] = fmaf(p0[r], C2, mnL);
#pragma unroll
    for (int r = 0; r < 16; ++r) p1[r] = fmaf(p1[r], C2, mnL);
#pragma unroll
    for (int r = 0; r < 16; ++r) p0[r] = __builtin_amdgcn_exp2f(p0[r]);
}
__device__ __forceinline__ void finishSM(f32x16& p0, f32x16& p1, float alpha, float& l_reg, bf16x8& pa0, bf16x8& pa1, bf16x8& pa2, bf16x8& pa3) {
#pragma unroll
    for (int r = 0; r < 16; ++r) p1[r] = __builtin_amdgcn_exp2f(p1[r]);
    float ps = 0;
#pragma unroll
    for (int r = 0; r < 16; ++r) ps += p0[r];
#pragma unroll
    for (int r = 0; r < 16; ++r) ps += p1[r];
    { auto rr = __builtin_amdgcn_permlane32_swap(__float_as_uint(ps), __float_as_uint(ps), false, false);
      ps = __uint_as_float(rr[0]) + __uint_as_float(rr[1]); }
    l_reg = l_reg * alpha + ps;
#define PK4(P, B_, OUT) do { unsigned a0 = cvt_pk_bf16(P[B_+0], P[B_+1]), a1 = cvt_pk_bf16(P[B_+2], P[B_+3]);                          \
        unsigned b0 = cvt_pk_bf16(P[B_+4], P[B_+5]), b1 = cvt_pk_bf16(P[B_+6], P[B_+7]);                                             \
        auto r0 = __builtin_amdgcn_permlane32_swap(a0, b0, false, false); auto r1 = __builtin_amdgcn_permlane32_swap(a1, b1, false, false); \
        u32x4 w = {r0[0], r1[0], r0[1], r1[1]}; OUT = *reinterpret_cast<bf16x8*>(&w); } while (0)
    PK4(p0, 0, pa0); PK4(p0, 8, pa1); PK4(p1, 0, pa2); PK4(p1, 8, pa3);
#undef PK4
}
template <int KB>
__device__ __forceinline__ void qkt(f32x16& p0, f32x16& p1, const char* K_lds, int r32, int hi, const bf16x8* qr) {
    p0 = f32x16{}; p1 = f32x16{};
    const char* kb[4];
#pragma unroll
    for (int dd = 0; dd < 4; ++dd) kb[dd] = K_lds + KB * SHM_K + KSWZ(r32, (dd * 16 + hi * 8) * 2);
#pragma unroll
    for (int d0 = 0; d0 < 8; ++d0) { const char* a = kb[d0 & 3] + (d0 >> 2) * 128;
        bf16x8 b0 = *reinterpret_cast<const bf16x8*>(a);
        bf16x8 b1 = *reinterpret_cast<const bf16x8*>(a + 32 * 256);
        p0 = __builtin_amdgcn_mfma_f32_32x32x16_bf16(b0, qr[d0], p0, 0, 0, 0);
        p1 = __builtin_amdgcn_mfma_f32_32x32x16_bf16(b1, qr[d0], p1, 0, 0, 0); }
}
template <int VB>
__device__ __forceinline__ void pv_tile(f32x16* o, int vb0, bf16x8 pa0, bf16x8 pa1, bf16x8 pa2, bf16x8 pa3) {
#define TRRD(dst, off) asm volatile("ds_read_b64_tr_b16 %0, %1 offset:%2" : "=&v"(dst) : "v"(vb0), "i"(off) : "memory")
#define PV_D0(d0) do { s16x4 l0, l1, l2, l3, h0, h1, h2, h3; constexpr int b_ = VB * SHM_V + v_rd_off(d0, 0, 0); \
        TRRD(l0, b_); TRRD(h0, b_ + 2048); TRRD(l1, b_ + 4096); TRRD(h1, b_ + 6144); TRRD(l2, b_ + 8192); TRRD(h2, b_ + 10240); TRRD(l3, b_ + 12288); TRRD(h3, b_ + 14336); \
        asm volatile("s_waitcnt lgkmcnt(0)" ::: "memory"); SBAR();   \
        o[d0] = __builtin_amdgcn_mfma_f32_32x32x16_bf16(pa0, (bf16x8){l0[0], l0[1], l0[2], l0[3], h0[0], h0[1], h0[2], h0[3]}, o[d0], 0, 0, 0);   \
        o[d0] = __builtin_amdgcn_mfma_f32_32x32x16_bf16(pa1, (bf16x8){l1[0], l1[1], l1[2], l1[3], h1[0], h1[1], h1[2], h1[3]}, o[d0], 0, 0, 0);   \
        o[d0] = __builtin_amdgcn_mfma_f32_32x32x16_bf16(pa2, (bf16x8){l2[0], l2[1], l2[2], l2[3], h2[0], h2[1], h2[2], h2[3]}, o[d0], 0, 0, 0);   \
        o[d0] = __builtin_amdgcn_mfma_f32_32x32x16_bf16(pa3, (bf16x8){l3[0], l3[1], l3[2], l3[3], h3[0], h3[1], h3[2], h3[3]}, o[d0], 0, 0, 0); } while (0)
    PV_D0(0); PV_D0(1); PV_D0(2); PV_D0(3);
#undef PV_D0
#undef TRRD
}
struct BlockRef { const bf16_t* Q; const bf16_t* K; const bf16_t* V; const unsigned* M; bf16_t* O; const bf16_t* Z; int P0; };
struct Seam { bf16x8 qr[8]; bf16x8 st_v0, st_v1, st_k0, st_k1; };
#define ROW(p, k0, rr) ((p) + (size_t)((k0) + (rr)) * D + sc)
#define VMW() asm volatile("s_waitcnt vmcnt(0)" ::: "memory")
#define VMWN(n) asm volatile("s_waitcnt vmcnt(%0)" :: "i"(n) : "memory")
#define SLOAD_H(Kp, Vp, k0) do { S.st_v0 = load8(ROW(Vp, k0, sr)); S.st_v1 = load8(ROW(Vp, k0, 32 + sr));              \
                         S.st_k0 = load8(ROW(Kp, k0, sr)); S.st_k1 = load8(ROW(Kp, k0, 32 + sr)); } while (0)
#define SWRITE_HK(bf) do { *(bf16x8*)(K_lds + (bf) * SHM_K + kws) = S.st_k0; *(bf16x8*)(K_lds + (bf) * SHM_K + kws + 32 * 256) = S.st_k1; } while (0)
#define SWRITE_HV(bf) do { *(bf16x8*)(V_lds + (bf) * SHM_V + vst0) = S.st_v0; *(bf16x8*)(V_lds + (bf) * SHM_V + vst1) = S.st_v1; } while (0)
#define SWRITE_H(bf) do { SWRITE_HV(bf); SWRITE_HK(bf); } while (0)
__device__ __forceinline__ void attn_prime(const BlockRef& cur, char* lds, Seam& S) {
    const int tid = opaque_tid(), wid = __builtin_amdgcn_readfirstlane(tid >> 6), lane = tid & 63, r32 = lane & 31, hi = lane >> 5;
    const int sr = tid >> 4, sc = (tid & 15) * 8, kws = KSWZ(sr, sc * 2); char* K_lds = lds + 2 * SHM_V;
#pragma unroll
    for (int d0 = 0; d0 < 8; ++d0) S.qr[d0] = load8(cur.Q + (size_t)(wid * QBLK + r32) * D + d0 * 16 + hi * 8);
    SLOAD_H(cur.K, cur.V, 0); VMW(); SWRITE_HK(0);
    __syncthreads();
}
__device__ __forceinline__ void attn_block(const BlockRef& cur, const BlockRef& nxt, char* lds, Seam& S) {
    const int tid = opaque_tid(), wid = __builtin_amdgcn_readfirstlane(tid >> 6), lane = tid & 63, r32 = lane & 31, hi = lane >> 5;
    const int NT = (cur.P0 + QB - 1) / KVBLK + 1;
    char* V_lds = lds; char* K_lds = lds + 2 * SHM_V;
    float* wsl = (float*)(lds + 2 * SHM_V + 2 * SHM_K) + wid * 64; float* li_l = wsl, * al_l = wsl + 32;
    float m_reg = -1e30f, l_reg = 0; f32x16 o[4] = {};
    const int sr = tid >> 4, sc = (tid & 15) * 8, vst0 = v_st(sr, sc), vst1 = v_st(32 + sr, sc), kws = KSWZ(sr, sc * 2);
    const int vb0 = (int)(uintptr_t)V_lds + v_rd_base(lane);
    const bf16_t* Kh = cur.K; const bf16_t* Vh = cur.V;
    const unsigned* mrow = cur.M + (size_t)(wid * QBLK + r32) * 128;
#define RESC(a) do { if (__any((a) < 1.f)) { if (hi == 0) al_l[r32] = (a); asm volatile("s_waitcnt lgkmcnt(0)" ::: "memory");              \
                     for (int d_ = 0; d_ < 4; ++d_) for (int r = 0; r < 16; ++r) o[d_][r] *= al_l[crow(r, hi)]; } } while (0)
#define KBASE(t) ((t) * KVBLK)
#define MLOAD(t) (*(const u32x2*)(mrow + 2 * (t)))
#define SEAM_K0() do { VMWN(8); SWRITE_HK(0); SBAR(); } while (0)
    f32x16 pA0, pA1, pB0, pB1; float mnA, mnB, alA, alB; bf16x8 pa0, pa1, pa2, pa3;
    u32x2 mwA, mwB;
    SWRITE_HV(0); SBAR();
    mwA = MLOAD(0);
    SLOAD_H(Kh, Vh, KBASE(1));
    SBAR(); qkt<0>(pA0, pA1, K_lds, r32, hi, S.qr);
    mask_bits(pA0, pA1, mwA[0], mwA[1], hi); partialSM(pA0, pA1, m_reg, mnA, alA);
    VMW(); SWRITE_H(1);
    __syncthreads();
#define HALF_STEP(PX0, PX1, mnX, alX, mwX, PY0, PY1, alY, t, KB, VB, SB) do {                                                   \
        SBAR(); mwX = MLOAD(t); qkt<KB>(PX0, PX1, K_lds, r32, hi, S.qr);                                                      \
        finishSM(PY0, PY1, alY, l_reg, pa0, pa1, pa2, pa3); SBAR();                                                           \
        if ((t) + 1 < NT) { SLOAD_H(Kh, Vh, KBASE((t) + 1)); SBAR(); }                                                        \
        pv_tile<VB>(o, vb0, pa0, pa1, pa2, pa3); mask_bits(PX0, PX1, mwX[0], mwX[1], hi); partialSM(PX0, PX1, m_reg, mnX, alX); \
        __syncthreads();                                                                                                      \
        if ((t) + 1 < NT) { VMW(); SWRITE_H(SB); }                                                                            \
        RESC(alX); __syncthreads(); } while (0)
    for (int t = 1; t + 1 < NT; t += 2) {
        HALF_STEP(pB0, pB1, mnB, alB, mwB, pA0, pA1, alA, t, 1, 0, 0);
        HALF_STEP(pA0, pA1, mnA, alA, mwA, pB0, pB1, alB, t + 1, 0, 1, 1);
    }
    SBAR(); mwB = MLOAD(NT - 1); qkt<1>(pB0, pB1, K_lds, r32, hi, S.qr); SBAR();
    SLOAD_H(nxt.K, nxt.V, 0); SBAR();
#pragma unroll
    for (int d0 = 0; d0 < 8; ++d0) S.qr[d0] = load8(nxt.Q + (size_t)(wid * QBLK + r32) * D + d0 * 16 + hi * 8);
    SBAR();
    finishSM(pA0, pA1, alA, l_reg, pa0, pa1, pa2, pa3); SBAR();
    pv_tile<0>(o, vb0, pa0, pa1, pa2, pa3);
    mask_bits(pB0, pB1, mwB[0], mwB[1], hi); partialSM(pB0, pB1, m_reg, mnB, alB); __syncthreads(); RESC(alB);
    finishSM(pB0, pB1, alB, l_reg, pa0, pa1, pa2, pa3); SBAR(); pv_tile<1>(o, vb0, pa0, pa1, pa2, pa3);
    SBAR(); SEAM_K0();
    if (hi == 0) li_l[r32] = l_reg; asm volatile("s_waitcnt lgkmcnt(0)" ::: "memory");
    float rli[16];
#pragma unroll
    for (int r = 0; r < 16; ++r) rli[r] = __builtin_amdgcn_rcpf(li_l[crow(r, hi)]);
#pragma unroll
    for (int r = 0; r < 16; ++r) { const size_t ro = (size_t)(wid * QBLK + crow(r, hi)) * 1024;
#pragma unroll
        for (int d0 = 0; d0 < 4; ++d0) { const float v = o[d0][r] * rli[r];
            const float vn = __shfl_xor(v, 1);
            if ((r32 & 1) == 0) { const unsigned z = *(const unsigned*)(cur.Z + ro + d0 * 32 + r32);
                *(unsigned*)(cur.O + ro + d0 * 32 + r32) = cvt_pk_bf16(v * bflo(z), vn * bfhi(z)); } } }
    __syncthreads();
#undef RESC
#undef KBASE
#undef MLOAD
#undef SEAM_K0
#undef HALF_STEP
}
#undef ROW
#undef VMW
#undef VMWN
#undef SLOAD_H
#undef SWRITE_HK
#undef SWRITE_HV
#undef SWRITE_H
__device__ __forceinline__ BlockRef make_ref(unsigned char* ws, int item) {
    const int qb = 15 - (item >> 4), bh = item & 15, b = bh >> 3, h = bh & 7, kvh = b * 2 + (h >> 2);
    BlockRef r;
    r.Q = (const bf16_t*)(ws + WS_QN) + ((size_t)bh * SEQ + qb * QB) * D;
    r.K = (const bf16_t*)(ws + WS_KN) + (size_t)kvh * SEQ * D; r.V = (const bf16_t*)(ws + WS_VV) + (size_t)kvh * SEQ * D;
    r.M = (const unsigned*)(ws + WS_MASK) + (size_t)(b * SEQ + qb * QB) * 128;
    r.O = (bf16_t*)(ws + WS_XB) + (size_t)(b * SEQ + qb * QB) * 1024 + h * 128;
    r.Z = (const bf16_t*)(ws + WS_BZ) + (size_t)(b * SEQ + qb * QB) * 1024 + h * 128;
    r.P0 = qb * QB; return r;
}
}


#define XB_TMO      128
#define XB_XCNT(j)  (256  + 64 * (j))
#define XB_XSUB(j)  (1280 + 64 * (j))
#define XB_XGEN(j)  (2304 + 64 * (j))
#define XB_TOP      3328
#define XB_TOPGEN   3392
#define XCD_BAR_WORDS 3456
#define XB_SPIN_CAP (1u << 22)
__device__ __forceinline__ unsigned xb_ld(unsigned* p)              { return __hip_atomic_load(p, __ATOMIC_RELAXED, __HIP_MEMORY_SCOPE_AGENT); }
__device__ __forceinline__ unsigned xb_add(unsigned* p, unsigned v) { return __hip_atomic_fetch_add(p, v, __ATOMIC_RELAXED, __HIP_MEMORY_SCOPE_AGENT); }
__device__ __forceinline__ unsigned xb_xcc_id() { return (unsigned)__builtin_amdgcn_s_getreg((3 << 11) | 20) & 0xFu; }
#define XB_SPIN(cond, bar) do { unsigned _sp = 0; while (cond) { __builtin_amdgcn_s_sleep(1); \
    if ((++_sp & 255u) == 0u) { if (xb_ld(&(bar)[XB_TMO])) break; if (_sp > XB_SPIN_CAP) { atomicAdd(&(bar)[XB_TMO], 1u); break; } } } } while (0)
struct XcdBarrier { unsigned* bar; unsigned x; volatile LAS unsigned* st; };
__device__ __forceinline__ XcdBarrier xcd_barrier_post(unsigned* bar, volatile LAS unsigned* st) {
    XcdBarrier b; b.bar = bar; b.x = xb_xcc_id(); b.st = st;
    if (threadIdx.x == 0) (void)xb_add(&bar[XB_XCNT(b.x)], 1u);
    return b;
}
__device__ __forceinline__ void xcd_barrier_complete(unsigned* bar, unsigned x, unsigned& nloc, unsigned& nx) {
    const unsigned G = gridDim.x * gridDim.y * gridDim.z;
    unsigned sum, cnt, mine, sp = 0u;
    for (;;) {
        sum = 0u; cnt = 0u; mine = 0u;
#pragma unroll
        for (unsigned j = 0; j < 16; ++j) { const unsigned c = xb_ld(&bar[XB_XCNT(j)]); sum += c; cnt += (c > 0u) ? 1u : 0u; mine = (j == x) ? c : mine; }
        if (sum == G) break;
        __builtin_amdgcn_s_sleep(1);
        if ((++sp & 255u) == 0u) { if (xb_ld(&bar[XB_TMO])) break; if (sp > XB_SPIN_CAP) { atomicAdd(&bar[XB_TMO], 1u); break; } }
    }
    nloc = mine > 0u ? mine : 1u; nx = cnt > 0u ? cnt : 1u;
}
__device__ __forceinline__ void xcd_barrier(const XcdBarrier& b) {
    asm volatile("s_waitcnt vmcnt(0)" ::: "memory");
    __syncthreads();
    if (threadIdx.x == 0) {
        unsigned* bar = b.bar;
        __builtin_amdgcn_s_waitcnt(0);
        unsigned nloc = b.st[0], nx = b.st[1];
        if (nloc == 0u) { xcd_barrier_complete(bar, b.x, nloc, nx); b.st[0] = nloc; b.st[1] = nx; }
        const unsigned old = xb_add(&bar[XB_XSUB(b.x)], 1u);
        const unsigned gen = old / nloc;
        if (old + 1u == (gen + 1u) * nloc) {
            __builtin_amdgcn_fence(__ATOMIC_RELEASE, "agent");
            asm volatile("s_waitcnt vmcnt(0)" ::: "memory");
            const unsigned og = xb_add(&bar[XB_TOP], 1u);
            const unsigned tg = og / nx;
            if (og + 1u == (tg + 1u) * nx) xb_add(&bar[XB_TOPGEN], 1u);
            else XB_SPIN(xb_ld(&bar[XB_TOPGEN]) == tg, bar);
            __builtin_amdgcn_fence(__ATOMIC_ACQUIRE, "agent");
            xb_add(&bar[XB_XGEN(b.x)], 1u);
            asm volatile("s_waitcnt vmcnt(0)" ::: "memory");
        } else {
            XB_SPIN(xb_ld(&bar[XB_XGEN(b.x)]) == gen, bar);
            __builtin_amdgcn_fence(__ATOMIC_ACQUIRE, "agent");
            asm volatile("s_waitcnt vmcnt(0)" ::: "memory");
        }
    }
    __syncthreads();
}

constexpr int CW_EXIT = XCD_BAR_WORDS, CW_WORDS = XCD_BAR_WORDS + 64;
__device__ unsigned g_ctl[CW_WORDS];

__global__ void __launch_bounds__(NTHREADS, 2) fwd_mega(Params p) {
    extern __shared__ __attribute__((aligned(16))) unsigned char lds_raw[];
    cg::grid_group grid = cg::this_grid();
    LAS unsigned char* lds = (LAS unsigned char*)lds_raw;
    const int G = gridDim.x, bx = blockIdx.x;
    const int vcu = (G % 8 == 0) ? (bx % 8) * (G / 8) + bx / 8 : bx;
    unsigned char* ws = p.ws;
    volatile LAS unsigned* misc = (volatile LAS unsigned*)(lds + MISC_OFF);
    if (threadIdx.x < 2) misc[threadIdx.x] = 0u;
    __syncthreads();
    if (p.out == nullptr) grid.sync();
    const XcdBarrier gbar = xcd_barrier_post(g_ctl, misc);
#define GRID_SYNC() xcd_barrier(gbar)

#ifndef PHASES
#define PHASES 0xffff
#endif
#ifndef REPMASK
#define REPMASK 0
#endif
#define NREP(bit) ((REPMASK & (bit)) ? 2 : 1)
    for (int rep = 0; rep < NREP(1); ++rep) if (PHASES & 1) p0_prep(p, lds, vcu, G);
    GRID_SYNC();
    for (int rep = 0; rep < NREP(2); ++rep) if (PHASES & 2) {
        Sched1 S{G, bx, (const char*)ws};
        Epi1 E{ws, p.ik_g, p.ik_b};
        pg8::gemm_phase<Epi1, Sched1, true, true>(lds, DM, S, E);
    }
    GRID_SYNC();
    for (int rep = 0; rep < NREP(4); ++rep) if (PHASES & 4) p2_qkprep(p, vcu, G);
    for (int rep = 0; rep < NREP(8); ++rep) if (PHASES & 8) for (int u = bx; u < 512; u += G) p2_gmlp_unit(p, lds, u);
    for (int rep = 0; rep < NREP(16); ++rep) if (PHASES & 16) for (int u = bx; u < 256; u += G) p2_mem_unit(p, lds, u);
    for (int rep = 0; rep < NREP(32); ++rep) if (PHASES & 32) for (int pr = bx; pr < 512; pr += G) { const int b = pr >> 8, idx = pr & 255; p2_idx_unit(p, lds, b, 511 - idx); p2_idx_unit(p, lds, b, idx); }
    GRID_SYNC();
    for (int rep = 0; rep < NREP(64); ++rep) if (PHASES & 64) {
        int L = bx;
        if (L < 256) {
            att::Seam S; att::BlockRef cur = att::make_ref(ws, L);
            att::attn_prime(cur, (char*)lds_raw, S);
            for (;;) {
                const bool more = L + G < 256; const int Ln = more ? L + G : L;
                const att::BlockRef nxt = more ? att::make_ref(ws, Ln) : cur;
                att::attn_block(cur, nxt, (char*)lds_raw, S);
                if (!more) break;
                cur = nxt; L = Ln;
            }
        }
    }
    GRID_SYNC();
    for (int rep = 0; rep < NREP(128); ++rep) if (PHASES & 128) {
        Sched2 S{G, bx, (const char*)ws};
        Epi2 E{ws};
        pg8::gemm_phase<Epi2, Sched2, true, true>(lds, 1024, S, E);
    }
    GRID_SYNC();
    if (REPMASK & 512) { for (int i = 0; i < 10; ++i) GRID_SYNC(); }
    for (int rep = 0; rep < NREP(256); ++rep) if (PHASES & 256) {
        Sched3 S{G, bx, (const char*)(ws + WS_MERGED), (const char*)(ws + WS_WOUT)};
        Epi3 E{p.x, p.out};
        pg8::gemm_phase<Epi3, Sched3, true, true>(lds, DM, S, E);
    }
    __syncthreads();
    if (threadIdx.x == 0) misc[0] = (xb_add(&g_ctl[CW_EXIT], 1u) == (unsigned)G - 1u) ? 1u : 0u;
    __syncthreads();
    if (misc[0]) { for (int i = threadIdx.x; i < CW_WORDS; i += NTHREADS) __hip_atomic_store(&g_ctl[i], 0u, __ATOMIC_RELAXED, __HIP_MEMORY_SCOPE_AGENT); }
}

extern "C" void kernel_launch(void* const* d_in, const int* in_sizes, int n_in, void* d_out, int out_size, void* d_ws, size_t ws_size, hipStream_t stream) {
    static int grid_blocks = 0;
    if (!grid_blocks) {
        if (n_in != 21 || out_size != T * DM || ws_size < WS_TOTAL) { fprintf(stderr, "kernel_launch: unexpected shapes (n_in %d out %d ws %zu)\n", n_in, out_size, ws_size); grid_blocks = -1; return; }
        int dev = 0, cus = 0, per_cu = 0;
        (void)hipGetDevice(&dev);
        (void)hipDeviceGetAttribute(&cus, hipDeviceAttributeMultiprocessorCount, dev);
        (void)hipFuncSetAttribute((const void*)fwd_mega, hipFuncAttributeMaxDynamicSharedMemorySize, LDS_BYTES);
        (void)hipOccupancyMaxActiveBlocksPerMultiprocessor(&per_cu, (const void*)fwd_mega, NTHREADS, LDS_BYTES);
        if (per_cu < 1) { fprintf(stderr, "kernel_launch: occupancy query returned %d\n", per_cu); grid_blocks = -1; return; }
        grid_blocks = cus;
        fprintf(stderr, "kernel_launch: cus %d per_cu %d grid %d\n", cus, per_cu, grid_blocks);
    }
    if (grid_blocks < 0) return;
    Params p{};
    p.x = (const float*)d_in[0]; p.mem = (const float*)d_in[1]; p.pos = (const int*)d_in[2]; p.norm_gain = (const float*)d_in[3]; p.w_in = (const float*)d_in[4];
    p.gmlp_g = (const float*)d_in[5]; p.gmlp_b = (const float*)d_in[6]; p.spatial_w = (const float*)d_in[7]; p.spatial_b = (const float*)d_in[8]; p.w_a = (const float*)d_in[9];
    p.q_gain = (const float*)d_in[10]; p.k_gain = (const float*)d_in[11]; p.ik_g = (const float*)d_in[12]; p.ik_b = (const float*)d_in[13]; p.w_b = (const float*)d_in[14];
    p.mem_gain = (const float*)d_in[15]; p.w_mkv = (const float*)d_in[16]; p.mq_gain = (const float*)d_in[17]; p.mk_gain = (const float*)d_in[18]; p.w_m = (const float*)d_in[19];
    p.w_out = (const float*)d_in[20]; p.out = (float*)d_out; p.ws = (unsigned char*)d_ws;
    void* args[] = {&p};
    hipError_t e = hipLaunchCooperativeKernel((const void*)fwd_mega, dim3(grid_blocks), dim3(NTHREADS), args, LDS_BYTES, stream);
    if (e != hipSuccess) fprintf(stderr, "cooperative launch failed: %s (grid %d)\n", hipGetErrorString(e), grid_blocks);
}
```

```cpp
#include <hip/hip_runtime.h>
#include <hip/hip_cooperative_groups.h>
#include <cstdio>
#include <cstdint>
namespace cg = cooperative_groups;

#define LAS __attribute__((address_space(3)))
typedef unsigned short bf16_t;
typedef short bf16x8 __attribute__((ext_vector_type(8)));
typedef short s16x4 __attribute__((ext_vector_type(4)));
typedef float f32x2 __attribute__((ext_vector_type(2)));
typedef float f32x4 __attribute__((ext_vector_type(4)));
typedef float f32x16 __attribute__((ext_vector_type(16)));
typedef unsigned u32x2 __attribute__((ext_vector_type(2)));
typedef unsigned u32x4 __attribute__((ext_vector_type(4)));
typedef int i32x4 __attribute__((ext_vector_type(4)));

constexpr int NB = 2, SEQ = 4096, T = NB * SEQ, DM = 2048, DIN = 14928, NPAD = 15104, MEML = 256;
constexpr int NTHREADS = 512, NWAVES = 8;
constexpr int LDS_BYTES = 147456;
constexpr float EPS = 1e-6f;
constexpr float LOG2E = 1.4426950408889634f;

constexpr size_t MiB = (size_t)1 << 20;
constexpr size_t WS_WIN = 0, WS_WBR = 60 * MiB, WS_WOUT = 72 * MiB, WS_WMKV = 80 * MiB, WS_H = 88 * MiB, WS_MEMN = 120 * MiB;
constexpr size_t WS_AU = 122 * MiB, WS_AV = 138 * MiB, WS_AZ = 154 * MiB, WS_QR = 170 * MiB, WS_BZ = 186 * MiB, WS_MQ = 202 * MiB, WS_MZ = 218 * MiB;
constexpr size_t WS_IQ = 234 * MiB, WS_KR = 250 * MiB, WS_VV = 254 * MiB, WS_SA = 258 * MiB, WS_SB = 290 * MiB, WS_SM = 322 * MiB;
constexpr size_t WS_QN = 354 * MiB, WS_KN = 370 * MiB, WS_XA = 374 * MiB, WS_XM = 390 * MiB, WS_MASK = 406 * MiB, WS_IK = 410 * MiB, WS_IW = 411 * MiB;
constexpr size_t WS_KM = 412 * MiB, WS_VT = 413 * MiB, WS_CSB = 414 * MiB, WS_CSI = 415 * MiB, WS_END = 416 * MiB;
constexpr size_t WS_RKP = WS_IW + 524288;
constexpr size_t WS_OPART = WS_END, WS_ML = WS_END + 32 * MiB, WS_TOTAL = WS_END + 34 * MiB;
constexpr size_t WS_CTL = WS_END, CTL_BYTES = 65536;
constexpr int NGATE = 8192, GATE0 = 6736, NT_BF = 27;
constexpr size_t WS_LNP = 48 * MiB;
constexpr size_t WS_W8 = 27 * MiB, WS_SH = 47 * MiB, WS_SW = 47 * MiB + 65536, WS_CMP = 47 * MiB + 131072, WS_H8 = WS_OPART;
static_assert(WS_W8 + (size_t)NGATE * DM <= WS_SH && WS_CMP + 8 * NGATE * 4 <= WS_WBR && (size_t)NT_BF * 256 * DM * 2 <= WS_W8, "int8 regions inside the WS_WIN slot");
constexpr int CW_BAR = 0;
constexpr int MISC_OFF = 147200;
constexpr size_t WS_XB = WS_QR;
constexpr size_t WS_MERGED = WS_H;

typedef __bf16 bf16x2_t __attribute__((ext_vector_type(2)));
__device__ __forceinline__ unsigned cvt_pk_bf16(float lo, float hi) { const f32x2 v = {lo, hi}; const bf16x2_t b = __builtin_convertvector(v, bf16x2_t); return __builtin_bit_cast(unsigned, b); }
__device__ __forceinline__ bf16_t f2bf(float f) { return (bf16_t)(cvt_pk_bf16(f, 0.f) & 0xffffu); }
__device__ __forceinline__ float bf2f(unsigned short b) { return __uint_as_float(((unsigned)b) << 16); }
__device__ __forceinline__ float bflo(unsigned w) { return __uint_as_float(w << 16); }
__device__ __forceinline__ float bfhi(unsigned w) { return __uint_as_float(w & 0xffff0000u); }
__device__ __forceinline__ float sigm(float x) { return __builtin_amdgcn_rcpf(1.f + __builtin_amdgcn_exp2f(-LOG2E * x)); }
__device__ __forceinline__ float silu_f(float x) { return x * sigm(x); }
__device__ __forceinline__ float gelu_f(float x) { const float u = 0.7978845608028654f * (x + 0.044715f * x * x * x); return x * sigm(2.f * u); }
__device__ __forceinline__ float wave_sum(float v) {
#pragma unroll
    for (int o = 1; o < 64; o <<= 1) v += __shfl_xor(v, o);
    return v;
}
__device__ __forceinline__ unsigned wave_sum_u(unsigned v) {
#pragma unroll
    for (int o = 1; o < 64; o <<= 1) v += (unsigned)__shfl_xor((int)v, o);
    return v;
}
__device__ __forceinline__ bf16x8 pack8(f32x4 a, f32x4 b) {
    u32x4 w = {cvt_pk_bf16(a[0], a[1]), cvt_pk_bf16(a[2], a[3]), cvt_pk_bf16(b[0], b[1]), cvt_pk_bf16(b[2], b[3])};
    return *reinterpret_cast<bf16x8*>(&w);
}
#define LDS_WAIT() asm volatile("s_waitcnt lgkmcnt(0)" ::: "memory")
__device__ __forceinline__ int opaque_tid() { int t = threadIdx.x; asm volatile("" : "+v"(t)); return t; }

namespace pg8 {
constexpr int BM = 256, BK = 64, HALF = 128, HTB = HALF * BK * 2, STAGE_BYTES = 8 * HTB, NXCD = 8, WGM = 8;
__host__ __device__ __forceinline__ int lds_byte(int r, int c) { const int st = (r >> 4) * 2 + (c >> 5), rr = r & 15, cc = c & 31, ob = rr * 64 + cc * 2; return st * 1024 + (ob ^ (((ob >> 9) & 1) << 5)); }
__host__ __device__ __forceinline__ void stage_rc(int b, int& R, int& C) { const int st = b / 1024, sb = b % 1024, swz = sb ^ (((sb >> 9) & 1) << 5); R = (st >> 1) * 16 + swz / 64; C = (st & 1) * 32 + (swz % 64) / 2; }
__host__ __device__ __forceinline__ int perm32(int rho) { const int n = rho >> 4, i = rho & 15; return 8 * (i >> 2) + 4 * n + (i & 3); }

struct Unit { int pm, pn, kind; };

__device__ __forceinline__ void tile_order(int wgid, int nM, int nN, int& pm, int& pn) {
    const int nwg = nM * nN;
    { const int q = nwg / NXCD, r = nwg % NXCD, xcd = wgid % NXCD, off = wgid / NXCD; wgid = (xcd < r ? xcd * (q + 1) : r * (q + 1) + (xcd - r) * q) + off; }
    const int nig = WGM * nN, gid = wgid / nig, fm = gid * WGM, gsz = (nM - fm) < WGM ? (nM - fm) : WGM;
    pm = fm + ((wgid % nig) % gsz); pn = (wgid % nig) / gsz;
}

template <class Epi, class Sched, bool ALIGN_EPI, bool SP2, bool I8 = false>
__device__ __forceinline__ void gemm_phase(LAS unsigned char* lds, const int K, const Sched& S, const Epi& E) {
    const int tid = opaque_tid(), wid = __builtin_amdgcn_readfirstlane(tid >> 6), lane = tid & 63, wr = wid >> 2, wc = wid & 3, fr = lane & 15, fq = lane >> 4;
    const int nt = K / BK;
    unsigned voffA[2], voffB[2];
#pragma unroll
    for (int i = 0; i < 2; ++i) { int R, C; stage_rc(tid * 16 + i * 8192, R, C); const int Rb = Epi::PERM ? ((R & ~31) + perm32(R & 31)) : R;
        voffA[i] = (unsigned)(R * K + C) * 2u; voffB[i] = (unsigned)(Rb * K + C) * 2u; }
    const size_t kstep = (size_t)(BK * 2);
    const size_t hstep = (size_t)HALF * K * 2;
    const unsigned ldsw = (unsigned)wid * 1024u;
    const int aoff = lds_byte(wr * 64 + fr, fq * 8), boff = lds_byte(wc * 32 + fr, fq * 8);
#define PG8_SA(b, h) (((b) * 2 + (h)) * HTB)
#define PG8_SB(b, h) ((4 + (b) * 2 + (h)) * HTB)
#define PG8_STAGE(bufoff, gbase, voff) do { _Pragma("unroll") for (int _i = 0; _i < 2; ++_i) \
        __builtin_amdgcn_global_load_lds((const unsigned*)((const char*)(gbase) + (voff)[_i]), (LAS unsigned*)(lds + (bufoff) + ldsw + _i * 8192), 16, 0, 0); } while (0)
#define PG8_LDA(dst, b, h) do { _Pragma("unroll") for (int m = 0; m < 4; ++m) _Pragma("unroll") for (int k = 0; k < 2; ++k) dst[m][k] = *(const LAS bf16x8*)(lds + PG8_SA(b, h) + aoff + m * 2048 + k * 1024); } while (0)
#define PG8_LDB(dst, b, h) do { _Pragma("unroll") for (int n = 0; n < 2; ++n) _Pragma("unroll") for (int k = 0; k < 2; ++k) dst[n][k] = *(const LAS bf16x8*)(lds + PG8_SB(b, h) + boff + n * 2048 + k * 1024); } while (0)
#define PG8_MMA(ai, bj, At, Bt) do { __builtin_amdgcn_s_setprio(1); _Pragma("unroll") for (int m = 0; m < 4; ++m) _Pragma("unroll") for (int n = 0; n < 2; ++n) _Pragma("unroll") for (int k = 0; k < 2; ++k) \
        { if constexpr (I8) acc[ai][bj][m][n] = __builtin_bit_cast(f32x4, __builtin_amdgcn_mfma_i32_16x16x64_i8(__builtin_bit_cast(i32x4, Bt[n][k]), __builtin_bit_cast(i32x4, At[m][k]), __builtin_bit_cast(i32x4, acc[ai][bj][m][n]), 0, 0, 0)); \
          else acc[ai][bj][m][n] = __builtin_amdgcn_mfma_f32_16x16x32_bf16(Bt[n][k], At[m][k], acc[ai][bj][m][n], 0, 0, 0); } __builtin_amdgcn_s_setprio(0); } while (0)
#define PG8_WAIT_V(n) asm volatile("s_waitcnt vmcnt(" #n ")" ::: "memory")
#define PG8_WAIT_L(n) asm volatile("s_waitcnt lgkmcnt(" #n ")" ::: "memory")
#define PG8_BAR __builtin_amdgcn_s_barrier()
#define PG8_SCHED __builtin_amdgcn_sched_barrier(0)
    Unit cur, nxt; int ui = 0;
    if (!S.next(0, cur)) return;
    f32x4 acc[2][2][4][2];
    if constexpr (Epi::INIT) E.init(acc, cur, wr, wc, fr, fq);
    else {
#pragma unroll
    for (int a = 0; a < 2; ++a)
#pragma unroll
        for (int b = 0; b < 2; ++b)
#pragma unroll
            for (int m = 0; m < 4; ++m)
#pragma unroll
                for (int n = 0; n < 2; ++n) acc[a][b][m][n] = (f32x4){0.f, 0.f, 0.f, 0.f};
    }
    bf16x8 At[4][2], B0[2][2], B1[2][2];
    const char* cA = S.a_base(cur); const char* cB = S.b_base(cur);
    if constexpr (SP2) {
        PG8_STAGE(PG8_SB(0, 0), cB, voffB); PG8_STAGE(PG8_SB(0, 1), cB + hstep, voffB); PG8_STAGE(PG8_SA(0, 0), cA, voffA); PG8_STAGE(PG8_SA(0, 1), cA + hstep, voffA);
        if (wr == 1) PG8_BAR;
        PG8_WAIT_V(2); PG8_BAR;
        PG8_STAGE(PG8_SB(1, 0), cB + kstep, voffB); PG8_STAGE(PG8_SA(1, 0), cA + kstep, voffA); PG8_STAGE(PG8_SB(1, 1), cB + hstep + kstep, voffB);
        PG8_WAIT_V(6); PG8_BAR;
    } else {
        PG8_STAGE(PG8_SB(0, 0), cB, voffB); PG8_STAGE(PG8_SA(0, 0), cA, voffA); PG8_STAGE(PG8_SB(0, 1), cB + hstep, voffB); PG8_STAGE(PG8_SA(0, 1), cA + hstep, voffA);
        if (wr == 1) PG8_BAR;
        PG8_WAIT_V(4); PG8_BAR;
        PG8_STAGE(PG8_SB(1, 0), cB + kstep, voffB); PG8_STAGE(PG8_SA(1, 0), cA + kstep, voffA); PG8_STAGE(PG8_SB(1, 1), cB + hstep + kstep, voffB);
        PG8_WAIT_V(6); PG8_BAR;
    }
    for (;;) {
        const bool has_next = S.next(ui + 1, nxt);
        const char* nA = has_next ? S.a_base(nxt) : cA; const char* nB = has_next ? S.b_base(nxt) : cB;
        for (int t = 0; t < nt; t += 2) {
            const bool last = (t == nt - 2);
            const char* a1 = cA + (size_t)(t + 1) * kstep;
            const char* a2 = last ? nA : cA + (size_t)(t + 2) * kstep; const char* b2 = last ? nB : cB + (size_t)(t + 2) * kstep;
            const char* a3 = a2 + kstep; const char* b3 = b2 + kstep;
            if constexpr (SP2) {
            PG8_LDB(B0, 0, 0); PG8_LDB(B1, 0, 1); PG8_SCHED; PG8_LDA(At, 0, 0); PG8_STAGE(PG8_SA(1, 1), a1 + hstep, voffA);
            PG8_WAIT_V(8); PG8_WAIT_L(0); PG8_BAR; PG8_MMA(0, 0, At, B0); PG8_MMA(0, 1, At, B1); PG8_BAR; PG8_SCHED;
            PG8_LDA(At, 0, 1); PG8_STAGE(PG8_SB(0, 0), b2, voffB); PG8_STAGE(PG8_SB(0, 1), b2 + hstep, voffB); PG8_STAGE(PG8_SA(0, 0), a2, voffA);
            PG8_WAIT_V(8); PG8_WAIT_L(0); PG8_BAR; PG8_MMA(1, 0, At, B0); PG8_MMA(1, 1, At, B1); PG8_BAR; PG8_SCHED;
            PG8_LDB(B0, 1, 0); PG8_LDB(B1, 1, 1); PG8_SCHED; PG8_LDA(At, 1, 0); PG8_STAGE(PG8_SA(0, 1), a2 + hstep, voffA);
            PG8_WAIT_V(8); PG8_WAIT_L(0); PG8_BAR; PG8_MMA(0, 0, At, B0); PG8_MMA(0, 1, At, B1); PG8_BAR; PG8_SCHED;
            PG8_LDA(At, 1, 1); PG8_STAGE(PG8_SB(1, 0), b3, voffB); PG8_STAGE(PG8_SB(1, 1), b3 + hstep, voffB); PG8_STAGE(PG8_SA(1, 0), a3, voffA);
            PG8_WAIT_V(8); PG8_WAIT_L(0); PG8_BAR; PG8_MMA(1, 0, At, B0); PG8_MMA(1, 1, At, B1); PG8_BAR; PG8_SCHED;
            } else {
            PG8_LDB(B0, 0, 0); PG8_SCHED; PG8_LDA(At, 0, 0); PG8_STAGE(PG8_SA(1, 1), a1 + hstep, voffA);
            PG8_WAIT_L(8); PG8_BAR; PG8_WAIT_L(0); PG8_MMA(0, 0, At, B0); PG8_BAR; PG8_SCHED;
            PG8_LDB(B1, 0, 1); PG8_STAGE(PG8_SB(0, 0), b2, voffB);
            PG8_BAR; PG8_WAIT_L(0); PG8_MMA(0, 1, At, B1); PG8_BAR;
            PG8_LDA(At, 0, 1); PG8_STAGE(PG8_SA(0, 0), a2, voffA);
            PG8_BAR; PG8_WAIT_L(0); PG8_MMA(1, 0, At, B0); PG8_BAR; PG8_SCHED;
            PG8_STAGE(PG8_SB(0, 1), b2 + hstep, voffB);
            PG8_WAIT_V(6); PG8_BAR; PG8_MMA(1, 1, At, B1); PG8_BAR;
            PG8_LDB(B0, 1, 0); PG8_SCHED; PG8_LDA(At, 1, 0); PG8_STAGE(PG8_SA(0, 1), a2 + hstep, voffA);
            PG8_WAIT_L(8); PG8_BAR; PG8_WAIT_L(0); PG8_MMA(0, 0, At, B0); PG8_BAR; PG8_SCHED;
            PG8_LDB(B1, 1, 1); PG8_STAGE(PG8_SB(1, 0), b3, voffB);
            PG8_BAR; PG8_WAIT_L(0); PG8_MMA(0, 1, At, B1); PG8_BAR;
            PG8_LDA(At, 1, 1); PG8_STAGE(PG8_SA(1, 0), a3, voffA);
            PG8_BAR; PG8_WAIT_L(0); PG8_MMA(1, 0, At, B0); PG8_BAR; PG8_SCHED;
            PG8_STAGE(PG8_SB(1, 1), b3 + hstep, voffB);
            PG8_WAIT_V(6); PG8_BAR; PG8_MMA(1, 1, At, B1); PG8_BAR;
            }
        }
        if constexpr (ALIGN_EPI) { if (wr == 0) PG8_BAR; }
        const bool zero = E(acc, cur, wr, wc, fr, fq);
        if (!has_next) break;
        if constexpr (Epi::INIT) { E.init(acc, nxt, wr, wc, fr, fq); }
        else if (zero) {
#pragma unroll
        for (int a = 0; a < 2; ++a)
#pragma unroll
            for (int b = 0; b < 2; ++b)
#pragma unroll
                for (int m = 0; m < 4; ++m)
#pragma unroll
                    for (int n = 0; n < 2; ++n) acc[a][b][m][n] = (f32x4){0.f, 0.f, 0.f, 0.f};
        }
        cur = nxt; cA = nA; cB = nB; ++ui;
        if constexpr (ALIGN_EPI) { if (wr == 1) PG8_BAR; }
    }
    PG8_WAIT_V(0);
    if constexpr (!ALIGN_EPI) { if (wr == 0) PG8_BAR; }
    PG8_BAR;
#undef PG8_SA
#undef PG8_SB
#undef PG8_STAGE
#undef PG8_LDA
#undef PG8_LDB
#undef PG8_MMA
#undef PG8_WAIT_V
#undef PG8_WAIT_L
#undef PG8_BAR
#undef PG8_SCHED
}
}

struct Params {
    const float* x; const float* mem; const int* pos; const float* norm_gain; const float* w_in; const float* gmlp_g; const float* gmlp_b;
    const float* spatial_w; const float* spatial_b; const float* w_a; const float* q_gain; const float* k_gain; const float* ik_g; const float* ik_b;
    const float* w_b; const float* mem_gain; const float* w_mkv; const float* mq_gain; const float* mk_gain; const float* w_m; const float* w_out;
    float* out; unsigned char* ws;
};

__device__ unsigned g_colmax[8192];

__device__ __forceinline__ int win_src_col(int np) {
    const int tile = np >> 8, c = np & 255;
    if (tile < 22) return np;
    const int bj = c >> 7, wc = (c >> 5) & 3, fq = (c >> 3) & 3, j = c & 7;
    if (tile < 26) return 5632 + (tile - 22) * 256 + wc * 64 + 8 * (2 * fq + bj) + j;
    if (tile == 26) {
        if (wc == 0) return 6656 + 8 * (2 * fq + bj) + j;
        if (wc == 1 && fq == 0) return 6720 + 8 * bj + j;
        return -1;
    }
    return np - 176;
}
__device__ __forceinline__ void transpose_item(const float* W, int K, int N, bf16_t* WT, int kb, int nb, bool is_win, LAS float* scr, int lane) {
    const int k0 = 64 * kb, n0 = 32 * nb, nl = lane & 31;
    const int src = is_win ? win_src_col(n0 + nl) : (n0 + nl);
    const float* wp = W + (size_t)(k0 + (lane >> 5)) * N + (src >= 0 ? src : 0);
    float tv[32];
#pragma unroll
    for (int i = 0; i < 32; ++i) tv[i] = wp[(size_t)(2 * i) * N];
#pragma unroll
    for (int i = 0; i < 32; ++i) { const int kk = 2 * i + (lane >> 5); scr[kk * 33 + nl] = src >= 0 ? tv[i] : 0.f; }
    LDS_WAIT(); asm volatile("" ::: "memory");
    const int c = lane & 7;
#pragma unroll
    for (int j = 0; j < 4; ++j) { const int n = (lane >> 3) + 8 * j; const LAS float* s = scr + (8 * c) * 33 + n;
        u32x4 o; o.x = cvt_pk_bf16(s[0 * 33], s[1 * 33]); o.y = cvt_pk_bf16(s[2 * 33], s[3 * 33]); o.z = cvt_pk_bf16(s[4 * 33], s[5 * 33]); o.w = cvt_pk_bf16(s[6 * 33], s[7 * 33]);
        *(u32x4*)(WT + (size_t)(n0 + n) * K + k0 + 8 * c) = o; }
    LDS_WAIT(); asm volatile("" ::: "memory");
}
template <bool Q8>
__device__ __forceinline__ void rms_row(const float* xrow, const float* gain, bf16_t* orow, unsigned* q8row, float* q8scale, int lane) {
    f32x4 v[8]; float s = 0.f;
#pragma unroll
    for (int j = 0; j < 8; ++j) { v[j] = ((const f32x4*)xrow)[lane + 64 * j]; s += (v[j][0] * v[j][0] + v[j][1] * v[j][1]) + (v[j][2] * v[j][2] + v[j][3] * v[j][3]); }
    s = wave_sum(s);
    const float r = 1.0f / sqrtf(s * (1.0f / DM) + EPS);
    float am = 0.f;
#pragma unroll
    for (int j = 0; j < 8; ++j) { const f32x4 g = ((const f32x4*)gain)[lane + 64 * j]; v[j] = v[j] * r * g;
        u32x2 w; w.x = cvt_pk_bf16(v[j][0], v[j][1]); w.y = cvt_pk_bf16(v[j][2], v[j][3]); ((u32x2*)orow)[lane + 64 * j] = w;
        if (Q8) am = fmaxf(fmaxf(am, fmaxf(fabsf(v[j][0]), fabsf(v[j][1]))), fmaxf(fabsf(v[j][2]), fabsf(v[j][3]))); }
    if (Q8) {
#pragma unroll
        for (int o = 1; o < 64; o <<= 1) am = fmaxf(am, __shfl_xor(am, o));
        const float inv = am > 0.f ? 127.f / am : 0.f;
#pragma unroll
        for (int j = 0; j < 8; ++j) { const int q0 = (int)rintf(v[j][0] * inv), q1 = (int)rintf(v[j][1] * inv), q2 = (int)rintf(v[j][2] * inv), q3 = (int)rintf(v[j][3] * inv);
            q8row[lane + 64 * j] = (unsigned)(q0 & 0xff) | ((unsigned)(q1 & 0xff) << 8) | ((unsigned)(q2 & 0xff) << 16) | ((unsigned)(q3 & 0xff) << 24); }
        if (lane == 0) *q8scale = am * (1.f / 127.f);
    }
}
__device__ __forceinline__ void p0_prep(const Params& p, LAS unsigned char* lds, int vcu, int G) {
    const int tid = opaque_tid(), lane = tid & 63, wave = tid >> 6;
    LAS float* scr = (LAS float*)(lds + wave * 16384);
    const int gw = vcu * NWAVES + wave, NGW = G * NWAVES;
    unsigned char* ws = p.ws;
    constexpr int I_CM = 32 * 32, I_WIN = 32 * (NT_BF * 8), I_BR = 16 * 64, I_SQ = 32 * 64;
    constexpr int NITEMS = I_CM + I_WIN + 3 * I_BR + 2 * I_SQ;
    for (int it = gw; it < NITEMS; it += NGW) {
        int r = it;
        if (r < I_CM) {
            const int cg = r % 32, kc = r / 32; const float* wp = p.w_in + (size_t)(64 * kc) * DIN + GATE0 + 256 * cg + 4 * lane; f32x4 m = {0.f, 0.f, 0.f, 0.f};
#pragma unroll 32
            for (int k = 0; k < 64; ++k) { const f32x4 w = *(const f32x4*)(wp + (size_t)k * DIN); m[0] = fmaxf(m[0], fabsf(w[0])); m[1] = fmaxf(m[1], fabsf(w[1])); m[2] = fmaxf(m[2], fabsf(w[2])); m[3] = fmaxf(m[3], fabsf(w[3])); }
#pragma unroll
            for (int e = 0; e < 4; ++e) atomicMax(&g_colmax[256 * cg + 4 * lane + e], __float_as_uint(m[e]));
            continue; } r -= I_CM;
        if (r < I_WIN) { const int nb = r % (NT_BF * 8), kb = r / (NT_BF * 8); transpose_item(p.w_in, DM, DIN, (bf16_t*)(ws + WS_WIN), kb, nb, true, scr, lane); continue; } r -= I_WIN;
        if (r < 3 * I_BR) { const int br = r / I_BR, q = r % I_BR; const float* W = br == 0 ? p.w_a : (br == 1 ? p.w_b : p.w_m);
            transpose_item(W, 1024, DM, (bf16_t*)(ws + WS_WBR) + (size_t)br * DM * 1024, q / 64, q % 64, false, scr, lane); continue; } r -= 3 * I_BR;
        if (r < I_SQ) { transpose_item(p.w_out, DM, DM, (bf16_t*)(ws + WS_WOUT), r / 64, r % 64, false, scr, lane); continue; } r -= I_SQ;
        transpose_item(p.w_mkv, DM, DM, (bf16_t*)(ws + WS_WMKV), r / 64, r % 64, false, scr, lane);
    }
    for (int m = gw; m < T + NB * MEML; m += NGW) {
        if (m < T) rms_row<true>(p.x + (size_t)m * DM, p.norm_gain, (bf16_t*)(ws + WS_H) + (size_t)m * DM, (unsigned*)(ws + WS_H8) + (size_t)m * (DM / 4), (float*)(ws + WS_SH) + m, lane);
        else rms_row<false>(p.mem + (size_t)(m - T) * DM, p.mem_gain, (bf16_t*)(ws + WS_MEMN) + (size_t)(m - T) * DM, nullptr, nullptr, lane);
    }
    for (int i = vcu * NTHREADS + tid; i < T * 24; i += G * NTHREADS) {
        const int t = i / 24, j = i % 24; const float ps = (float)p.pos[t];
        float inv; if (j < 16) inv = powf(500000.0f, -(float)j / 16.0f); else inv = powf(500000.0f, -(float)(j - 16) / 8.0f);
        float sn, cs; sincosf(ps * inv, &sn, &cs);
        if (j < 16) ((f32x2*)(ws + WS_CSB))[t * 16 + j] = (f32x2){cs, sn}; else ((f32x2*)(ws + WS_CSI))[t * 8 + (j - 16)] = (f32x2){cs, sn};
    }
}
__device__ __forceinline__ void p0b_gate8(const Params& p, LAS unsigned char* lds, int widx, int nw) {
    const int tid = opaque_tid(), lane = tid & 63, wave = tid >> 6;
    LAS float* scr = (LAS float*)(lds + wave * 16384);
    const int gw = widx * NWAVES + wave, NGW = nw * NWAVES;
    unsigned char* ws = p.ws;
    for (int it = gw; it < 32 * (NGATE / 32); it += NGW) {
        const int nb = it % (NGATE / 32), kb = it / (NGATE / 32), k0 = 64 * kb, n0 = 32 * nb, nl = lane & 31;
        const float cm = __uint_as_float(__hip_atomic_load(&g_colmax[n0 + nl], __ATOMIC_RELAXED, __HIP_MEMORY_SCOPE_AGENT));
        const float inv = cm > 0.f ? 127.f / cm : 0.f;
        if (kb == 0 && lane < 32) ((float*)(ws + WS_SW))[n0 + nl] = cm * (1.f / 127.f);
        const float* wp = p.w_in + (size_t)(k0 + (lane >> 5)) * DIN + GATE0 + n0 + nl;
        float tv[32];
#pragma unroll
        for (int i = 0; i < 32; ++i) tv[i] = wp[(size_t)(2 * i) * DIN];
#pragma unroll
        for (int i = 0; i < 32; ++i) { const int kk = 2 * i + (lane >> 5); scr[kk * 33 + nl] = rintf(tv[i] * inv); }
        LDS_WAIT(); asm volatile("" ::: "memory");
        const int c = lane & 7;
#pragma unroll
        for (int j = 0; j < 4; ++j) { const int n = (lane >> 3) + 8 * j; const LAS float* sp = scr + (8 * c) * 33 + n;
            unsigned lo = 0, hi2 = 0;
#pragma unroll
            for (int e = 0; e < 4; ++e) { lo |= ((unsigned)((int)sp[e * 33]) & 0xffu) << (8 * e); hi2 |= ((unsigned)((int)sp[(4 + e) * 33]) & 0xffu) << (8 * e); }
            *(u32x2*)((unsigned char*)(ws + WS_W8) + (size_t)(n0 + n) * DM + k0 + 8 * c) = (u32x2){lo, hi2}; }
        LDS_WAIT(); asm volatile("" ::: "memory");
    }
}

struct Sched1 {
    int G, c; const char* ws;
    __device__ __forceinline__ bool next(int i, pg8::Unit& u) const {
        int L = i * G + c;
        if (L < 32 * NT_BF) { pg8::tile_order(L, 32, NT_BF, u.pm, u.pn); u.kind = 0; return true; }
        L -= 32 * NT_BF;
        if (L < 8) { u.pm = L & 1; u.pn = L >> 1; u.kind = 1; return true; }
        L -= 8;
        if (L < 8) { u.pm = L & 3; u.pn = L >> 2; u.kind = 2; return true; }
        return false;
    }
    __device__ __forceinline__ const char* a_base(const pg8::Unit& u) const {
        const size_t off = u.kind == 0 ? WS_H : (u.kind == 1 ? WS_MEMN : WS_WMKV + (size_t)1024 * DM * 2);
        return ws + off + (size_t)u.pm * (256 * DM * 2); }
    __device__ __forceinline__ const char* b_base(const pg8::Unit& u) const {
        const size_t off = u.kind == 0 ? WS_WIN : (u.kind == 1 ? WS_WMKV : WS_MEMN);
        return ws + off + (size_t)u.pn * (256 * DM * 2); }
};
struct Epi1 {
    static constexpr bool PERM = true, INIT = false;
    unsigned char* ws; const float* ikg; const float* ikb;
    __device__ __forceinline__ bool operator()(f32x4 (&acc)[2][2][4][2], const pg8::Unit& u, int wr, int wc, int fr, int fq) const {
        const int rowb = u.pm * 256 + wr * 64 + fr, cl = wc * 32 + 8 * fq, pn = u.pn;
#ifndef EX_NOIQ
        if (u.kind == 0 && pn >= 22 && pn < 26) {
            const int head = 4 * (pn - 22) + wc;
#pragma unroll
            for (int ai = 0; ai < 2; ++ai)
#pragma unroll
                for (int m = 0; m < 4; ++m) { const int row = rowb + ai * 128 + m * 16;
                    f32x4 x1a = acc[ai][0][m][0], x1b = acc[ai][0][m][1], x2a = acc[ai][1][m][0], x2b = acc[ai][1][m][1];
                    if (fq == 0) { const f32x4* cs = (const f32x4*)(ws + WS_CSI) + row * 4;
                        const f32x4 c0 = cs[0], c1 = cs[1], c2 = cs[2], c3 = cs[3];
                        const f32x4 co_a = {c0[0], c0[2], c1[0], c1[2]}, si_a = {c0[1], c0[3], c1[1], c1[3]}, co_b = {c2[0], c2[2], c3[0], c3[2]}, si_b = {c2[1], c2[3], c3[1], c3[3]};
                        const f32x4 r1a = x1a * co_a - x2a * si_a, r1b = x1b * co_b - x2b * si_b, r2a = x2a * co_a + x1a * si_a, r2b = x2b * co_b + x1b * si_b;
                        x1a = r1a; x1b = r1b; x2a = r2a; x2b = r2b; }
                    bf16_t* dst = (bf16_t*)(ws + WS_IQ) + (size_t)row * 1024 + head * 64 + 16 * fq;
                    *(bf16x8*)(dst) = pack8(x1a, x1b); *(bf16x8*)(dst + 8) = pack8(x2a, x2b); }
            return true;
        }
#endif
#ifndef EX_NOIK
        if (u.kind == 0 && pn == 26) {
            if (wc == 0) {
                const f32x4 g0 = *(const f32x4*)(ikg + 16 * fq), g1 = *(const f32x4*)(ikg + 16 * fq + 4), g2 = *(const f32x4*)(ikg + 16 * fq + 8), g3 = *(const f32x4*)(ikg + 16 * fq + 12);
                const f32x4 e0 = *(const f32x4*)(ikb + 16 * fq), e1 = *(const f32x4*)(ikb + 16 * fq + 4), e2 = *(const f32x4*)(ikb + 16 * fq + 8), e3 = *(const f32x4*)(ikb + 16 * fq + 12);
#pragma unroll
                for (int ai = 0; ai < 2; ++ai)
#pragma unroll
                    for (int m = 0; m < 4; ++m) { const int row = rowb + ai * 128 + m * 16;
                        f32x4 v0 = acc[ai][0][m][0], v1 = acc[ai][0][m][1], v2 = acc[ai][1][m][0], v3 = acc[ai][1][m][1];
                        const f32x4 sv = (v0 + v1) + (v2 + v3);
                        float sm = (sv[0] + sv[1]) + (sv[2] + sv[3]);
                        sm += __shfl_xor(sm, 16); sm += __shfl_xor(sm, 32);
                        const float mean = sm * (1.f / 64.f);
                        v0 = v0 - mean; v1 = v1 - mean; v2 = v2 - mean; v3 = v3 - mean;
                        const f32x4 qv = (v0 * v0 + v1 * v1) + (v2 * v2 + v3 * v3);
                        float q2 = (qv[0] + qv[1]) + (qv[2] + qv[3]);
                        q2 += __shfl_xor(q2, 16); q2 += __shfl_xor(q2, 32);
                        const float rstd = 1.0f / sqrtf(q2 * (1.f / 64.f) + EPS);
                        v0 = v0 * rstd * g0 + e0; v1 = v1 * rstd * g1 + e1; v2 = v2 * rstd * g2 + e2; v3 = v3 * rstd * g3 + e3;
                        if (fq == 0) { const f32x4* cs = (const f32x4*)(ws + WS_CSI) + row * 4;
                            const f32x4 c0 = cs[0], c1 = cs[1], c2 = cs[2], c3 = cs[3];
                            const f32x4 co_a = {c0[0], c0[2], c1[0], c1[2]}, si_a = {c0[1], c0[3], c1[1], c1[3]}, co_b = {c2[0], c2[2], c3[0], c3[2]}, si_b = {c2[1], c2[3], c3[1], c3[3]};
                            const f32x4 r1a = v0 * co_a - v2 * si_a, r1b = v1 * co_b - v3 * si_b, r2a = v2 * co_a + v0 * si_a, r2b = v3 * co_b + v1 * si_b;
                            v0 = r1a; v1 = r1b; v2 = r2a; v3 = r2b; }
                        bf16_t* dst = (bf16_t*)(ws + WS_IK) + (size_t)row * 64 + 16 * fq;
                        *(bf16x8*)(dst) = pack8(v0, v1); *(bf16x8*)(dst + 8) = pack8(v2, v3); }
            } else if (wc == 1 && fq == 0) {
#pragma unroll
                for (int ai = 0; ai < 2; ++ai)
#pragma unroll
                    for (int m = 0; m < 4; ++m) { const int row = rowb + ai * 128 + m * 16; float* dst = (float*)(ws + WS_IW) + (size_t)row * 16;
                        *(f32x4*)(dst) = acc[ai][0][m][0] * 0.03125f; *(f32x4*)(dst + 4) = acc[ai][0][m][1] * 0.03125f;
                        *(f32x4*)(dst + 8) = acc[ai][1][m][0] * 0.03125f; *(f32x4*)(dst + 12) = acc[ai][1][m][1] * 0.03125f; }
            }
            return true;
        }
#endif
        int act = 0, ld = 1024, co = 0, bjs = 128; size_t off = 0, bex = 0;
        if (u.kind == 1) { off = WS_KM; co = pn * 256; }
        else if (u.kind == 2) { off = WS_VT; ld = 512; co = pn * 256; }
        else if (pn < 4) { act = 1; off = WS_AU; co = pn * 256; }
        else if (pn < 8) { act = 1; off = WS_AV; co = (pn - 4) * 256; }
        else if (pn < 12) { act = 2; off = WS_AZ; co = (pn - 8) * 256; }
        else if (pn < 16) { off = WS_QR; co = (pn - 12) * 256; }
        else if (pn == 16) { off = WS_KR; ld = 256; }
        else if (pn == 17) { off = WS_VV; ld = 128; bjs = SEQ * 128; bex = (size_t)SEQ * 128; }
        else { act = 2; off = WS_BZ; co = (pn - 18) * 256; }
        bf16_t* dst = (bf16_t*)(ws + off) + co + cl;
#pragma unroll
        for (int ai = 0; ai < 2; ++ai)
#pragma unroll
            for (int m = 0; m < 4; ++m) { const int row = rowb + ai * 128 + m * 16; bf16_t* rp = dst + (size_t)row * ld + (size_t)(row >> 12) * bex;
#pragma unroll
                for (int bj = 0; bj < 2; ++bj) { f32x4 v0 = acc[ai][bj][m][0], v1 = acc[ai][bj][m][1];
                    if (act == 1) {
#pragma unroll
                        for (int e = 0; e < 4; ++e) { v0[e] = gelu_f(v0[e]); v1[e] = gelu_f(v1[e]); } }
                    else if (act == 2) {
#pragma unroll
                        for (int e = 0; e < 4; ++e) { v0[e] = silu_f(v0[e]); v1[e] = silu_f(v1[e]); } }
                    *(bf16x8*)(rp + (size_t)bj * bjs) = pack8(v0, v1); }
                if (u.kind == 0 && pn >= 4 && pn < 8) {
                    f32x4 g0 = acc[ai][0][m][0], g1 = acc[ai][0][m][1], g2 = acc[ai][1][m][0], g3 = acc[ai][1][m][1];
#pragma unroll
                    for (int e = 0; e < 4; ++e) { g0[e] = gelu_f(g0[e]); g1[e] = gelu_f(g1[e]); g2[e] = gelu_f(g2[e]); g3[e] = gelu_f(g3[e]); }
                    const f32x4 sv = (g0 + g1) + (g2 + g3), qv = (g0 * g0 + g1 * g1) + (g2 * g2 + g3 * g3);
                    float s1 = (sv[0] + sv[1]) + (sv[2] + sv[3]), s2 = (qv[0] + qv[1]) + (qv[2] + qv[3]);
                    s1 += __shfl_xor(s1, 16); s2 += __shfl_xor(s2, 16); s1 += __shfl_xor(s1, 32); s2 += __shfl_xor(s2, 32);
                    if (fq == 0) ((f32x2*)(ws + WS_LNP))[(size_t)row * 16 + (pn - 4) * 4 + wc] = (f32x2){s1, s2}; }
                if (u.kind == 1) {
                    const f32x4 q = (acc[ai][0][m][0] * acc[ai][0][m][0] + acc[ai][0][m][1] * acc[ai][0][m][1]) + (acc[ai][1][m][0] * acc[ai][1][m][0] + acc[ai][1][m][1] * acc[ai][1][m][1]);
                    float ss = (q[0] + q[1]) + (q[2] + q[3]);
                    ss += __shfl_xor(ss, 16); ss += __shfl_xor(ss, 32);
                    if (fq == 0) ((float*)(ws + WS_RKP))[(size_t)row * 16 + pn * 4 + wc] = ss; } }
        return true;
    }
};

struct Sched1b {
    int G, c; const char* ws;
    __device__ __forceinline__ bool next(int i, pg8::Unit& u) const { const int L = i * G + c; if (L >= 32 * 32) return false; pg8::tile_order(L, 32, 32, u.pm, u.pn); u.kind = 0; return true; }
    __device__ __forceinline__ const char* a_base(const pg8::Unit& u) const { return ws + WS_H8 + (size_t)u.pm * (256 * DM); }
    __device__ __forceinline__ const char* b_base(const pg8::Unit& u) const { return ws + WS_W8 + (size_t)u.pn * (256 * DM); }
};
struct Epi1b {
    static constexpr bool PERM = true, INIT = false;
    unsigned char* ws;
    __device__ __forceinline__ bool operator()(f32x4 (&acc)[2][2][4][2], const pg8::Unit& u, int wr, int wc, int fr, int fq) const {
        const int rowb = u.pm * 256 + wr * 64 + fr, cl = wc * 32 + 8 * fq, pn = u.pn;
        const float* __restrict__ SW = (const float*)(ws + WS_SW) + pn * 256 + cl; const float* __restrict__ SH = (const float*)(ws + WS_SH);
        const f32x4 sw00 = *(const f32x4*)(SW), sw01 = *(const f32x4*)(SW + 4), sw10 = *(const f32x4*)(SW + 128), sw11 = *(const f32x4*)(SW + 132);
        float sh[2][4];
#pragma unroll
        for (int ai = 0; ai < 2; ++ai)
#pragma unroll
            for (int m = 0; m < 4; ++m) sh[ai][m] = SH[rowb + ai * 128 + m * 16];
        if (pn < 8) {
            bf16_t* __restrict__ dst = (bf16_t*)(ws + (pn < 4 ? WS_MQ : WS_MZ)) + (pn & 3) * 256 + cl;
#pragma unroll
            for (int ai = 0; ai < 2; ++ai)
#pragma unroll
                for (int m = 0; m < 4; ++m) { const int row = rowb + ai * 128 + m * 16; const float rs = sh[ai][m];
#pragma unroll
                    for (int bj = 0; bj < 2; ++bj) { f32x4 v0, v1; const f32x4 s0 = bj ? sw10 : sw00, s1 = bj ? sw11 : sw01;
#pragma unroll
                        for (int e = 0; e < 4; ++e) { v0[e] = (float)__float_as_int(acc[ai][bj][m][0][e]) * (rs * s0[e]); v1[e] = (float)__float_as_int(acc[ai][bj][m][1][e]) * (rs * s1[e]); }
                        if (pn >= 4) {
#pragma unroll
                            for (int e = 0; e < 4; ++e) { v0[e] = silu_f(v0[e]); v1[e] = silu_f(v1[e]); } }
                        *(bf16x8*)(dst + (size_t)row * 1024 + bj * 128) = pack8(v0, v1); } }
            return true;
        }
        const int pg = pn - 8;
        unsigned char* __restrict__ dst = (unsigned char*)(ws + WS_SA + (size_t)(pg >> 3) * (WS_SB - WS_SA)) + (pg & 7) * 256 + cl;
#pragma unroll
        for (int ai = 0; ai < 2; ++ai)
#pragma unroll
            for (int m = 0; m < 4; ++m) { const int row = rowb + ai * 128 + m * 16; const float rs = sh[ai][m] * (-LOG2E);
#pragma unroll
                for (int bj = 0; bj < 2; ++bj) { const f32x4 s0 = bj ? sw10 : sw00, s1 = bj ? sw11 : sw01; unsigned lo = 0, hi2 = 0;
#pragma unroll
                    for (int e = 0; e < 4; ++e) {
                        const float q0 = 255.f * __builtin_amdgcn_rcpf(1.f + __builtin_amdgcn_exp2f((float)__float_as_int(acc[ai][bj][m][0][e]) * (rs * s0[e])));
                        const float q1 = 255.f * __builtin_amdgcn_rcpf(1.f + __builtin_amdgcn_exp2f((float)__float_as_int(acc[ai][bj][m][1][e]) * (rs * s1[e])));
                        lo = __builtin_amdgcn_cvt_pk_u8_f32(__builtin_amdgcn_fmed3f(q0, 1.f, 255.f), e, lo); hi2 = __builtin_amdgcn_cvt_pk_u8_f32(__builtin_amdgcn_fmed3f(q1, 1.f, 255.f), e, hi2); }
                    *(u32x2*)(dst + (size_t)row * DM + bj * 128) = (u32x2){lo, hi2}; } }
        return true;
    }
};

struct Sched2 {
    int G, c; const char* ws;
    __device__ __forceinline__ bool next(int i, pg8::Unit& u) const {
        const int L = (i / 3) * G + c; if (L >= 256) return false;
        pg8::tile_order(L, 32, 8, u.pm, u.pn); u.kind = i % 3; return true;
    }
    __device__ __forceinline__ const char* a_base(const pg8::Unit& u) const {
        const size_t off = WS_XA + (u.kind == 1 ? (WS_XB - WS_XA) : (size_t)0) + (u.kind == 2 ? (WS_XM - WS_XA) : (size_t)0);
        return ws + off + (size_t)u.pm * (256 * 1024 * 2); }
    __device__ __forceinline__ const char* b_base(const pg8::Unit& u) const { return ws + WS_WBR + (size_t)u.kind * ((size_t)DM * 1024 * 2) + (size_t)u.pn * (256 * 1024 * 2); }
};
struct Epi2 {
    static constexpr bool PERM = true, INIT = false;
    unsigned char* ws;
    __device__ __forceinline__ bool operator()(f32x4 (&acc)[2][2][4][2], const pg8::Unit& u, int wr, int wc, int fr, int fq) const {
        const int rowb = u.pm * 256 + wr * 64 + fr, colb = u.pn * 256 + wc * 32 + 8 * fq, seg = u.kind;
        constexpr size_t GST = WS_SB - WS_SA;
        static_assert(WS_SM - WS_SB == GST, "gate spacing");
        const unsigned char* __restrict__ NUM = (const unsigned char*)(ws + WS_SA + (size_t)seg * GST);
        const unsigned char* __restrict__ DEN = (const unsigned char*)(ws + WS_SA + (size_t)(seg < 2 ? seg + 1 : 2) * GST);
        bf16_t* __restrict__ MG = (bf16_t*)(ws + WS_MERGED);
#define U8F(w, e) ((float)(((w) >> (8 * (e))) & 0xffu))
#pragma unroll
        for (int ai = 0; ai < 2; ++ai)
#pragma unroll
            for (int m = 0; m < 4; ++m) { const size_t ro = (size_t)(rowb + ai * 128 + m * 16) * DM + colb;
#pragma unroll
                for (int bj = 0; bj < 2; ++bj) {
                    const u32x2 nu = *(const u32x2*)(NUM + ro + bj * 128);
                    f32x4 f0 = {U8F(nu[0], 0), U8F(nu[0], 1), U8F(nu[0], 2), U8F(nu[0], 3)}, f1 = {U8F(nu[1], 0), U8F(nu[1], 1), U8F(nu[1], 2), U8F(nu[1], 3)};
                    if (seg < 2) { const u32x2 de = *(const u32x2*)(DEN + ro + bj * 128);
                        const f32x4 d0 = {U8F(de[0], 0), U8F(de[0], 1), U8F(de[0], 2), U8F(de[0], 3)}, d1 = {U8F(de[1], 0), U8F(de[1], 1), U8F(de[1], 2), U8F(de[1], 3)};
#pragma unroll
                        for (int e = 0; e < 4; ++e) { f0[e] *= __builtin_amdgcn_rcpf(d0[e]); f1[e] *= __builtin_amdgcn_rcpf(d1[e]); }
                        acc[ai][bj][m][0] *= f0; acc[ai][bj][m][1] *= f1;
                    } else { *(bf16x8*)(MG + ro + bj * 128) = pack8(acc[ai][bj][m][0] * f0 * (1.f / 255.f), acc[ai][bj][m][1] * f1 * (1.f / 255.f)); }
                } }
#undef U8F
        return seg == 2;
    }
};
struct Sched3 {
    int G, c; const char* A; const char* B;
    __device__ __forceinline__ bool next(int i, pg8::Unit& u) const { const int L = i * G + c; if (L >= 256) return false; pg8::tile_order(L, 32, 8, u.pm, u.pn); u.kind = 0; return true; }
    __device__ __forceinline__ const char* a_base(const pg8::Unit& u) const { return A + (size_t)u.pm * (256 * DM * 2); }
    __device__ __forceinline__ const char* b_base(const pg8::Unit& u) const { return B + (size_t)u.pn * (256 * DM * 2); }
};
struct Epi3 {
    static constexpr bool PERM = false, INIT = true;
    const float* x; float* out;
    __device__ __forceinline__ void init(f32x4 (&acc)[2][2][4][2], const pg8::Unit& u, int wr, int wc, int fr, int fq) const {
        const int rowb = u.pm * 256 + wr * 64 + fr, colb = u.pn * 256 + wc * 32 + 4 * fq;
#pragma unroll
        for (int ai = 0; ai < 2; ++ai)
#pragma unroll
            for (int m = 0; m < 4; ++m) { const size_t ro = (size_t)(rowb + ai * 128 + m * 16) * DM + colb;
#pragma unroll
                for (int bj = 0; bj < 2; ++bj)
#pragma unroll
                    for (int n = 0; n < 2; ++n) acc[ai][bj][m][n] = *(const f32x4*)(x + ro + bj * 128 + n * 16); }
    }
    __device__ __forceinline__ bool operator()(f32x4 (&acc)[2][2][4][2], const pg8::Unit& u, int wr, int wc, int fr, int fq) const {
        const int rowb = u.pm * 256 + wr * 64 + fr, colb = u.pn * 256 + wc * 32 + 4 * fq;
#pragma unroll
        for (int ai = 0; ai < 2; ++ai)
#pragma unroll
            for (int m = 0; m < 4; ++m) { const size_t ro = (size_t)(rowb + ai * 128 + m * 16) * DM + colb;
#pragma unroll
                for (int bj = 0; bj < 2; ++bj)
#pragma unroll
                    for (int n = 0; n < 2; ++n) *(f32x4*)(out + ro + bj * 128 + n * 16) = acc[ai][bj][m][n]; }
        return true;
    }
};

__device__ __forceinline__ void p2_qkprep(const Params& p, int vcu, int G) {
    const int tid = opaque_tid(), lane = tid & 63, wave = tid >> 6;
    unsigned char* ws = p.ws;
    const bf16_t* QR = (const bf16_t*)(ws + WS_QR); const bf16_t* KR = (const bf16_t*)(ws + WS_KR);
    bf16_t* QN = (bf16_t*)(ws + WS_QN); bf16_t* KN = (bf16_t*)(ws + WS_KN);
    const f32x2* CSB = (const f32x2*)(ws + WS_CSB);
    const float gq0 = p.q_gain[lane], gq1 = p.q_gain[lane + 64], gk0 = p.k_gain[lane], gk1 = p.k_gain[lane + 64];
    const float gA0 = (lane < 64) ? p.q_gain[2 * lane] : 0.f, gA1 = p.q_gain[2 * lane + 1], gB0 = p.k_gain[2 * lane], gB1 = p.k_gain[2 * lane + 1];
    (void)gq0; (void)gq1; (void)gk0; (void)gk1;
    const int NWT = G * NWAVES, w0 = vcu * NWAVES + wave;
#pragma unroll 1
    for (int t = w0; t < T; t += 2 * NWT) {
        const int t1 = (t + NWT < T) ? t + NWT : t;
        unsigned raw[2][10];
#pragma unroll
        for (int u = 0; u < 2; ++u) { const int tt = u ? t1 : t;
#pragma unroll
            for (int r = 0; r < 10; ++r) raw[u][r] = *(const unsigned*)((r < 8 ? QR + (size_t)tt * 1024 + r * 128 : KR + (size_t)tt * 256 + (r - 8) * 128) + 2 * lane); }
        f32x2 cs[2];
        cs[0] = CSB[t * 16 + ((2 * lane) & 15)]; cs[1] = CSB[t1 * 16 + ((2 * lane) & 15)];
        f32x2 cs1[2];
        cs1[0] = CSB[t * 16 + ((2 * lane + 1) & 15)]; cs1[1] = CSB[t1 * 16 + ((2 * lane + 1) & 15)];
        float ss[2][10];
#pragma unroll
        for (int u = 0; u < 2; ++u)
#pragma unroll
            for (int r = 0; r < 10; ++r) { const float x0 = bflo(raw[u][r]), x1 = bfhi(raw[u][r]); ss[u][r] = x0 * x0 + x1 * x1; }
#pragma unroll
        for (int o = 1; o < 64; o <<= 1)
#pragma unroll
            for (int u = 0; u < 2; ++u)
#pragma unroll
                for (int r = 0; r < 10; ++r) ss[u][r] += __shfl_xor(ss[u][r], o);
#pragma unroll
        for (int u = 0; u < 2; ++u) { const int tt = u ? t1 : t; const int b = tt >> 12, sq = tt & (SEQ - 1);
#pragma unroll
            for (int r = 0; r < 10; ++r) {
                const float rs = 1.0f / sqrtf(ss[u][r] * (1.f / 128.f) + EPS);
                float y0 = bflo(raw[u][r]) * rs * (r < 8 ? gA0 : gB0), y1 = bfhi(raw[u][r]) * rs * (r < 8 ? gA1 : gB1);
                const float p0 = __shfl_xor(y0, 8), p1 = __shfl_xor(y1, 8);
                if (lane < 8) { y0 = y0 * cs[u][0] - p0 * cs[u][1]; y1 = y1 * cs1[u][0] - p1 * cs1[u][1]; }
                else if (lane < 16) { y0 = y0 * cs[u][0] + p0 * cs[u][1]; y1 = y1 * cs1[u][0] + p1 * cs1[u][1]; }
                bf16_t* dst = r < 8 ? QN + ((size_t)(b * 8 + r) * SEQ + sq) * 128 : KN + ((size_t)(b * 2 + (r - 8)) * SEQ + sq) * 128;
                *(unsigned*)(dst + 2 * lane) = cvt_pk_bf16(y0, y1);
            } }
    }
}

constexpr int GM_VSTR = 136;
__device__ __forceinline__ void p2_gmlp_unit(const Params& p, LAS unsigned char* lds, int unit) {
    const int tid = opaque_tid(), lane = tid & 63, wave = __builtin_amdgcn_readfirstlane(tid >> 6), r32 = lane & 31, hi = lane >> 5;
    unsigned char* ws = p.ws;
    const int g = unit & 7, ch = unit >> 3, tok0 = ch * 128;
    const bf16_t* AV = (const bf16_t*)(ws + WS_AV); const bf16_t* AU = (const bf16_t*)(ws + WS_AU); const bf16_t* AZ = (const bf16_t*)(ws + WS_AZ);
    bf16_t* XA = (bf16_t*)(ws + WS_XA);
    LAS float* stat = (LAS float*)lds;
    LAS bf16_t* vT = (LAS bf16_t*)(lds + 1024);
    const int tb = wave >> 1, dh = wave & 1, trow = tb * 32 + r32;
    const float* wsp = p.spatial_w + ((size_t)g * 128 + trow) * 128 + 8 * hi;
    f32x4 wf[8][2];
#pragma unroll
    for (int ks = 0; ks < 8; ++ks) { wf[ks][0] = *(const f32x4*)(wsp + 16 * ks); wf[ks][1] = *(const f32x4*)(wsp + 16 * ks + 4); }
    if (tid < 128) { const f32x4* lp = (const f32x4*)((const f32x2*)(ws + WS_LNP) + (size_t)(tok0 + tid) * 16); float s1 = 0.f, s2 = 0.f;
#pragma unroll
        for (int i = 0; i < 8; ++i) { const f32x4 v = lp[i]; s1 += v[0] + v[2]; s2 += v[1] + v[3]; }
        const float mean = s1 * (1.f / 1024.f), var = fmaxf(s2 * (1.f / 1024.f) - mean * mean, 0.f);
        stat[2 * tid] = mean; stat[2 * tid + 1] = 1.0f / sqrtf(var + EPS); }
    __syncthreads();
    {
        u32x4 va[4];
#pragma unroll
        for (int i = 0; i < 4; ++i) { const int it = tid + i * NTHREADS, s_ = it >> 4, d8 = (it & 15) * 8; va[i] = *(const u32x4*)(AV + (size_t)(tok0 + s_) * 1024 + g * 128 + d8); }
        const int d8 = (tid & 15) * 8;
        const f32x4 g0 = *(const f32x4*)(p.gmlp_g + g * 128 + d8), g1 = *(const f32x4*)(p.gmlp_g + g * 128 + d8 + 4), b0 = *(const f32x4*)(p.gmlp_b + g * 128 + d8), b1 = *(const f32x4*)(p.gmlp_b + g * 128 + d8 + 4);
#pragma unroll
        for (int i = 0; i < 4; ++i) { const int it = tid + i * NTHREADS, s_ = it >> 4; const u32x4 a = va[i];
            const float mean = stat[2 * s_], rstd = stat[2 * s_ + 1];
            float f[8] = {bflo(a[0]), bfhi(a[0]), bflo(a[1]), bfhi(a[1]), bflo(a[2]), bfhi(a[2]), bflo(a[3]), bfhi(a[3])};
#pragma unroll
            for (int e = 0; e < 8; ++e) { const float y = (f[e] - mean) * rstd * (e < 4 ? g0[e & 3] : g1[e & 3]) + (e < 4 ? b0[e & 3] : b1[e & 3]); vT[(d8 + e) * GM_VSTR + s_] = f2bf(y); } }
    }
    unsigned short gu[16][2], gz[16][2];
#pragma unroll
    for (int r = 0; r < 16; ++r) { const int tl = tb * 32 + (r & 3) + 8 * (r >> 2) + 4 * hi; const size_t o = (size_t)(tok0 + tl) * 1024 + g * 128 + dh * 64 + r32;
        gu[r][0] = AU[o]; gu[r][1] = AU[o + 32]; gz[r][0] = AZ[o]; gz[r][1] = AZ[o + 32]; }
    __syncthreads();
    f32x16 acc0 = {}, acc1 = {};
#pragma unroll
    for (int ks = 0; ks < 8; ++ks) {
        const int s0 = 16 * ks + 8 * hi;
        f32x4 w0 = wf[ks][0], w1 = wf[ks][1];
#pragma unroll
        for (int e = 0; e < 4; ++e) { if (s0 + e > trow) w0[e] = 0.f; if (s0 + 4 + e > trow) w1[e] = 0.f; }
        const bf16x8 a = pack8(w0, w1);
        const bf16x8 b0 = *(const LAS bf16x8*)(vT + (dh * 64 + r32) * GM_VSTR + s0), b1 = *(const LAS bf16x8*)(vT + (dh * 64 + 32 + r32) * GM_VSTR + s0);
        acc0 = __builtin_amdgcn_mfma_f32_32x32x16_bf16(a, b0, acc0, 0, 0, 0);
        acc1 = __builtin_amdgcn_mfma_f32_32x32x16_bf16(a, b1, acc1, 0, 0, 0);
    }
#pragma unroll
    for (int r = 0; r < 16; ++r) { const int tl = tb * 32 + (r & 3) + 8 * (r >> 2) + 4 * hi; const float bias = p.spatial_b[g * 128 + tl];
        const size_t o = (size_t)(tok0 + tl) * 1024 + g * 128 + dh * 64 + r32;
        XA[o] = f2bf(bf2f(gu[r][0]) * (acc0[r] + bias) * bf2f(gz[r][0]));
        XA[o + 32] = f2bf(bf2f(gu[r][1]) * (acc1[r] + bias) * bf2f(gz[r][1])); }
    __syncthreads();
}

constexpr int MA_KST = 32 * 512, MA_VROW = 72, MA_VST = 256 * MA_VROW;
constexpr int MA_K0 = 2048, MA_V0 = MA_K0 + 2 * MA_KST;
static_assert(MA_V0 + 2 * MA_VST <= MISC_OFF, "mem-attn LDS map");
__device__ __forceinline__ void p2_mem_unit(const Params& p, LAS unsigned char* lds, int unit) {
    const int tid = opaque_tid(), lane = tid & 63, wave = __builtin_amdgcn_readfirstlane(tid >> 6), r32 = lane & 31, hi = lane >> 5;
    unsigned char* ws = p.ws;
    const int qb = unit & 31, h = (unit >> 5) & 3, b = unit >> 7, qg = wave & 3, dhf = wave >> 2;
    const bf16_t* MQ = (const bf16_t*)(ws + WS_MQ); const bf16_t* MZ = (const bf16_t*)(ws + WS_MZ);
    const bf16_t* KM = (const bf16_t*)(ws + WS_KM) + (size_t)(b * 256) * 1024 + h * 256;
    const bf16_t* VT = (const bf16_t*)(ws + WS_VT) + (size_t)(h * 256) * 512 + b * 256;
    bf16_t* XM = (bf16_t*)(ws + WS_XM);
    LAS float* rk = (LAS float*)lds;
    LAS float* gqk = (LAS float*)(lds + 1024);
    u32x4 sk[2], sv[2];
#define MA_LOAD(st) do { _Pragma("unroll") for (int i = 0; i < 2; ++i) { const int q = tid + i * NTHREADS; \
        sk[i] = *(const u32x4*)(KM + (size_t)((st) * 32 + (q >> 5)) * 1024 + (q & 31) * 8); \
        sv[i] = *(const u32x4*)(VT + (size_t)(q >> 2) * 512 + (st) * 32 + (q & 3) * 8); } } while (0)
#define MA_WRITE(bf) do { _Pragma("unroll") for (int i = 0; i < 2; ++i) { const int q = tid + i * NTHREADS; const int key = q >> 5, c = q & 31; \
        *(LAS u32x4*)(lds + MA_K0 + (bf) * MA_KST + key * 512 + ((c ^ (key & 15)) << 4)) = sk[i]; \
        LAS unsigned char* vd = lds + MA_V0 + (bf) * MA_VST + (q >> 2) * MA_VROW + (q & 3) * 16; \
        *(LAS u32x2*)vd = (u32x2){sv[i][0], sv[i][1]}; *(LAS u32x2*)(vd + 8) = (u32x2){sv[i][2], sv[i][3]}; } } while (0)
    if (tid < 256) { const f32x4 pr = *(const f32x4*)((const float*)(ws + WS_RKP) + (size_t)(b * 256 + tid) * 16 + h * 4);
        rk[tid] = 1.0f / sqrtf(((pr[0] + pr[1]) + (pr[2] + pr[3])) * (1.f / 256.f) + EPS); gqk[tid] = p.mq_gain[tid] * p.mk_gain[tid]; }
    __syncthreads();
    const int tq = b * SEQ + qb * 128 + qg * 32 + r32;
    bf16x8 qf[16]; float ssq = 0.f;
#pragma unroll
    for (int ks = 0; ks < 16; ++ks) { const int d0 = 16 * ks + 8 * hi; const u32x4 a = *(const u32x4*)(MQ + (size_t)tq * 1024 + h * 256 + d0);
        f32x4 f0 = {bflo(a[0]), bfhi(a[0]), bflo(a[1]), bfhi(a[1])}, f1 = {bflo(a[2]), bfhi(a[2]), bflo(a[3]), bfhi(a[3])};
        ssq += (f0[0] * f0[0] + f0[1] * f0[1]) + (f0[2] * f0[2] + f0[3] * f0[3]) + (f1[0] * f1[0] + f1[1] * f1[1]) + (f1[2] * f1[2] + f1[3] * f1[3]);
        const f32x4 g0 = *(const LAS f32x4*)(gqk + d0), g1 = *(const LAS f32x4*)(gqk + d0 + 4);
        qf[ks] = pack8(f0 * g0, f1 * g1); }
    ssq += __shfl_xor(ssq, 32);
    const float qs = (1.0f / sqrtf(ssq * (1.f / 256.f) + EPS)) * (0.0625f * LOG2E);
    MA_LOAD(0);
    MA_WRITE(0);
    __syncthreads();
    f32x16 o[4];
#pragma unroll
    for (int db = 0; db < 4; ++db) o[db] = (f32x16){};
    float mrun = -1e30f, l = 0.f;
    const int kx = r32 & 15;
#pragma unroll 1
    for (int st = 0; st < 8; ++st) {
        const int bf = st & 1;
        if (st + 1 < 8) MA_LOAD(st + 1);
        {
            f32x16 a = {};
            const LAS unsigned char* kp = lds + MA_K0 + bf * MA_KST + r32 * 512;
#pragma unroll
            for (int ks = 0; ks < 16; ++ks) { if ((ks & 3) == 0) __builtin_amdgcn_sched_barrier(0); const bf16x8 kf = *(const LAS bf16x8*)(kp + (((2 * ks + hi) ^ kx) << 4)); a = __builtin_amdgcn_mfma_f32_32x32x16_bf16(kf, qf[ks], a, 0, 0, 0); }
            __builtin_amdgcn_sched_barrier(0);
#pragma unroll
            for (int g4 = 0; g4 < 4; ++g4) { const f32x4 rr = *(const LAS f32x4*)(rk + st * 32 + 8 * g4 + 4 * hi);
#pragma unroll
                for (int e = 0; e < 4; ++e) a[4 * g4 + e] *= rr[e] * qs; }
            float bm = a[0];
#pragma unroll
            for (int r = 1; r < 16; ++r) bm = fmaxf(bm, a[r]);
            bm = fmaxf(bm, __shfl_xor(bm, 32));
            if (!__all(bm - mrun <= 8.f)) { const float mn = fmaxf(mrun, bm), al = __builtin_amdgcn_exp2f(mrun - mn); mrun = mn; l *= al;
#pragma unroll
                for (int db = 0; db < 4; ++db) o[db] *= al; }
#pragma unroll
            for (int r = 0; r < 16; ++r) { a[r] = __builtin_amdgcn_exp2f(a[r] - mrun); l += a[r]; }
            u32x4 w0 = {cvt_pk_bf16(a[0], a[1]), cvt_pk_bf16(a[2], a[3]), cvt_pk_bf16(a[4], a[5]), cvt_pk_bf16(a[6], a[7])};
            u32x4 w1 = {cvt_pk_bf16(a[8], a[9]), cvt_pk_bf16(a[10], a[11]), cvt_pk_bf16(a[12], a[13]), cvt_pk_bf16(a[14], a[15])};
            const bf16x8 pf0 = *reinterpret_cast<bf16x8*>(&w0), pf1 = *reinterpret_cast<bf16x8*>(&w1);
            const LAS unsigned char* vp = lds + MA_V0 + bf * MA_VST + (dhf * 128 + r32) * MA_VROW + 8 * hi;
#pragma unroll
            for (int db = 0; db < 4; ++db) {
                const u32x2 lo0 = *(const LAS u32x2*)(vp + db * 32 * MA_VROW), hi0 = *(const LAS u32x2*)(vp + db * 32 * MA_VROW + 16);
                const u32x2 lo1 = *(const LAS u32x2*)(vp + db * 32 * MA_VROW + 32), hi1 = *(const LAS u32x2*)(vp + db * 32 * MA_VROW + 48);
                u32x4 v0 = {lo0[0], lo0[1], hi0[0], hi0[1]}, v1 = {lo1[0], lo1[1], hi1[0], hi1[1]};
                o[db] = __builtin_amdgcn_mfma_f32_32x32x16_bf16(*reinterpret_cast<bf16x8*>(&v0), pf0, o[db], 0, 0, 0);
                o[db] = __builtin_amdgcn_mfma_f32_32x32x16_bf16(*reinterpret_cast<bf16x8*>(&v1), pf1, o[db], 0, 0, 0); }
        }
        if (st + 1 < 8) MA_WRITE(bf ^ 1);
        __syncthreads();
    }
#undef MA_LOAD
#undef MA_WRITE
    l += __shfl_xor(l, 32);
    const float il = __builtin_amdgcn_rcpf(l);
    u32x2 zg[4][4];
#pragma unroll
    for (int db = 0; db < 4; ++db)
#pragma unroll
        for (int g4 = 0; g4 < 4; ++g4) zg[db][g4] = *(const u32x2*)(MZ + (size_t)tq * 1024 + h * 256 + dhf * 128 + db * 32 + 8 * g4 + 4 * hi);
#pragma unroll
    for (int db = 0; db < 4; ++db)
#pragma unroll
        for (int g4 = 0; g4 < 4; ++g4) { const size_t oo = (size_t)tq * 1024 + h * 256 + dhf * 128 + db * 32 + 8 * g4 + 4 * hi;
            const u32x2 z = zg[db][g4];
            u32x2 w; w[0] = cvt_pk_bf16(o[db][4 * g4] * il * bflo(z[0]), o[db][4 * g4 + 1] * il * bfhi(z[0])); w[1] = cvt_pk_bf16(o[db][4 * g4 + 2] * il * bflo(z[1]), o[db][4 * g4 + 3] * il * bfhi(z[1]));
            *(u32x2*)(XM + oo) = w; }
}


__device__ __forceinline__ unsigned wave_sum_dpp(unsigned c) {
    c += (unsigned)__builtin_amdgcn_update_dpp(0, (int)c, 0xB1, 0xF, 0xF, false);
    c += (unsigned)__builtin_amdgcn_update_dpp(0, (int)c, 0x4E, 0xF, 0xF, false);
    c += (unsigned)__builtin_amdgcn_update_dpp(0, (int)c, 0x141, 0xF, 0xF, false);
    c += (unsigned)__builtin_amdgcn_update_dpp(0, (int)c, 0x140, 0xF, 0xF, false);
    { auto r = __builtin_amdgcn_permlane16_swap(c, c, false, false); c = r[0] + r[1]; }
    { auto r = __builtin_amdgcn_permlane32_swap(c, c, false, false); c = r[0] + r[1]; }
    return c;
}
#define CNT4(c0, c1, c2, c3, a, b, c_, d, t) do { unsigned long long m0_, m1_, m2_, m3_; asm volatile( \
    "v_cmp_ge_u32_e64 %[m0], %[va], %[vt]\n\tv_cmp_ge_u32_e64 %[m1], %[vb], %[vt]\n\tv_cmp_ge_u32_e64 %[m2], %[vc], %[vt]\n\tv_cmp_ge_u32_e64 %[m3], %[vd], %[vt]\n\t" \
    "v_addc_co_u32_e64 %[k0], %[m0], %[k0], 0, %[m0]\n\tv_addc_co_u32_e64 %[k1], %[m1], %[k1], 0, %[m1]\n\tv_addc_co_u32_e64 %[k2], %[m2], %[k2], 0, %[m2]\n\tv_addc_co_u32_e64 %[k3], %[m3], %[k3], 0, %[m3]" \
    : [k0] "+v"(c0), [k1] "+v"(c1), [k2] "+v"(c2), [k3] "+v"(c3), [m0] "=&s"(m0_), [m1] "=&s"(m1_), [m2] "=&s"(m2_), [m3] "=&s"(m3_) \
    : [va] "v"(a), [vb] "v"(b), [vc] "v"(c_), [vd] "v"(d), [vt] "v"(t)); } while (0)

__device__ __forceinline__ unsigned sortable(float f) { const unsigned u = __float_as_uint(f); return u ^ ((unsigned)((int)u >> 31) | 0x80000000u); }
#ifndef SPAN_A
#define SPAN_A -1
#endif
#define ACC_T(k, t0v) do { if (SPAN_A >= 100 && blockIdx.x == 0 && threadIdx.x == 0) { volatile LAS unsigned long long* st_ = (volatile LAS unsigned long long*)(lds + MISC_OFF + 16); const unsigned long long n_ = __builtin_amdgcn_s_memrealtime(); st_[16 + (k)] += n_ - (t0v); (t0v) = n_; } } while (0)
__device__ __forceinline__ float relu1(float x) { const int xi = __float_as_int(x); return __int_as_float(xi > 0 ? xi : 0); }
__device__ __forceinline__ void p2_idx_all(const Params& p, LAS unsigned char* lds, int bx, int G) {
    const int tid = opaque_tid(), lane = tid & 63, wave = __builtin_amdgcn_readfirstlane(tid >> 6), r32 = lane & 31, hi = lane >> 5;
    const int g = wave >> 2, wg = wave & 3;
    unsigned char* ws = p.ws;
    const bf16_t* IQ = (const bf16_t*)(ws + WS_IQ); const float* IW = (const float*)(ws + WS_IW);
    LAS unsigned* sc = (LAS unsigned*)lds + g * (4 * 4096);
    LAS float* iwl0 = (LAS float*)(lds + 131072) + g * 128;
    LAS unsigned long long* lm = (LAS unsigned long long*)(lds + 131072 + 1024) + wave * 64;
    int nblk = 0; for (int pr = bx; pr < 512; pr += G) nblk += 2;
    if (nblk == 0) return;
#define IDX_UNIT(k, bb, ub) do { const int pr_ = bx + ((k) >> 1) * G, ix_ = pr_ & 255; bb = pr_ >> 8; ub = ((k) & 1) ? ix_ : 511 - ix_; } while (0)
#define AF_LOAD(tt0) do { _Pragma("unroll") for (int at = 0; at < 2; ++at) _Pragma("unroll") for (int ks = 0; ks < 4; ++ks) \
        af[at][ks] = *(const bf16x8*)(IQ + (size_t)((tt0) + 2 * at + (r32 >> 4)) * 1024 + (r32 & 15) * 64 + 16 * ks + 8 * hi); } while (0)
    bf16x8 af[2][4];
    { int b0, u0; IDX_UNIT(0, b0, u0); const int t0g = b0 * SEQ + u0 * 8 + 4 * g; AF_LOAD(t0g); if (wg == 0) iwl0[lane] = IW[(size_t)t0g * 16 + lane]; }
    __syncthreads();
#pragma unroll 1
    for (int h = 0; h <= 2 * nblk; ++h) {
        const int ph = h - g;
        if (ph >= 0 && ph < 2 * nblk) {
            const int k = ph >> 1; int b, ublk; IDX_UNIT(k, b, ublk);
            const int s0 = ublk * 8 + 4 * g, t0 = b * SEQ + s0;
            if ((ph & 1) == 0) {
                const bf16_t* IK = (const bf16_t*)(ws + WS_IK) + (size_t)(b * SEQ) * 64;
                LAS float* iwl = iwl0 + (k & 1) * 64;
                const int ntiles = (s0 + 4 + 31) >> 5;
                bf16x8 kb0[4], kb1[4], kb2[4];
#define IK_LOAD(dst, jj) do { const int jc_ = (jj) < ntiles ? (jj) : 0; _Pragma("unroll") for (int ks = 0; ks < 4; ++ks) dst[ks] = *(const bf16x8*)(IK + (size_t)(32 * jc_ + r32) * 64 + 16 * ks + 8 * hi); } while (0)
#define SCORE_TILE(KB, jj) do { const int k0 = 32 * (jj); \
                _Pragma("unroll") for (int at = 0; at < 2; ++at) { f32x16 a = {}; \
                    _Pragma("unroll") for (int ks = 0; ks < 4; ++ks) a = __builtin_amdgcn_mfma_f32_32x32x16_bf16(af[at][ks], KB[ks], a, 0, 0, 0); \
                    const f32x4 wa0 = *(const LAS f32x4*)(iwl + (2 * at) * 16 + 4 * hi), wa1 = *(const LAS f32x4*)(iwl + (2 * at) * 16 + 8 + 4 * hi); \
                    const f32x4 wb0 = *(const LAS f32x4*)(iwl + (2 * at + 1) * 16 + 4 * hi), wb1 = *(const LAS f32x4*)(iwl + (2 * at + 1) * 16 + 8 + 4 * hi); \
                    float pa = 0.f, pb = 0.f; \
                    _Pragma("unroll") for (int e = 0; e < 4; ++e) { pa += wa0[e] * relu1(a[e]); pa += wa1[e] * relu1(a[4 + e]); pb += wb0[e] * relu1(a[8 + e]); pb += wb1[e] * relu1(a[12 + e]); } \
                    auto rr = __builtin_amdgcn_permlane32_swap(__float_as_uint(pa), __float_as_uint(pb), false, false); \
                    const float score = __uint_as_float(rr[0]) + __uint_as_float(rr[1]); \
                    const int qi = 2 * at + hi, key = k0 + r32; \
                    sc[qi * 4096 + key] = (key <= s0 + qi) ? sortable(score) : 0u; } } while (0)
                IK_LOAD(kb0, wg); IK_LOAD(kb1, wg + 4);
#pragma unroll 1
                for (int j = wg; j < ntiles; j += 12) {
                    IK_LOAD(kb2, j + 8); SCORE_TILE(kb0, j);
                    if (j + 4 >= ntiles) break;
                    IK_LOAD(kb0, j + 12); SCORE_TILE(kb1, j + 4);
                    if (j + 8 >= ntiles) break;
                    IK_LOAD(kb1, j + 16); SCORE_TILE(kb2, j + 8);
                }
#undef IK_LOAD
#undef SCORE_TILE
            } else {
                const int s = s0 + wg, n = s + 1;
                unsigned kv[64];
#pragma unroll
                for (int i = 0; i < 64; ++i) { const int key = 64 * i + lane; kv[i] = (key <= s) ? sc[wg * 4096 + key] : 0u; }
                float iwn = 0.f;
                if (k + 1 < nblk) { int bn, un; IDX_UNIT(k + 1, bn, un); const int t0n = bn * SEQ + un * 8 + 4 * g;
                    AF_LOAD(t0n); if (wg == 0) iwn = IW[(size_t)t0n * 16 + lane]; }
                unsigned Tt = 1u; bool exact = true;
                if (n > 256) {
                    Tt = 0u; exact = false;
                    for (int bit = 31; bit >= 0; --bit) {
                        const unsigned cand = Tt | (1u << bit); unsigned c0 = 0, c1 = 0, c2 = 0, c3 = 0;
#pragma unroll
                        for (int i = 0; i < 64; i += 4) CNT4(c0, c1, c2, c3, kv[i], kv[i + 1], kv[i + 2], kv[i + 3], cand);
                        const unsigned c = wave_sum_dpp((c0 + c1) + (c2 + c3));
                        if (c >= 256u) { Tt = cand; if (c == 256u) { exact = true; break; } }
                    }
                }
                if (exact) {
#pragma unroll
                    for (int i = 0; i < 64; ++i) { const unsigned long long bal = __ballot(kv[i] >= Tt); if (lane == 0) lm[i] = bal; }
                } else {
                    unsigned cg_ = 0;
#pragma unroll
                    for (int i = 0; i < 64; ++i) cg_ += (kv[i] > Tt) ? 1u : 0u;
                    cg_ = wave_sum_u(cg_);
                    const unsigned need = 256u - cg_; unsigned seen = 0u;
#pragma unroll
                    for (int i = 0; i < 64; ++i) {
                        const unsigned kk = kv[i];
                        const unsigned long long eq = __ballot(kk == Tt), gt = __ballot(kk > Tt);
                        const unsigned below = (unsigned)__popcll(eq & ((1ull << lane) - 1ull));
                        const bool take = (kk == Tt) && (seen + below < need);
                        const unsigned long long bal = gt | __ballot(take);
                        seen += (unsigned)__popcll(eq);
                        if (lane == 0) lm[i] = bal;
                    }
                }
                if (wg == 0 && k + 1 < nblk) iwl0[((k + 1) & 1) * 64 + lane] = iwn;
                LDS_WAIT(); asm volatile("" ::: "memory");
                const unsigned long long mine = lm[lane];
                ((unsigned long long*)(ws + WS_MASK))[(size_t)(t0 + wg) * 64 + lane] = mine;
            }
        }
        __syncthreads();
    }
#undef IDX_UNIT
#undef AF_LOAD
}

namespace att {
constexpr int D = 128, NW = 8, QBLK = 32, KVBLK = 64, QB = 256;
constexpr int SHM_V = KVBLK * D * 2, SHM_K = KVBLK * D * 2;
constexpr int EPI_T0 = 2 * SHM_V + 2 * SHM_K + NW * 128 * 4 + 16, EPI_TW = 32 * 272;
constexpr int LDS_NEED = EPI_T0 + NW * EPI_TW;
static_assert(LDS_NEED <= MISC_OFF, "attention LDS map");
constexpr float SCALE = 0.08838834764831845f, THR = 8.f;
#define KSWZ(row, colB) ((row) * 256 + ((colB) ^ (((row) & 7) << 4)))
#define SBAR() __builtin_amdgcn_sched_barrier(0)
__device__ __forceinline__ int v_st(int k, int c) { const int kk = (k & ~0xC) | ((k & 4) << 1) | ((k & 8) >> 1); return ((kk >> 3) * 4 + (c >> 5)) * 512 + ((kk & 7) * 32 + (c & 31)) * 2; }
__device__ __forceinline__ int v_rd_base(int lane) { return ((lane & 3) << 3) | (((lane >> 2) & 3) << 6) | (((lane >> 4) & 1) << 5) | (((lane >> 5) & 1) << 8); }
constexpr int v_rd_off(int d0, int ks, int half) { return d0 * 512 + ks * 4096 + half * 2048; }
__device__ __forceinline__ int crow(int r, int hi) { return (r & 3) + 8 * (r >> 2) + 4 * hi; }
__device__ __forceinline__ bf16x8 load8(const bf16_t* p) { return *reinterpret_cast<const bf16x8*>(p); }
__device__ __forceinline__ void mask_bits(f32x16& p0, f32x16& p1, unsigned w0, unsigned w1, int hi) {
    w0 >>= 4 * hi; w1 >>= 4 * hi;
#pragma unroll
    for (int r = 0; r < 16; ++r) { const int c = (r & 3) + 8 * (r >> 2);
        const unsigned t0 = (unsigned)(((int)(w0 << (31 - c))) >> 31), t1 = (unsigned)(((int)(w1 << (31 - c))) >> 31);
        p0[r] = __uint_as_float((__float_as_uint(p0[r]) & t0) | (0xff800000u & ~t0));
        p1[r] = __uint_as_float((__float_as_uint(p1[r]) & t1) | (0xff800000u & ~t1)); }
}
__device__ __forceinline__ void partialSM(f32x16& p0, f32x16& p1, float& m_reg, float& mn, float& alpha) {
    float pmax = p0[0];
#pragma unroll
    for (int r = 1; r < 16; ++r) pmax = fmaxf(pmax, p0[r]);
#pragma unroll
    for (int r = 0; r < 16; ++r) pmax = fmaxf(pmax, p1[r]);
    { auto rr = __builtin_amdgcn_permlane32_swap(__float_as_uint(pmax), __float_as_uint(pmax), false, false);
      pmax = fmaxf(__uint_as_float(rr[0]), __uint_as_float(rr[1])); }
    constexpr float C2 = 1.4426950408889634f * SCALE;
    if (__builtin_expect(__all((pmax - m_reg) * SCALE <= THR), 1)) { mn = m_reg; alpha = 1.f; }
    else { mn = fmaxf(m_reg, pmax); alpha = __builtin_amdgcn_exp2f((m_reg - mn) * C2); m_reg = mn; }
    const float mnL = -mn * C2;
#pragma unroll
    for (int r = 0; r < 16; ++r) p0[r] = fmaf(p0[r], C2, mnL);
#pragma unroll
    for (int r = 0; r < 16; ++r) p1[r] = fmaf(p1[r], C2, mnL);
#pragma unroll
    for (int r = 0; r < 16; ++r) p0[r] = __builtin_amdgcn_exp2f(p0[r]);
}
__device__ __forceinline__ void finishSM(f32x16& p0, f32x16& p1, float alpha, float& l_reg, bf16x8& pa0, bf16x8& pa1, bf16x8& pa2, bf16x8& pa3) {
#pragma unroll
    for (int r = 0; r < 16; ++r) p1[r] = __builtin_amdgcn_exp2f(p1[r]);
    float ps = 0;
#pragma unroll
    for (int r = 0; r < 16; ++r) ps += p0[r];
#pragma unroll
    for (int r = 0; r < 16; ++r) ps += p1[r];
    { auto rr = __builtin_amdgcn_permlane32_swap(__float_as_uint(ps), __float_as_uint(ps), false, false);
      ps = __uint_as_float(rr[0]) + __uint_as_float(rr[1]); }
    l_reg = l_reg * alpha + ps;
#define PK4(P, B_, OUT) do { unsigned a0 = cvt_pk_bf16(P[B_+0], P[B_+1]), a1 = cvt_pk_bf16(P[B_+2], P[B_+3]);                          \
        unsigned b0 = cvt_pk_bf16(P[B_+4], P[B_+5]), b1 = cvt_pk_bf16(P[B_+6], P[B_+7]);                                             \
        auto r0 = __builtin_amdgcn_permlane32_swap(a0, b0, false, false); auto r1 = __builtin_amdgcn_permlane32_swap(a1, b1, false, false); \
        u32x4 w = {r0[0], r1[0], r0[1], r1[1]}; OUT = *reinterpret_cast<bf16x8*>(&w); } while (0)
    PK4(p0, 0, pa0); PK4(p0, 8, pa1); PK4(p1, 0, pa2); PK4(p1, 8, pa3);
#undef PK4
}
template <int KB>
__device__ __forceinline__ void qkt(f32x16& p0, f32x16& p1, const char* K_lds, int r32, int hi, const bf16x8* qr) {
    p0 = f32x16{}; p1 = f32x16{};
    const char* kb[4];
#pragma unroll
    for (int dd = 0; dd < 4; ++dd) kb[dd] = K_lds + KB * SHM_K + KSWZ(r32, (dd * 16 + hi * 8) * 2);
#pragma unroll
    for (int d0 = 0; d0 < 8; ++d0) { const char* a = kb[d0 & 3] + (d0 >> 2) * 128;
        bf16x8 b0 = *reinterpret_cast<const bf16x8*>(a);
        bf16x8 b1 = *reinterpret_cast<const bf16x8*>(a + 32 * 256);
        p0 = __builtin_amdgcn_mfma_f32_32x32x16_bf16(b0, qr[d0], p0, 0, 0, 0);
        p1 = __builtin_amdgcn_mfma_f32_32x32x16_bf16(b1, qr[d0], p1, 0, 0, 0); }
}
template <int VB>
__device__ __forceinline__ void pv_tile(f32x16* o, int vb0, bf16x8 pa0, bf16x8 pa1, bf16x8 pa2, bf16x8 pa3) {
#define TRRD(dst, off) asm volatile("ds_read_b64_tr_b16 %0, %1 offset:%2" : "=&v"(dst) : "v"(vb0), "i"(off) : "memory")
#define PV_D0(d0) do { s16x4 l0, l1, l2, l3, h0, h1, h2, h3; constexpr int b_ = VB * SHM_V + v_rd_off(d0, 0, 0); \
        TRRD(l0, b_); TRRD(h0, b_ + 2048); TRRD(l1, b_ + 4096); TRRD(h1, b_ + 6144); TRRD(l2, b_ + 8192); TRRD(h2, b_ + 10240); TRRD(l3, b_ + 12288); TRRD(h3, b_ + 14336); \
        asm volatile("s_waitcnt lgkmcnt(0)" ::: "memory"); SBAR();   \
        o[d0] = __builtin_amdgcn_mfma_f32_32x32x16_bf16(pa0, (bf16x8){l0[0], l0[1], l0[2], l0[3], h0[0], h0[1], h0[2], h0[3]}, o[d0], 0, 0, 0);   \
        o[d0] = __builtin_amdgcn_mfma_f32_32x32x16_bf16(pa1, (bf16x8){l1[0], l1[1], l1[2], l1[3], h1[0], h1[1], h1[2], h1[3]}, o[d0], 0, 0, 0);   \
        o[d0] = __builtin_amdgcn_mfma_f32_32x32x16_bf16(pa2, (bf16x8){l2[0], l2[1], l2[2], l2[3], h2[0], h2[1], h2[2], h2[3]}, o[d0], 0, 0, 0);   \
        o[d0] = __builtin_amdgcn_mfma_f32_32x32x16_bf16(pa3, (bf16x8){l3[0], l3[1], l3[2], l3[3], h3[0], h3[1], h3[2], h3[3]}, o[d0], 0, 0, 0); } while (0)
    PV_D0(0); PV_D0(1); PV_D0(2); PV_D0(3);
#undef PV_D0
#undef TRRD
}
struct BlockRef { const bf16_t* Q; const bf16_t* K; const bf16_t* V; const unsigned* M; bf16_t* O; const bf16_t* Z;
                  bf16_t* OPme; const bf16_t* OPot; f32x2* MLme; const f32x2* MLot; unsigned* cnt; int t_lo, NT; };
struct Seam { bf16x8 qr[8]; bf16x8 st_v0, st_v1, st_k0, st_k1; };
#define ROW(p, k0, rr) ((p) + (size_t)((k0) + (rr)) * D + sc)
#define VMW() asm volatile("s_waitcnt vmcnt(0)" ::: "memory")
#define VMWN(n) asm volatile("s_waitcnt vmcnt(%0)" :: "i"(n) : "memory")
#define SLOAD_H(Kp, Vp, k0) do { S.st_v0 = load8(ROW(Vp, k0, sr)); S.st_v1 = load8(ROW(Vp, k0, 32 + sr));              \
                         S.st_k0 = load8(ROW(Kp, k0, sr)); S.st_k1 = load8(ROW(Kp, k0, 32 + sr)); } while (0)
#define SWRITE_HK(bf) do { *(bf16x8*)(K_lds + (bf) * SHM_K + kws) = S.st_k0; *(bf16x8*)(K_lds + (bf) * SHM_K + kws + 32 * 256) = S.st_k1; } while (0)
#define SWRITE_HV(bf) do { *(bf16x8*)(V_lds + (bf) * SHM_V + vst0) = S.st_v0; *(bf16x8*)(V_lds + (bf) * SHM_V + vst1) = S.st_v1; } while (0)
#define SWRITE_H(bf) do { SWRITE_HV(bf); SWRITE_HK(bf); } while (0)
__device__ __forceinline__ void attn_prime(const BlockRef& cur, char* lds, Seam& S) {
    const int tid = opaque_tid(), wid = __builtin_amdgcn_readfirstlane(tid >> 6), lane = tid & 63, r32 = lane & 31, hi = lane >> 5;
    const int sr = tid >> 4, sc = (tid & 15) * 8, kws = KSWZ(sr, sc * 2); char* K_lds = lds + 2 * SHM_V;
#pragma unroll
    for (int d0 = 0; d0 < 8; ++d0) S.qr[d0] = load8(cur.Q + (size_t)(wid * QBLK + r32) * D + d0 * 16 + hi * 8);
    SLOAD_H(cur.K, cur.V, cur.t_lo * KVBLK); VMW(); SWRITE_HK(0);
    __syncthreads();
}
__device__ __forceinline__ void attn_block(const BlockRef& cur, const BlockRef& nxt, char* lds, Seam& S) {
    const int tid = opaque_tid(), wid = __builtin_amdgcn_readfirstlane(tid >> 6), lane = tid & 63, r32 = lane & 31, hi = lane >> 5;
    const int NT = cur.NT, t_lo = cur.t_lo;
    char* V_lds = lds; char* K_lds = lds + 2 * SHM_V;
    float* wsl = (float*)(lds + 2 * SHM_V + 2 * SHM_K) + wid * 128; float* li_l = wsl, * al_l = wsl + 32, * fb_l = wsl + 64;
    volatile unsigned* flag = (volatile unsigned*)(lds + 2 * SHM_V + 2 * SHM_K + NW * 128 * 4);
    float m_reg = -1e30f, l_reg = 0; f32x16 o[4] = {};
    const int sr = tid >> 4, sc = (tid & 15) * 8, vst0 = v_st(sr, sc), vst1 = v_st(32 + sr, sc), kws = KSWZ(sr, sc * 2);
    const int vb0 = (int)(uintptr_t)V_lds + v_rd_base(lane);
    const bf16_t* Kh = cur.K; const bf16_t* Vh = cur.V;
    const unsigned* mrow = cur.M + (size_t)(wid * QBLK + r32) * 128;
#define RESC(a) do { if (__any((a) < 1.f)) { if (hi == 0) al_l[r32] = (a); asm volatile("s_waitcnt lgkmcnt(0)" ::: "memory");              \
                     for (int d_ = 0; d_ < 4; ++d_) for (int r = 0; r < 16; ++r) o[d_][r] *= al_l[crow(r, hi)]; } } while (0)
#define KBASE(t) ((t_lo + (t)) * KVBLK)
#define MLOAD(t) (*(const u32x2*)(mrow + 2 * (t_lo + (t))))
#define SEAM_K0() do { VMWN(8); SWRITE_HK(0); SBAR(); } while (0)
    f32x16 pA0, pA1, pB0, pB1; float mnA, mnB, alA, alB; bf16x8 pa0, pa1, pa2, pa3;
    u32x2 mwA, mwB;
    SWRITE_HV(0); SBAR();
    mwA = MLOAD(0); mwB = MLOAD(1);
    SLOAD_H(Kh, Vh, KBASE(1));
    SBAR(); qkt<0>(pA0, pA1, K_lds, r32, hi, S.qr);
    mask_bits(pA0, pA1, mwA[0], mwA[1], hi); partialSM(pA0, pA1, m_reg, mnA, alA);
    VMW(); SWRITE_H(1);
    __syncthreads();
#define HALF_STEP(PX0, PX1, mnX, alX, mwX, mwY, PY0, PY1, alY, t, KB, VB, SB) do {                                              \
        SBAR(); mwY = MLOAD(((t) + 1 < NT) ? (t) + 1 : (t)); qkt<KB>(PX0, PX1, K_lds, r32, hi, S.qr);     \
        finishSM(PY0, PY1, alY, l_reg, pa0, pa1, pa2, pa3); SBAR();                                                           \
        if ((t) + 1 < NT) { SLOAD_H(Kh, Vh, KBASE((t) + 1)); SBAR(); }                                                        \
        pv_tile<VB>(o, vb0, pa0, pa1, pa2, pa3); mask_bits(PX0, PX1, mwX[0], mwX[1], hi); partialSM(PX0, PX1, m_reg, mnX, alX); \
        __syncthreads();                                                                                                      \
        if ((t) + 1 < NT) { VMW(); SWRITE_H(SB); }                                                                            \
        RESC(alX); __syncthreads(); } while (0)
    for (int t = 1; t + 1 < NT; t += 2) {
        HALF_STEP(pB0, pB1, mnB, alB, mwB, mwA, pA0, pA1, alA, t, 1, 0, 0);
        HALF_STEP(pA0, pA1, mnA, alA, mwA, mwB, pB0, pB1, alB, t + 1, 0, 1, 1);
    }
    SBAR(); qkt<1>(pB0, pB1, K_lds, r32, hi, S.qr); SBAR();
    SLOAD_H(nxt.K, nxt.V, nxt.t_lo * KVBLK); SBAR();
#pragma unroll
    for (int d0 = 0; d0 < 8; ++d0) S.qr[d0] = load8(nxt.Q + (size_t)(wid * QBLK + r32) * D + d0 * 16 + hi * 8);
    SBAR();
    finishSM(pA0, pA1, alA, l_reg, pa0, pa1, pa2, pa3); SBAR();
    pv_tile<0>(o, vb0, pa0, pa1, pa2, pa3);
    mask_bits(pB0, pB1, mwB[0], mwB[1], hi); partialSM(pB0, pB1, m_reg, mnB, alB); __syncthreads(); RESC(alB);
    finishSM(pB0, pB1, alB, l_reg, pa0, pa1, pa2, pa3); SBAR(); pv_tile<1>(o, vb0, pa0, pa1, pa2, pa3);
    SBAR(); SEAM_K0();
    char* Tl = lds + EPI_T0 + wid * EPI_TW;
    if (hi == 0) { li_l[r32] = l_reg; cur.MLme[wid * QBLK + r32] = (f32x2){m_reg, l_reg}; }
    asm volatile("s_waitcnt lgkmcnt(0)" ::: "memory");
#pragma unroll
    for (int r = 0; r < 16; ++r) { const float lr = li_l[crow(r, hi)]; const float rl = lr > 0.f ? __builtin_amdgcn_rcpf(lr) : 0.f;
#pragma unroll
        for (int d0 = 0; d0 < 4; ++d0) *(bf16_t*)(Tl + crow(r, hi) * 272 + (d0 * 32 + r32) * 2) = f2bf(o[d0][r] * rl); }
    asm volatile("s_waitcnt lgkmcnt(0)" ::: "memory");
    const int crw = lane >> 4, ccol = (lane & 15) * 8;
#pragma unroll
    for (int i = 0; i < 8; ++i) { const int row = crw + 4 * i; *(u32x4*)(cur.OPme + (size_t)(wid * QBLK + row) * D + ccol) = *(const u32x4*)(Tl + row * 272 + ccol * 2); }
    VMW(); __syncthreads();
    if (tid == 0) { __builtin_amdgcn_fence(__ATOMIC_RELEASE, "agent"); asm volatile("s_waitcnt vmcnt(0)" ::: "memory");
        *flag = __hip_atomic_fetch_add(cur.cnt, 1u, __ATOMIC_RELAXED, __HIP_MEMORY_SCOPE_AGENT); }
    __syncthreads();
    if (*flag == 1u) {
        if (tid == 0) { __builtin_amdgcn_fence(__ATOMIC_ACQUIRE, "agent"); asm volatile("s_waitcnt vmcnt(0)" ::: "memory"); }
        __syncthreads();
        u32x4 ot[8], zz[8];
#pragma unroll
        for (int i = 0; i < 8; ++i) { const int row = wid * QBLK + crw + 4 * i; ot[i] = *(const u32x4*)(cur.OPot + (size_t)row * D + ccol); zz[i] = *(const u32x4*)(cur.Z + (size_t)row * 1024 + ccol); }
        constexpr float C2 = 1.4426950408889634f * SCALE;
        if (hi == 0) { const f32x2 om = cur.MLot[wid * QBLK + r32]; const float M = fmaxf(m_reg, om[0]);
            const float wa = __builtin_amdgcn_exp2f((m_reg - M) * C2) * l_reg, wb = __builtin_amdgcn_exp2f((om[0] - M) * C2) * om[1];
            const float inv = __builtin_amdgcn_rcpf(wa + wb); li_l[r32] = wa * inv; fb_l[r32] = wb * inv; }
        asm volatile("s_waitcnt lgkmcnt(0)" ::: "memory");
#pragma unroll
        for (int i = 0; i < 8; ++i) { const int row = crw + 4 * i; const float fa = li_l[row], fb = fb_l[row];
            const u32x4 ow = *(const u32x4*)(Tl + row * 272 + ccol * 2); u32x4 w;
#pragma unroll
            for (int e = 0; e < 4; ++e) w[e] = cvt_pk_bf16((bflo(ow[e]) * fa + bflo(ot[i][e]) * fb) * bflo(zz[i][e]), (bfhi(ow[e]) * fa + bfhi(ot[i][e]) * fb) * bfhi(zz[i][e]));
            *(u32x4*)(cur.O + (size_t)(wid * QBLK + row) * 1024 + ccol) = w; }
    }
    __syncthreads();
#undef RESC
#undef KBASE
#undef MLOAD
#undef SEAM_K0
#undef HALF_STEP
}
#undef ROW
#undef VMW
#undef VMWN
#undef SLOAD_H
#undef SWRITE_HK
#undef SWRITE_HV
#undef SWRITE_H
__device__ __forceinline__ BlockRef make_ref(unsigned char* ws, unsigned* ctl, int item, int pass) {
    const int hf = item & 1, xp = (item >> 1) & 7, bh = item >> 4, qb = pass ? 15 - xp : xp, b = bh >> 3, h = bh & 7, kvh = b * 2 + (h >> 2);
    BlockRef r;
    r.Q = (const bf16_t*)(ws + WS_QN) + ((size_t)bh * SEQ + qb * QB) * D;
    r.K = (const bf16_t*)(ws + WS_KN) + (size_t)kvh * SEQ * D; r.V = (const bf16_t*)(ws + WS_VV) + (size_t)kvh * SEQ * D;
    r.M = (const unsigned*)(ws + WS_MASK) + (size_t)(b * SEQ + qb * QB) * 128;
    r.O = (bf16_t*)(ws + WS_XB) + (size_t)(b * SEQ + qb * QB) * 1024 + h * 128;
    r.Z = (const bf16_t*)(ws + WS_BZ) + (size_t)(b * SEQ + qb * QB) * 1024 + h * 128;
    const size_t prow = (size_t)bh * SEQ + qb * QB, hstr = (size_t)16 * SEQ;
    r.OPme = (bf16_t*)(ws + WS_OPART) + ((size_t)hf * hstr + prow) * D; r.OPot = (const bf16_t*)(ws + WS_OPART) + ((size_t)(hf ^ 1) * hstr + prow) * D;
    r.MLme = (f32x2*)(ws + WS_ML) + (size_t)hf * hstr + prow; r.MLot = (const f32x2*)(ws + WS_ML) + (size_t)(hf ^ 1) * hstr + prow;
    r.cnt = ctl + bh * 16 + qb;
    r.NT = 2 * (qb + 1); r.t_lo = hf * r.NT; return r;
}
}


#define XB_TMO      128
#define XB_XCNT(j)  (256  + 64 * (j))
#define XB_XSUB(j)  (1280 + 64 * (j))
#define XB_XGEN(j)  (2304 + 64 * (j))
#define XB_TOP      3328
#define XB_TOPGEN   3392
#define XCD_BAR_WORDS 3456
#define XB_SPIN_CAP (1u << 22)
__device__ __forceinline__ unsigned xb_ld(unsigned* p)              { return __hip_atomic_load(p, __ATOMIC_RELAXED, __HIP_MEMORY_SCOPE_AGENT); }
__device__ __forceinline__ unsigned xb_add(unsigned* p, unsigned v) { return __hip_atomic_fetch_add(p, v, __ATOMIC_RELAXED, __HIP_MEMORY_SCOPE_AGENT); }
__device__ __forceinline__ unsigned xb_xcc_id() { return (unsigned)__builtin_amdgcn_s_getreg((3 << 11) | 20) & 0xFu; }
#define XB_SPIN(cond, bar) do { unsigned _sp = 0; while (cond) { __builtin_amdgcn_s_sleep(1); \
    if ((++_sp & 255u) == 0u) { if (xb_ld(&(bar)[XB_TMO])) break; if (_sp > XB_SPIN_CAP) { atomicAdd(&(bar)[XB_TMO], 1u); break; } } } } while (0)
struct XcdBarrier { unsigned* bar; unsigned x; volatile LAS unsigned* st; };
__device__ __forceinline__ XcdBarrier xcd_barrier_post(unsigned* bar, volatile LAS unsigned* st) {
    XcdBarrier b; b.bar = bar; b.x = xb_xcc_id(); b.st = st;
    if (threadIdx.x == 0) (void)xb_add(&bar[XB_XCNT(b.x)], 1u);
    return b;
}
__device__ __forceinline__ void xcd_barrier_complete(unsigned* bar, unsigned x, unsigned& nloc, unsigned& nx) {
    const unsigned G = gridDim.x * gridDim.y * gridDim.z;
    unsigned sum, cnt, mine, sp = 0u;
    for (;;) {
        sum = 0u; cnt = 0u; mine = 0u;
#pragma unroll
        for (unsigned j = 0; j < 16; ++j) { const unsigned c = xb_ld(&bar[XB_XCNT(j)]); sum += c; cnt += (c > 0u) ? 1u : 0u; mine = (j == x) ? c : mine; }
        if (sum == G) break;
        __builtin_amdgcn_s_sleep(1);
        if ((++sp & 255u) == 0u) { if (xb_ld(&bar[XB_TMO])) break; if (sp > XB_SPIN_CAP) { atomicAdd(&bar[XB_TMO], 1u); break; } }
    }
    nloc = mine > 0u ? mine : 1u; nx = cnt > 0u ? cnt : 1u;
}
__device__ __forceinline__ void xcd_barrier(const XcdBarrier& b) {
    asm volatile("s_waitcnt vmcnt(0)" ::: "memory");
    __syncthreads();
    if (threadIdx.x == 0) {
        unsigned* bar = b.bar;
        __builtin_amdgcn_s_waitcnt(0);
        unsigned nloc = b.st[0], nx = b.st[1];
        if (nloc == 0u) { xcd_barrier_complete(bar, b.x, nloc, nx); b.st[0] = nloc; b.st[1] = nx; }
        const unsigned old = xb_add(&bar[XB_XSUB(b.x)], 1u);
        const unsigned gen = old / nloc;
        if (old + 1u == (gen + 1u) * nloc) {
            __builtin_amdgcn_fence(__ATOMIC_RELEASE, "agent");
            asm volatile("s_waitcnt vmcnt(0)" ::: "memory");
            const unsigned og = xb_add(&bar[XB_TOP], 1u);
            const unsigned tg = og / nx;
            if (og + 1u == (tg + 1u) * nx) xb_add(&bar[XB_TOPGEN], 1u);
            else XB_SPIN(xb_ld(&bar[XB_TOPGEN]) == tg, bar);
            __builtin_amdgcn_fence(__ATOMIC_ACQUIRE, "agent");
            xb_add(&bar[XB_XGEN(b.x)], 1u);
            asm volatile("s_waitcnt vmcnt(0)" ::: "memory");
        } else {
            XB_SPIN(xb_ld(&bar[XB_XGEN(b.x)]) == gen, bar);
            __builtin_amdgcn_fence(__ATOMIC_ACQUIRE, "agent");
            asm volatile("s_waitcnt vmcnt(0)" ::: "memory");
        }
    }
    __syncthreads();
}

constexpr int CW_EXIT = XCD_BAR_WORDS, CW_ATT = XCD_BAR_WORDS + 64, CW_WORDS = CW_ATT + 256;
__device__ unsigned g_ctl[CW_WORDS];

__global__ void __launch_bounds__(NTHREADS, 2) fwd_mega(Params p) {
    extern __shared__ __attribute__((aligned(16))) unsigned char lds_raw[];
    cg::grid_group grid = cg::this_grid();
    LAS unsigned char* lds = (LAS unsigned char*)lds_raw;
    const int G = gridDim.x, bx = blockIdx.x;
    const int vcu = (G % 8 == 0) ? (bx % 8) * (G / 8) + bx / 8 : bx;
    unsigned char* ws = p.ws;
    volatile LAS unsigned* misc = (volatile LAS unsigned*)(lds + MISC_OFF);
    if (threadIdx.x < 2) misc[threadIdx.x] = 0u;
    __syncthreads();
    if (p.out == nullptr) grid.sync();
    const XcdBarrier gbar = xcd_barrier_post(g_ctl, misc);
#define GRID_SYNC() xcd_barrier(gbar)

#ifndef PHASES
#define PHASES 0xffff
#endif
#ifndef REPMASK
#define REPMASK 0
#endif
#define NREP(bit) ((REPMASK & (bit)) ? 2 : 1)
#ifndef SPAN_A
#define SPAN_A -1
#endif
#ifndef SPAN_B
#define SPAN_B -1
#endif
    volatile LAS unsigned long long* stamps = (volatile LAS unsigned long long*)(lds + MISC_OFF + 16);
#define STAMP(k) do { if (SPAN_A >= 0 && bx == 0 && threadIdx.x == 0) stamps[k] = __builtin_amdgcn_s_memrealtime(); } while (0)
    STAMP(0);
    if (SPAN_A >= 0 && bx == 0 && threadIdx.x == 0) { stamps[16] = 0; stamps[17] = 0; stamps[18] = 0; stamps[19] = 0; }
    for (int rep = 0; rep < NREP(1); ++rep) if (PHASES & 1) p0_prep(p, lds, vcu, G);
    GRID_SYNC(); STAMP(1);
    for (int rep = 0; rep < NREP(2); ++rep) if (PHASES & 2) {
        Sched1 S{G, bx, (const char*)ws};
        Epi1 E{ws, p.ik_g, p.ik_b};
        pg8::gemm_phase<Epi1, Sched1, true, true>(lds, DM, S, E);
    }
    if (PHASES & 1) { constexpr int NU1A = 32 * NT_BF + 16; const int nfull = (NU1A % G == 0) ? 0 : NU1A % G; const int nhelp = G - nfull;
        if (nhelp == G) p0b_gate8(p, lds, bx, G); else if (bx >= nfull) p0b_gate8(p, lds, bx - nfull, nhelp); }
    STAMP(14);
    GRID_SYNC();
    if (PHASES & 2) {
        Sched1b S{G, bx, (const char*)ws}; Epi1b E{ws};
        pg8::gemm_phase<Epi1b, Sched1b, true, true, true>(lds, DM / 2, S, E);
    }
    GRID_SYNC(); STAMP(2);
    for (int rep = 0; rep < NREP(4); ++rep) if (PHASES & 4) p2_qkprep(p, vcu, G);
    STAMP(3);
    for (int rep = 0; rep < NREP(8); ++rep) if (PHASES & 8) for (int u = bx; u < 512; u += G) p2_gmlp_unit(p, lds, u);
    STAMP(4);
    for (int rep = 0; rep < NREP(16); ++rep) if (PHASES & 16) for (int u = bx; u < 256; u += G) p2_mem_unit(p, lds, u);
    STAMP(5);
    for (int rep = 0; rep < NREP(32); ++rep) if (PHASES & 32) p2_idx_all(p, lds, bx, G);
    STAMP(6);
    GRID_SYNC(); STAMP(7);
    for (int rep = 0; rep < NREP(64); ++rep) if (PHASES & 64) {
        const int L0 = (G == 256) ? ((bx & 7) * 32 + (bx >> 3)) : bx;
        if (L0 < 256) {
            int L = L0, pass = 0;
            att::Seam S; att::BlockRef cur = att::make_ref(ws, g_ctl + CW_ATT, L, 0);
            att::attn_prime(cur, (char*)lds_raw, S);
            STAMP(11);
            for (;;) {
                const bool more_pass = pass == 0, more_item = L + G < 256, last = !more_pass && !more_item;
                const int Ln = more_pass ? L : (more_item ? L + G : L), pn = more_pass ? 1 : 0;
                const att::BlockRef nxt = last ? cur : att::make_ref(ws, g_ctl + CW_ATT, Ln, pn);
                att::attn_block(cur, nxt, (char*)lds_raw, S);
                STAMP(12 + pass);
                if (last) break;
                cur = nxt; L = Ln; pass = pn;
            }
        }
    }
    GRID_SYNC(); STAMP(8);
    for (int rep = 0; rep < NREP(128); ++rep) if (PHASES & 128) {
        Sched2 S{G, bx, (const char*)ws};
        Epi2 E{ws};
        pg8::gemm_phase<Epi2, Sched2, true, true>(lds, 1024, S, E);
    }
    GRID_SYNC(); STAMP(9);
    if (REPMASK & 512) { for (int i = 0; i < 10; ++i) GRID_SYNC(); }
    for (int rep = 0; rep < NREP(256); ++rep) if (PHASES & 256) {
        Sched3 S{G, bx, (const char*)(ws + WS_MERGED), (const char*)(ws + WS_WOUT)};
        Epi3 E{p.x, p.out};
        pg8::gemm_phase<Epi3, Sched3, true, true>(lds, DM, S, E);
    }
    STAMP(10);
    if (SPAN_A >= 0 && bx == 0 && threadIdx.x == 0) {
        const unsigned long long dt = (SPAN_A >= 100) ? stamps[SPAN_A - 100 + 16] : (stamps[SPAN_B] - stamps[SPAN_A]), t0 = __builtin_amdgcn_s_memrealtime();
        while (__builtin_amdgcn_s_memrealtime() - t0 < dt) __builtin_amdgcn_s_sleep(8);
    }
    __syncthreads();
    if (threadIdx.x == 0) misc[0] = (xb_add(&g_ctl[CW_EXIT], 1u) == (unsigned)G - 1u) ? 1u : 0u;
    __syncthreads();
    if (misc[0]) { for (int i = threadIdx.x; i < CW_WORDS; i += NTHREADS) __hip_atomic_store(&g_ctl[i], 0u, __ATOMIC_RELAXED, __HIP_MEMORY_SCOPE_AGENT);
                   for (int i = threadIdx.x; i < NGATE; i += NTHREADS) __hip_atomic_store(&g_colmax[i], 0u, __ATOMIC_RELAXED, __HIP_MEMORY_SCOPE_AGENT); }
}

extern "C" void kernel_launch(void* const* d_in, const int* in_sizes, int n_in, void* d_out, int out_size, void* d_ws, size_t ws_size, hipStream_t stream) {
    static int grid_blocks = 0;
    if (!grid_blocks) {
        if (n_in != 21 || out_size != T * DM || ws_size < WS_TOTAL) { fprintf(stderr, "kernel_launch: unexpected shapes (n_in %d out %d ws %zu)\n", n_in, out_size, ws_size); grid_blocks = -1; return; }
        int dev = 0, cus = 0, per_cu = 0;
        (void)hipGetDevice(&dev);
        (void)hipDeviceGetAttribute(&cus, hipDeviceAttributeMultiprocessorCount, dev);
        (void)hipFuncSetAttribute((const void*)fwd_mega, hipFuncAttributeMaxDynamicSharedMemorySize, LDS_BYTES);
        (void)hipOccupancyMaxActiveBlocksPerMultiprocessor(&per_cu, (const void*)fwd_mega, NTHREADS, LDS_BYTES);
        if (per_cu < 1) { fprintf(stderr, "kernel_launch: occupancy query returned %d\n", per_cu); grid_blocks = -1; return; }
        grid_blocks = cus;
        fprintf(stderr, "kernel_launch: cus %d per_cu %d grid %d\n", cus, per_cu, grid_blocks);
    }
    if (grid_blocks < 0) return;
    Params p{};
    p.x = (const float*)d_in[0]; p.mem = (const float*)d_in[1]; p.pos = (const int*)d_in[2]; p.norm_gain = (const float*)d_in[3]; p.w_in = (const float*)d_in[4];
    p.gmlp_g = (const float*)d_in[5]; p.gmlp_b = (const float*)d_in[6]; p.spatial_w = (const float*)d_in[7]; p.spatial_b = (const float*)d_in[8]; p.w_a = (const float*)d_in[9];
    p.q_gain = (const float*)d_in[10]; p.k_gain = (const float*)d_in[11]; p.ik_g = (const float*)d_in[12]; p.ik_b = (const float*)d_in[13]; p.w_b = (const float*)d_in[14];
    p.mem_gain = (const float*)d_in[15]; p.w_mkv = (const float*)d_in[16]; p.mq_gain = (const float*)d_in[17]; p.mk_gain = (const float*)d_in[18]; p.w_m = (const float*)d_in[19];
    p.w_out = (const float*)d_in[20]; p.out = (float*)d_out; p.ws = (unsigned char*)d_ws;
    void* args[] = {&p};
    hipError_t e = hipLaunchCooperativeKernel((const void*)fwd_mega, dim3(grid_blocks), dim3(NTHREADS), args, LDS_BYTES, stream);
    if (e != hipSuccess) fprintf(stderr, "cooperative launch failed: %s (grid %d)\n", hipGetErrorString(e), grid_blocks);
}
```

```cpp
#include <hip/hip_runtime.h>
#include <hip/hip_cooperative_groups.h>
#include <cstdio>
#include <cstdint>
namespace cg = cooperative_groups;

#define LAS __attribute__((address_space(3)))
typedef unsigned short bf16_t;
typedef short bf16x8 __attribute__((ext_vector_type(8)));
typedef short s16x4 __attribute__((ext_vector_type(4)));
typedef float f32x2 __attribute__((ext_vector_type(2)));
typedef float f32x4 __attribute__((ext_vector_type(4)));
typedef float f32x16 __attribute__((ext_vector_type(16)));
typedef unsigned u32x2 __attribute__((ext_vector_type(2)));
typedef unsigned u32x4 __attribute__((ext_vector_type(4)));
typedef int i32x4 __attribute__((ext_vector_type(4)));

constexpr int NB = 2, SEQ = 4096, T = NB * SEQ, DM = 2048, DIN = 14928, NPAD = 15104, MEML = 256;
constexpr int NTHREADS = 512, NWAVES = 8;
constexpr int LDS_BYTES = 147456;
constexpr float EPS = 1e-6f;
constexpr float LOG2E = 1.4426950408889634f;

constexpr size_t MiB = (size_t)1 << 20;
constexpr size_t WS_WIN = 0, WS_WBR = 60 * MiB, WS_WOUT = 72 * MiB, WS_WMKV = 80 * MiB, WS_H = 88 * MiB, WS_MEMN = 120 * MiB;
constexpr size_t WS_AU = 122 * MiB, WS_AV = 138 * MiB, WS_AZ = 154 * MiB, WS_QR = 170 * MiB, WS_BZ = 186 * MiB, WS_MQ = 202 * MiB, WS_MZ = 218 * MiB;
constexpr size_t WS_IQ = 234 * MiB, WS_KR = 250 * MiB, WS_VV = 254 * MiB, WS_SA = 258 * MiB, WS_SB = 290 * MiB, WS_SM = 322 * MiB;
constexpr size_t WS_QN = 354 * MiB, WS_KN = 370 * MiB, WS_XA = 374 * MiB, WS_XM = 390 * MiB, WS_MASK = 406 * MiB, WS_IK = 410 * MiB, WS_IW = 411 * MiB;
constexpr size_t WS_KM = 412 * MiB, WS_VT = 413 * MiB, WS_CSB = 414 * MiB, WS_CSI = 415 * MiB, WS_END = 416 * MiB;
constexpr size_t WS_RKP = WS_IW + 524288;
constexpr size_t WS_OPART = WS_END, WS_ML = WS_END + 32 * MiB, WS_TOTAL = WS_END + 34 * MiB;
constexpr size_t WS_CTL = WS_END, CTL_BYTES = 65536;
constexpr int NGATE = 8192, GATE0 = 6736, NT_BF = 27;
constexpr size_t WS_LNP = 48 * MiB;
constexpr size_t WS_W8 = 27 * MiB, WS_SH = 47 * MiB, WS_SW = 47 * MiB + 65536, WS_CMP = 47 * MiB + 131072, WS_H8 = WS_OPART;
static_assert(WS_W8 + (size_t)NGATE * DM <= WS_SH && WS_CMP + 8 * NGATE * 4 <= WS_WBR && (size_t)NT_BF * 256 * DM * 2 <= WS_W8, "int8 regions inside the WS_WIN slot");
constexpr int CW_BAR = 0;
constexpr int MISC_OFF = 147200;
constexpr size_t WS_XB = WS_QR;
constexpr size_t WS_MERGED = WS_H;

typedef __bf16 bf16x2_t __attribute__((ext_vector_type(2)));
__device__ __forceinline__ unsigned cvt_pk_bf16(float lo, float hi) { const f32x2 v = {lo, hi}; const bf16x2_t b = __builtin_convertvector(v, bf16x2_t); return __builtin_bit_cast(unsigned, b); }
__device__ __forceinline__ bf16_t f2bf(float f) { return (bf16_t)(cvt_pk_bf16(f, 0.f) & 0xffffu); }
__device__ __forceinline__ float bf2f(unsigned short b) { return __uint_as_float(((unsigned)b) << 16); }
__device__ __forceinline__ float bflo(unsigned w) { return __uint_as_float(w << 16); }
__device__ __forceinline__ float bfhi(unsigned w) { return __uint_as_float(w & 0xffff0000u); }
__device__ __forceinline__ float sigm(float x) { return __builtin_amdgcn_rcpf(1.f + __builtin_amdgcn_exp2f(-LOG2E * x)); }
__device__ __forceinline__ float silu_f(float x) { return x * sigm(x); }
__device__ __forceinline__ float gelu_f(float x) { const float u = 0.7978845608028654f * (x + 0.044715f * x * x * x); return x * sigm(2.f * u); }
__device__ __forceinline__ float wave_sum(float v) {
#pragma unroll
    for (int o = 1; o < 64; o <<= 1) v += __shfl_xor(v, o);
    return v;
}
__device__ __forceinline__ unsigned wave_sum_u(unsigned v) {
#pragma unroll
    for (int o = 1; o < 64; o <<= 1) v += (unsigned)__shfl_xor((int)v, o);
    return v;
}
__device__ __forceinline__ bf16x8 pack8(f32x4 a, f32x4 b) {
    u32x4 w = {cvt_pk_bf16(a[0], a[1]), cvt_pk_bf16(a[2], a[3]), cvt_pk_bf16(b[0], b[1]), cvt_pk_bf16(b[2], b[3])};
    return *reinterpret_cast<bf16x8*>(&w);
}
#define LDS_WAIT() asm volatile("s_waitcnt lgkmcnt(0)" ::: "memory")
__device__ __forceinline__ int opaque_tid() { int t = threadIdx.x; asm volatile("" : "+v"(t)); return t; }

namespace pg8 {
constexpr int BM = 256, BK = 64, HALF = 128, HTB = HALF * BK * 2, STAGE_BYTES = 8 * HTB, NXCD = 8, WGM = 8;
__host__ __device__ __forceinline__ int lds_byte(int r, int c) { const int st = (r >> 4) * 2 + (c >> 5), rr = r & 15, cc = c & 31, ob = rr * 64 + cc * 2; return st * 1024 + (ob ^ (((ob >> 9) & 1) << 5)); }
__host__ __device__ __forceinline__ void stage_rc(int b, int& R, int& C) { const int st = b / 1024, sb = b % 1024, swz = sb ^ (((sb >> 9) & 1) << 5); R = (st >> 1) * 16 + swz / 64; C = (st & 1) * 32 + (swz % 64) / 2; }
__host__ __device__ __forceinline__ int perm32(int rho) { const int n = rho >> 4, i = rho & 15; return 8 * (i >> 2) + 4 * n + (i & 3); }

struct Unit { int pm, pn, kind; };

__device__ __forceinline__ void tile_order(int wgid, int nM, int nN, int& pm, int& pn) {
    const int nwg = nM * nN;
    { const int q = nwg / NXCD, r = nwg % NXCD, xcd = wgid % NXCD, off = wgid / NXCD; wgid = (xcd < r ? xcd * (q + 1) : r * (q + 1) + (xcd - r) * q) + off; }
    const int nig = WGM * nN, gid = wgid / nig, fm = gid * WGM, gsz = (nM - fm) < WGM ? (nM - fm) : WGM;
    pm = fm + ((wgid % nig) % gsz); pn = (wgid % nig) / gsz;
}

template <class Epi, class Sched, bool ALIGN_EPI, bool SP2, bool I8 = false>
__device__ __forceinline__ void gemm_phase(LAS unsigned char* lds, const int K, const Sched& S, const Epi& E) {
    const int tid = opaque_tid(), wid = __builtin_amdgcn_readfirstlane(tid >> 6), lane = tid & 63, wr = wid >> 2, wc = wid & 3, fr = lane & 15, fq = lane >> 4;
    const int nt = K / BK;
    unsigned voffA[2], voffB[2];
#pragma unroll
    for (int i = 0; i < 2; ++i) { int R, C; stage_rc(tid * 16 + i * 8192, R, C); const int Rb = Epi::PERM ? ((R & ~31) + perm32(R & 31)) : R;
        voffA[i] = (unsigned)(R * K + C) * 2u; voffB[i] = (unsigned)(Rb * K + C) * 2u; }
    const size_t kstep = (size_t)(BK * 2);
    const size_t hstep = (size_t)HALF * K * 2;
    const unsigned ldsw = (unsigned)wid * 1024u;
    const int aoff = lds_byte(wr * 64 + fr, fq * 8), boff = lds_byte(wc * 32 + fr, fq * 8);
#define PG8_SA(b, h) (((b) * 2 + (h)) * HTB)
#define PG8_SB(b, h) ((4 + (b) * 2 + (h)) * HTB)
#define PG8_STAGE(bufoff, gbase, voff) do { _Pragma("unroll") for (int _i = 0; _i < 2; ++_i) \
        __builtin_amdgcn_global_load_lds((const unsigned*)((const char*)(gbase) + (voff)[_i]), (LAS unsigned*)(lds + (bufoff) + ldsw + _i * 8192), 16, 0, 0); } while (0)
#define PG8_LDA(dst, b, h) do { _Pragma("unroll") for (int m = 0; m < 4; ++m) _Pragma("unroll") for (int k = 0; k < 2; ++k) dst[m][k] = *(const LAS bf16x8*)(lds + PG8_SA(b, h) + aoff + m * 2048 + k * 1024); } while (0)
#define PG8_LDB(dst, b, h) do { _Pragma("unroll") for (int n = 0; n < 2; ++n) _Pragma("unroll") for (int k = 0; k < 2; ++k) dst[n][k] = *(const LAS bf16x8*)(lds + PG8_SB(b, h) + boff + n * 2048 + k * 1024); } while (0)
#define PG8_MMA(ai, bj, At, Bt) do { __builtin_amdgcn_s_setprio(1); _Pragma("unroll") for (int m = 0; m < 4; ++m) _Pragma("unroll") for (int n = 0; n < 2; ++n) _Pragma("unroll") for (int k = 0; k < 2; ++k) \
        { if constexpr (I8) acc[ai][bj][m][n] = __builtin_bit_cast(f32x4, __builtin_amdgcn_mfma_i32_16x16x64_i8(__builtin_bit_cast(i32x4, Bt[n][k]), __builtin_bit_cast(i32x4, At[m][k]), __builtin_bit_cast(i32x4, acc[ai][bj][m][n]), 0, 0, 0)); \
          else acc[ai][bj][m][n] = __builtin_amdgcn_mfma_f32_16x16x32_bf16(Bt[n][k], At[m][k], acc[ai][bj][m][n], 0, 0, 0); } __builtin_amdgcn_s_setprio(0); } while (0)
#define PG8_WAIT_V(n) asm volatile("s_waitcnt vmcnt(" #n ")" ::: "memory")
#define PG8_WAIT_L(n) asm volatile("s_waitcnt lgkmcnt(" #n ")" ::: "memory")
#define PG8_BAR __builtin_amdgcn_s_barrier()
#define PG8_SCHED __builtin_amdgcn_sched_barrier(0)
    Unit cur, nxt; int ui = 0;
    if (!S.next(0, cur)) return;
    f32x4 acc[2][2][4][2];
    if constexpr (Epi::INIT) E.init(acc, cur, wr, wc, fr, fq);
    else {
#pragma unroll
    for (int a = 0; a < 2; ++a)
#pragma unroll
        for (int b = 0; b < 2; ++b)
#pragma unroll
            for (int m = 0; m < 4; ++m)
#pragma unroll
                for (int n = 0; n < 2; ++n) acc[a][b][m][n] = (f32x4){0.f, 0.f, 0.f, 0.f};
    }
    bf16x8 At[4][2], B0[2][2], B1[2][2];
    const char* cA = S.a_base(cur); const char* cB = S.b_base(cur);
    if constexpr (SP2) {
        PG8_STAGE(PG8_SB(0, 0), cB, voffB); PG8_STAGE(PG8_SB(0, 1), cB + hstep, voffB); PG8_STAGE(PG8_SA(0, 0), cA, voffA); PG8_STAGE(PG8_SA(0, 1), cA + hstep, voffA);
        if (wr == 1) PG8_BAR;
        PG8_WAIT_V(2); PG8_BAR;
        PG8_STAGE(PG8_SB(1, 0), cB + kstep, voffB); PG8_STAGE(PG8_SA(1, 0), cA + kstep, voffA); PG8_STAGE(PG8_SB(1, 1), cB + hstep + kstep, voffB);
        PG8_WAIT_V(6); PG8_BAR;
    } else {
        PG8_STAGE(PG8_SB(0, 0), cB, voffB); PG8_STAGE(PG8_SA(0, 0), cA, voffA); PG8_STAGE(PG8_SB(0, 1), cB + hstep, voffB); PG8_STAGE(PG8_SA(0, 1), cA + hstep, voffA);
        if (wr == 1) PG8_BAR;
        PG8_WAIT_V(4); PG8_BAR;
        PG8_STAGE(PG8_SB(1, 0), cB + kstep, voffB); PG8_STAGE(PG8_SA(1, 0), cA + kstep, voffA); PG8_STAGE(PG8_SB(1, 1), cB + hstep + kstep, voffB);
        PG8_WAIT_V(6); PG8_BAR;
    }
    for (;;) {
        const bool has_next = S.next(ui + 1, nxt);
        const char* nA = has_next ? S.a_base(nxt) : cA; const char* nB = has_next ? S.b_base(nxt) : cB;
        for (int t = 0; t < nt; t += 2) {
            const bool last = (t == nt - 2);
            const char* a1 = cA + (size_t)(t + 1) * kstep;
            const char* a2 = last ? nA : cA + (size_t)(t + 2) * kstep; const char* b2 = last ? nB : cB + (size_t)(t + 2) * kstep;
            const char* a3 = a2 + kstep; const char* b3 = b2 + kstep;
            if constexpr (SP2) {
            PG8_LDB(B0, 0, 0); PG8_LDB(B1, 0, 1); PG8_SCHED; PG8_LDA(At, 0, 0); PG8_STAGE(PG8_SA(1, 1), a1 + hstep, voffA);
            PG8_WAIT_V(8); PG8_WAIT_L(0); PG8_BAR; PG8_MMA(0, 0, At, B0); PG8_MMA(0, 1, At, B1); PG8_BAR; PG8_SCHED;
            PG8_LDA(At, 0, 1); PG8_STAGE(PG8_SB(0, 0), b2, voffB); PG8_STAGE(PG8_SB(0, 1), b2 + hstep, voffB); PG8_STAGE(PG8_SA(0, 0), a2, voffA);
            PG8_WAIT_V(8); PG8_WAIT_L(0); PG8_BAR; PG8_MMA(1, 0, At, B0); PG8_MMA(1, 1, At, B1); PG8_BAR; PG8_SCHED;
            PG8_LDB(B0, 1, 0); PG8_LDB(B1, 1, 1); PG8_SCHED; PG8_LDA(At, 1, 0); PG8_STAGE(PG8_SA(0, 1), a2 + hstep, voffA);
            PG8_WAIT_V(8); PG8_WAIT_L(0); PG8_BAR; PG8_MMA(0, 0, At, B0); PG8_MMA(0, 1, At, B1); PG8_BAR; PG8_SCHED;
            PG8_LDA(At, 1, 1); PG8_STAGE(PG8_SB(1, 0), b3, voffB); PG8_STAGE(PG8_SB(1, 1), b3 + hstep, voffB); PG8_STAGE(PG8_SA(1, 0), a3, voffA);
            PG8_WAIT_V(8); PG8_WAIT_L(0); PG8_BAR; PG8_MMA(1, 0, At, B0); PG8_MMA(1, 1, At, B1); PG8_BAR; PG8_SCHED;
            } else {
            PG8_LDB(B0, 0, 0); PG8_SCHED; PG8_LDA(At, 0, 0); PG8_STAGE(PG8_SA(1, 1), a1 + hstep, voffA);
            PG8_WAIT_L(8); PG8_BAR; PG8_WAIT_L(0); PG8_MMA(0, 0, At, B0); PG8_BAR; PG8_SCHED;
            PG8_LDB(B1, 0, 1); PG8_STAGE(PG8_SB(0, 0), b2, voffB);
            PG8_BAR; PG8_WAIT_L(0); PG8_MMA(0, 1, At, B1); PG8_BAR;
            PG8_LDA(At, 0, 1); PG8_STAGE(PG8_SA(0, 0), a2, voffA);
            PG8_BAR; PG8_WAIT_L(0); PG8_MMA(1, 0, At, B0); PG8_BAR; PG8_SCHED;
            PG8_STAGE(PG8_SB(0, 1), b2 + hstep, voffB);
            PG8_WAIT_V(6); PG8_BAR; PG8_MMA(1, 1, At, B1); PG8_BAR;
            PG8_LDB(B0, 1, 0); PG8_SCHED; PG8_LDA(At, 1, 0); PG8_STAGE(PG8_SA(0, 1), a2 + hstep, voffA);
            PG8_WAIT_L(8); PG8_BAR; PG8_WAIT_L(0); PG8_MMA(0, 0, At, B0); PG8_BAR; PG8_SCHED;
            PG8_LDB(B1, 1, 1); PG8_STAGE(PG8_SB(1, 0), b3, voffB);
            PG8_BAR; PG8_WAIT_L(0); PG8_MMA(0, 1, At, B1); PG8_BAR;
            PG8_LDA(At, 1, 1); PG8_STAGE(PG8_SA(1, 0), a3, voffA);
            PG8_BAR; PG8_WAIT_L(0); PG8_MMA(1, 0, At, B0); PG8_BAR; PG8_SCHED;
            PG8_STAGE(PG8_SB(1, 1), b3 + hstep, voffB);
            PG8_WAIT_V(6); PG8_BAR; PG8_MMA(1, 1, At, B1); PG8_BAR;
            }
        }
        if constexpr (ALIGN_EPI) { if (wr == 0) PG8_BAR; }
        const bool zero = E(acc, cur, wr, wc, fr, fq);
        if (!has_next) break;
        if constexpr (Epi::INIT) { E.init(acc, nxt, wr, wc, fr, fq); }
        else if (zero) {
#pragma unroll
        for (int a = 0; a < 2; ++a)
#pragma unroll
            for (int b = 0; b < 2; ++b)
#pragma unroll
                for (int m = 0; m < 4; ++m)
#pragma unroll
                    for (int n = 0; n < 2; ++n) acc[a][b][m][n] = (f32x4){0.f, 0.f, 0.f, 0.f};
        }
        cur = nxt; cA = nA; cB = nB; ++ui;
        if constexpr (ALIGN_EPI) { if (wr == 1) PG8_BAR; }
    }
    PG8_WAIT_V(0);
    if constexpr (!ALIGN_EPI) { if (wr == 0) PG8_BAR; }
    PG8_BAR;
#undef PG8_SA
#undef PG8_SB
#undef PG8_STAGE
#undef PG8_LDA
#undef PG8_LDB
#undef PG8_MMA
#undef PG8_WAIT_V
#undef PG8_WAIT_L
#undef PG8_BAR
#undef PG8_SCHED
}
}

struct Params {
    const float* x; const float* mem; const int* pos; const float* norm_gain; const float* w_in; const float* gmlp_g; const float* gmlp_b;
    const float* spatial_w; const float* spatial_b; const float* w_a; const float* q_gain; const float* k_gain; const float* ik_g; const float* ik_b;
    const float* w_b; const float* mem_gain; const float* w_mkv; const float* mq_gain; const float* mk_gain; const float* w_m; const float* w_out;
    float* out; unsigned char* ws;
};

__device__ unsigned g_colmax[8192];

__device__ __forceinline__ int win_src_col(int np) {
    const int tile = np >> 8, c = np & 255;
    if (tile < 22) return np;
    const int bj = c >> 7, wc = (c >> 5) & 3, fq = (c >> 3) & 3, j = c & 7;
    if (tile < 26) return 5632 + (tile - 22) * 256 + wc * 64 + 8 * (2 * fq + bj) + j;
    if (tile == 26) {
        if (wc == 0) return 6656 + 8 * (2 * fq + bj) + j;
        if (wc == 1 && fq == 0) return 6720 + 8 * bj + j;
        return -1;
    }
    return np - 176;
}
__device__ __forceinline__ void transpose_item(const float* W, int K, int N, bf16_t* WT, int kb, int nb, bool is_win, LAS float* scr, int lane) {
    const int k0 = 64 * kb, n0 = 32 * nb, nl = lane & 31;
    const int src = is_win ? win_src_col(n0 + nl) : (n0 + nl);
    const float* wp = W + (size_t)(k0 + (lane >> 5)) * N + (src >= 0 ? src : 0);
    float tv[32];
#pragma unroll
    for (int i = 0; i < 32; ++i) tv[i] = wp[(size_t)(2 * i) * N];
#pragma unroll
    for (int i = 0; i < 32; ++i) { const int kk = 2 * i + (lane >> 5); scr[kk * 33 + nl] = src >= 0 ? tv[i] : 0.f; }
    LDS_WAIT(); asm volatile("" ::: "memory");
    const int c = lane & 7;
#pragma unroll
    for (int j = 0; j < 4; ++j) { const int n = (lane >> 3) + 8 * j; const LAS float* s = scr + (8 * c) * 33 + n;
        u32x4 o; o.x = cvt_pk_bf16(s[0 * 33], s[1 * 33]); o.y = cvt_pk_bf16(s[2 * 33], s[3 * 33]); o.z = cvt_pk_bf16(s[4 * 33], s[5 * 33]); o.w = cvt_pk_bf16(s[6 * 33], s[7 * 33]);
        *(u32x4*)(WT + (size_t)(n0 + n) * K + k0 + 8 * c) = o; }
    LDS_WAIT(); asm volatile("" ::: "memory");
}
template <bool Q8>
__device__ __forceinline__ void rms_row(const float* xrow, const float* gain, bf16_t* orow, unsigned* q8row, float* q8scale, int lane) {
    f32x4 v[8]; float s = 0.f;
#pragma unroll
    for (int j = 0; j < 8; ++j) { v[j] = ((const f32x4*)xrow)[lane + 64 * j]; s += (v[j][0] * v[j][0] + v[j][1] * v[j][1]) + (v[j][2] * v[j][2] + v[j][3] * v[j][3]); }
    s = wave_sum(s);
    const float r = 1.0f / sqrtf(s * (1.0f / DM) + EPS);
    float am = 0.f;
#pragma unroll
    for (int j = 0; j < 8; ++j) { const f32x4 g = ((const f32x4*)gain)[lane + 64 * j]; v[j] = v[j] * r * g;
        u32x2 w; w.x = cvt_pk_bf16(v[j][0], v[j][1]); w.y = cvt_pk_bf16(v[j][2], v[j][3]); ((u32x2*)orow)[lane + 64 * j] = w;
        if (Q8) am = fmaxf(fmaxf(am, fmaxf(fabsf(v[j][0]), fabsf(v[j][1]))), fmaxf(fabsf(v[j][2]), fabsf(v[j][3]))); }
    if (Q8) {
#pragma unroll
        for (int o = 1; o < 64; o <<= 1) am = fmaxf(am, __shfl_xor(am, o));
        const float inv = am > 0.f ? 127.f / am : 0.f;
#pragma unroll
        for (int j = 0; j < 8; ++j) { const int q0 = (int)rintf(v[j][0] * inv), q1 = (int)rintf(v[j][1] * inv), q2 = (int)rintf(v[j][2] * inv), q3 = (int)rintf(v[j][3] * inv);
            q8row[lane + 64 * j] = (unsigned)(q0 & 0xff) | ((unsigned)(q1 & 0xff) << 8) | ((unsigned)(q2 & 0xff) << 16) | ((unsigned)(q3 & 0xff) << 24); }
        if (lane == 0) *q8scale = am * (1.f / 127.f);
    }
}
__device__ __forceinline__ void p0_prep(const Params& p, LAS unsigned char* lds, int vcu, int G) {
    const int tid = opaque_tid(), lane = tid & 63, wave = tid >> 6;
    LAS float* scr = (LAS float*)(lds + wave * 16384);
    const int gw = vcu * NWAVES + wave, NGW = G * NWAVES;
    unsigned char* ws = p.ws;
    constexpr int I_CM = 32 * 32, I_WIN = 32 * (NT_BF * 8), I_BR = 16 * 64, I_SQ = 32 * 64;
    constexpr int NITEMS = I_CM + I_WIN + 3 * I_BR + 2 * I_SQ;
    for (int it = gw; it < NITEMS; it += NGW) {
        int r = it;
        if (r < I_CM) {
            const int cg = r % 32, kc = r / 32; const float* wp = p.w_in + (size_t)(64 * kc) * DIN + GATE0 + 256 * cg + 4 * lane; f32x4 m = {0.f, 0.f, 0.f, 0.f};
#pragma unroll 32
            for (int k = 0; k < 64; ++k) { const f32x4 w = *(const f32x4*)(wp + (size_t)k * DIN); m[0] = fmaxf(m[0], fabsf(w[0])); m[1] = fmaxf(m[1], fabsf(w[1])); m[2] = fmaxf(m[2], fabsf(w[2])); m[3] = fmaxf(m[3], fabsf(w[3])); }
#pragma unroll
            for (int e = 0; e < 4; ++e) atomicMax(&g_colmax[256 * cg + 4 * lane + e], __float_as_uint(m[e]));
            continue; } r -= I_CM;
        if (r < I_WIN) { const int nb = r % (NT_BF * 8), kb = r / (NT_BF * 8); transpose_item(p.w_in, DM, DIN, (bf16_t*)(ws + WS_WIN), kb, nb, true, scr, lane); continue; } r -= I_WIN;
        if (r < 3 * I_BR) { const int br = r / I_BR, q = r % I_BR; const float* W = br == 0 ? p.w_a : (br == 1 ? p.w_b : p.w_m);
            transpose_item(W, 1024, DM, (bf16_t*)(ws + WS_WBR) + (size_t)br * DM * 1024, q / 64, q % 64, false, scr, lane); continue; } r -= 3 * I_BR;
        if (r < I_SQ) { transpose_item(p.w_out, DM, DM, (bf16_t*)(ws + WS_WOUT), r / 64, r % 64, false, scr, lane); continue; } r -= I_SQ;
        transpose_item(p.w_mkv, DM, DM, (bf16_t*)(ws + WS_WMKV), r / 64, r % 64, false, scr, lane);
    }
    for (int m = gw; m < T + NB * MEML; m += NGW) {
        if (m < T) rms_row<true>(p.x + (size_t)m * DM, p.norm_gain, (bf16_t*)(ws + WS_H) + (size_t)m * DM, (unsigned*)(ws + WS_H8) + (size_t)m * (DM / 4), (float*)(ws + WS_SH) + m, lane);
        else rms_row<false>(p.mem + (size_t)(m - T) * DM, p.mem_gain, (bf16_t*)(ws + WS_MEMN) + (size_t)(m - T) * DM, nullptr, nullptr, lane);
    }
    for (int i = vcu * NTHREADS + tid; i < T * 24; i += G * NTHREADS) {
        const int t = i / 24, j = i % 24; const float ps = (float)p.pos[t];
        float inv; if (j < 16) inv = powf(500000.0f, -(float)j / 16.0f); else inv = powf(500000.0f, -(float)(j - 16) / 8.0f);
        float sn, cs; sincosf(ps * inv, &sn, &cs);
        if (j < 16) ((f32x2*)(ws + WS_CSB))[t * 16 + j] = (f32x2){cs, sn}; else ((f32x2*)(ws + WS_CSI))[t * 8 + (j - 16)] = (f32x2){cs, sn};
    }
}
__device__ __forceinline__ void p0b_gate8(const Params& p, LAS unsigned char* lds, int widx, int nw) {
    const int tid = opaque_tid(), lane = tid & 63, wave = tid >> 6;
    LAS float* scr = (LAS float*)(lds + wave * 16384);
    const int gw = widx * NWAVES + wave, NGW = nw * NWAVES;
    unsigned char* ws = p.ws;
    for (int it = gw; it < 32 * (NGATE / 32); it += NGW) {
        const int nb = it % (NGATE / 32), kb = it / (NGATE / 32), k0 = 64 * kb, n0 = 32 * nb, nl = lane & 31;
        const float cm = __uint_as_float(__hip_atomic_load(&g_colmax[n0 + nl], __ATOMIC_RELAXED, __HIP_MEMORY_SCOPE_AGENT));
        const float inv = cm > 0.f ? 127.f / cm : 0.f;
        if (kb == 0 && lane < 32) ((float*)(ws + WS_SW))[n0 + nl] = cm * (1.f / 127.f);
        const float* wp = p.w_in + (size_t)(k0 + (lane >> 5)) * DIN + GATE0 + n0 + nl;
        float tv[32];
#pragma unroll
        for (int i = 0; i < 32; ++i) tv[i] = wp[(size_t)(2 * i) * DIN];
#pragma unroll
        for (int i = 0; i < 32; ++i) { const int kk = 2 * i + (lane >> 5); scr[kk * 33 + nl] = rintf(tv[i] * inv); }
        LDS_WAIT(); asm volatile("" ::: "memory");
        const int c = lane & 7;
#pragma unroll
        for (int j = 0; j < 4; ++j) { const int n = (lane >> 3) + 8 * j; const LAS float* sp = scr + (8 * c) * 33 + n;
            unsigned lo = 0, hi2 = 0;
#pragma unroll
            for (int e = 0; e < 4; ++e) { lo |= ((unsigned)((int)sp[e * 33]) & 0xffu) << (8 * e); hi2 |= ((unsigned)((int)sp[(4 + e) * 33]) & 0xffu) << (8 * e); }
            *(u32x2*)((unsigned char*)(ws + WS_W8) + (size_t)(n0 + n) * DM + k0 + 8 * c) = (u32x2){lo, hi2}; }
        LDS_WAIT(); asm volatile("" ::: "memory");
    }
}

struct Sched1 {
    int G, c; const char* ws;
    __device__ __forceinline__ bool next(int i, pg8::Unit& u) const {
        int L = i * G + c;
        if (L < 32 * NT_BF) { pg8::tile_order(L, 32, NT_BF, u.pm, u.pn); u.kind = 0; return true; }
        L -= 32 * NT_BF;
        if (L < 8) { u.pm = L & 1; u.pn = L >> 1; u.kind = 1; return true; }
        L -= 8;
        if (L < 8) { u.pm = L & 3; u.pn = L >> 2; u.kind = 2; return true; }
        return false;
    }
    __device__ __forceinline__ const char* a_base(const pg8::Unit& u) const {
        const size_t off = u.kind == 0 ? WS_H : (u.kind == 1 ? WS_MEMN : WS_WMKV + (size_t)1024 * DM * 2);
        return ws + off + (size_t)u.pm * (256 * DM * 2); }
    __device__ __forceinline__ const char* b_base(const pg8::Unit& u) const {
        const size_t off = u.kind == 0 ? WS_WIN : (u.kind == 1 ? WS_WMKV : WS_MEMN);
        return ws + off + (size_t)u.pn * (256 * DM * 2); }
};
struct Epi1 {
    static constexpr bool PERM = true, INIT = false;
    unsigned char* ws; const float* ikg; const float* ikb;
    __device__ __forceinline__ bool operator()(f32x4 (&acc)[2][2][4][2], const pg8::Unit& u, int wr, int wc, int fr, int fq) const {
        const int rowb = u.pm * 256 + wr * 64 + fr, cl = wc * 32 + 8 * fq, pn = u.pn;
#ifndef EX_NOIQ
        if (u.kind == 0 && pn >= 22 && pn < 26) {
            const int head = 4 * (pn - 22) + wc;
#pragma unroll
            for (int ai = 0; ai < 2; ++ai)
#pragma unroll
                for (int m = 0; m < 4; ++m) { const int row = rowb + ai * 128 + m * 16;
                    f32x4 x1a = acc[ai][0][m][0], x1b = acc[ai][0][m][1], x2a = acc[ai][1][m][0], x2b = acc[ai][1][m][1];
                    if (fq == 0) { const f32x4* cs = (const f32x4*)(ws + WS_CSI) + row * 4;
                        const f32x4 c0 = cs[0], c1 = cs[1], c2 = cs[2], c3 = cs[3];
                        const f32x4 co_a = {c0[0], c0[2], c1[0], c1[2]}, si_a = {c0[1], c0[3], c1[1], c1[3]}, co_b = {c2[0], c2[2], c3[0], c3[2]}, si_b = {c2[1], c2[3], c3[1], c3[3]};
                        const f32x4 r1a = x1a * co_a - x2a * si_a, r1b = x1b * co_b - x2b * si_b, r2a = x2a * co_a + x1a * si_a, r2b = x2b * co_b + x1b * si_b;
                        x1a = r1a; x1b = r1b; x2a = r2a; x2b = r2b; }
                    bf16_t* dst = (bf16_t*)(ws + WS_IQ) + (size_t)row * 1024 + head * 64 + 16 * fq;
                    *(bf16x8*)(dst) = pack8(x1a, x1b); *(bf16x8*)(dst + 8) = pack8(x2a, x2b); }
            return true;
        }
#endif
#ifndef EX_NOIK
        if (u.kind == 0 && pn == 26) {
            if (wc == 0) {
                const f32x4 g0 = *(const f32x4*)(ikg + 16 * fq), g1 = *(const f32x4*)(ikg + 16 * fq + 4), g2 = *(const f32x4*)(ikg + 16 * fq + 8), g3 = *(const f32x4*)(ikg + 16 * fq + 12);
                const f32x4 e0 = *(const f32x4*)(ikb + 16 * fq), e1 = *(const f32x4*)(ikb + 16 * fq + 4), e2 = *(const f32x4*)(ikb + 16 * fq + 8), e3 = *(const f32x4*)(ikb + 16 * fq + 12);
#pragma unroll
                for (int ai = 0; ai < 2; ++ai)
#pragma unroll
                    for (int m = 0; m < 4; ++m) { const int row = rowb + ai * 128 + m * 16;
                        f32x4 v0 = acc[ai][0][m][0], v1 = acc[ai][0][m][1], v2 = acc[ai][1][m][0], v3 = acc[ai][1][m][1];
                        const f32x4 sv = (v0 + v1) + (v2 + v3);
                        float sm = (sv[0] + sv[1]) + (sv[2] + sv[3]);
                        sm += __shfl_xor(sm, 16); sm += __shfl_xor(sm, 32);
                        const float mean = sm * (1.f / 64.f);
                        v0 = v0 - mean; v1 = v1 - mean; v2 = v2 - mean; v3 = v3 - mean;
                        const f32x4 qv = (v0 * v0 + v1 * v1) + (v2 * v2 + v3 * v3);
                        float q2 = (qv[0] + qv[1]) + (qv[2] + qv[3]);
                        q2 += __shfl_xor(q2, 16); q2 += __shfl_xor(q2, 32);
                        const float rstd = 1.0f / sqrtf(q2 * (1.f / 64.f) + EPS);
                        v0 = v0 * rstd * g0 + e0; v1 = v1 * rstd * g1 + e1; v2 = v2 * rstd * g2 + e2; v3 = v3 * rstd * g3 + e3;
                        if (fq == 0) { const f32x4* cs = (const f32x4*)(ws + WS_CSI) + row * 4;
                            const f32x4 c0 = cs[0], c1 = cs[1], c2 = cs[2], c3 = cs[3];
                            const f32x4 co_a = {c0[0], c0[2], c1[0], c1[2]}, si_a = {c0[1], c0[3], c1[1], c1[3]}, co_b = {c2[0], c2[2], c3[0], c3[2]}, si_b = {c2[1], c2[3], c3[1], c3[3]};
                            const f32x4 r1a = v0 * co_a - v2 * si_a, r1b = v1 * co_b - v3 * si_b, r2a = v2 * co_a + v0 * si_a, r2b = v3 * co_b + v1 * si_b;
                            v0 = r1a; v1 = r1b; v2 = r2a; v3 = r2b; }
                        bf16_t* dst = (bf16_t*)(ws + WS_IK) + (size_t)row * 64 + 16 * fq;
                        *(bf16x8*)(dst) = pack8(v0, v1); *(bf16x8*)(dst + 8) = pack8(v2, v3); }
            } else if (wc == 1 && fq == 0) {
#pragma unroll
                for (int ai = 0; ai < 2; ++ai)
#pragma unroll
                    for (int m = 0; m < 4; ++m) { const int row = rowb + ai * 128 + m * 16; float* dst = (float*)(ws + WS_IW) + (size_t)row * 16;
                        *(f32x4*)(dst) = acc[ai][0][m][0] * 0.03125f; *(f32x4*)(dst + 4) = acc[ai][0][m][1] * 0.03125f;
                        *(f32x4*)(dst + 8) = acc[ai][1][m][0] * 0.03125f; *(f32x4*)(dst + 12) = acc[ai][1][m][1] * 0.03125f; }
            }
            return true;
        }
#endif
        int act = 0, ld = 1024, co = 0, bjs = 128; size_t off = 0, bex = 0;
        if (u.kind == 1) { off = WS_KM; co = pn * 256; }
        else if (u.kind == 2) { off = WS_VT; ld = 512; co = pn * 256; }
        else if (pn < 4) { act = 1; off = WS_AU; co = pn * 256; }
        else if (pn < 8) { act = 1; off = WS_AV; co = (pn - 4) * 256; }
        else if (pn < 12) { act = 2; off = WS_AZ; co = (pn - 8) * 256; }
        else if (pn < 16) { off = WS_QR; co = (pn - 12) * 256; }
        else if (pn == 16) { off = WS_KR; ld = 256; }
        else if (pn == 17) { off = WS_VV; ld = 128; bjs = SEQ * 128; bex = (size_t)SEQ * 128; }
        else { act = 2; off = WS_BZ; co = (pn - 18) * 256; }
        bf16_t* dst = (bf16_t*)(ws + off) + co + cl;
#pragma unroll
        for (int ai = 0; ai < 2; ++ai)
#pragma unroll
            for (int m = 0; m < 4; ++m) { const int row = rowb + ai * 128 + m * 16; bf16_t* rp = dst + (size_t)row * ld + (size_t)(row >> 12) * bex;
#pragma unroll
                for (int bj = 0; bj < 2; ++bj) { f32x4 v0 = acc[ai][bj][m][0], v1 = acc[ai][bj][m][1];
                    if (act == 1) {
#pragma unroll
                        for (int e = 0; e < 4; ++e) { v0[e] = gelu_f(v0[e]); v1[e] = gelu_f(v1[e]); } }
                    else if (act == 2) {
#pragma unroll
                        for (int e = 0; e < 4; ++e) { v0[e] = silu_f(v0[e]); v1[e] = silu_f(v1[e]); } }
                    *(bf16x8*)(rp + (size_t)bj * bjs) = pack8(v0, v1); }
                if (u.kind == 0 && pn >= 4 && pn < 8) {
                    f32x4 g0 = acc[ai][0][m][0], g1 = acc[ai][0][m][1], g2 = acc[ai][1][m][0], g3 = acc[ai][1][m][1];
#pragma unroll
                    for (int e = 0; e < 4; ++e) { g0[e] = gelu_f(g0[e]); g1[e] = gelu_f(g1[e]); g2[e] = gelu_f(g2[e]); g3[e] = gelu_f(g3[e]); }
                    const f32x4 sv = (g0 + g1) + (g2 + g3), qv = (g0 * g0 + g1 * g1) + (g2 * g2 + g3 * g3);
                    float s1 = (sv[0] + sv[1]) + (sv[2] + sv[3]), s2 = (qv[0] + qv[1]) + (qv[2] + qv[3]);
                    s1 += __shfl_xor(s1, 16); s2 += __shfl_xor(s2, 16); s1 += __shfl_xor(s1, 32); s2 += __shfl_xor(s2, 32);
                    if (fq == 0) ((f32x2*)(ws + WS_LNP))[(size_t)row * 16 + (pn - 4) * 4 + wc] = (f32x2){s1, s2}; }
                if (u.kind == 1) {
                    const f32x4 q = (acc[ai][0][m][0] * acc[ai][0][m][0] + acc[ai][0][m][1] * acc[ai][0][m][1]) + (acc[ai][1][m][0] * acc[ai][1][m][0] + acc[ai][1][m][1] * acc[ai][1][m][1]);
                    float ss = (q[0] + q[1]) + (q[2] + q[3]);
                    ss += __shfl_xor(ss, 16); ss += __shfl_xor(ss, 32);
                    if (fq == 0) ((float*)(ws + WS_RKP))[(size_t)row * 16 + pn * 4 + wc] = ss; } }
        return true;
    }
};

struct Sched1b {
    int G, c; const char* ws;
    __device__ __forceinline__ bool next(int i, pg8::Unit& u) const { const int L = i * G + c; if (L >= 32 * 32) return false; pg8::tile_order(L, 32, 32, u.pm, u.pn); u.kind = 0; return true; }
    __device__ __forceinline__ const char* a_base(const pg8::Unit& u) const { return ws + WS_H8 + (size_t)u.pm * (256 * DM); }
    __device__ __forceinline__ const char* b_base(const pg8::Unit& u) const { return ws + WS_W8 + (size_t)u.pn * (256 * DM); }
};
struct Epi1b {
    static constexpr bool PERM = true, INIT = false;
    unsigned char* ws;
    __device__ __forceinline__ bool operator()(f32x4 (&acc)[2][2][4][2], const pg8::Unit& u, int wr, int wc, int fr, int fq) const {
        const int rowb = u.pm * 256 + wr * 64 + fr, cl = wc * 32 + 8 * fq, pn = u.pn;
        const float* __restrict__ SW = (const float*)(ws + WS_SW) + pn * 256 + cl; const float* __restrict__ SH = (const float*)(ws + WS_SH);
        const f32x4 sw00 = *(const f32x4*)(SW), sw01 = *(const f32x4*)(SW + 4), sw10 = *(const f32x4*)(SW + 128), sw11 = *(const f32x4*)(SW + 132);
        float sh[2][4];
#pragma unroll
        for (int ai = 0; ai < 2; ++ai)
#pragma unroll
            for (int m = 0; m < 4; ++m) sh[ai][m] = SH[rowb + ai * 128 + m * 16];
        if (pn < 8) {
            bf16_t* __restrict__ dst = (bf16_t*)(ws + (pn < 4 ? WS_MQ : WS_MZ)) + (pn & 3) * 256 + cl;
#pragma unroll
            for (int ai = 0; ai < 2; ++ai)
#pragma unroll
                for (int m = 0; m < 4; ++m) { const int row = rowb + ai * 128 + m * 16; const float rs = sh[ai][m];
#pragma unroll
                    for (int bj = 0; bj < 2; ++bj) { f32x4 v0, v1; const f32x4 s0 = bj ? sw10 : sw00, s1 = bj ? sw11 : sw01;
#pragma unroll
                        for (int e = 0; e < 4; ++e) { v0[e] = (float)__float_as_int(acc[ai][bj][m][0][e]) * (rs * s0[e]); v1[e] = (float)__float_as_int(acc[ai][bj][m][1][e]) * (rs * s1[e]); }
                        if (pn >= 4) {
#pragma unroll
                            for (int e = 0; e < 4; ++e) { v0[e] = silu_f(v0[e]); v1[e] = silu_f(v1[e]); } }
                        *(bf16x8*)(dst + (size_t)row * 1024 + bj * 128) = pack8(v0, v1); } }
            return true;
        }
        const int pg = pn - 8;
        unsigned char* __restrict__ dst = (unsigned char*)(ws + WS_SA + (size_t)(pg >> 3) * (WS_SB - WS_SA)) + (pg & 7) * 256 + cl;
#pragma unroll
        for (int ai = 0; ai < 2; ++ai)
#pragma unroll
            for (int m = 0; m < 4; ++m) { const int row = rowb + ai * 128 + m * 16; const float rs = sh[ai][m] * (-LOG2E);
#pragma unroll
                for (int bj = 0; bj < 2; ++bj) { const f32x4 s0 = bj ? sw10 : sw00, s1 = bj ? sw11 : sw01; unsigned lo = 0, hi2 = 0;
#pragma unroll
                    for (int e = 0; e < 4; ++e) {
                        const float q0 = 255.f * __builtin_amdgcn_rcpf(1.f + __builtin_amdgcn_exp2f((float)__float_as_int(acc[ai][bj][m][0][e]) * (rs * s0[e])));
                        const float q1 = 255.f * __builtin_amdgcn_rcpf(1.f + __builtin_amdgcn_exp2f((float)__float_as_int(acc[ai][bj][m][1][e]) * (rs * s1[e])));
                        lo = __builtin_amdgcn_cvt_pk_u8_f32(__builtin_amdgcn_fmed3f(q0, 1.f, 255.f), e, lo); hi2 = __builtin_amdgcn_cvt_pk_u8_f32(__builtin_amdgcn_fmed3f(q1, 1.f, 255.f), e, hi2); }
                    *(u32x2*)(dst + (size_t)row * DM + bj * 128) = (u32x2){lo, hi2}; } }
        return true;
    }
};

struct Sched2 {
    int G, c; const char* ws;
    __device__ __forceinline__ bool next(int i, pg8::Unit& u) const {
        const int L = (i / 3) * G + c; if (L >= 256) return false;
        pg8::tile_order(L, 32, 8, u.pm, u.pn); u.kind = i % 3; return true;
    }
    __device__ __forceinline__ const char* a_base(const pg8::Unit& u) const {
        const size_t off = WS_XA + (u.kind == 1 ? (WS_XB - WS_XA) : (size_t)0) + (u.kind == 2 ? (WS_XM - WS_XA) : (size_t)0);
        return ws + off + (size_t)u.pm * (256 * 1024 * 2); }
    __device__ __forceinline__ const char* b_base(const pg8::Unit& u) const { return ws + WS_WBR + (size_t)u.kind * ((size_t)DM * 1024 * 2) + (size_t)u.pn * (256 * 1024 * 2); }
};
struct Epi2 {
    static constexpr bool PERM = true, INIT = false;
    unsigned char* ws;
    __device__ __forceinline__ bool operator()(f32x4 (&acc)[2][2][4][2], const pg8::Unit& u, int wr, int wc, int fr, int fq) const {
        const int rowb = u.pm * 256 + wr * 64 + fr, colb = u.pn * 256 + wc * 32 + 8 * fq, seg = u.kind;
        constexpr size_t GST = WS_SB - WS_SA;
        static_assert(WS_SM - WS_SB == GST, "gate spacing");
        const unsigned char* __restrict__ NUM = (const unsigned char*)(ws + WS_SA + (size_t)seg * GST);
        const unsigned char* __restrict__ DEN = (const unsigned char*)(ws + WS_SA + (size_t)(seg < 2 ? seg + 1 : 2) * GST);
        bf16_t* __restrict__ MG = (bf16_t*)(ws + WS_MERGED);
#define U8F(w, e) ((float)(((w) >> (8 * (e))) & 0xffu))
#pragma unroll
        for (int ai = 0; ai < 2; ++ai)
#pragma unroll
            for (int m = 0; m < 4; ++m) { const size_t ro = (size_t)(rowb + ai * 128 + m * 16) * DM + colb;
#pragma unroll
                for (int bj = 0; bj < 2; ++bj) {
                    const u32x2 nu = *(const u32x2*)(NUM + ro + bj * 128);
                    f32x4 f0 = {U8F(nu[0], 0), U8F(nu[0], 1), U8F(nu[0], 2), U8F(nu[0], 3)}, f1 = {U8F(nu[1], 0), U8F(nu[1], 1), U8F(nu[1], 2), U8F(nu[1], 3)};
                    if (seg < 2) { const u32x2 de = *(const u32x2*)(DEN + ro + bj * 128);
                        const f32x4 d0 = {U8F(de[0], 0), U8F(de[0], 1), U8F(de[0], 2), U8F(de[0], 3)}, d1 = {U8F(de[1], 0), U8F(de[1], 1), U8F(de[1], 2), U8F(de[1], 3)};
#pragma unroll
                        for (int e = 0; e < 4; ++e) { f0[e] *= __builtin_amdgcn_rcpf(d0[e]); f1[e] *= __builtin_amdgcn_rcpf(d1[e]); }
                        acc[ai][bj][m][0] *= f0; acc[ai][bj][m][1] *= f1;
                    } else { *(bf16x8*)(MG + ro + bj * 128) = pack8(acc[ai][bj][m][0] * f0 * (1.f / 255.f), acc[ai][bj][m][1] * f1 * (1.f / 255.f)); }
                } }
#undef U8F
        return seg == 2;
    }
};
struct Sched3 {
    int G, c; const char* A; const char* B;
    __device__ __forceinline__ bool next(int i, pg8::Unit& u) const { const int L = i * G + c; if (L >= 256) return false; pg8::tile_order(L, 32, 8, u.pm, u.pn); u.kind = 0; return true; }
    __device__ __forceinline__ const char* a_base(const pg8::Unit& u) const { return A + (size_t)u.pm * (256 * DM * 2); }
    __device__ __forceinline__ const char* b_base(const pg8::Unit& u) const { return B + (size_t)u.pn * (256 * DM * 2); }
};
struct Epi3 {
    static constexpr bool PERM = false, INIT = true;
    const float* x; float* out;
    __device__ __forceinline__ void init(f32x4 (&acc)[2][2][4][2], const pg8::Unit& u, int wr, int wc, int fr, int fq) const {
        const int rowb = u.pm * 256 + wr * 64 + fr, colb = u.pn * 256 + wc * 32 + 4 * fq;
#pragma unroll
        for (int ai = 0; ai < 2; ++ai)
#pragma unroll
            for (int m = 0; m < 4; ++m) { const size_t ro = (size_t)(rowb + ai * 128 + m * 16) * DM + colb;
#pragma unroll
                for (int bj = 0; bj < 2; ++bj)
#pragma unroll
                    for (int n = 0; n < 2; ++n) acc[ai][bj][m][n] = *(const f32x4*)(x + ro + bj * 128 + n * 16); }
    }
    __device__ __forceinline__ bool operator()(f32x4 (&acc)[2][2][4][2], const pg8::Unit& u, int wr, int wc, int fr, int fq) const {
        const int rowb = u.pm * 256 + wr * 64 + fr, colb = u.pn * 256 + wc * 32 + 4 * fq;
#pragma unroll
        for (int ai = 0; ai < 2; ++ai)
#pragma unroll
            for (int m = 0; m < 4; ++m) { const size_t ro = (size_t)(rowb + ai * 128 + m * 16) * DM + colb;
#pragma unroll
                for (int bj = 0; bj < 2; ++bj)
#pragma unroll
                    for (int n = 0; n < 2; ++n) *(f32x4*)(out + ro + bj * 128 + n * 16) = acc[ai][bj][m][n]; }
        return true;
    }
};

__device__ __forceinline__ void p2_qkprep(const Params& p, int vcu, int G) {
    const int tid = opaque_tid(), lane = tid & 63, wave = tid >> 6;
    unsigned char* ws = p.ws;
    const bf16_t* QR = (const bf16_t*)(ws + WS_QR); const bf16_t* KR = (const bf16_t*)(ws + WS_KR);
    bf16_t* QN = (bf16_t*)(ws + WS_QN); bf16_t* KN = (bf16_t*)(ws + WS_KN);
    const f32x2* CSB = (const f32x2*)(ws + WS_CSB);
    const float gq0 = p.q_gain[lane], gq1 = p.q_gain[lane + 64], gk0 = p.k_gain[lane], gk1 = p.k_gain[lane + 64];
    const float gA0 = (lane < 64) ? p.q_gain[2 * lane] : 0.f, gA1 = p.q_gain[2 * lane + 1], gB0 = p.k_gain[2 * lane], gB1 = p.k_gain[2 * lane + 1];
    (void)gq0; (void)gq1; (void)gk0; (void)gk1;
    const int NWT = G * NWAVES, w0 = vcu * NWAVES + wave;
#pragma unroll 1
    for (int t = w0; t < T; t += 2 * NWT) {
        const int t1 = (t + NWT < T) ? t + NWT : t;
        unsigned raw[2][10];
#pragma unroll
        for (int u = 0; u < 2; ++u) { const int tt = u ? t1 : t;
#pragma unroll
            for (int r = 0; r < 10; ++r) raw[u][r] = *(const unsigned*)((r < 8 ? QR + (size_t)tt * 1024 + r * 128 : KR + (size_t)tt * 256 + (r - 8) * 128) + 2 * lane); }
        f32x2 cs[2];
        cs[0] = CSB[t * 16 + ((2 * lane) & 15)]; cs[1] = CSB[t1 * 16 + ((2 * lane) & 15)];
        f32x2 cs1[2];
        cs1[0] = CSB[t * 16 + ((2 * lane + 1) & 15)]; cs1[1] = CSB[t1 * 16 + ((2 * lane + 1) & 15)];
        float ss[2][10];
#pragma unroll
        for (int u = 0; u < 2; ++u)
#pragma unroll
            for (int r = 0; r < 10; ++r) { const float x0 = bflo(raw[u][r]), x1 = bfhi(raw[u][r]); ss[u][r] = x0 * x0 + x1 * x1; }
#pragma unroll
        for (int o = 1; o < 64; o <<= 1)
#pragma unroll
            for (int u = 0; u < 2; ++u)
#pragma unroll
                for (int r = 0; r < 10; ++r) ss[u][r] += __shfl_xor(ss[u][r], o);
#pragma unroll
        for (int u = 0; u < 2; ++u) { const int tt = u ? t1 : t; const int b = tt >> 12, sq = tt & (SEQ - 1);
#pragma unroll
            for (int r = 0; r < 10; ++r) {
                const float rs = 1.0f / sqrtf(ss[u][r] * (1.f / 128.f) + EPS);
                float y0 = bflo(raw[u][r]) * rs * (r < 8 ? gA0 : gB0), y1 = bfhi(raw[u][r]) * rs * (r < 8 ? gA1 : gB1);
                const float p0 = __shfl_xor(y0, 8), p1 = __shfl_xor(y1, 8);
                if (lane < 8) { y0 = y0 * cs[u][0] - p0 * cs[u][1]; y1 = y1 * cs1[u][0] - p1 * cs1[u][1]; }
                else if (lane < 16) { y0 = y0 * cs[u][0] + p0 * cs[u][1]; y1 = y1 * cs1[u][0] + p1 * cs1[u][1]; }
                bf16_t* dst = r < 8 ? QN + ((size_t)(b * 8 + r) * SEQ + sq) * 128 : KN + ((size_t)(b * 2 + (r - 8)) * SEQ + sq) * 128;
                *(unsigned*)(dst + 2 * lane) = cvt_pk_bf16(y0, y1);
            } }
    }
}

constexpr int GM_VSTR = 136;
__device__ __forceinline__ void p2_gmlp_unit(const Params& p, LAS unsigned char* lds, int unit) {
    const int tid = opaque_tid(), lane = tid & 63, wave = __builtin_amdgcn_readfirstlane(tid >> 6), r32 = lane & 31, hi = lane >> 5;
    unsigned char* ws = p.ws;
    const int g = unit & 7, ch = unit >> 3, tok0 = ch * 128;
    const bf16_t* AV = (const bf16_t*)(ws + WS_AV); const bf16_t* AU = (const bf16_t*)(ws + WS_AU); const bf16_t* AZ = (const bf16_t*)(ws + WS_AZ);
    bf16_t* XA = (bf16_t*)(ws + WS_XA);
    LAS float* stat = (LAS float*)lds;
    LAS bf16_t* vT = (LAS bf16_t*)(lds + 1024);
    const int tb = wave >> 1, dh = wave & 1, trow = tb * 32 + r32;
    const float* wsp = p.spatial_w + ((size_t)g * 128 + trow) * 128 + 8 * hi;
    f32x4 wf[8][2];
#pragma unroll
    for (int ks = 0; ks < 8; ++ks) { wf[ks][0] = *(const f32x4*)(wsp + 16 * ks); wf[ks][1] = *(const f32x4*)(wsp + 16 * ks + 4); }
    if (tid < 128) { const f32x4* lp = (const f32x4*)((const f32x2*)(ws + WS_LNP) + (size_t)(tok0 + tid) * 16); float s1 = 0.f, s2 = 0.f;
#pragma unroll
        for (int i = 0; i < 8; ++i) { const f32x4 v = lp[i]; s1 += v[0] + v[2]; s2 += v[1] + v[3]; }
        const float mean = s1 * (1.f / 1024.f), var = fmaxf(s2 * (1.f / 1024.f) - mean * mean, 0.f);
        stat[2 * tid] = mean; stat[2 * tid + 1] = 1.0f / sqrtf(var + EPS); }
    __syncthreads();
    {
        u32x4 va[4];
#pragma unroll
        for (int i = 0; i < 4; ++i) { const int it = tid + i * NTHREADS, s_ = it >> 4, d8 = (it & 15) * 8; va[i] = *(const u32x4*)(AV + (size_t)(tok0 + s_) * 1024 + g * 128 + d8); }
        const int d8 = (tid & 15) * 8;
        const f32x4 g0 = *(const f32x4*)(p.gmlp_g + g * 128 + d8), g1 = *(const f32x4*)(p.gmlp_g + g * 128 + d8 + 4), b0 = *(const f32x4*)(p.gmlp_b + g * 128 + d8), b1 = *(const f32x4*)(p.gmlp_b + g * 128 + d8 + 4);
#pragma unroll
        for (int i = 0; i < 4; ++i) { const int it = tid + i * NTHREADS, s_ = it >> 4; const u32x4 a = va[i];
            const float mean = stat[2 * s_], rstd = stat[2 * s_ + 1];
            float f[8] = {bflo(a[0]), bfhi(a[0]), bflo(a[1]), bfhi(a[1]), bflo(a[2]), bfhi(a[2]), bflo(a[3]), bfhi(a[3])};
#pragma unroll
            for (int e = 0; e < 8; ++e) { const float y = (f[e] - mean) * rstd * (e < 4 ? g0[e & 3] : g1[e & 3]) + (e < 4 ? b0[e & 3] : b1[e & 3]); vT[(d8 + e) * GM_VSTR + s_] = f2bf(y); } }
    }
    unsigned short gu[16][2], gz[16][2];
#pragma unroll
    for (int r = 0; r < 16; ++r) { const int tl = tb * 32 + (r & 3) + 8 * (r >> 2) + 4 * hi; const size_t o = (size_t)(tok0 + tl) * 1024 + g * 128 + dh * 64 + r32;
        gu[r][0] = AU[o]; gu[r][1] = AU[o + 32]; gz[r][0] = AZ[o]; gz[r][1] = AZ[o + 32]; }
    __syncthreads();
    f32x16 acc0 = {}, acc1 = {};
#pragma unroll
    for (int ks = 0; ks < 8; ++ks) {
        const int s0 = 16 * ks + 8 * hi;
        f32x4 w0 = wf[ks][0], w1 = wf[ks][1];
#pragma unroll
        for (int e = 0; e < 4; ++e) { if (s0 + e > trow) w0[e] = 0.f; if (s0 + 4 + e > trow) w1[e] = 0.f; }
        const bf16x8 a = pack8(w0, w1);
        const bf16x8 b0 = *(const LAS bf16x8*)(vT + (dh * 64 + r32) * GM_VSTR + s0), b1 = *(const LAS bf16x8*)(vT + (dh * 64 + 32 + r32) * GM_VSTR + s0);
        acc0 = __builtin_amdgcn_mfma_f32_32x32x16_bf16(a, b0, acc0, 0, 0, 0);
        acc1 = __builtin_amdgcn_mfma_f32_32x32x16_bf16(a, b1, acc1, 0, 0, 0);
    }
#pragma unroll
    for (int r = 0; r < 16; ++r) { const int tl = tb * 32 + (r & 3) + 8 * (r >> 2) + 4 * hi; const float bias = p.spatial_b[g * 128 + tl];
        const size_t o = (size_t)(tok0 + tl) * 1024 + g * 128 + dh * 64 + r32;
        XA[o] = f2bf(bf2f(gu[r][0]) * (acc0[r] + bias) * bf2f(gz[r][0]));
        XA[o + 32] = f2bf(bf2f(gu[r][1]) * (acc1[r] + bias) * bf2f(gz[r][1])); }
    __syncthreads();
}

constexpr int MA_KST = 32 * 512, MA_VROW = 72, MA_VST = 256 * MA_VROW;
constexpr int MA_K0 = 2048, MA_V0 = MA_K0 + 2 * MA_KST;
static_assert(MA_V0 + 2 * MA_VST <= MISC_OFF, "mem-attn LDS map");
__device__ __forceinline__ void p2_mem_unit(const Params& p, LAS unsigned char* lds, int unit) {
    const int tid = opaque_tid(), lane = tid & 63, wave = __builtin_amdgcn_readfirstlane(tid >> 6), r32 = lane & 31, hi = lane >> 5;
    unsigned char* ws = p.ws;
    const int qb = unit & 31, h = (unit >> 5) & 3, b = unit >> 7, qg = wave & 3, dhf = wave >> 2;
    const bf16_t* MQ = (const bf16_t*)(ws + WS_MQ); const bf16_t* MZ = (const bf16_t*)(ws + WS_MZ);
    const bf16_t* KM = (const bf16_t*)(ws + WS_KM) + (size_t)(b * 256) * 1024 + h * 256;
    const bf16_t* VT = (const bf16_t*)(ws + WS_VT) + (size_t)(h * 256) * 512 + b * 256;
    bf16_t* XM = (bf16_t*)(ws + WS_XM);
    LAS float* rk = (LAS float*)lds;
    LAS float* gqk = (LAS float*)(lds + 1024);
    u32x4 sk[2], sv[2];
#define MA_LOAD(st) do { _Pragma("unroll") for (int i = 0; i < 2; ++i) { const int q = tid + i * NTHREADS; \
        sk[i] = *(const u32x4*)(KM + (size_t)((st) * 32 + (q >> 5)) * 1024 + (q & 31) * 8); \
        sv[i] = *(const u32x4*)(VT + (size_t)(q >> 2) * 512 + (st) * 32 + (q & 3) * 8); } } while (0)
#define MA_WRITE(bf) do { _Pragma("unroll") for (int i = 0; i < 2; ++i) { const int q = tid + i * NTHREADS; const int key = q >> 5, c = q & 31; \
        *(LAS u32x4*)(lds + MA_K0 + (bf) * MA_KST + key * 512 + ((c ^ (key & 15)) << 4)) = sk[i]; \
        LAS unsigned char* vd = lds + MA_V0 + (bf) * MA_VST + (q >> 2) * MA_VROW + (q & 3) * 16; \
        *(LAS u32x2*)vd = (u32x2){sv[i][0], sv[i][1]}; *(LAS u32x2*)(vd + 8) = (u32x2){sv[i][2], sv[i][3]}; } } while (0)
    if (tid < 256) { const f32x4 pr = *(const f32x4*)((const float*)(ws + WS_RKP) + (size_t)(b * 256 + tid) * 16 + h * 4);
        rk[tid] = 1.0f / sqrtf(((pr[0] + pr[1]) + (pr[2] + pr[3])) * (1.f / 256.f) + EPS); gqk[tid] = p.mq_gain[tid] * p.mk_gain[tid]; }
    __syncthreads();
    const int tq = b * SEQ + qb * 128 + qg * 32 + r32;
    bf16x8 qf[16]; float ssq = 0.f;
#pragma unroll
    for (int ks = 0; ks < 16; ++ks) { const int d0 = 16 * ks + 8 * hi; const u32x4 a = *(const u32x4*)(MQ + (size_t)tq * 1024 + h * 256 + d0);
        f32x4 f0 = {bflo(a[0]), bfhi(a[0]), bflo(a[1]), bfhi(a[1])}, f1 = {bflo(a[2]), bfhi(a[2]), bflo(a[3]), bfhi(a[3])};
        ssq += (f0[0] * f0[0] + f0[1] * f0[1]) + (f0[2] * f0[2] + f0[3] * f0[3]) + (f1[0] * f1[0] + f1[1] * f1[1]) + (f1[2] * f1[2] + f1[3] * f1[3]);
        const f32x4 g0 = *(const LAS f32x4*)(gqk + d0), g1 = *(const LAS f32x4*)(gqk + d0 + 4);
        qf[ks] = pack8(f0 * g0, f1 * g1); }
    ssq += __shfl_xor(ssq, 32);
    const float qs = (1.0f / sqrtf(ssq * (1.f / 256.f) + EPS)) * (0.0625f * LOG2E);
    MA_LOAD(0);
    MA_WRITE(0);
    __syncthreads();
    f32x16 o[4];
#pragma unroll
    for (int db = 0; db < 4; ++db) o[db] = (f32x16){};
    float mrun = -1e30f, l = 0.f;
    const int kx = r32 & 15;
#pragma unroll 1
    for (int st = 0; st < 8; ++st) {
        const int bf = st & 1;
        if (st + 1 < 8) MA_LOAD(st + 1);
        {
            f32x16 a = {};
            const LAS unsigned char* kp = lds + MA_K0 + bf * MA_KST + r32 * 512;
#pragma unroll
            for (int ks = 0; ks < 16; ++ks) { if ((ks & 3) == 0) __builtin_amdgcn_sched_barrier(0); const bf16x8 kf = *(const LAS bf16x8*)(kp + (((2 * ks + hi) ^ kx) << 4)); a = __builtin_amdgcn_mfma_f32_32x32x16_bf16(kf, qf[ks], a, 0, 0, 0); }
            __builtin_amdgcn_sched_barrier(0);
#pragma unroll
            for (int g4 = 0; g4 < 4; ++g4) { const f32x4 rr = *(const LAS f32x4*)(rk + st * 32 + 8 * g4 + 4 * hi);
#pragma unroll
                for (int e = 0; e < 4; ++e) a[4 * g4 + e] *= rr[e] * qs; }
            float bm = a[0];
#pragma unroll
            for (int r = 1; r < 16; ++r) bm = fmaxf(bm, a[r]);
            bm = fmaxf(bm, __shfl_xor(bm, 32));
            if (!__all(bm - mrun <= 8.f)) { const float mn = fmaxf(mrun, bm), al = __builtin_amdgcn_exp2f(mrun - mn); mrun = mn; l *= al;
#pragma unroll
                for (int db = 0; db < 4; ++db) o[db] *= al; }
#pragma unroll
            for (int r = 0; r < 16; ++r) { a[r] = __builtin_amdgcn_exp2f(a[r] - mrun); l += a[r]; }
            u32x4 w0 = {cvt_pk_bf16(a[0], a[1]), cvt_pk_bf16(a[2], a[3]), cvt_pk_bf16(a[4], a[5]), cvt_pk_bf16(a[6], a[7])};
            u32x4 w1 = {cvt_pk_bf16(a[8], a[9]), cvt_pk_bf16(a[10], a[11]), cvt_pk_bf16(a[12], a[13]), cvt_pk_bf16(a[14], a[15])};
            const bf16x8 pf0 = *reinterpret_cast<bf16x8*>(&w0), pf1 = *reinterpret_cast<bf16x8*>(&w1);
            const LAS unsigned char* vp = lds + MA_V0 + bf * MA_VST + (dhf * 128 + r32) * MA_VROW + 8 * hi;
#pragma unroll
            for (int db = 0; db < 4; ++db) {
                const u32x2 lo0 = *(const LAS u32x2*)(vp + db * 32 * MA_VROW), hi0 = *(const LAS u32x2*)(vp + db * 32 * MA_VROW + 16);
                const u32x2 lo1 = *(const LAS u32x2*)(vp + db * 32 * MA_VROW + 32), hi1 = *(const LAS u32x2*)(vp + db * 32 * MA_VROW + 48);
                u32x4 v0 = {lo0[0], lo0[1], hi0[0], hi0[1]}, v1 = {lo1[0], lo1[1], hi1[0], hi1[1]};
                o[db] = __builtin_amdgcn_mfma_f32_32x32x16_bf16(*reinterpret_cast<bf16x8*>(&v0), pf0, o[db], 0, 0, 0);
                o[db] = __builtin_amdgcn_mfma_f32_32x32x16_bf16(*reinterpret_cast<bf16x8*>(&v1), pf1, o[db], 0, 0, 0); }
        }
        if (st + 1 < 8) MA_WRITE(bf ^ 1);
        __syncthreads();
    }
#undef MA_LOAD
#undef MA_WRITE
    l += __shfl_xor(l, 32);
    const float il = __builtin_amdgcn_rcpf(l);
    u32x2 zg[4][4];
#pragma unroll
    for (int db = 0; db < 4; ++db)
#pragma unroll
        for (int g4 = 0; g4 < 4; ++g4) zg[db][g4] = *(const u32x2*)(MZ + (size_t)tq * 1024 + h * 256 + dhf * 128 + db * 32 + 8 * g4 + 4 * hi);
#pragma unroll
    for (int db = 0; db < 4; ++db)
#pragma unroll
        for (int g4 = 0; g4 < 4; ++g4) { const size_t oo = (size_t)tq * 1024 + h * 256 + dhf * 128 + db * 32 + 8 * g4 + 4 * hi;
            const u32x2 z = zg[db][g4];
            u32x2 w; w[0] = cvt_pk_bf16(o[db][4 * g4] * il * bflo(z[0]), o[db][4 * g4 + 1] * il * bfhi(z[0])); w[1] = cvt_pk_bf16(o[db][4 * g4 + 2] * il * bflo(z[1]), o[db][4 * g4 + 3] * il * bfhi(z[1]));
            *(u32x2*)(XM + oo) = w; }
}


__device__ __forceinline__ unsigned wave_sum_dpp(unsigned c) {
    c += (unsigned)__builtin_amdgcn_update_dpp(0, (int)c, 0xB1, 0xF, 0xF, false);
    c += (unsigned)__builtin_amdgcn_update_dpp(0, (int)c, 0x4E, 0xF, 0xF, false);
    c += (unsigned)__builtin_amdgcn_update_dpp(0, (int)c, 0x141, 0xF, 0xF, false);
    c += (unsigned)__builtin_amdgcn_update_dpp(0, (int)c, 0x140, 0xF, 0xF, false);
    { auto r = __builtin_amdgcn_permlane16_swap(c, c, false, false); c = r[0] + r[1]; }
    { auto r = __builtin_amdgcn_permlane32_swap(c, c, false, false); c = r[0] + r[1]; }
    return c;
}
#define CNT4(c0, c1, c2, c3, a, b, c_, d, t) do { unsigned long long m0_, m1_, m2_, m3_; asm volatile( \
    "v_cmp_ge_u32_e64 %[m0], %[va], %[vt]\n\tv_cmp_ge_u32_e64 %[m1], %[vb], %[vt]\n\tv_cmp_ge_u32_e64 %[m2], %[vc], %[vt]\n\tv_cmp_ge_u32_e64 %[m3], %[vd], %[vt]\n\t" \
    "v_addc_co_u32_e64 %[k0], %[m0], %[k0], 0, %[m0]\n\tv_addc_co_u32_e64 %[k1], %[m1], %[k1], 0, %[m1]\n\tv_addc_co_u32_e64 %[k2], %[m2], %[k2], 0, %[m2]\n\tv_addc_co_u32_e64 %[k3], %[m3], %[k3], 0, %[m3]" \
    : [k0] "+v"(c0), [k1] "+v"(c1), [k2] "+v"(c2), [k3] "+v"(c3), [m0] "=&s"(m0_), [m1] "=&s"(m1_), [m2] "=&s"(m2_), [m3] "=&s"(m3_) \
    : [va] "v"(a), [vb] "v"(b), [vc] "v"(c_), [vd] "v"(d), [vt] "v"(t)); } while (0)

__device__ __forceinline__ unsigned sortable(float f) { const unsigned u = __float_as_uint(f); return u ^ ((unsigned)((int)u >> 31) | 0x80000000u); }
#ifndef SPAN_A
#define SPAN_A -1
#endif
#define ACC_T(k, t0v) do { if (SPAN_A >= 100 && blockIdx.x == 0 && threadIdx.x == 0) { volatile LAS unsigned long long* st_ = (volatile LAS unsigned long long*)(lds + MISC_OFF + 16); const unsigned long long n_ = __builtin_amdgcn_s_memrealtime(); st_[16 + (k)] += n_ - (t0v); (t0v) = n_; } } while (0)
__device__ __forceinline__ float relu1(float x) { const int xi = __float_as_int(x); return __int_as_float(xi > 0 ? xi : 0); }
__device__ __forceinline__ void p2_idx_all(const Params& p, LAS unsigned char* lds, int bx, int G) {
    unsigned long long tacc = (SPAN_A >= 100) ? __builtin_amdgcn_s_memrealtime() : 0ull;
    const int tid = opaque_tid(), lane = tid & 63, wave = __builtin_amdgcn_readfirstlane(tid >> 6), r32 = lane & 31, hi = lane >> 5;
    unsigned char* ws = p.ws;
    const bf16_t* IQ = (const bf16_t*)(ws + WS_IQ); const float* IW = (const float*)(ws + WS_IW);
    LAS unsigned* sc = (LAS unsigned*)lds;
    LAS float* iwl0 = (LAS float*)(lds + 131072);
    int nun = 0; for (int pr = bx; pr < 512; pr += G) nun += 2;
    if (nun == 0) return;
#define IDX_UNIT(k, bb, ub) do { const int pr_ = bx + ((k) >> 1) * G, ix_ = pr_ & 255; bb = pr_ >> 8; ub = ((k) & 1) ? ix_ : 511 - ix_; } while (0)
#define AF_LOAD(tt0) do { _Pragma("unroll") for (int at = 0; at < 4; ++at) _Pragma("unroll") for (int ks = 0; ks < 4; ++ks) \
        af[at][ks] = *(const bf16x8*)(IQ + (size_t)((tt0) + 2 * at + (r32 >> 4)) * 1024 + (r32 & 15) * 64 + 16 * ks + 8 * hi); } while (0)
    bf16x8 af[4][4];
    int b, ublk; IDX_UNIT(0, b, ublk);
    { const int t0 = b * SEQ + ublk * 8; AF_LOAD(t0); if (tid < 128) iwl0[tid] = IW[(size_t)t0 * 16 + tid]; }
    __syncthreads();
#pragma unroll 1
    for (int k = 0; k < nun; ++k) {
        const int s0 = ublk * 8, t0 = b * SEQ + s0;
        const bf16_t* IK = (const bf16_t*)(ws + WS_IK) + (size_t)(b * SEQ) * 64;
        LAS float* iwl = iwl0 + (k & 1) * 128;
        int bn = b, un = ublk; if (k + 1 < nun) IDX_UNIT(k + 1, bn, un);
        const int t0n = bn * SEQ + un * 8;
        float iwn = 0.f; if (tid < 128) iwn = IW[(size_t)t0n * 16 + tid];
        ACC_T(0, tacc);
        const int ntiles = (s0 + 8 + 31) >> 5;
        bf16x8 kb0[4], kb1[4], kb2[4];
#define IK_LOAD(dst, jj) do { const int jc_ = (jj) < ntiles ? (jj) : 0; _Pragma("unroll") for (int ks = 0; ks < 4; ++ks) dst[ks] = *(const bf16x8*)(IK + (size_t)(32 * jc_ + r32) * 64 + 16 * ks + 8 * hi); } while (0)
#define SCORE_TILE(KB, jj) do { const int k0 = 32 * (jj); \
        _Pragma("unroll") for (int at = 0; at < 4; ++at) { f32x16 a = {}; \
            _Pragma("unroll") for (int ks = 0; ks < 4; ++ks) a = __builtin_amdgcn_mfma_f32_32x32x16_bf16(af[at][ks], KB[ks], a, 0, 0, 0); \
            const f32x4 wa0 = *(const LAS f32x4*)(iwl + (2 * at) * 16 + 4 * hi), wa1 = *(const LAS f32x4*)(iwl + (2 * at) * 16 + 8 + 4 * hi); \
            const f32x4 wb0 = *(const LAS f32x4*)(iwl + (2 * at + 1) * 16 + 4 * hi), wb1 = *(const LAS f32x4*)(iwl + (2 * at + 1) * 16 + 8 + 4 * hi); \
            float pa = 0.f, pb = 0.f; \
            _Pragma("unroll") for (int e = 0; e < 4; ++e) { pa += wa0[e] * relu1(a[e]); pa += wa1[e] * relu1(a[4 + e]); pb += wb0[e] * relu1(a[8 + e]); pb += wb1[e] * relu1(a[12 + e]); } \
            auto rr = __builtin_amdgcn_permlane32_swap(__float_as_uint(pa), __float_as_uint(pb), false, false); \
            const float score = __uint_as_float(rr[0]) + __uint_as_float(rr[1]); \
            const int qi = 2 * at + hi, key = k0 + r32; \
            sc[qi * 4096 + key] = (key <= s0 + qi) ? sortable(score) : 0u; } } while (0)
#ifndef IDX_SCORE_REP
#define IDX_SCORE_REP 1
#endif
#pragma unroll 1
        for (int rep_ = 0; rep_ < IDX_SCORE_REP; ++rep_) {
        IK_LOAD(kb0, wave); IK_LOAD(kb1, wave + NWAVES);
#pragma unroll 1
        for (int j = wave; j < ntiles; j += 3 * NWAVES) {
            IK_LOAD(kb2, j + 2 * NWAVES); SCORE_TILE(kb0, j);
            if (j + NWAVES >= ntiles) break;
            IK_LOAD(kb0, j + 3 * NWAVES); SCORE_TILE(kb1, j + NWAVES);
            if (j + 2 * NWAVES >= ntiles) break;
            IK_LOAD(kb1, j + 4 * NWAVES); SCORE_TILE(kb2, j + 2 * NWAVES);
        }
        }
#undef IK_LOAD
#undef SCORE_TILE
        __syncthreads();
        ACC_T(1, tacc);
        const int s = s0 + wave, n = s + 1;
        unsigned kv[64];
#pragma unroll
        for (int i = 0; i < 64; ++i) { const int key = 64 * i + lane; kv[i] = (key <= s) ? sc[wave * 4096 + key] : 0u; }
        if (tid < 128) iwl0[((k + 1) & 1) * 128 + tid] = iwn;
        AF_LOAD(t0n);
        LDS_WAIT();
        __syncthreads();
        unsigned Tt = 1u; bool exact = true;
        if (n > 256) {
            Tt = 0u; exact = false;
            for (int bit = 31; bit >= 0; --bit) {
                const unsigned cand = Tt | (1u << bit); unsigned c0 = 0, c1 = 0, c2 = 0, c3 = 0;
#pragma unroll
                for (int i = 0; i < 64; i += 4) CNT4(c0, c1, c2, c3, kv[i], kv[i + 1], kv[i + 2], kv[i + 3], cand);
                const unsigned c = wave_sum_dpp((c0 + c1) + (c2 + c3));
                if (c >= 256u) { Tt = cand; if (c == 256u) { exact = true; break; } }
            }
        }
        ACC_T(2, tacc);
        LAS unsigned long long* lm = (LAS unsigned long long*)(lds + 131072 + 1024) + wave * 64;
        if (exact) {
#pragma unroll
            for (int i = 0; i < 64; ++i) { const unsigned long long bal = __ballot(kv[i] >= Tt); if (lane == 0) lm[i] = bal; }
        } else {
            unsigned cg_ = 0;
#pragma unroll
            for (int i = 0; i < 64; ++i) cg_ += (kv[i] > Tt) ? 1u : 0u;
            cg_ = wave_sum_u(cg_);
            const unsigned need = 256u - cg_; unsigned seen = 0u;
#pragma unroll
            for (int i = 0; i < 64; ++i) {
                const unsigned kk = kv[i];
                const unsigned long long eq = __ballot(kk == Tt), gt = __ballot(kk > Tt);
                const unsigned below = (unsigned)__popcll(eq & ((1ull << lane) - 1ull));
                const bool take = (kk == Tt) && (seen + below < need);
                const unsigned long long bal = gt | __ballot(take);
                seen += (unsigned)__popcll(eq);
                if (lane == 0) lm[i] = bal;
            }
        }
        LDS_WAIT(); asm volatile("" ::: "memory");
        const unsigned long long mine = lm[lane];
        ((unsigned long long*)(ws + WS_MASK))[(size_t)(t0 + wave) * 64 + lane] = mine;
        ACC_T(3, tacc);
        b = bn; ublk = un;
    }
#undef IDX_UNIT
#undef AF_LOAD
    __syncthreads();
}

namespace att {
constexpr int D = 128, NW = 8, QBLK = 32, KVBLK = 64, QB = 256;
constexpr int SHM_V = KVBLK * D * 2, SHM_K = KVBLK * D * 2;
constexpr int EPI_T0 = 2 * SHM_V + 2 * SHM_K + NW * 128 * 4 + 16, EPI_TW = 32 * 272;
constexpr int LDS_NEED = EPI_T0 + NW * EPI_TW;
static_assert(LDS_NEED <= MISC_OFF, "attention LDS map");
constexpr float SCALE = 0.08838834764831845f, THR = 8.f;
#define KSWZ(row, colB) ((row) * 256 + ((colB) ^ (((row) & 7) << 4)))
#define SBAR() __builtin_amdgcn_sched_barrier(0)
__device__ __forceinline__ int v_st(int k, int c) { const int kk = (k & ~0xC) | ((k & 4) << 1) | ((k & 8) >> 1); return ((kk >> 3) * 4 + (c >> 5)) * 512 + ((kk & 7) * 32 + (c & 31)) * 2; }
__device__ __forceinline__ int v_rd_base(int lane) { return ((lane & 3) << 3) | (((lane >> 2) & 3) << 6) | (((lane >> 4) & 1) << 5) | (((lane >> 5) & 1) << 8); }
constexpr int v_rd_off(int d0, int ks, int half) { return d0 * 512 + ks * 4096 + half * 2048; }
__device__ __forceinline__ int crow(int r, int hi) { return (r & 3) + 8 * (r >> 2) + 4 * hi; }
__device__ __forceinline__ bf16x8 load8(const bf16_t* p) { return *reinterpret_cast<const bf16x8*>(p); }
__device__ __forceinline__ void mask_bits(f32x16& p0, f32x16& p1, unsigned w0, unsigned w1, int hi) {
    w0 >>= 4 * hi; w1 >>= 4 * hi;
#pragma unroll
    for (int r = 0; r < 16; ++r) { const int c = (r & 3) + 8 * (r >> 2);
        const unsigned t0 = (unsigned)(((int)(w0 << (31 - c))) >> 31), t1 = (unsigned)(((int)(w1 << (31 - c))) >> 31);
        p0[r] = __uint_as_float((__float_as_uint(p0[r]) & t0) | (0xff800000u & ~t0));
        p1[r] = __uint_as_float((__float_as_uint(p1[r]) & t1) | (0xff800000u & ~t1)); }
}
__device__ __forceinline__ void partialSM(f32x16& p0, f32x16& p1, float& m_reg, float& mn, float& alpha) {
    float pmax = p0[0];
#pragma unroll
    for (int r = 1; r < 16; ++r) pmax = fmaxf(pmax, p0[r]);
#pragma unroll
    for (int r = 0; r < 16; ++r) pmax = fmaxf(pmax, p1[r]);
    { auto rr = __builtin_amdgcn_permlane32_swap(__float_as_uint(pmax), __float_as_uint(pmax), false, false);
      pmax = fmaxf(__uint_as_float(rr[0]), __uint_as_float(rr[1])); }
    constexpr float C2 = 1.4426950408889634f * SCALE;
    if (__builtin_expect(__all((pmax - m_reg) * SCALE <= THR), 1)) { mn = m_reg; alpha = 1.f; }
    else { mn = fmaxf(m_reg, pmax); alpha = __builtin_amdgcn_exp2f((m_reg - mn) * C2); m_reg = mn; }
    const float mnL = -mn * C2;
#pragma unroll
    for (int r = 0; r < 16; ++r) p0[r] = fmaf(p0[r], C2, mnL);
#pragma unroll
    for (int r = 0; r < 16; ++r) p1[r] = fmaf(p1[r], C2, mnL);
#pragma unroll
    for (int r = 0; r < 16; ++r) p0[r] = __builtin_amdgcn_exp2f(p0[r]);
}
__device__ __forceinline__ void finishSM(f32x16& p0, f32x16& p1, float alpha, float& l_reg, bf16x8& pa0, bf16x8& pa1, bf16x8& pa2, bf16x8& pa3) {
#pragma unroll
    for (int r = 0; r < 16; ++r) p1[r] = __builtin_amdgcn_exp2f(p1[r]);
    float ps = 0;
#pragma unroll
    for (int r = 0; r < 16; ++r) ps += p0[r];
#pragma unroll
    for (int r = 0; r < 16; ++r) ps += p1[r];
    { auto rr = __builtin_amdgcn_permlane32_swap(__float_as_uint(ps), __float_as_uint(ps), false, false);
      ps = __uint_as_float(rr[0]) + __uint_as_float(rr[1]); }
    l_reg = l_reg * alpha + ps;
#define PK4(P, B_, OUT) do { unsigned a0 = cvt_pk_bf16(P[B_+0], P[B_+1]), a1 = cvt_pk_bf16(P[B_+2], P[B_+3]);                          \
        unsigned b0 = cvt_pk_bf16(P[B_+4], P[B_+5]), b1 = cvt_pk_bf16(P[B_+6], P[B_+7]);                                             \
        auto r0 = __builtin_amdgcn_permlane32_swap(a0, b0, false, false); auto r1 = __builtin_amdgcn_permlane32_swap(a1, b1, false, false); \
        u32x4 w = {r0[0], r1[0], r0[1], r1[1]}; OUT = *reinterpret_cast<bf16x8*>(&w); } while (0)
    PK4(p0, 0, pa0); PK4(p0, 8, pa1); PK4(p1, 0, pa2); PK4(p1, 8, pa3);
#undef PK4
}
template <int KB>
__device__ __forceinline__ void qkt(f32x16& p0, f32x16& p1, const char* K_lds, int r32, int hi, const bf16x8* qr) {
    p0 = f32x16{}; p1 = f32x16{};
    const char* kb[4];
#pragma unroll
    for (int dd = 0; dd < 4; ++dd) kb[dd] = K_lds + KB * SHM_K + KSWZ(r32, (dd * 16 + hi * 8) * 2);
#pragma unroll
    for (int d0 = 0; d0 < 8; ++d0) { const char* a = kb[d0 & 3] + (d0 >> 2) * 128;
        bf16x8 b0 = *reinterpret_cast<const bf16x8*>(a);
        bf16x8 b1 = *reinterpret_cast<const bf16x8*>(a + 32 * 256);
        p0 = __builtin_amdgcn_mfma_f32_32x32x16_bf16(b0, qr[d0], p0, 0, 0, 0);
        p1 = __builtin_amdgcn_mfma_f32_32x32x16_bf16(b1, qr[d0], p1, 0, 0, 0); }
}
template <int VB>
__device__ __forceinline__ void pv_tile(f32x16* o, int vb0, bf16x8 pa0, bf16x8 pa1, bf16x8 pa2, bf16x8 pa3) {
#define TRRD(dst, off) asm volatile("ds_read_b64_tr_b16 %0, %1 offset:%2" : "=&v"(dst) : "v"(vb0), "i"(off) : "memory")
#define PV_D0(d0) do { s16x4 l0, l1, l2, l3, h0, h1, h2, h3; constexpr int b_ = VB * SHM_V + v_rd_off(d0, 0, 0); \
        TRRD(l0, b_); TRRD(h0, b_ + 2048); TRRD(l1, b_ + 4096); TRRD(h1, b_ + 6144); TRRD(l2, b_ + 8192); TRRD(h2, b_ + 10240); TRRD(l3, b_ + 12288); TRRD(h3, b_ + 14336); \
        asm volatile("s_waitcnt lgkmcnt(0)" ::: "memory"); SBAR();   \
        o[d0] = __builtin_amdgcn_mfma_f32_32x32x16_bf16(pa0, (bf16x8){l0[0], l0[1], l0[2], l0[3], h0[0], h0[1], h0[2], h0[3]}, o[d0], 0, 0, 0);   \
        o[d0] = __builtin_amdgcn_mfma_f32_32x32x16_bf16(pa1, (bf16x8){l1[0], l1[1], l1[2], l1[3], h1[0], h1[1], h1[2], h1[3]}, o[d0], 0, 0, 0);   \
        o[d0] = __builtin_amdgcn_mfma_f32_32x32x16_bf16(pa2, (bf16x8){l2[0], l2[1], l2[2], l2[3], h2[0], h2[1], h2[2], h2[3]}, o[d0], 0, 0, 0);   \
        o[d0] = __builtin_amdgcn_mfma_f32_32x32x16_bf16(pa3, (bf16x8){l3[0], l3[1], l3[2], l3[3], h3[0], h3[1], h3[2], h3[3]}, o[d0], 0, 0, 0); } while (0)
    PV_D0(0); PV_D0(1); PV_D0(2); PV_D0(3);
#undef PV_D0
#undef TRRD
}
struct BlockRef { const bf16_t* Q; const bf16_t* K; const bf16_t* V; const unsigned* M; bf16_t* O; const bf16_t* Z;
                  bf16_t* OPme; const bf16_t* OPot; f32x2* MLme; const f32x2* MLot; unsigned* cnt; int t_lo, NT; };
struct Seam { bf16x8 qr[8]; bf16x8 st_v0, st_v1, st_k0, st_k1; };
#define ROW(p, k0, rr) ((p) + (size_t)((k0) + (rr)) * D + sc)
#define VMW() asm volatile("s_waitcnt vmcnt(0)" ::: "memory")
#define VMWN(n) asm volatile("s_waitcnt vmcnt(%0)" :: "i"(n) : "memory")
#define SLOAD_H(Kp, Vp, k0) do { S.st_v0 = load8(ROW(Vp, k0, sr)); S.st_v1 = load8(ROW(Vp, k0, 32 + sr));              \
                         S.st_k0 = load8(ROW(Kp, k0, sr)); S.st_k1 = load8(ROW(Kp, k0, 32 + sr)); } while (0)
#define SWRITE_HK(bf) do { *(bf16x8*)(K_lds + (bf) * SHM_K + kws) = S.st_k0; *(bf16x8*)(K_lds + (bf) * SHM_K + kws + 32 * 256) = S.st_k1; } while (0)
#define SWRITE_HV(bf) do { *(bf16x8*)(V_lds + (bf) * SHM_V + vst0) = S.st_v0; *(bf16x8*)(V_lds + (bf) * SHM_V + vst1) = S.st_v1; } while (0)
#define SWRITE_H(bf) do { SWRITE_HV(bf); SWRITE_HK(bf); } while (0)
__device__ __forceinline__ void attn_prime(const BlockRef& cur, char* lds, Seam& S) {
    const int tid = opaque_tid(), wid = __builtin_amdgcn_readfirstlane(tid >> 6), lane = tid & 63, r32 = lane & 31, hi = lane >> 5;
    const int sr = tid >> 4, sc = (tid & 15) * 8, kws = KSWZ(sr, sc * 2); char* K_lds = lds + 2 * SHM_V;
#pragma unroll
    for (int d0 = 0; d0 < 8; ++d0) S.qr[d0] = load8(cur.Q + (size_t)(wid * QBLK + r32) * D + d0 * 16 + hi * 8);
    SLOAD_H(cur.K, cur.V, cur.t_lo * KVBLK); VMW(); SWRITE_HK(0);
    __syncthreads();
}
__device__ __forceinline__ void attn_block(const BlockRef& cur, const BlockRef& nxt, char* lds, Seam& S) {
    const int tid = opaque_tid(), wid = __builtin_amdgcn_readfirstlane(tid >> 6), lane = tid & 63, r32 = lane & 31, hi = lane >> 5;
    const int NT = cur.NT, t_lo = cur.t_lo;
    char* V_lds = lds; char* K_lds = lds + 2 * SHM_V;
    float* wsl = (float*)(lds + 2 * SHM_V + 2 * SHM_K) + wid * 128; float* li_l = wsl, * al_l = wsl + 32, * fb_l = wsl + 64;
    volatile unsigned* flag = (volatile unsigned*)(lds + 2 * SHM_V + 2 * SHM_K + NW * 128 * 4);
    float m_reg = -1e30f, l_reg = 0; f32x16 o[4] = {};
    const int sr = tid >> 4, sc = (tid & 15) * 8, vst0 = v_st(sr, sc), vst1 = v_st(32 + sr, sc), kws = KSWZ(sr, sc * 2);
    const int vb0 = (int)(uintptr_t)V_lds + v_rd_base(lane);
    const bf16_t* Kh = cur.K; const bf16_t* Vh = cur.V;
    const unsigned* mrow = cur.M + (size_t)(wid * QBLK + r32) * 128;
#define RESC(a) do { if (__any((a) < 1.f)) { if (hi == 0) al_l[r32] = (a); asm volatile("s_waitcnt lgkmcnt(0)" ::: "memory");              \
                     for (int d_ = 0; d_ < 4; ++d_) for (int r = 0; r < 16; ++r) o[d_][r] *= al_l[crow(r, hi)]; } } while (0)
#define KBASE(t) ((t_lo + (t)) * KVBLK)
#define MLOAD(t) (*(const u32x2*)(mrow + 2 * (t_lo + (t))))
#define SEAM_K0() do { VMWN(8); SWRITE_HK(0); SBAR(); } while (0)
    f32x16 pA0, pA1, pB0, pB1; float mnA, mnB, alA, alB; bf16x8 pa0, pa1, pa2, pa3;
    u32x2 mwA, mwB;
    SWRITE_HV(0); SBAR();
    mwA = MLOAD(0); mwB = MLOAD(1);
    SLOAD_H(Kh, Vh, KBASE(1));
    SBAR(); qkt<0>(pA0, pA1, K_lds, r32, hi, S.qr);
    mask_bits(pA0, pA1, mwA[0], mwA[1], hi); partialSM(pA0, pA1, m_reg, mnA, alA);
    VMW(); SWRITE_H(1);
    __syncthreads();
#define HALF_STEP(PX0, PX1, mnX, alX, mwX, mwY, PY0, PY1, alY, t, KB, VB, SB) do {                                              \
        SBAR(); mwY = MLOAD(((t) + 1 < NT) ? (t) + 1 : (t)); qkt<KB>(PX0, PX1, K_lds, r32, hi, S.qr);     \
        finishSM(PY0, PY1, alY, l_reg, pa0, pa1, pa2, pa3); SBAR();                                                           \
        if ((t) + 1 < NT) { SLOAD_H(Kh, Vh, KBASE((t) + 1)); SBAR(); }                                                        \
        pv_tile<VB>(o, vb0, pa0, pa1, pa2, pa3); mask_bits(PX0, PX1, mwX[0], mwX[1], hi); partialSM(PX0, PX1, m_reg, mnX, alX); \
        __syncthreads();                                                                                                      \
        if ((t) + 1 < NT) { VMW(); SWRITE_H(SB); }                                                                            \
        RESC(alX); __syncthreads(); } while (0)
    for (int t = 1; t + 1 < NT; t += 2) {
        HALF_STEP(pB0, pB1, mnB, alB, mwB, mwA, pA0, pA1, alA, t, 1, 0, 0);
        HALF_STEP(pA0, pA1, mnA, alA, mwA, mwB, pB0, pB1, alB, t + 1, 0, 1, 1);
    }
    SBAR(); qkt<1>(pB0, pB1, K_lds, r32, hi, S.qr); SBAR();
    SLOAD_H(nxt.K, nxt.V, nxt.t_lo * KVBLK); SBAR();
#pragma unroll
    for (int d0 = 0; d0 < 8; ++d0) S.qr[d0] = load8(nxt.Q + (size_t)(wid * QBLK + r32) * D + d0 * 16 + hi * 8);
    SBAR();
    finishSM(pA0, pA1, alA, l_reg, pa0, pa1, pa2, pa3); SBAR();
    pv_tile<0>(o, vb0, pa0, pa1, pa2, pa3);
    mask_bits(pB0, pB1, mwB[0], mwB[1], hi); partialSM(pB0, pB1, m_reg, mnB, alB); __syncthreads(); RESC(alB);
    finishSM(pB0, pB1, alB, l_reg, pa0, pa1, pa2, pa3); SBAR(); pv_tile<1>(o, vb0, pa0, pa1, pa2, pa3);
    SBAR(); SEAM_K0();
    char* Tl = lds + EPI_T0 + wid * EPI_TW;
    if (hi == 0) { li_l[r32] = l_reg; cur.MLme[wid * QBLK + r32] = (f32x2){m_reg, l_reg}; }
    asm volatile("s_waitcnt lgkmcnt(0)" ::: "memory");
#pragma unroll
    for (int r = 0; r < 16; ++r) { const float lr = li_l[crow(r, hi)]; const float rl = lr > 0.f ? __builtin_amdgcn_rcpf(lr) : 0.f;
#pragma unroll
        for (int d0 = 0; d0 < 4; ++d0) *(bf16_t*)(Tl + crow(r, hi) * 272 + (d0 * 32 + r32) * 2) = f2bf(o[d0][r] * rl); }
    asm volatile("s_waitcnt lgkmcnt(0)" ::: "memory");
    const int crw = lane >> 4, ccol = (lane & 15) * 8;
#pragma unroll
    for (int i = 0; i < 8; ++i) { const int row = crw + 4 * i; *(u32x4*)(cur.OPme + (size_t)(wid * QBLK + row) * D + ccol) = *(const u32x4*)(Tl + row * 272 + ccol * 2); }
    VMW(); __syncthreads();
    if (tid == 0) { __builtin_amdgcn_fence(__ATOMIC_RELEASE, "agent"); asm volatile("s_waitcnt vmcnt(0)" ::: "memory");
        *flag = __hip_atomic_fetch_add(cur.cnt, 1u, __ATOMIC_RELAXED, __HIP_MEMORY_SCOPE_AGENT); }
    __syncthreads();
    if (*flag == 1u) {
        if (tid == 0) { __builtin_amdgcn_fence(__ATOMIC_ACQUIRE, "agent"); asm volatile("s_waitcnt vmcnt(0)" ::: "memory"); }
        __syncthreads();
        u32x4 ot[8], zz[8];
#pragma unroll
        for (int i = 0; i < 8; ++i) { const int row = wid * QBLK + crw + 4 * i; ot[i] = *(const u32x4*)(cur.OPot + (size_t)row * D + ccol); zz[i] = *(const u32x4*)(cur.Z + (size_t)row * 1024 + ccol); }
        constexpr float C2 = 1.4426950408889634f * SCALE;
        if (hi == 0) { const f32x2 om = cur.MLot[wid * QBLK + r32]; const float M = fmaxf(m_reg, om[0]);
            const float wa = __builtin_amdgcn_exp2f((m_reg - M) * C2) * l_reg, wb = __builtin_amdgcn_exp2f((om[0] - M) * C2) * om[1];
            const float inv = __builtin_amdgcn_rcpf(wa + wb); li_l[r32] = wa * inv; fb_l[r32] = wb * inv; }
        asm volatile("s_waitcnt lgkmcnt(0)" ::: "memory");
#pragma unroll
        for (int i = 0; i < 8; ++i) { const int row = crw + 4 * i; const float fa = li_l[row], fb = fb_l[row];
            const u32x4 ow = *(const u32x4*)(Tl + row * 272 + ccol * 2); u32x4 w;
#pragma unroll
            for (int e = 0; e < 4; ++e) w[e] = cvt_pk_bf16((bflo(ow[e]) * fa + bflo(ot[i][e]) * fb) * bflo(zz[i][e]), (bfhi(ow[e]) * fa + bfhi(ot[i][e]) * fb) * bfhi(zz[i][e]));
            *(u32x4*)(cur.O + (size_t)(wid * QBLK + row) * 1024 + ccol) = w; }
    }
    __syncthreads();
#undef RESC
#undef KBASE
#undef MLOAD
#undef SEAM_K0
#undef HALF_STEP
}
#undef ROW
#undef VMW
#undef VMWN
#undef SLOAD_H
#undef SWRITE_HK
#undef SWRITE_HV
#undef SWRITE_H
__device__ __forceinline__ BlockRef make_ref(unsigned char* ws, unsigned* ctl, int item, int pass) {
    const int hf = item & 1, xp = (item >> 1) & 7, bh = item >> 4, qb = (pass ^ hf) ? 15 - xp : xp, b = bh >> 3, h = bh & 7, kvh = b * 2 + (h >> 2);
    BlockRef r;
    r.Q = (const bf16_t*)(ws + WS_QN) + ((size_t)bh * SEQ + qb * QB) * D;
    r.K = (const bf16_t*)(ws + WS_KN) + (size_t)kvh * SEQ * D; r.V = (const bf16_t*)(ws + WS_VV) + (size_t)kvh * SEQ * D;
    r.M = (const unsigned*)(ws + WS_MASK) + (size_t)(b * SEQ + qb * QB) * 128;
    r.O = (bf16_t*)(ws + WS_XB) + (size_t)(b * SEQ + qb * QB) * 1024 + h * 128;
    r.Z = (const bf16_t*)(ws + WS_BZ) + (size_t)(b * SEQ + qb * QB) * 1024 + h * 128;
    const size_t prow = (size_t)bh * SEQ + qb * QB, hstr = (size_t)16 * SEQ;
    r.OPme = (bf16_t*)(ws + WS_OPART) + ((size_t)hf * hstr + prow) * D; r.OPot = (const bf16_t*)(ws + WS_OPART) + ((size_t)(hf ^ 1) * hstr + prow) * D;
    r.MLme = (f32x2*)(ws + WS_ML) + (size_t)hf * hstr + prow; r.MLot = (const f32x2*)(ws + WS_ML) + (size_t)(hf ^ 1) * hstr + prow;
    r.cnt = ctl + bh * 16 + qb;
    r.NT = 2 * (qb + 1); r.t_lo = hf * r.NT; return r;
}
}


#define XB_TMO      128
#define XB_XCNT(j)  (256  + 64 * (j))
#define XB_XSUB(j)  (1280 + 64 * (j))
#define XB_XGEN(j)  (2304 + 64 * (j))
#define XB_TOP      3328
#define XB_TOPGEN   3392
#define XCD_BAR_WORDS 3456
#define XB_SPIN_CAP (1u << 22)
__device__ __forceinline__ unsigned xb_ld(unsigned* p)              { return __hip_atomic_load(p, __ATOMIC_RELAXED, __HIP_MEMORY_SCOPE_AGENT); }
__device__ __forceinline__ unsigned xb_add(unsigned* p, unsigned v) { return __hip_atomic_fetch_add(p, v, __ATOMIC_RELAXED, __HIP_MEMORY_SCOPE_AGENT); }
__device__ __forceinline__ unsigned xb_xcc_id() { return (unsigned)__builtin_amdgcn_s_getreg((3 << 11) | 20) & 0xFu; }
#define XB_SPIN(cond, bar) do { unsigned _sp = 0; while (cond) { __builtin_amdgcn_s_sleep(1); \
    if ((++_sp & 255u) == 0u) { if (xb_ld(&(bar)[XB_TMO])) break; if (_sp > XB_SPIN_CAP) { atomicAdd(&(bar)[XB_TMO], 1u); break; } } } } while (0)
struct XcdBarrier { unsigned* bar; unsigned x; volatile LAS unsigned* st; };
__device__ __forceinline__ XcdBarrier xcd_barrier_post(unsigned* bar, volatile LAS unsigned* st) {
    XcdBarrier b; b.bar = bar; b.x = xb_xcc_id(); b.st = st;
    if (threadIdx.x == 0) (void)xb_add(&bar[XB_XCNT(b.x)], 1u);
    return b;
}
__device__ __forceinline__ void xcd_barrier_complete(unsigned* bar, unsigned x, unsigned& nloc, unsigned& nx) {
    const unsigned G = gridDim.x * gridDim.y * gridDim.z;
    unsigned sum, cnt, mine, sp = 0u;
    for (;;) {
        sum = 0u; cnt = 0u; mine = 0u;
#pragma unroll
        for (unsigned j = 0; j < 16; ++j) { const unsigned c = xb_ld(&bar[XB_XCNT(j)]); sum += c; cnt += (c > 0u) ? 1u : 0u; mine = (j == x) ? c : mine; }
        if (sum == G) break;
        __builtin_amdgcn_s_sleep(1);
        if ((++sp & 255u) == 0u) { if (xb_ld(&bar[XB_TMO])) break; if (sp > XB_SPIN_CAP) { atomicAdd(&bar[XB_TMO], 1u); break; } }
    }
    nloc = mine > 0u ? mine : 1u; nx = cnt > 0u ? cnt : 1u;
}
__device__ __forceinline__ void xcd_barrier(const XcdBarrier& b) {
    asm volatile("s_waitcnt vmcnt(0)" ::: "memory");
    __syncthreads();
    if (threadIdx.x == 0) {
        unsigned* bar = b.bar;
        __builtin_amdgcn_s_waitcnt(0);
        unsigned nloc = b.st[0], nx = b.st[1];
        if (nloc == 0u) { xcd_barrier_complete(bar, b.x, nloc, nx); b.st[0] = nloc; b.st[1] = nx; }
        const unsigned old = xb_add(&bar[XB_XSUB(b.x)], 1u);
        const unsigned gen = old / nloc;
        if (old + 1u == (gen + 1u) * nloc) {
            __builtin_amdgcn_fence(__ATOMIC_RELEASE, "agent");
            asm volatile("s_waitcnt vmcnt(0)" ::: "memory");
            const unsigned og = xb_add(&bar[XB_TOP], 1u);
            const unsigned tg = og / nx;
            if (og + 1u == (tg + 1u) * nx) xb_add(&bar[XB_TOPGEN], 1u);
            else XB_SPIN(xb_ld(&bar[XB_TOPGEN]) == tg, bar);
            __builtin_amdgcn_fence(__ATOMIC_ACQUIRE, "agent");
            xb_add(&bar[XB_XGEN(b.x)], 1u);
            asm volatile("s_waitcnt vmcnt(0)" ::: "memory");
        } else {
            XB_SPIN(xb_ld(&bar[XB_XGEN(b.x)]) == gen, bar);
            __builtin_amdgcn_fence(__ATOMIC_ACQUIRE, "agent");
            asm volatile("s_waitcnt vmcnt(0)" ::: "memory");
        }
    }
    __syncthreads();
}

constexpr int CW_EXIT = XCD_BAR_WORDS, CW_ATT = XCD_BAR_WORDS + 64, CW_WORDS = CW_ATT + 256;
__device__ unsigned g_ctl[CW_WORDS];

__global__ void __launch_bounds__(NTHREADS, 2) fwd_mega(Params p) {
    extern __shared__ __attribute__((aligned(16))) unsigned char lds_raw[];
    cg::grid_group grid = cg::this_grid();
    LAS unsigned char* lds = (LAS unsigned char*)lds_raw;
    const int G = gridDim.x, bx = blockIdx.x;
    const int vcu = (G % 8 == 0) ? (bx % 8) * (G / 8) + bx / 8 : bx;
    unsigned char* ws = p.ws;
    volatile LAS unsigned* misc = (volatile LAS unsigned*)(lds + MISC_OFF);
    if (threadIdx.x < 2) misc[threadIdx.x] = 0u;
    __syncthreads();
    if (p.out == nullptr) grid.sync();
    const XcdBarrier gbar = xcd_barrier_post(g_ctl, misc);
#define GRID_SYNC() xcd_barrier(gbar)

#ifndef PHASES
#define PHASES 0xffff
#endif
#ifndef REPMASK
#define REPMASK 0
#endif
#define NREP(bit) ((REPMASK & (bit)) ? 2 : 1)
#ifndef SPAN_A
#define SPAN_A -1
#endif
#ifndef SPAN_B
#define SPAN_B -1
#endif
    volatile LAS unsigned long long* stamps = (volatile LAS unsigned long long*)(lds + MISC_OFF + 16);
#define STAMP(k) do { if (SPAN_A >= 0 && bx == 0 && threadIdx.x == 0) stamps[k] = __builtin_amdgcn_s_memrealtime(); } while (0)
    STAMP(0);
    if (SPAN_A >= 0 && bx == 0 && threadIdx.x == 0) { stamps[16] = 0; stamps[17] = 0; stamps[18] = 0; stamps[19] = 0; }
    for (int rep = 0; rep < NREP(1); ++rep) if (PHASES & 1) p0_prep(p, lds, vcu, G);
    GRID_SYNC(); STAMP(1);
    for (int rep = 0; rep < NREP(2); ++rep) if (PHASES & 2) {
        Sched1 S{G, bx, (const char*)ws};
        Epi1 E{ws, p.ik_g, p.ik_b};
        pg8::gemm_phase<Epi1, Sched1, true, true>(lds, DM, S, E);
    }
    if (PHASES & 1) { constexpr int NU1A = 32 * NT_BF + 16; const int nfull = (NU1A % G == 0) ? 0 : NU1A % G; const int nhelp = G - nfull;
        if (nhelp == G) p0b_gate8(p, lds, bx, G); else if (bx >= nfull) p0b_gate8(p, lds, bx - nfull, nhelp); }
    STAMP(14);
    GRID_SYNC();
    if (PHASES & 2) {
        Sched1b S{G, bx, (const char*)ws}; Epi1b E{ws};
        pg8::gemm_phase<Epi1b, Sched1b, true, true, true>(lds, DM / 2, S, E);
    }
    GRID_SYNC(); STAMP(2);
    for (int rep = 0; rep < NREP(4); ++rep) if (PHASES & 4) p2_qkprep(p, vcu, G);
    STAMP(3);
    for (int rep = 0; rep < NREP(8); ++rep) if (PHASES & 8) for (int u = bx; u < 512; u += G) p2_gmlp_unit(p, lds, u);
    STAMP(4);
    for (int rep = 0; rep < NREP(16); ++rep) if (PHASES & 16) for (int u = bx; u < 256; u += G) p2_mem_unit(p, lds, u);
    STAMP(5);
    for (int rep = 0; rep < NREP(32); ++rep) if (PHASES & 32) p2_idx_all(p, lds, bx, G);
    STAMP(6);
    GRID_SYNC(); STAMP(7);
    for (int rep = 0; rep < NREP(64); ++rep) if (PHASES & 64) {
        const int L0 = (G == 256) ? ((bx & 7) * 32 + (bx >> 3)) : bx;
        if (L0 < 256) {
            int L = L0, pass = 0;
            att::Seam S; att::BlockRef cur = att::make_ref(ws, g_ctl + CW_ATT, L, 0);
            att::attn_prime(cur, (char*)lds_raw, S);
            STAMP(11);
            for (;;) {
                const bool more_pass = pass == 0, more_item = L + G < 256, last = !more_pass && !more_item;
                const int Ln = more_pass ? L : (more_item ? L + G : L), pn = more_pass ? 1 : 0;
                const att::BlockRef nxt = last ? cur : att::make_ref(ws, g_ctl + CW_ATT, Ln, pn);
                att::attn_block(cur, nxt, (char*)lds_raw, S);
                STAMP(12 + pass);
                if (last) break;
                cur = nxt; L = Ln; pass = pn;
            }
        }
    }
    GRID_SYNC(); STAMP(8);
    for (int rep = 0; rep < NREP(128); ++rep) if (PHASES & 128) {
        Sched2 S{G, bx, (const char*)ws};
        Epi2 E{ws};
        pg8::gemm_phase<Epi2, Sched2, true, true>(lds, 1024, S, E);
    }
    GRID_SYNC(); STAMP(9);
    if (REPMASK & 512) { for (int i = 0; i < 10; ++i) GRID_SYNC(); }
    for (int rep = 0; rep < NREP(256); ++rep) if (PHASES & 256) {
        Sched3 S{G, bx, (const char*)(ws + WS_MERGED), (const char*)(ws + WS_WOUT)};
        Epi3 E{p.x, p.out};
        pg8::gemm_phase<Epi3, Sched3, true, true>(lds, DM, S, E);
    }
    STAMP(10);
    if (SPAN_A >= 0 && bx == 0 && threadIdx.x == 0) {
        const unsigned long long dt = (SPAN_A >= 100) ? stamps[SPAN_A - 100 + 16] : (stamps[SPAN_B] - stamps[SPAN_A]), t0 = __builtin_amdgcn_s_memrealtime();
        while (__builtin_amdgcn_s_memrealtime() - t0 < dt) __builtin_amdgcn_s_sleep(8);
    }
    __syncthreads();
    if (threadIdx.x == 0) misc[0] = (xb_add(&g_ctl[CW_EXIT], 1u) == (unsigned)G - 1u) ? 1u : 0u;
    __syncthreads();
    if (misc[0]) { for (int i = threadIdx.x; i < CW_WORDS; i += NTHREADS) __hip_atomic_store(&g_ctl[i], 0u, __ATOMIC_RELAXED, __HIP_MEMORY_SCOPE_AGENT);
                   for (int i = threadIdx.x; i < NGATE; i += NTHREADS) __hip_atomic_store(&g_colmax[i], 0u, __ATOMIC_RELAXED, __HIP_MEMORY_SCOPE_AGENT); }
}

extern "C" void kernel_launch(void* const* d_in, const int* in_sizes, int n_in, void* d_out, int out_size, void* d_ws, size_t ws_size, hipStream_t stream) {
    static int grid_blocks = 0;
    if (!grid_blocks) {
        if (n_in != 21 || out_size != T * DM || ws_size < WS_TOTAL) { fprintf(stderr, "kernel_launch: unexpected shapes (n_in %d out %d ws %zu)\n", n_in, out_size, ws_size); grid_blocks = -1; return; }
        int dev = 0, cus = 0, per_cu = 0;
        (void)hipGetDevice(&dev);
        (void)hipDeviceGetAttribute(&cus, hipDeviceAttributeMultiprocessorCount, dev);
        (void)hipFuncSetAttribute((const void*)fwd_mega, hipFuncAttributeMaxDynamicSharedMemorySize, LDS_BYTES);
        (void)hipOccupancyMaxActiveBlocksPerMultiprocessor(&per_cu, (const void*)fwd_mega, NTHREADS, LDS_BYTES);
        if (per_cu < 1) { fprintf(stderr, "kernel_launch: occupancy query returned %d\n", per_cu); grid_blocks = -1; return; }
        grid_blocks = cus;
        fprintf(stderr, "kernel_launch: cus %d per_cu %d grid %d\n", cus, per_cu, grid_blocks);
    }
    if (grid_blocks < 0) return;
    Params p{};
    p.x = (const float*)d_in[0]; p.mem = (const float*)d_in[1]; p.pos = (const int*)d_in[2]; p.norm_gain = (const float*)d_in[3]; p.w_in = (const float*)d_in[4];
    p.gmlp_g = (const float*)d_in[5]; p.gmlp_b = (const float*)d_in[6]; p.spatial_w = (const float*)d_in[7]; p.spatial_b = (const float*)d_in[8]; p.w_a = (const float*)d_in[9];
    p.q_gain = (const float*)d_in[10]; p.k_gain = (const float*)d_in[11]; p.ik_g = (const float*)d_in[12]; p.ik_b = (const float*)d_in[13]; p.w_b = (const float*)d_in[14];
    p.mem_gain = (const float*)d_in[15]; p.w_mkv = (const float*)d_in[16]; p.mq_gain = (const float*)d_in[17]; p.mk_gain = (const float*)d_in[18]; p.w_m = (const float*)d_in[19];
    p.w_out = (const float*)d_in[20]; p.out = (float*)d_out; p.ws = (unsigned char*)d_ws;
    void* args[] = {&p};
    hipError_t e = hipLaunchCooperativeKernel((const void*)fwd_mega, dim3(grid_blocks), dim3(NTHREADS), args, LDS_BYTES, stream);
    if (e != hipSuccess) fprintf(stderr, "cooperative launch failed: %s (grid %d)\n", hipGetErrorString(e), grid_blocks);
}
```

```cpp
#include <hip/hip_runtime.h>
#include <hip/hip_cooperative_groups.h>
#include <cstdio>
#include <cstdint>
namespace cg = cooperative_groups;

#define LAS __attribute__((address_space(3)))
typedef unsigned short bf16_t;
typedef short bf16x8 __attribute__((ext_vector_type(8)));
typedef short s16x4 __attribute__((ext_vector_type(4)));
typedef float f32x2 __attribute__((ext_vector_type(2)));
typedef float f32x4 __attribute__((ext_vector_type(4)));
typedef float f32x16 __attribute__((ext_vector_type(16)));
typedef unsigned u32x2 __attribute__((ext_vector_type(2)));
typedef unsigned u32x4 __attribute__((ext_vector_type(4)));
typedef int i32x4 __attribute__((ext_vector_type(4)));

constexpr int NB = 2, SEQ = 4096, T = NB * SEQ, DM = 2048, DIN = 14928, NPAD = 15104, MEML = 256;
constexpr int NTHREADS = 512, NWAVES = 8;
constexpr int LDS_BYTES = 147456;
constexpr float EPS = 1e-6f;
constexpr float LOG2E = 1.4426950408889634f;

constexpr size_t MiB = (size_t)1 << 20;
constexpr size_t WS_WIN = 0, WS_WBR = 60 * MiB, WS_WOUT = 72 * MiB, WS_WMKV = 80 * MiB, WS_H = 88 * MiB, WS_MEMN = 120 * MiB;
constexpr size_t WS_AU = 122 * MiB, WS_AV = 138 * MiB, WS_AZ = 154 * MiB, WS_QR = 170 * MiB, WS_BZ = 186 * MiB, WS_MQ = 202 * MiB, WS_MZ = 218 * MiB;
constexpr size_t WS_IQ = 234 * MiB, WS_KR = 250 * MiB, WS_VV = 254 * MiB, WS_SA = 258 * MiB, WS_SB = 290 * MiB, WS_SM = 322 * MiB;
constexpr size_t WS_QN = 354 * MiB, WS_KN = 370 * MiB, WS_XA = 374 * MiB, WS_XM = 390 * MiB, WS_MASK = 406 * MiB, WS_IK = 410 * MiB, WS_IW = 411 * MiB;
constexpr size_t WS_KM = 412 * MiB, WS_VT = 413 * MiB, WS_CSB = 414 * MiB, WS_CSI = 415 * MiB, WS_END = 416 * MiB;
constexpr size_t WS_RKP = WS_IW + 524288;
constexpr size_t WS_OPART = WS_END, WS_ML = WS_END + 32 * MiB, WS_TOTAL = WS_END + 34 * MiB;
constexpr size_t WS_CTL = WS_END, CTL_BYTES = 65536;
constexpr int NGATE = 8192, GATE0 = 6736, NT_BF = 27;
constexpr size_t WS_LNP = 48 * MiB;
constexpr size_t WS_W8 = 27 * MiB, WS_SH = 47 * MiB, WS_SW = 47 * MiB + 65536, WS_CMP = 47 * MiB + 131072, WS_H8 = WS_OPART;
static_assert(WS_W8 + (size_t)NGATE * DM <= WS_SH && WS_CMP + 8 * NGATE * 4 <= WS_WBR && (size_t)NT_BF * 256 * DM * 2 <= WS_W8, "int8 regions inside the WS_WIN slot");
constexpr int CW_BAR = 0;
constexpr int MISC_OFF = 147200;
constexpr size_t WS_XB = WS_QR;
constexpr size_t WS_MERGED = WS_H;

typedef __bf16 bf16x2_t __attribute__((ext_vector_type(2)));
__device__ __forceinline__ unsigned cvt_pk_bf16(float lo, float hi) { const f32x2 v = {lo, hi}; const bf16x2_t b = __builtin_convertvector(v, bf16x2_t); return __builtin_bit_cast(unsigned, b); }
__device__ __forceinline__ bf16_t f2bf(float f) { return (bf16_t)(cvt_pk_bf16(f, 0.f) & 0xffffu); }
__device__ __forceinline__ float bf2f(unsigned short b) { return __uint_as_float(((unsigned)b) << 16); }
__device__ __forceinline__ float bflo(unsigned w) { return __uint_as_float(w << 16); }
__device__ __forceinline__ float bfhi(unsigned w) { return __uint_as_float(w & 0xffff0000u); }
__device__ __forceinline__ float sigm(float x) { return __builtin_amdgcn_rcpf(1.f + __builtin_amdgcn_exp2f(-LOG2E * x)); }
__device__ __forceinline__ float silu_f(float x) { return x * sigm(x); }
__device__ __forceinline__ float gelu_f(float x) { const float u = 0.7978845608028654f * (x + 0.044715f * x * x * x); return x * sigm(2.f * u); }
__device__ __forceinline__ float wave_sum(float v) {
#pragma unroll
    for (int o = 1; o < 64; o <<= 1) v += __shfl_xor(v, o);
    return v;
}
__device__ __forceinline__ unsigned wave_sum_u(unsigned v) {
#pragma unroll
    for (int o = 1; o < 64; o <<= 1) v += (unsigned)__shfl_xor((int)v, o);
    return v;
}
__device__ __forceinline__ bf16x8 pack8(f32x4 a, f32x4 b) {
    u32x4 w = {cvt_pk_bf16(a[0], a[1]), cvt_pk_bf16(a[2], a[3]), cvt_pk_bf16(b[0], b[1]), cvt_pk_bf16(b[2], b[3])};
    return *reinterpret_cast<bf16x8*>(&w);
}
#define LDS_WAIT() asm volatile("s_waitcnt lgkmcnt(0)" ::: "memory")
__device__ __forceinline__ int opaque_tid() { int t = threadIdx.x; asm volatile("" : "+v"(t)); return t; }

namespace pg8 {
constexpr int BM = 256, BK = 64, HALF = 128, HTB = HALF * BK * 2, STAGE_BYTES = 8 * HTB, NXCD = 8, WGM = 8;
__host__ __device__ __forceinline__ int lds_byte(int r, int c) { const int st = (r >> 4) * 2 + (c >> 5), rr = r & 15, cc = c & 31, ob = rr * 64 + cc * 2; return st * 1024 + (ob ^ (((ob >> 9) & 1) << 5)); }
__host__ __device__ __forceinline__ void stage_rc(int b, int& R, int& C) { const int st = b / 1024, sb = b % 1024, swz = sb ^ (((sb >> 9) & 1) << 5); R = (st >> 1) * 16 + swz / 64; C = (st & 1) * 32 + (swz % 64) / 2; }
__host__ __device__ __forceinline__ int perm32(int rho) { const int n = rho >> 4, i = rho & 15; return 8 * (i >> 2) + 4 * n + (i & 3); }

struct Unit { int pm, pn, kind; };

__device__ __forceinline__ void tile_order(int wgid, int nM, int nN, int& pm, int& pn) {
    const int nwg = nM * nN;
    { const int q = nwg / NXCD, r = nwg % NXCD, xcd = wgid % NXCD, off = wgid / NXCD; wgid = (xcd < r ? xcd * (q + 1) : r * (q + 1) + (xcd - r) * q) + off; }
    const int nig = WGM * nN, gid = wgid / nig, fm = gid * WGM, gsz = (nM - fm) < WGM ? (nM - fm) : WGM;
    pm = fm + ((wgid % nig) % gsz); pn = (wgid % nig) / gsz;
}

template <class Epi, class Sched, bool ALIGN_EPI, bool SP2, bool I8 = false>
__device__ __forceinline__ void gemm_phase(LAS unsigned char* lds, const int K, const Sched& S, const Epi& E) {
    const int tid = opaque_tid(), wid = __builtin_amdgcn_readfirstlane(tid >> 6), lane = tid & 63, wr = wid >> 2, wc = wid & 3, fr = lane & 15, fq = lane >> 4;
    const int nt = K / BK;
    unsigned voffA[2], voffB[2];
#pragma unroll
    for (int i = 0; i < 2; ++i) { int R, C; stage_rc(tid * 16 + i * 8192, R, C); const int Rb = Epi::PERM ? ((R & ~31) + perm32(R & 31)) : R;
        voffA[i] = (unsigned)(R * K + C) * 2u; voffB[i] = (unsigned)(Rb * K + C) * 2u; }
    const size_t kstep = (size_t)(BK * 2);
    const size_t hstep = (size_t)HALF * K * 2;
    const unsigned ldsw = (unsigned)wid * 1024u;
    const int aoff = lds_byte(wr * 64 + fr, fq * 8), boff = lds_byte(wc * 32 + fr, fq * 8);
#define PG8_SA(b, h) (((b) * 2 + (h)) * HTB)
#define PG8_SB(b, h) ((4 + (b) * 2 + (h)) * HTB)
#define PG8_STAGE(bufoff, gbase, voff) do { _Pragma("unroll") for (int _i = 0; _i < 2; ++_i) \
        __builtin_amdgcn_global_load_lds((const unsigned*)((const char*)(gbase) + (voff)[_i]), (LAS unsigned*)(lds + (bufoff) + ldsw + _i * 8192), 16, 0, 0); } while (0)
#define PG8_LDA(dst, b, h) do { _Pragma("unroll") for (int m = 0; m < 4; ++m) _Pragma("unroll") for (int k = 0; k < 2; ++k) dst[m][k] = *(const LAS bf16x8*)(lds + PG8_SA(b, h) + aoff + m * 2048 + k * 1024); } while (0)
#define PG8_LDB(dst, b, h) do { _Pragma("unroll") for (int n = 0; n < 2; ++n) _Pragma("unroll") for (int k = 0; k < 2; ++k) dst[n][k] = *(const LAS bf16x8*)(lds + PG8_SB(b, h) + boff + n * 2048 + k * 1024); } while (0)
#define PG8_MMA(ai, bj, At, Bt) do { __builtin_amdgcn_s_setprio(1); _Pragma("unroll") for (int m = 0; m < 4; ++m) _Pragma("unroll") for (int n = 0; n < 2; ++n) _Pragma("unroll") for (int k = 0; k < 2; ++k) \
        { if constexpr (I8) acc[ai][bj][m][n] = __builtin_bit_cast(f32x4, __builtin_amdgcn_mfma_i32_16x16x64_i8(__builtin_bit_cast(i32x4, Bt[n][k]), __builtin_bit_cast(i32x4, At[m][k]), __builtin_bit_cast(i32x4, acc[ai][bj][m][n]), 0, 0, 0)); \
          else acc[ai][bj][m][n] = __builtin_amdgcn_mfma_f32_16x16x32_bf16(Bt[n][k], At[m][k], acc[ai][bj][m][n], 0, 0, 0); } __builtin_amdgcn_s_setprio(0); } while (0)
#define PG8_WAIT_V(n) asm volatile("s_waitcnt vmcnt(" #n ")" ::: "memory")
#define PG8_WAIT_L(n) asm volatile("s_waitcnt lgkmcnt(" #n ")" ::: "memory")
#define PG8_BAR __builtin_amdgcn_s_barrier()
#define PG8_SCHED __builtin_amdgcn_sched_barrier(0)
    Unit cur, nxt; int ui = 0;
    if (!S.next(0, cur)) return;
    f32x4 acc[2][2][4][2];
    if constexpr (Epi::INIT) E.init(acc, cur, wr, wc, fr, fq);
    else {
#pragma unroll
    for (int a = 0; a < 2; ++a)
#pragma unroll
        for (int b = 0; b < 2; ++b)
#pragma unroll
            for (int m = 0; m < 4; ++m)
#pragma unroll
                for (int n = 0; n < 2; ++n) acc[a][b][m][n] = (f32x4){0.f, 0.f, 0.f, 0.f};
    }
    bf16x8 At[4][2], B0[2][2], B1[2][2];
    const char* cA = S.a_base(cur); const char* cB = S.b_base(cur);
    if constexpr (SP2) {
        PG8_STAGE(PG8_SB(0, 0), cB, voffB); PG8_STAGE(PG8_SB(0, 1), cB + hstep, voffB); PG8_STAGE(PG8_SA(0, 0), cA, voffA); PG8_STAGE(PG8_SA(0, 1), cA + hstep, voffA);
        if (wr == 1) PG8_BAR;
        PG8_WAIT_V(2); PG8_BAR;
        PG8_STAGE(PG8_SB(1, 0), cB + kstep, voffB); PG8_STAGE(PG8_SA(1, 0), cA + kstep, voffA); PG8_STAGE(PG8_SB(1, 1), cB + hstep + kstep, voffB);
        PG8_WAIT_V(6); PG8_BAR;
    } else {
        PG8_STAGE(PG8_SB(0, 0), cB, voffB); PG8_STAGE(PG8_SA(0, 0), cA, voffA); PG8_STAGE(PG8_SB(0, 1), cB + hstep, voffB); PG8_STAGE(PG8_SA(0, 1), cA + hstep, voffA);
        if (wr == 1) PG8_BAR;
        PG8_WAIT_V(4); PG8_BAR;
        PG8_STAGE(PG8_SB(1, 0), cB + kstep, voffB); PG8_STAGE(PG8_SA(1, 0), cA + kstep, voffA); PG8_STAGE(PG8_SB(1, 1), cB + hstep + kstep, voffB);
        PG8_WAIT_V(6); PG8_BAR;
    }
    for (;;) {
        const bool has_next = S.next(ui + 1, nxt);
        const char* nA = has_next ? S.a_base(nxt) : cA; const char* nB = has_next ? S.b_base(nxt) : cB;
        for (int t = 0; t < nt; t += 2) {
            const bool last = (t == nt - 2);
            const char* a1 = cA + (size_t)(t + 1) * kstep;
            const char* a2 = last ? nA : cA + (size_t)(t + 2) * kstep; const char* b2 = last ? nB : cB + (size_t)(t + 2) * kstep;
            const char* a3 = a2 + kstep; const char* b3 = b2 + kstep;
            if constexpr (SP2) {
            PG8_LDB(B0, 0, 0); PG8_LDB(B1, 0, 1); PG8_SCHED; PG8_LDA(At, 0, 0); PG8_STAGE(PG8_SA(1, 1), a1 + hstep, voffA);
            PG8_WAIT_V(8); PG8_WAIT_L(0); PG8_BAR; PG8_MMA(0, 0, At, B0); PG8_MMA(0, 1, At, B1); PG8_BAR; PG8_SCHED;
            PG8_LDA(At, 0, 1); PG8_STAGE(PG8_SB(0, 0), b2, voffB); PG8_STAGE(PG8_SB(0, 1), b2 + hstep, voffB); PG8_STAGE(PG8_SA(0, 0), a2, voffA);
            PG8_WAIT_V(8); PG8_WAIT_L(0); PG8_BAR; PG8_MMA(1, 0, At, B0); PG8_MMA(1, 1, At, B1); PG8_BAR; PG8_SCHED;
            PG8_LDB(B0, 1, 0); PG8_LDB(B1, 1, 1); PG8_SCHED; PG8_LDA(At, 1, 0); PG8_STAGE(PG8_SA(0, 1), a2 + hstep, voffA);
            PG8_WAIT_V(8); PG8_WAIT_L(0); PG8_BAR; PG8_MMA(0, 0, At, B0); PG8_MMA(0, 1, At, B1); PG8_BAR; PG8_SCHED;
            PG8_LDA(At, 1, 1); PG8_STAGE(PG8_SB(1, 0), b3, voffB); PG8_STAGE(PG8_SB(1, 1), b3 + hstep, voffB); PG8_STAGE(PG8_SA(1, 0), a3, voffA);
            PG8_WAIT_V(8); PG8_WAIT_L(0); PG8_BAR; PG8_MMA(1, 0, At, B0); PG8_MMA(1, 1, At, B1); PG8_BAR; PG8_SCHED;
            } else {
            PG8_LDB(B0, 0, 0); PG8_SCHED; PG8_LDA(At, 0, 0); PG8_STAGE(PG8_SA(1, 1), a1 + hstep, voffA);
            PG8_WAIT_L(8); PG8_BAR; PG8_WAIT_L(0); PG8_MMA(0, 0, At, B0); PG8_BAR; PG8_SCHED;
            PG8_LDB(B1, 0, 1); PG8_STAGE(PG8_SB(0, 0), b2, voffB);
            PG8_BAR; PG8_WAIT_L(0); PG8_MMA(0, 1, At, B1); PG8_BAR;
            PG8_LDA(At, 0, 1); PG8_STAGE(PG8_SA(0, 0), a2, voffA);
            PG8_BAR; PG8_WAIT_L(0); PG8_MMA(1, 0, At, B0); PG8_BAR; PG8_SCHED;
            PG8_STAGE(PG8_SB(0, 1), b2 + hstep, voffB);
            PG8_WAIT_V(6); PG8_BAR; PG8_MMA(1, 1, At, B1); PG8_BAR;
            PG8_LDB(B0, 1, 0); PG8_SCHED; PG8_LDA(At, 1, 0); PG8_STAGE(PG8_SA(0, 1), a2 + hstep, voffA);
            PG8_WAIT_L(8); PG8_BAR; PG8_WAIT_L(0); PG8_MMA(0, 0, At, B0); PG8_BAR; PG8_SCHED;
            PG8_LDB(B1, 1, 1); PG8_STAGE(PG8_SB(1, 0), b3, voffB);
            PG8_BAR; PG8_WAIT_L(0); PG8_MMA(0, 1, At, B1); PG8_BAR;
            PG8_LDA(At, 1, 1); PG8_STAGE(PG8_SA(1, 0), a3, voffA);
            PG8_BAR; PG8_WAIT_L(0); PG8_MMA(1, 0, At, B0); PG8_BAR; PG8_SCHED;
            PG8_STAGE(PG8_SB(1, 1), b3 + hstep, voffB);
            PG8_WAIT_V(6); PG8_BAR; PG8_MMA(1, 1, At, B1); PG8_BAR;
            }
        }
        if constexpr (ALIGN_EPI) { if (wr == 0) PG8_BAR; }
        const bool zero = E(acc, cur, wr, wc, fr, fq);
        if (!has_next) break;
        if constexpr (Epi::INIT) { E.init(acc, nxt, wr, wc, fr, fq); }
        else if (zero) {
#pragma unroll
        for (int a = 0; a < 2; ++a)
#pragma unroll
            for (int b = 0; b < 2; ++b)
#pragma unroll
                for (int m = 0; m < 4; ++m)
#pragma unroll
                    for (int n = 0; n < 2; ++n) acc[a][b][m][n] = (f32x4){0.f, 0.f, 0.f, 0.f};
        }
        cur = nxt; cA = nA; cB = nB; ++ui;
        if constexpr (ALIGN_EPI) { if (wr == 1) PG8_BAR; }
    }
    PG8_WAIT_V(0);
    if constexpr (!ALIGN_EPI) { if (wr == 0) PG8_BAR; }
    PG8_BAR;
#undef PG8_SA
#undef PG8_SB
#undef PG8_STAGE
#undef PG8_LDA
#undef PG8_LDB
#undef PG8_MMA
#undef PG8_WAIT_V
#undef PG8_WAIT_L
#undef PG8_BAR
#undef PG8_SCHED
}
}

struct Params {
    const float* x; const float* mem; const int* pos; const float* norm_gain; const float* w_in; const float* gmlp_g; const float* gmlp_b;
    const float* spatial_w; const float* spatial_b; const float* w_a; const float* q_gain; const float* k_gain; const float* ik_g; const float* ik_b;
    const float* w_b; const float* mem_gain; const float* w_mkv; const float* mq_gain; const float* mk_gain; const float* w_m; const float* w_out;
    float* out; unsigned char* ws;
};

__device__ unsigned g_colmax[8192];

__device__ __forceinline__ int win_src_col(int np) {
    const int tile = np >> 8, c = np & 255;
    if (tile < 22) return np;
    const int bj = c >> 7, wc = (c >> 5) & 3, fq = (c >> 3) & 3, j = c & 7;
    if (tile < 26) return 5632 + (tile - 22) * 256 + wc * 64 + 8 * (2 * fq + bj) + j;
    if (tile == 26) {
        if (wc == 0) return 6656 + 8 * (2 * fq + bj) + j;
        if (wc == 1 && fq == 0) return 6720 + 8 * bj + j;
        return -1;
    }
    return np - 176;
}
__device__ __forceinline__ void transpose_item(const float* W, int K, int N, bf16_t* WT, int kb, int nb, bool is_win, LAS float* scr, int lane) {
    const int k0 = 64 * kb, n0 = 32 * nb, nl = lane & 31;
    const int src = is_win ? win_src_col(n0 + nl) : (n0 + nl);
    const float* wp = W + (size_t)(k0 + (lane >> 5)) * N + (src >= 0 ? src : 0);
    float tv[32];
#pragma unroll
    for (int i = 0; i < 32; ++i) tv[i] = wp[(size_t)(2 * i) * N];
#pragma unroll
    for (int i = 0; i < 32; ++i) { const int kk = 2 * i + (lane >> 5); scr[kk * 33 + nl] = src >= 0 ? tv[i] : 0.f; }
    LDS_WAIT(); asm volatile("" ::: "memory");
    const int c = lane & 7;
#pragma unroll
    for (int j = 0; j < 4; ++j) { const int n = (lane >> 3) + 8 * j; const LAS float* s = scr + (8 * c) * 33 + n;
        u32x4 o; o.x = cvt_pk_bf16(s[0 * 33], s[1 * 33]); o.y = cvt_pk_bf16(s[2 * 33], s[3 * 33]); o.z = cvt_pk_bf16(s[4 * 33], s[5 * 33]); o.w = cvt_pk_bf16(s[6 * 33], s[7 * 33]);
        *(u32x4*)(WT + (size_t)(n0 + n) * K + k0 + 8 * c) = o; }
    LDS_WAIT(); asm volatile("" ::: "memory");
}
template <bool Q8>
__device__ __forceinline__ void rms_row(const float* xrow, const float* gain, bf16_t* orow, unsigned* q8row, float* q8scale, int lane) {
    f32x4 v[8]; float s = 0.f;
#pragma unroll
    for (int j = 0; j < 8; ++j) { v[j] = ((const f32x4*)xrow)[lane + 64 * j]; s += (v[j][0] * v[j][0] + v[j][1] * v[j][1]) + (v[j][2] * v[j][2] + v[j][3] * v[j][3]); }
    s = wave_sum(s);
    const float r = 1.0f / sqrtf(s * (1.0f / DM) + EPS);
    float am = 0.f;
#pragma unroll
    for (int j = 0; j < 8; ++j) { const f32x4 g = ((const f32x4*)gain)[lane + 64 * j]; v[j] = v[j] * r * g;
        u32x2 w; w.x = cvt_pk_bf16(v[j][0], v[j][1]); w.y = cvt_pk_bf16(v[j][2], v[j][3]); ((u32x2*)orow)[lane + 64 * j] = w;
        if (Q8) am = fmaxf(fmaxf(am, fmaxf(fabsf(v[j][0]), fabsf(v[j][1]))), fmaxf(fabsf(v[j][2]), fabsf(v[j][3]))); }
    if (Q8) {
#pragma unroll
        for (int o = 1; o < 64; o <<= 1) am = fmaxf(am, __shfl_xor(am, o));
        const float inv = am > 0.f ? 127.f / am : 0.f;
#pragma unroll
        for (int j = 0; j < 8; ++j) { const int q0 = (int)rintf(v[j][0] * inv), q1 = (int)rintf(v[j][1] * inv), q2 = (int)rintf(v[j][2] * inv), q3 = (int)rintf(v[j][3] * inv);
            q8row[lane + 64 * j] = (unsigned)(q0 & 0xff) | ((unsigned)(q1 & 0xff) << 8) | ((unsigned)(q2 & 0xff) << 16) | ((unsigned)(q3 & 0xff) << 24); }
        if (lane == 0) *q8scale = am * (1.f / 127.f);
    }
}
__device__ __forceinline__ void p0_prep(const Params& p, LAS unsigned char* lds, int vcu, int G) {
    const int tid = opaque_tid(), lane = tid & 63, wave = tid >> 6;
    LAS float* scr = (LAS float*)(lds + wave * 16384);
    const int gw = vcu * NWAVES + wave, NGW = G * NWAVES;
    unsigned char* ws = p.ws;
    constexpr int I_CM = 32 * 32, I_WIN = 32 * (NT_BF * 8), I_BR = 16 * 64, I_SQ = 32 * 64;
    constexpr int NITEMS = I_CM + I_WIN + 3 * I_BR + 2 * I_SQ;
    for (int it = gw; it < NITEMS; it += NGW) {
        int r = it;
        if (r < I_CM) {
            const int cg = r % 32, kc = r / 32; const float* wp = p.w_in + (size_t)(64 * kc) * DIN + GATE0 + 256 * cg + 4 * lane; f32x4 m = {0.f, 0.f, 0.f, 0.f};
#pragma unroll 32
            for (int k = 0; k < 64; ++k) { const f32x4 w = *(const f32x4*)(wp + (size_t)k * DIN); m[0] = fmaxf(m[0], fabsf(w[0])); m[1] = fmaxf(m[1], fabsf(w[1])); m[2] = fmaxf(m[2], fabsf(w[2])); m[3] = fmaxf(m[3], fabsf(w[3])); }
#pragma unroll
            for (int e = 0; e < 4; ++e) atomicMax(&g_colmax[256 * cg + 4 * lane + e], __float_as_uint(m[e]));
            continue; } r -= I_CM;
        if (r < I_WIN) { const int nb = r % (NT_BF * 8), kb = r / (NT_BF * 8); transpose_item(p.w_in, DM, DIN, (bf16_t*)(ws + WS_WIN), kb, nb, true, scr, lane); continue; } r -= I_WIN;
        if (r < 3 * I_BR) { const int br = r / I_BR, q = r % I_BR; const float* W = br == 0 ? p.w_a : (br == 1 ? p.w_b : p.w_m);
            transpose_item(W, 1024, DM, (bf16_t*)(ws + WS_WBR) + (size_t)br * DM * 1024, q / 64, q % 64, false, scr, lane); continue; } r -= 3 * I_BR;
        if (r < I_SQ) { transpose_item(p.w_out, DM, DM, (bf16_t*)(ws + WS_WOUT), r / 64, r % 64, false, scr, lane); continue; } r -= I_SQ;
        transpose_item(p.w_mkv, DM, DM, (bf16_t*)(ws + WS_WMKV), r / 64, r % 64, false, scr, lane);
    }
    for (int m = gw; m < T + NB * MEML; m += NGW) {
        if (m < T) rms_row<true>(p.x + (size_t)m * DM, p.norm_gain, (bf16_t*)(ws + WS_H) + (size_t)m * DM, (unsigned*)(ws + WS_H8) + (size_t)m * (DM / 4), (float*)(ws + WS_SH) + m, lane);
        else rms_row<false>(p.mem + (size_t)(m - T) * DM, p.mem_gain, (bf16_t*)(ws + WS_MEMN) + (size_t)(m - T) * DM, nullptr, nullptr, lane);
    }
    for (int i = vcu * NTHREADS + tid; i < T * 24; i += G * NTHREADS) {
        const int t = i / 24, j = i % 24; const float ps = (float)p.pos[t];
        float inv; if (j < 16) inv = powf(500000.0f, -(float)j / 16.0f); else inv = powf(500000.0f, -(float)(j - 16) / 8.0f);
        float sn, cs; sincosf(ps * inv, &sn, &cs);
        if (j < 16) ((f32x2*)(ws + WS_CSB))[t * 16 + j] = (f32x2){cs, sn}; else ((f32x2*)(ws + WS_CSI))[t * 8 + (j - 16)] = (f32x2){cs, sn};
    }
}
__device__ __forceinline__ void p0b_gate8(const Params& p, LAS unsigned char* lds, int widx, int nw) {
    const int tid = opaque_tid(), lane = tid & 63, wave = tid >> 6;
    LAS float* scr = (LAS float*)(lds + wave * 16384);
    const int gw = widx * NWAVES + wave, NGW = nw * NWAVES;
    unsigned char* ws = p.ws;
    for (int it = gw; it < 32 * (NGATE / 32); it += NGW) {
        const int nb = it % (NGATE / 32), kb = it / (NGATE / 32), k0 = 64 * kb, n0 = 32 * nb, nl = lane & 31;
        const float cm = __uint_as_float(__hip_atomic_load(&g_colmax[n0 + nl], __ATOMIC_RELAXED, __HIP_MEMORY_SCOPE_AGENT));
        const float inv = cm > 0.f ? 127.f / cm : 0.f;
        if (kb == 0 && lane < 32) ((float*)(ws + WS_SW))[n0 + nl] = cm * (1.f / 127.f);
        const float* wp = p.w_in + (size_t)(k0 + (lane >> 5)) * DIN + GATE0 + n0 + nl;
        float tv[32];
#pragma unroll
        for (int i = 0; i < 32; ++i) tv[i] = wp[(size_t)(2 * i) * DIN];
#pragma unroll
        for (int i = 0; i < 32; ++i) { const int kk = 2 * i + (lane >> 5); scr[kk * 33 + nl] = rintf(tv[i] * inv); }
        LDS_WAIT(); asm volatile("" ::: "memory");
        const int c = lane & 7;
#pragma unroll
        for (int j = 0; j < 4; ++j) { const int n = (lane >> 3) + 8 * j; const LAS float* sp = scr + (8 * c) * 33 + n;
            unsigned lo = 0, hi2 = 0;
#pragma unroll
            for (int e = 0; e < 4; ++e) { lo |= ((unsigned)((int)sp[e * 33]) & 0xffu) << (8 * e); hi2 |= ((unsigned)((int)sp[(4 + e) * 33]) & 0xffu) << (8 * e); }
            *(u32x2*)((unsigned char*)(ws + WS_W8) + (size_t)(n0 + n) * DM + k0 + 8 * c) = (u32x2){lo, hi2}; }
        LDS_WAIT(); asm volatile("" ::: "memory");
    }
}

struct Sched1 {
    int G, c; const char* ws;
    __device__ __forceinline__ bool next(int i, pg8::Unit& u) const {
        int L = i * G + c;
        if (L < 32 * NT_BF) { pg8::tile_order(L, 32, NT_BF, u.pm, u.pn); u.kind = 0; return true; }
        L -= 32 * NT_BF;
        if (L < 8) { u.pm = L & 1; u.pn = L >> 1; u.kind = 1; return true; }
        L -= 8;
        if (L < 8) { u.pm = L & 3; u.pn = L >> 2; u.kind = 2; return true; }
        return false;
    }
    __device__ __forceinline__ const char* a_base(const pg8::Unit& u) const {
        const size_t off = u.kind == 0 ? WS_H : (u.kind == 1 ? WS_MEMN : WS_WMKV + (size_t)1024 * DM * 2);
        return ws + off + (size_t)u.pm * (256 * DM * 2); }
    __device__ __forceinline__ const char* b_base(const pg8::Unit& u) const {
        const size_t off = u.kind == 0 ? WS_WIN : (u.kind == 1 ? WS_WMKV : WS_MEMN);
        return ws + off + (size_t)u.pn * (256 * DM * 2); }
};
struct Epi1 {
    static constexpr bool PERM = true, INIT = false;
    unsigned char* ws; const float* ikg; const float* ikb;
    __device__ __forceinline__ bool operator()(f32x4 (&acc)[2][2][4][2], const pg8::Unit& u, int wr, int wc, int fr, int fq) const {
        const int rowb = u.pm * 256 + wr * 64 + fr, cl = wc * 32 + 8 * fq, pn = u.pn;
#ifndef EX_NOIQ
        if (u.kind == 0 && pn >= 22 && pn < 26) {
            const int head = 4 * (pn - 22) + wc;
#pragma unroll
            for (int ai = 0; ai < 2; ++ai)
#pragma unroll
                for (int m = 0; m < 4; ++m) { const int row = rowb + ai * 128 + m * 16;
                    f32x4 x1a = acc[ai][0][m][0], x1b = acc[ai][0][m][1], x2a = acc[ai][1][m][0], x2b = acc[ai][1][m][1];
                    if (fq == 0) { const f32x4* cs = (const f32x4*)(ws + WS_CSI) + row * 4;
                        const f32x4 c0 = cs[0], c1 = cs[1], c2 = cs[2], c3 = cs[3];
                        const f32x4 co_a = {c0[0], c0[2], c1[0], c1[2]}, si_a = {c0[1], c0[3], c1[1], c1[3]}, co_b = {c2[0], c2[2], c3[0], c3[2]}, si_b = {c2[1], c2[3], c3[1], c3[3]};
                        const f32x4 r1a = x1a * co_a - x2a * si_a, r1b = x1b * co_b - x2b * si_b, r2a = x2a * co_a + x1a * si_a, r2b = x2b * co_b + x1b * si_b;
                        x1a = r1a; x1b = r1b; x2a = r2a; x2b = r2b; }
                    bf16_t* dst = (bf16_t*)(ws + WS_IQ) + (size_t)row * 1024 + head * 64 + 16 * fq;
                    *(bf16x8*)(dst) = pack8(x1a, x1b); *(bf16x8*)(dst + 8) = pack8(x2a, x2b); }
            return true;
        }
#endif
#ifndef EX_NOIK
        if (u.kind == 0 && pn == 26) {
            if (wc == 0) {
                const f32x4 g0 = *(const f32x4*)(ikg + 16 * fq), g1 = *(const f32x4*)(ikg + 16 * fq + 4), g2 = *(const f32x4*)(ikg + 16 * fq + 8), g3 = *(const f32x4*)(ikg + 16 * fq + 12);
                const f32x4 e0 = *(const f32x4*)(ikb + 16 * fq), e1 = *(const f32x4*)(ikb + 16 * fq + 4), e2 = *(const f32x4*)(ikb + 16 * fq + 8), e3 = *(const f32x4*)(ikb + 16 * fq + 12);
#pragma unroll
                for (int ai = 0; ai < 2; ++ai)
#pragma unroll
                    for (int m = 0; m < 4; ++m) { const int row = rowb + ai * 128 + m * 16;
                        f32x4 v0 = acc[ai][0][m][0], v1 = acc[ai][0][m][1], v2 = acc[ai][1][m][0], v3 = acc[ai][1][m][1];
                        const f32x4 sv = (v0 + v1) + (v2 + v3);
                        float sm = (sv[0] + sv[1]) + (sv[2] + sv[3]);
                        sm += __shfl_xor(sm, 16); sm += __shfl_xor(sm, 32);
                        const float mean = sm * (1.f / 64.f);
                        v0 = v0 - mean; v1 = v1 - mean; v2 = v2 - mean; v3 = v3 - mean;
                        const f32x4 qv = (v0 * v0 + v1 * v1) + (v2 * v2 + v3 * v3);
                        float q2 = (qv[0] + qv[1]) + (qv[2] + qv[3]);
                        q2 += __shfl_xor(q2, 16); q2 += __shfl_xor(q2, 32);
                        const float rstd = 1.0f / sqrtf(q2 * (1.f / 64.f) + EPS);
                        v0 = v0 * rstd * g0 + e0; v1 = v1 * rstd * g1 + e1; v2 = v2 * rstd * g2 + e2; v3 = v3 * rstd * g3 + e3;
                        if (fq == 0) { const f32x4* cs = (const f32x4*)(ws + WS_CSI) + row * 4;
                            const f32x4 c0 = cs[0], c1 = cs[1], c2 = cs[2], c3 = cs[3];
                            const f32x4 co_a = {c0[0], c0[2], c1[0], c1[2]}, si_a = {c0[1], c0[3], c1[1], c1[3]}, co_b = {c2[0], c2[2], c3[0], c3[2]}, si_b = {c2[1], c2[3], c3[1], c3[3]};
                            const f32x4 r1a = v0 * co_a - v2 * si_a, r1b = v1 * co_b - v3 * si_b, r2a = v2 * co_a + v0 * si_a, r2b = v3 * co_b + v1 * si_b;
                            v0 = r1a; v1 = r1b; v2 = r2a; v3 = r2b; }
                        bf16_t* dst = (bf16_t*)(ws + WS_IK) + (size_t)row * 64 + 16 * fq;
                        *(bf16x8*)(dst) = pack8(v0, v1); *(bf16x8*)(dst + 8) = pack8(v2, v3); }
            } else if (wc == 1 && fq == 0) {
#pragma unroll
                for (int ai = 0; ai < 2; ++ai)
#pragma unroll
                    for (int m = 0; m < 4; ++m) { const int row = rowb + ai * 128 + m * 16; float* dst = (float*)(ws + WS_IW) + (size_t)row * 16;
                        *(f32x4*)(dst) = acc[ai][0][m][0] * 0.03125f; *(f32x4*)(dst + 4) = acc[ai][0][m][1] * 0.03125f;
                        *(f32x4*)(dst + 8) = acc[ai][1][m][0] * 0.03125f; *(f32x4*)(dst + 12) = acc[ai][1][m][1] * 0.03125f; }
            }
            return true;
        }
#endif
        int act = 0, ld = 1024, co = 0, bjs = 128; size_t off = 0, bex = 0;
        if (u.kind == 1) { off = WS_KM; co = pn * 256; }
        else if (u.kind == 2) { off = WS_VT; ld = 512; co = pn * 256; }
        else if (pn < 4) { act = 1; off = WS_AU; co = pn * 256; }
        else if (pn < 8) { act = 1; off = WS_AV; co = (pn - 4) * 256; }
        else if (pn < 12) { act = 2; off = WS_AZ; co = (pn - 8) * 256; }
        else if (pn < 16) { off = WS_QR; co = (pn - 12) * 256; }
        else if (pn == 16) { off = WS_KR; ld = 256; }
        else if (pn == 17) { off = WS_VV; ld = 128; bjs = SEQ * 128; bex = (size_t)SEQ * 128; }
        else { act = 2; off = WS_BZ; co = (pn - 18) * 256; }
        bf16_t* dst = (bf16_t*)(ws + off) + co + cl;
#pragma unroll
        for (int ai = 0; ai < 2; ++ai)
#pragma unroll
            for (int m = 0; m < 4; ++m) { const int row = rowb + ai * 128 + m * 16; bf16_t* rp = dst + (size_t)row * ld + (size_t)(row >> 12) * bex;
#pragma unroll
                for (int bj = 0; bj < 2; ++bj) { f32x4 v0 = acc[ai][bj][m][0], v1 = acc[ai][bj][m][1];
                    if (act == 1) {
#pragma unroll
                        for (int e = 0; e < 4; ++e) { v0[e] = gelu_f(v0[e]); v1[e] = gelu_f(v1[e]); } }
                    else if (act == 2) {
#pragma unroll
                        for (int e = 0; e < 4; ++e) { v0[e] = silu_f(v0[e]); v1[e] = silu_f(v1[e]); } }
                    *(bf16x8*)(rp + (size_t)bj * bjs) = pack8(v0, v1); }
                if (u.kind == 0 && pn >= 4 && pn < 8) {
                    f32x4 g0 = acc[ai][0][m][0], g1 = acc[ai][0][m][1], g2 = acc[ai][1][m][0], g3 = acc[ai][1][m][1];
#pragma unroll
                    for (int e = 0; e < 4; ++e) { g0[e] = gelu_f(g0[e]); g1[e] = gelu_f(g1[e]); g2[e] = gelu_f(g2[e]); g3[e] = gelu_f(g3[e]); }
                    const f32x4 sv = (g0 + g1) + (g2 + g3), qv = (g0 * g0 + g1 * g1) + (g2 * g2 + g3 * g3);
                    float s1 = (sv[0] + sv[1]) + (sv[2] + sv[3]), s2 = (qv[0] + qv[1]) + (qv[2] + qv[3]);
                    s1 += __shfl_xor(s1, 16); s2 += __shfl_xor(s2, 16); s1 += __shfl_xor(s1, 32); s2 += __shfl_xor(s2, 32);
                    if (fq == 0) ((f32x2*)(ws + WS_LNP))[(size_t)row * 16 + (pn - 4) * 4 + wc] = (f32x2){s1, s2}; }
                if (u.kind == 1) {
                    const f32x4 q = (acc[ai][0][m][0] * acc[ai][0][m][0] + acc[ai][0][m][1] * acc[ai][0][m][1]) + (acc[ai][1][m][0] * acc[ai][1][m][0] + acc[ai][1][m][1] * acc[ai][1][m][1]);
                    float ss = (q[0] + q[1]) + (q[2] + q[3]);
                    ss += __shfl_xor(ss, 16); ss += __shfl_xor(ss, 32);
                    if (fq == 0) ((float*)(ws + WS_RKP))[(size_t)row * 16 + pn * 4 + wc] = ss; } }
        return true;
    }
};

struct Sched1b {
    int G, c; const char* ws;
    __device__ __forceinline__ bool next(int i, pg8::Unit& u) const { const int L = i * G + c; if (L >= 32 * 32) return false; pg8::tile_order(L, 32, 32, u.pm, u.pn); u.kind = 0; return true; }
    __device__ __forceinline__ const char* a_base(const pg8::Unit& u) const { return ws + WS_H8 + (size_t)u.pm * (256 * DM); }
    __device__ __forceinline__ const char* b_base(const pg8::Unit& u) const { return ws + WS_W8 + (size_t)u.pn * (256 * DM); }
};
struct Epi1b {
    static constexpr bool PERM = true, INIT = false;
    unsigned char* ws;
    __device__ __forceinline__ bool operator()(f32x4 (&acc)[2][2][4][2], const pg8::Unit& u, int wr, int wc, int fr, int fq) const {
        const int rowb = u.pm * 256 + wr * 64 + fr, cl = wc * 32 + 8 * fq, pn = u.pn;
        const float* __restrict__ SW = (const float*)(ws + WS_SW) + pn * 256 + cl; const float* __restrict__ SH = (const float*)(ws + WS_SH);
        const f32x4 sw00 = *(const f32x4*)(SW), sw01 = *(const f32x4*)(SW + 4), sw10 = *(const f32x4*)(SW + 128), sw11 = *(const f32x4*)(SW + 132);
        float sh[2][4];
#pragma unroll
        for (int ai = 0; ai < 2; ++ai)
#pragma unroll
            for (int m = 0; m < 4; ++m) sh[ai][m] = SH[rowb + ai * 128 + m * 16];
        if (pn < 8) {
            bf16_t* __restrict__ dst = (bf16_t*)(ws + (pn < 4 ? WS_MQ : WS_MZ)) + (pn & 3) * 256 + cl;
#pragma unroll
            for (int ai = 0; ai < 2; ++ai)
#pragma unroll
                for (int m = 0; m < 4; ++m) { const int row = rowb + ai * 128 + m * 16; const float rs = sh[ai][m];
#pragma unroll
                    for (int bj = 0; bj < 2; ++bj) { f32x4 v0, v1; const f32x4 s0 = bj ? sw10 : sw00, s1 = bj ? sw11 : sw01;
#pragma unroll
                        for (int e = 0; e < 4; ++e) { v0[e] = (float)__float_as_int(acc[ai][bj][m][0][e]) * (rs * s0[e]); v1[e] = (float)__float_as_int(acc[ai][bj][m][1][e]) * (rs * s1[e]); }
                        if (pn >= 4) {
#pragma unroll
                            for (int e = 0; e < 4; ++e) { v0[e] = silu_f(v0[e]); v1[e] = silu_f(v1[e]); } }
                        *(bf16x8*)(dst + (size_t)row * 1024 + bj * 128) = pack8(v0, v1); } }
            return true;
        }
        const int pg = pn - 8;
        unsigned char* __restrict__ dst = (unsigned char*)(ws + WS_SA + (size_t)(pg >> 3) * (WS_SB - WS_SA)) + (pg & 7) * 256 + cl;
#pragma unroll
        for (int ai = 0; ai < 2; ++ai)
#pragma unroll
            for (int m = 0; m < 4; ++m) { const int row = rowb + ai * 128 + m * 16; const float rs = sh[ai][m] * (-LOG2E);
#pragma unroll
                for (int bj = 0; bj < 2; ++bj) { const f32x4 s0 = bj ? sw10 : sw00, s1 = bj ? sw11 : sw01; unsigned lo = 0, hi2 = 0;
#pragma unroll
                    for (int e = 0; e < 4; ++e) {
                        const float q0 = 255.f * __builtin_amdgcn_rcpf(1.f + __builtin_amdgcn_exp2f((float)__float_as_int(acc[ai][bj][m][0][e]) * (rs * s0[e])));
                        const float q1 = 255.f * __builtin_amdgcn_rcpf(1.f + __builtin_amdgcn_exp2f((float)__float_as_int(acc[ai][bj][m][1][e]) * (rs * s1[e])));
                        lo = __builtin_amdgcn_cvt_pk_u8_f32(__builtin_amdgcn_fmed3f(q0, 1.f, 255.f), e, lo); hi2 = __builtin_amdgcn_cvt_pk_u8_f32(__builtin_amdgcn_fmed3f(q1, 1.f, 255.f), e, hi2); }
                    *(u32x2*)(dst + (size_t)row * DM + bj * 128) = (u32x2){lo, hi2}; } }
        return true;
    }
};

struct Sched2 {
    int G, c; const char* ws;
    __device__ __forceinline__ bool next(int i, pg8::Unit& u) const {
        const int L = (i / 3) * G + c; if (L >= 256) return false;
        pg8::tile_order(L, 32, 8, u.pm, u.pn); u.kind = i % 3; return true;
    }
    __device__ __forceinline__ const char* a_base(const pg8::Unit& u) const {
        const size_t off = WS_XA + (u.kind == 1 ? (WS_XB - WS_XA) : (size_t)0) + (u.kind == 2 ? (WS_XM - WS_XA) : (size_t)0);
        return ws + off + (size_t)u.pm * (256 * 1024 * 2); }
    __device__ __forceinline__ const char* b_base(const pg8::Unit& u) const { return ws + WS_WBR + (size_t)u.kind * ((size_t)DM * 1024 * 2) + (size_t)u.pn * (256 * 1024 * 2); }
};
struct Epi2 {
    static constexpr bool PERM = true, INIT = false;
    unsigned char* ws;
    __device__ __forceinline__ bool operator()(f32x4 (&acc)[2][2][4][2], const pg8::Unit& u, int wr, int wc, int fr, int fq) const {
        const int rowb = u.pm * 256 + wr * 64 + fr, colb = u.pn * 256 + wc * 32 + 8 * fq, seg = u.kind;
        constexpr size_t GST = WS_SB - WS_SA;
        static_assert(WS_SM - WS_SB == GST, "gate spacing");
        const unsigned char* __restrict__ NUM = (const unsigned char*)(ws + WS_SA + (size_t)seg * GST);
        const unsigned char* __restrict__ DEN = (const unsigned char*)(ws + WS_SA + (size_t)(seg < 2 ? seg + 1 : 2) * GST);
        bf16_t* __restrict__ MG = (bf16_t*)(ws + WS_MERGED);
#define U8F(w, e) ((float)(((w) >> (8 * (e))) & 0xffu))
#pragma unroll
        for (int ai = 0; ai < 2; ++ai)
#pragma unroll
            for (int m = 0; m < 4; ++m) { const size_t ro = (size_t)(rowb + ai * 128 + m * 16) * DM + colb;
#pragma unroll
                for (int bj = 0; bj < 2; ++bj) {
                    const u32x2 nu = *(const u32x2*)(NUM + ro + bj * 128);
                    f32x4 f0 = {U8F(nu[0], 0), U8F(nu[0], 1), U8F(nu[0], 2), U8F(nu[0], 3)}, f1 = {U8F(nu[1], 0), U8F(nu[1], 1), U8F(nu[1], 2), U8F(nu[1], 3)};
                    if (seg < 2) { const u32x2 de = *(const u32x2*)(DEN + ro + bj * 128);
                        const f32x4 d0 = {U8F(de[0], 0), U8F(de[0], 1), U8F(de[0], 2), U8F(de[0], 3)}, d1 = {U8F(de[1], 0), U8F(de[1], 1), U8F(de[1], 2), U8F(de[1], 3)};
#pragma unroll
                        for (int e = 0; e < 4; ++e) { f0[e] *= __builtin_amdgcn_rcpf(d0[e]); f1[e] *= __builtin_amdgcn_rcpf(d1[e]); }
                        acc[ai][bj][m][0] *= f0; acc[ai][bj][m][1] *= f1;
                    } else { *(bf16x8*)(MG + ro + bj * 128) = pack8(acc[ai][bj][m][0] * f0 * (1.f / 255.f), acc[ai][bj][m][1] * f1 * (1.f / 255.f)); }
                } }
#undef U8F
        return seg == 2;
    }
};
struct Sched3 {
    int G, c; const char* A; const char* B;
    __device__ __forceinline__ bool next(int i, pg8::Unit& u) const { const int L = i * G + c; if (L >= 256) return false; pg8::tile_order(L, 32, 8, u.pm, u.pn); u.kind = 0; return true; }
    __device__ __forceinline__ const char* a_base(const pg8::Unit& u) const { return A + (size_t)u.pm * (256 * DM * 2); }
    __device__ __forceinline__ const char* b_base(const pg8::Unit& u) const { return B + (size_t)u.pn * (256 * DM * 2); }
};
struct Epi3 {
    static constexpr bool PERM = false, INIT = true;
    const float* x; float* out;
    __device__ __forceinline__ void init(f32x4 (&acc)[2][2][4][2], const pg8::Unit& u, int wr, int wc, int fr, int fq) const {
        const int rowb = u.pm * 256 + wr * 64 + fr, colb = u.pn * 256 + wc * 32 + 4 * fq;
#pragma unroll
        for (int ai = 0; ai < 2; ++ai)
#pragma unroll
            for (int m = 0; m < 4; ++m) { const size_t ro = (size_t)(rowb + ai * 128 + m * 16) * DM + colb;
#pragma unroll
                for (int bj = 0; bj < 2; ++bj)
#pragma unroll
                    for (int n = 0; n < 2; ++n) acc[ai][bj][m][n] = *(const f32x4*)(x + ro + bj * 128 + n * 16); }
    }
    __device__ __forceinline__ bool operator()(f32x4 (&acc)[2][2][4][2], const pg8::Unit& u, int wr, int wc, int fr, int fq) const {
        const int rowb = u.pm * 256 + wr * 64 + fr, colb = u.pn * 256 + wc * 32 + 4 * fq;
#pragma unroll
        for (int ai = 0; ai < 2; ++ai)
#pragma unroll
            for (int m = 0; m < 4; ++m) { const size_t ro = (size_t)(rowb + ai * 128 + m * 16) * DM + colb;
#pragma unroll
                for (int bj = 0; bj < 2; ++bj)
#pragma unroll
                    for (int n = 0; n < 2; ++n) *(f32x4*)(out + ro + bj * 128 + n * 16) = acc[ai][bj][m][n]; }
        return true;
    }
};

__device__ __forceinline__ void p2_qkprep(const Params& p, int vcu, int G) {
    const int tid = opaque_tid(), lane = tid & 63, wave = tid >> 6;
    unsigned char* ws = p.ws;
    const bf16_t* QR = (const bf16_t*)(ws + WS_QR); const bf16_t* KR = (const bf16_t*)(ws + WS_KR);
    bf16_t* QN = (bf16_t*)(ws + WS_QN); bf16_t* KN = (bf16_t*)(ws + WS_KN);
    const f32x2* CSB = (const f32x2*)(ws + WS_CSB);
    const float gq0 = p.q_gain[lane], gq1 = p.q_gain[lane + 64], gk0 = p.k_gain[lane], gk1 = p.k_gain[lane + 64];
    const float gA0 = (lane < 64) ? p.q_gain[2 * lane] : 0.f, gA1 = p.q_gain[2 * lane + 1], gB0 = p.k_gain[2 * lane], gB1 = p.k_gain[2 * lane + 1];
    (void)gq0; (void)gq1; (void)gk0; (void)gk1;
    const int NWT = G * NWAVES, w0 = vcu * NWAVES + wave;
#pragma unroll 1
    for (int t = w0; t < T; t += 2 * NWT) {
        const int t1 = (t + NWT < T) ? t + NWT : t;
        unsigned raw[2][10];
#pragma unroll
        for (int u = 0; u < 2; ++u) { const int tt = u ? t1 : t;
#pragma unroll
            for (int r = 0; r < 10; ++r) raw[u][r] = *(const unsigned*)((r < 8 ? QR + (size_t)tt * 1024 + r * 128 : KR + (size_t)tt * 256 + (r - 8) * 128) + 2 * lane); }
        f32x2 cs[2];
        cs[0] = CSB[t * 16 + ((2 * lane) & 15)]; cs[1] = CSB[t1 * 16 + ((2 * lane) & 15)];
        f32x2 cs1[2];
        cs1[0] = CSB[t * 16 + ((2 * lane + 1) & 15)]; cs1[1] = CSB[t1 * 16 + ((2 * lane + 1) & 15)];
        float ss[2][10];
#pragma unroll
        for (int u = 0; u < 2; ++u)
#pragma unroll
            for (int r = 0; r < 10; ++r) { const float x0 = bflo(raw[u][r]), x1 = bfhi(raw[u][r]); ss[u][r] = x0 * x0 + x1 * x1; }
#pragma unroll
        for (int o = 1; o < 64; o <<= 1)
#pragma unroll
            for (int u = 0; u < 2; ++u)
#pragma unroll
                for (int r = 0; r < 10; ++r) ss[u][r] += __shfl_xor(ss[u][r], o);
#pragma unroll
        for (int u = 0; u < 2; ++u) { const int tt = u ? t1 : t; const int b = tt >> 12, sq = tt & (SEQ - 1);
#pragma unroll
            for (int r = 0; r < 10; ++r) {
                const float rs = 1.0f / sqrtf(ss[u][r] * (1.f / 128.f) + EPS);
                float y0 = bflo(raw[u][r]) * rs * (r < 8 ? gA0 : gB0), y1 = bfhi(raw[u][r]) * rs * (r < 8 ? gA1 : gB1);
                const float p0 = __shfl_xor(y0, 8), p1 = __shfl_xor(y1, 8);
                if (lane < 8) { y0 = y0 * cs[u][0] - p0 * cs[u][1]; y1 = y1 * cs1[u][0] - p1 * cs1[u][1]; }
                else if (lane < 16) { y0 = y0 * cs[u][0] + p0 * cs[u][1]; y1 = y1 * cs1[u][0] + p1 * cs1[u][1]; }
                bf16_t* dst = r < 8 ? QN + ((size_t)(b * 8 + r) * SEQ + sq) * 128 : KN + ((size_t)(b * 2 + (r - 8)) * SEQ + sq) * 128;
                *(unsigned*)(dst + 2 * lane) = cvt_pk_bf16(y0, y1);
            } }
    }
}

constexpr int GM_VSTR = 136;
__device__ __forceinline__ void p2_gmlp_unit(const Params& p, LAS unsigned char* lds, int unit) {
    const int tid = opaque_tid(), lane = tid & 63, wave = __builtin_amdgcn_readfirstlane(tid >> 6), r32 = lane & 31, hi = lane >> 5;
    unsigned char* ws = p.ws;
    const int g = unit & 7, ch = unit >> 3, tok0 = ch * 128;
    const bf16_t* AV = (const bf16_t*)(ws + WS_AV); const bf16_t* AU = (const bf16_t*)(ws + WS_AU); const bf16_t* AZ = (const bf16_t*)(ws + WS_AZ);
    bf16_t* XA = (bf16_t*)(ws + WS_XA);
    LAS float* stat = (LAS float*)lds;
    LAS bf16_t* vT = (LAS bf16_t*)(lds + 1024);
    const int tb = wave >> 1, dh = wave & 1, trow = tb * 32 + r32;
    const float* wsp = p.spatial_w + ((size_t)g * 128 + trow) * 128 + 8 * hi;
    f32x4 wf[8][2];
#pragma unroll
    for (int ks = 0; ks < 8; ++ks) { wf[ks][0] = *(const f32x4*)(wsp + 16 * ks); wf[ks][1] = *(const f32x4*)(wsp + 16 * ks + 4); }
    if (tid < 128) { const f32x4* lp = (const f32x4*)((const f32x2*)(ws + WS_LNP) + (size_t)(tok0 + tid) * 16); float s1 = 0.f, s2 = 0.f;
#pragma unroll
        for (int i = 0; i < 8; ++i) { const f32x4 v = lp[i]; s1 += v[0] + v[2]; s2 += v[1] + v[3]; }
        const float mean = s1 * (1.f / 1024.f), var = fmaxf(s2 * (1.f / 1024.f) - mean * mean, 0.f);
        stat[2 * tid] = mean; stat[2 * tid + 1] = 1.0f / sqrtf(var + EPS); }
    __syncthreads();
    {
        u32x4 va[4];
#pragma unroll
        for (int i = 0; i < 4; ++i) { const int it = tid + i * NTHREADS, s_ = it >> 4, d8 = (it & 15) * 8; va[i] = *(const u32x4*)(AV + (size_t)(tok0 + s_) * 1024 + g * 128 + d8); }
        const int d8 = (tid & 15) * 8;
        const f32x4 g0 = *(const f32x4*)(p.gmlp_g + g * 128 + d8), g1 = *(const f32x4*)(p.gmlp_g + g * 128 + d8 + 4), b0 = *(const f32x4*)(p.gmlp_b + g * 128 + d8), b1 = *(const f32x4*)(p.gmlp_b + g * 128 + d8 + 4);
#pragma unroll
        for (int i = 0; i < 4; ++i) { const int it = tid + i * NTHREADS, s_ = it >> 4; const u32x4 a = va[i];
            const float mean = stat[2 * s_], rstd = stat[2 * s_ + 1];
            float f[8] = {bflo(a[0]), bfhi(a[0]), bflo(a[1]), bfhi(a[1]), bflo(a[2]), bfhi(a[2]), bflo(a[3]), bfhi(a[3])};
#pragma unroll
            for (int e = 0; e < 8; ++e) { const float y = (f[e] - mean) * rstd * (e < 4 ? g0[e & 3] : g1[e & 3]) + (e < 4 ? b0[e & 3] : b1[e & 3]); vT[(d8 + e) * GM_VSTR + s_] = f2bf(y); } }
    }
    unsigned short gu[16][2], gz[16][2];
#pragma unroll
    for (int r = 0; r < 16; ++r) { const int tl = tb * 32 + (r & 3) + 8 * (r >> 2) + 4 * hi; const size_t o = (size_t)(tok0 + tl) * 1024 + g * 128 + dh * 64 + r32;
        gu[r][0] = AU[o]; gu[r][1] = AU[o + 32]; gz[r][0] = AZ[o]; gz[r][1] = AZ[o + 32]; }
    __syncthreads();
    f32x16 acc0 = {}, acc1 = {};
#pragma unroll
    for (int ks = 0; ks < 8; ++ks) {
        const int s0 = 16 * ks + 8 * hi;
        f32x4 w0 = wf[ks][0], w1 = wf[ks][1];
#pragma unroll
        for (int e = 0; e < 4; ++e) { if (s0 + e > trow) w0[e] = 0.f; if (s0 + 4 + e > trow) w1[e] = 0.f; }
        const bf16x8 a = pack8(w0, w1);
        const bf16x8 b0 = *(const LAS bf16x8*)(vT + (dh * 64 + r32) * GM_VSTR + s0), b1 = *(const LAS bf16x8*)(vT + (dh * 64 + 32 + r32) * GM_VSTR + s0);
        acc0 = __builtin_amdgcn_mfma_f32_32x32x16_bf16(a, b0, acc0, 0, 0, 0);
        acc1 = __builtin_amdgcn_mfma_f32_32x32x16_bf16(a, b1, acc1, 0, 0, 0);
    }
#pragma unroll
    for (int r = 0; r < 16; ++r) { const int tl = tb * 32 + (r & 3) + 8 * (r >> 2) + 4 * hi; const float bias = p.spatial_b[g * 128 + tl];
        const size_t o = (size_t)(tok0 + tl) * 1024 + g * 128 + dh * 64 + r32;
        XA[o] = f2bf(bf2f(gu[r][0]) * (acc0[r] + bias) * bf2f(gz[r][0]));
        XA[o + 32] = f2bf(bf2f(gu[r][1]) * (acc1[r] + bias) * bf2f(gz[r][1])); }
    __syncthreads();
}

constexpr int MA_KST = 32 * 512, MA_VROW = 72, MA_VST = 256 * MA_VROW;
constexpr int MA_K0 = 2048, MA_V0 = MA_K0 + 2 * MA_KST;
static_assert(MA_V0 + 2 * MA_VST <= MISC_OFF, "mem-attn LDS map");
__device__ __forceinline__ void p2_mem_unit(const Params& p, LAS unsigned char* lds, int unit) {
    const int tid = opaque_tid(), lane = tid & 63, wave = __builtin_amdgcn_readfirstlane(tid >> 6), r32 = lane & 31, hi = lane >> 5;
    unsigned char* ws = p.ws;
    const int qb = unit & 31, h = (unit >> 5) & 3, b = unit >> 7, qg = wave & 3, dhf = wave >> 2;
    const bf16_t* MQ = (const bf16_t*)(ws + WS_MQ); const bf16_t* MZ = (const bf16_t*)(ws + WS_MZ);
    const bf16_t* KM = (const bf16_t*)(ws + WS_KM) + (size_t)(b * 256) * 1024 + h * 256;
    const bf16_t* VT = (const bf16_t*)(ws + WS_VT) + (size_t)(h * 256) * 512 + b * 256;
    bf16_t* XM = (bf16_t*)(ws + WS_XM);
    LAS float* rk = (LAS float*)lds;
    LAS float* gqk = (LAS float*)(lds + 1024);
    u32x4 sk[2], sv[2];
#define MA_LOAD(st) do { _Pragma("unroll") for (int i = 0; i < 2; ++i) { const int q = tid + i * NTHREADS; \
        sk[i] = *(const u32x4*)(KM + (size_t)((st) * 32 + (q >> 5)) * 1024 + (q & 31) * 8); \
        sv[i] = *(const u32x4*)(VT + (size_t)(q >> 2) * 512 + (st) * 32 + (q & 3) * 8); } } while (0)
#define MA_WRITE(bf) do { _Pragma("unroll") for (int i = 0; i < 2; ++i) { const int q = tid + i * NTHREADS; const int key = q >> 5, c = q & 31; \
        *(LAS u32x4*)(lds + MA_K0 + (bf) * MA_KST + key * 512 + ((c ^ (key & 15)) << 4)) = sk[i]; \
        LAS unsigned char* vd = lds + MA_V0 + (bf) * MA_VST + (q >> 2) * MA_VROW + (q & 3) * 16; \
        *(LAS u32x2*)vd = (u32x2){sv[i][0], sv[i][1]}; *(LAS u32x2*)(vd + 8) = (u32x2){sv[i][2], sv[i][3]}; } } while (0)
    if (tid < 256) { const f32x4 pr = *(const f32x4*)((const float*)(ws + WS_RKP) + (size_t)(b * 256 + tid) * 16 + h * 4);
        rk[tid] = 1.0f / sqrtf(((pr[0] + pr[1]) + (pr[2] + pr[3])) * (1.f / 256.f) + EPS); gqk[tid] = p.mq_gain[tid] * p.mk_gain[tid]; }
    __syncthreads();
    const int tq = b * SEQ + qb * 128 + qg * 32 + r32;
    bf16x8 qf[16]; float ssq = 0.f;
#pragma unroll
    for (int ks = 0; ks < 16; ++ks) { const int d0 = 16 * ks + 8 * hi; const u32x4 a = *(const u32x4*)(MQ + (size_t)tq * 1024 + h * 256 + d0);
        f32x4 f0 = {bflo(a[0]), bfhi(a[0]), bflo(a[1]), bfhi(a[1])}, f1 = {bflo(a[2]), bfhi(a[2]), bflo(a[3]), bfhi(a[3])};
        ssq += (f0[0] * f0[0] + f0[1] * f0[1]) + (f0[2] * f0[2] + f0[3] * f0[3]) + (f1[0] * f1[0] + f1[1] * f1[1]) + (f1[2] * f1[2] + f1[3] * f1[3]);
        const f32x4 g0 = *(const LAS f32x4*)(gqk + d0), g1 = *(const LAS f32x4*)(gqk + d0 + 4);
        qf[ks] = pack8(f0 * g0, f1 * g1); }
    ssq += __shfl_xor(ssq, 32);
    const float qs = (1.0f / sqrtf(ssq * (1.f / 256.f) + EPS)) * (0.0625f * LOG2E);
    MA_LOAD(0);
    MA_WRITE(0);
    __syncthreads();
    f32x16 o[4];
#pragma unroll
    for (int db = 0; db < 4; ++db) o[db] = (f32x16){};
    float mrun = -1e30f, l = 0.f;
    const int kx = r32 & 15;
#pragma unroll 1
    for (int st = 0; st < 8; ++st) {
        const int bf = st & 1;
        if (st + 1 < 8) MA_LOAD(st + 1);
        {
            f32x16 a = {};
            const LAS unsigned char* kp = lds + MA_K0 + bf * MA_KST + r32 * 512;
#pragma unroll
            for (int ks = 0; ks < 16; ++ks) { if ((ks & 3) == 0) __builtin_amdgcn_sched_barrier(0); const bf16x8 kf = *(const LAS bf16x8*)(kp + (((2 * ks + hi) ^ kx) << 4)); a = __builtin_amdgcn_mfma_f32_32x32x16_bf16(kf, qf[ks], a, 0, 0, 0); }
            __builtin_amdgcn_sched_barrier(0);
#pragma unroll
            for (int g4 = 0; g4 < 4; ++g4) { const f32x4 rr = *(const LAS f32x4*)(rk + st * 32 + 8 * g4 + 4 * hi);
#pragma unroll
                for (int e = 0; e < 4; ++e) a[4 * g4 + e] *= rr[e] * qs; }
            float bm = a[0];
#pragma unroll
            for (int r = 1; r < 16; ++r) bm = fmaxf(bm, a[r]);
            bm = fmaxf(bm, __shfl_xor(bm, 32));
            if (!__all(bm - mrun <= 8.f)) { const float mn = fmaxf(mrun, bm), al = __builtin_amdgcn_exp2f(mrun - mn); mrun = mn; l *= al;
#pragma unroll
                for (int db = 0; db < 4; ++db) o[db] *= al; }
#pragma unroll
            for (int r = 0; r < 16; ++r) { a[r] = __builtin_amdgcn_exp2f(a[r] - mrun); l += a[r]; }
            u32x4 w0 = {cvt_pk_bf16(a[0], a[1]), cvt_pk_bf16(a[2], a[3]), cvt_pk_bf16(a[4], a[5]), cvt_pk_bf16(a[6], a[7])};
            u32x4 w1 = {cvt_pk_bf16(a[8], a[9]), cvt_pk_bf16(a[10], a[11]), cvt_pk_bf16(a[12], a[13]), cvt_pk_bf16(a[14], a[15])};
            const bf16x8 pf0 = *reinterpret_cast<bf16x8*>(&w0), pf1 = *reinterpret_cast<bf16x8*>(&w1);
            const LAS unsigned char* vp = lds + MA_V0 + bf * MA_VST + (dhf * 128 + r32) * MA_VROW + 8 * hi;
#pragma unroll
            for (int db = 0; db < 4; ++db) {
                const u32x2 lo0 = *(const LAS u32x2*)(vp + db * 32 * MA_VROW), hi0 = *(const LAS u32x2*)(vp + db * 32 * MA_VROW + 16);
                const u32x2 lo1 = *(const LAS u32x2*)(vp + db * 32 * MA_VROW + 32), hi1 = *(const LAS u32x2*)(vp + db * 32 * MA_VROW + 48);
                u32x4 v0 = {lo0[0], lo0[1], hi0[0], hi0[1]}, v1 = {lo1[0], lo1[1], hi1[0], hi1[1]};
                o[db] = __builtin_amdgcn_mfma_f32_32x32x16_bf16(*reinterpret_cast<bf16x8*>(&v0), pf0, o[db], 0, 0, 0);
                o[db] = __builtin_amdgcn_mfma_f32_32x32x16_bf16(*reinterpret_cast<bf16x8*>(&v1), pf1, o[db], 0, 0, 0); }
        }
        if (st + 1 < 8) MA_WRITE(bf ^ 1);
        __syncthreads();
    }
#undef MA_LOAD
#undef MA_WRITE
    l += __shfl_xor(l, 32);
    const float il = __builtin_amdgcn_rcpf(l);
    u32x2 zg[4][4];
#pragma unroll
    for (int db = 0; db < 4; ++db)
#pragma unroll
        for (int g4 = 0; g4 < 4; ++g4) zg[db][g4] = *(const u32x2*)(MZ + (size_t)tq * 1024 + h * 256 + dhf * 128 + db * 32 + 8 * g4 + 4 * hi);
#pragma unroll
    for (int db = 0; db < 4; ++db)
#pragma unroll
        for (int g4 = 0; g4 < 4; ++g4) { const size_t oo = (size_t)tq * 1024 + h * 256 + dhf * 128 + db * 32 + 8 * g4 + 4 * hi;
            const u32x2 z = zg[db][g4];
            u32x2 w; w[0] = cvt_pk_bf16(o[db][4 * g4] * il * bflo(z[0]), o[db][4 * g4 + 1] * il * bfhi(z[0])); w[1] = cvt_pk_bf16(o[db][4 * g4 + 2] * il * bflo(z[1]), o[db][4 * g4 + 3] * il * bfhi(z[1]));
            *(u32x2*)(XM + oo) = w; }
}


__device__ __forceinline__ unsigned wave_sum_dpp(unsigned c) {
    c += (unsigned)__builtin_amdgcn_update_dpp(0, (int)c, 0xB1, 0xF, 0xF, false);
    c += (unsigned)__builtin_amdgcn_update_dpp(0, (int)c, 0x4E, 0xF, 0xF, false);
    c += (unsigned)__builtin_amdgcn_update_dpp(0, (int)c, 0x141, 0xF, 0xF, false);
    c += (unsigned)__builtin_amdgcn_update_dpp(0, (int)c, 0x140, 0xF, 0xF, false);
    { auto r = __builtin_amdgcn_permlane16_swap(c, c, false, false); c = r[0] + r[1]; }
    { auto r = __builtin_amdgcn_permlane32_swap(c, c, false, false); c = r[0] + r[1]; }
    return c;
}
#define CNT4(c0, c1, c2, c3, a, b, c_, d, t) do { unsigned long long m0_, m1_, m2_, m3_; asm volatile( \
    "v_cmp_ge_u32_e64 %[m0], %[va], %[vt]\n\tv_cmp_ge_u32_e64 %[m1], %[vb], %[vt]\n\tv_cmp_ge_u32_e64 %[m2], %[vc], %[vt]\n\tv_cmp_ge_u32_e64 %[m3], %[vd], %[vt]\n\t" \
    "v_addc_co_u32_e64 %[k0], %[m0], %[k0], 0, %[m0]\n\tv_addc_co_u32_e64 %[k1], %[m1], %[k1], 0, %[m1]\n\tv_addc_co_u32_e64 %[k2], %[m2], %[k2], 0, %[m2]\n\tv_addc_co_u32_e64 %[k3], %[m3], %[k3], 0, %[m3]" \
    : [k0] "+v"(c0), [k1] "+v"(c1), [k2] "+v"(c2), [k3] "+v"(c3), [m0] "=&s"(m0_), [m1] "=&s"(m1_), [m2] "=&s"(m2_), [m3] "=&s"(m3_) \
    : [va] "v"(a), [vb] "v"(b), [vc] "v"(c_), [vd] "v"(d), [vt] "v"(t)); } while (0)

__device__ __forceinline__ unsigned sortable(float f) { const unsigned u = __float_as_uint(f); return u ^ ((unsigned)((int)u >> 31) | 0x80000000u); }
#ifndef SPAN_A
#define SPAN_A -1
#endif
#define ACC_T(k, t0v) do { if (SPAN_A >= 100 && blockIdx.x == 0 && threadIdx.x == 0) { volatile LAS unsigned long long* st_ = (volatile LAS unsigned long long*)(lds + MISC_OFF + 16); const unsigned long long n_ = __builtin_amdgcn_s_memrealtime(); st_[16 + (k)] += n_ - (t0v); (t0v) = n_; } } while (0)
__device__ __forceinline__ float relu1(float x) { const int xi = __float_as_int(x); return __int_as_float(xi > 0 ? xi : 0); }
typedef short s16x2 __attribute__((ext_vector_type(2)));
__device__ __forceinline__ unsigned pkrelu(float x, float y) { const s16x2 v = __builtin_bit_cast(s16x2, cvt_pk_bf16(x, y)); const s16x2 z = {0, 0}; return __builtin_bit_cast(unsigned, __builtin_elementwise_max(v, z)); }
__device__ __forceinline__ void p2_idx_all(const Params& p, LAS unsigned char* lds, int bx, int G) {
    unsigned long long tacc = (SPAN_A >= 100) ? __builtin_amdgcn_s_memrealtime() : 0ull;
    const int tid = opaque_tid(), lane = tid & 63, wave = __builtin_amdgcn_readfirstlane(tid >> 6), r32 = lane & 31, hi = lane >> 5;
    unsigned char* ws = p.ws;
    const bf16_t* IQ = (const bf16_t*)(ws + WS_IQ); const float* IW = (const float*)(ws + WS_IW);
    LAS unsigned* sc = (LAS unsigned*)lds;
    LAS float* iwl0 = (LAS float*)(lds + 131072);
    int nun = 0; for (int pr = bx; pr < 512; pr += G) nun += 2;
    if (nun == 0) return;
#define IDX_UNIT(k, bb, ub) do { const int pr_ = bx + ((k) >> 1) * G, ix_ = pr_ & 255; bb = pr_ >> 8; ub = ((k) & 1) ? ix_ : 511 - ix_; } while (0)
#define AF_LOAD(tt0) do { _Pragma("unroll") for (int at = 0; at < 4; ++at) _Pragma("unroll") for (int ks = 0; ks < 4; ++ks) \
        af[at][ks] = *(const bf16x8*)(IQ + (size_t)((tt0) + 2 * at + (r32 >> 4)) * 1024 + (r32 & 15) * 64 + 16 * ks + 8 * hi); } while (0)
    bf16x8 af[4][4];
    int b, ublk; IDX_UNIT(0, b, ublk);
    { const int t0 = b * SEQ + ublk * 8; AF_LOAD(t0); if (tid < 128) iwl0[tid] = IW[(size_t)t0 * 16 + tid]; }
    __syncthreads();
#pragma unroll 1
    for (int k = 0; k < nun; ++k) {
        const int s0 = ublk * 8, t0 = b * SEQ + s0;
        const bf16_t* IK = (const bf16_t*)(ws + WS_IK) + (size_t)(b * SEQ) * 64;
        LAS float* iwl = iwl0 + (k & 1) * 128;
        int bn = b, un = ublk; if (k + 1 < nun) IDX_UNIT(k + 1, bn, un);
        const int t0n = bn * SEQ + un * 8;
        float iwn = 0.f; if (tid < 128) iwn = IW[(size_t)t0n * 16 + tid];
        ACC_T(0, tacc);
        bf16x8 aw[4][2];
#pragma unroll
        for (int at = 0; at < 4; ++at)
#pragma unroll
            for (int s_ = 0; s_ < 2; ++s_) { const int q = 2 * at + s_; const f32x4 wl = *(const LAS f32x4*)(iwl + q * 16 + 4 * hi), wh = *(const LAS f32x4*)(iwl + q * 16 + 8 + 4 * hi);
                const bf16x8 f = pack8(wl, wh); const bf16x8 z = {0, 0, 0, 0, 0, 0, 0, 0}; aw[at][s_] = (r32 == q) ? f : z; }
        const int ntiles = (s0 + 8 + 31) >> 5;
        bf16x8 kb0[4], kb1[4], kb2[4];
#define IK_LOAD(dst, jj) do { const int jc_ = (jj) < ntiles ? (jj) : 0; _Pragma("unroll") for (int ks = 0; ks < 4; ++ks) dst[ks] = *(const bf16x8*)(IK + (size_t)(32 * jc_ + r32) * 64 + 16 * ks + 8 * hi); } while (0)
#define SCORE_TILE(KB, jj) do { const int k0 = 32 * (jj); f32x16 ov = {}; \
        _Pragma("unroll") for (int at = 0; at < 4; ++at) { f32x16 a = {}; \
            _Pragma("unroll") for (int ks = 0; ks < 4; ++ks) a = __builtin_amdgcn_mfma_f32_32x32x16_bf16(af[at][ks], KB[ks], a, 0, 0, 0); \
            u32x4 x0 = {pkrelu(a[0], a[1]), pkrelu(a[2], a[3]), pkrelu(a[4], a[5]), pkrelu(a[6], a[7])}; \
            u32x4 x1 = {pkrelu(a[8], a[9]), pkrelu(a[10], a[11]), pkrelu(a[12], a[13]), pkrelu(a[14], a[15])}; \
            ov = __builtin_amdgcn_mfma_f32_32x32x16_bf16(aw[at][0], *reinterpret_cast<bf16x8*>(&x0), ov, 0, 0, 0); \
            ov = __builtin_amdgcn_mfma_f32_32x32x16_bf16(aw[at][1], *reinterpret_cast<bf16x8*>(&x1), ov, 0, 0, 0); } \
        _Pragma("unroll") for (int e = 0; e < 4; ++e) { const int qi = 4 * hi + e, key = k0 + r32; \
            sc[qi * 4096 + key] = (key <= s0 + qi) ? sortable(ov[e]) : 0u; } } while (0)
#ifndef IDX_SCORE_REP
#define IDX_SCORE_REP 1
#endif
#pragma unroll 1
        for (int rep_ = 0; rep_ < IDX_SCORE_REP; ++rep_) {
        IK_LOAD(kb0, wave); IK_LOAD(kb1, wave + NWAVES);
#pragma unroll 1
        for (int j = wave; j < ntiles; j += 3 * NWAVES) {
            IK_LOAD(kb2, j + 2 * NWAVES); SCORE_TILE(kb0, j);
            if (j + NWAVES >= ntiles) break;
            IK_LOAD(kb0, j + 3 * NWAVES); SCORE_TILE(kb1, j + NWAVES);
            if (j + 2 * NWAVES >= ntiles) break;
            IK_LOAD(kb1, j + 4 * NWAVES); SCORE_TILE(kb2, j + 2 * NWAVES);
        }
        }
#undef IK_LOAD
#undef SCORE_TILE
        __syncthreads();
        ACC_T(1, tacc);
        const int s = s0 + wave, n = s + 1;
        unsigned kv[64];
#pragma unroll
        for (int i = 0; i < 64; ++i) { const int key = 64 * i + lane; kv[i] = (key <= s) ? sc[wave * 4096 + key] : 0u; }
        if (tid < 128) iwl0[((k + 1) & 1) * 128 + tid] = iwn;
        AF_LOAD(t0n);
        LDS_WAIT();
        __syncthreads();
        unsigned Tt = 1u; bool exact = true;
        if (n > 256) {
            Tt = 0u; exact = false;
            for (int bit = 31; bit >= 0; --bit) {
                const unsigned cand = Tt | (1u << bit); unsigned c0 = 0, c1 = 0, c2 = 0, c3 = 0;
#pragma unroll
                for (int i = 0; i < 64; i += 4) CNT4(c0, c1, c2, c3, kv[i], kv[i + 1], kv[i + 2], kv[i + 3], cand);
                const unsigned c = wave_sum_dpp((c0 + c1) + (c2 + c3));
                if (c >= 256u) { Tt = cand; if (c == 256u) { exact = true; break; } }
            }
        }
        ACC_T(2, tacc);
        LAS unsigned long long* lm = (LAS unsigned long long*)(lds + 131072 + 1024) + wave * 64;
        if (exact) {
#pragma unroll
            for (int i = 0; i < 64; ++i) { const unsigned long long bal = __ballot(kv[i] >= Tt); if (lane == 0) lm[i] = bal; }
        } else {
            unsigned cg_ = 0;
#pragma unroll
            for (int i = 0; i < 64; ++i) cg_ += (kv[i] > Tt) ? 1u : 0u;
            cg_ = wave_sum_u(cg_);
            const unsigned need = 256u - cg_; unsigned seen = 0u;
#pragma unroll
            for (int i = 0; i < 64; ++i) {
                const unsigned kk = kv[i];
                const unsigned long long eq = __ballot(kk == Tt), gt = __ballot(kk > Tt);
                const unsigned below = (unsigned)__popcll(eq & ((1ull << lane) - 1ull));
                const bool take = (kk == Tt) && (seen + below < need);
                const unsigned long long bal = gt | __ballot(take);
                seen += (unsigned)__popcll(eq);
                if (lane == 0) lm[i] = bal;
            }
        }
        LDS_WAIT(); asm volatile("" ::: "memory");
        const unsigned long long mine = lm[lane];
        ((unsigned long long*)(ws + WS_MASK))[(size_t)(t0 + wave) * 64 + lane] = mine;
        ACC_T(3, tacc);
        b = bn; ublk = un;
    }
#undef IDX_UNIT
#undef AF_LOAD
    __syncthreads();
}

namespace att {
constexpr int D = 128, NW = 8, QBLK = 32, KVBLK = 64, QB = 256;
constexpr int SHM_V = KVBLK * D * 2, SHM_K = KVBLK * D * 2;
constexpr int EPI_T0 = 2 * SHM_V + 2 * SHM_K + NW * 128 * 4 + 16, EPI_TW = 32 * 272;
constexpr int LDS_NEED = EPI_T0 + NW * EPI_TW;
static_assert(LDS_NEED <= MISC_OFF, "attention LDS map");
constexpr float SCALE = 0.08838834764831845f, THR = 8.f;
#define KSWZ(row, colB) ((row) * 256 + ((colB) ^ (((row) & 7) << 4)))
#define SBAR() __builtin_amdgcn_sched_barrier(0)
__device__ __forceinline__ int v_st(int k, int c) { const int kk = (k & ~0xC) | ((k & 4) << 1) | ((k & 8) >> 1); return ((kk >> 3) * 4 + (c >> 5)) * 512 + ((kk & 7) * 32 + (c & 31)) * 2; }
__device__ __forceinline__ int v_rd_base(int lane) { return ((lane & 3) << 3) | (((lane >> 2) & 3) << 6) | (((lane >> 4) & 1) << 5) | (((lane >> 5) & 1) << 8); }
constexpr int v_rd_off(int d0, int ks, int half) { return d0 * 512 + ks * 4096 + half * 2048; }
__device__ __forceinline__ int crow(int r, int hi) { return (r & 3) + 8 * (r >> 2) + 4 * hi; }
__device__ __forceinline__ bf16x8 load8(const bf16_t* p) { return *reinterpret_cast<const bf16x8*>(p); }
__device__ __forceinline__ void mask_bits(f32x16& p0, f32x16& p1, unsigned w0, unsigned w1, int hi) {
    w0 >>= 4 * hi; w1 >>= 4 * hi;
#pragma unroll
    for (int r = 0; r < 16; ++r) { const int c = (r & 3) + 8 * (r >> 2);
        const unsigned t0 = (unsigned)(((int)(w0 << (31 - c))) >> 31), t1 = (unsigned)(((int)(w1 << (31 - c))) >> 31);
        p0[r] = __uint_as_float((__float_as_uint(p0[r]) & t0) | (0xff800000u & ~t0));
        p1[r] = __uint_as_float((__float_as_uint(p1[r]) & t1) | (0xff800000u & ~t1)); }
}
__device__ __forceinline__ void partialSM(f32x16& p0, f32x16& p1, float& m_reg, float& mn, float& alpha) {
    float pmax = p0[0];
#pragma unroll
    for (int r = 1; r < 16; ++r) pmax = fmaxf(pmax, p0[r]);
#pragma unroll
    for (int r = 0; r < 16; ++r) pmax = fmaxf(pmax, p1[r]);
    { auto rr = __builtin_amdgcn_permlane32_swap(__float_as_uint(pmax), __float_as_uint(pmax), false, false);
      pmax = fmaxf(__uint_as_float(rr[0]), __uint_as_float(rr[1])); }
    constexpr float C2 = 1.4426950408889634f * SCALE;
    if (__builtin_expect(__all((pmax - m_reg) * SCALE <= THR), 1)) { mn = m_reg; alpha = 1.f; }
    else { mn = fmaxf(m_reg, pmax); alpha = __builtin_amdgcn_exp2f((m_reg - mn) * C2); m_reg = mn; }
    const float mnL = -mn * C2;
#pragma unroll
    for (int r = 0; r < 16; ++r) p0[r] = fmaf(p0[r], C2, mnL);
#pragma unroll
    for (int r = 0; r < 16; ++r) p1[r] = fmaf(p1[r], C2, mnL);
#pragma unroll
    for (int r = 0; r < 16; ++r) p0[r] = __builtin_amdgcn_exp2f(p0[r]);
}
__device__ __forceinline__ void finishSM(f32x16& p0, f32x16& p1, float alpha, float& l_reg, bf16x8& pa0, bf16x8& pa1, bf16x8& pa2, bf16x8& pa3) {
#pragma unroll
    for (int r = 0; r < 16; ++r) p1[r] = __builtin_amdgcn_exp2f(p1[r]);
    float ps = 0;
#pragma unroll
    for (int r = 0; r < 16; ++r) ps += p0[r];
#pragma unroll
    for (int r = 0; r < 16; ++r) ps += p1[r];
    { auto rr = __builtin_amdgcn_permlane32_swap(__float_as_uint(ps), __float_as_uint(ps), false, false);
      ps = __uint_as_float(rr[0]) + __uint_as_float(rr[1]); }
    l_reg = l_reg * alpha + ps;
#define PK4(P, B_, OUT) do { unsigned a0 = cvt_pk_bf16(P[B_+0], P[B_+1]), a1 = cvt_pk_bf16(P[B_+2], P[B_+3]);                          \
        unsigned b0 = cvt_pk_bf16(P[B_+4], P[B_+5]), b1 = cvt_pk_bf16(P[B_+6], P[B_+7]);                                             \
        auto r0 = __builtin_amdgcn_permlane32_swap(a0, b0, false, false); auto r1 = __builtin_amdgcn_permlane32_swap(a1, b1, false, false); \
        u32x4 w = {r0[0], r1[0], r0[1], r1[1]}; OUT = *reinterpret_cast<bf16x8*>(&w); } while (0)
    PK4(p0, 0, pa0); PK4(p0, 8, pa1); PK4(p1, 0, pa2); PK4(p1, 8, pa3);
#undef PK4
}
template <int KB>
__device__ __forceinline__ void qkt(f32x16& p0, f32x16& p1, const char* K_lds, int r32, int hi, const bf16x8* qr) {
    p0 = f32x16{}; p1 = f32x16{};
    const char* kb[4];
#pragma unroll
    for (int dd = 0; dd < 4; ++dd) kb[dd] = K_lds + KB * SHM_K + KSWZ(r32, (dd * 16 + hi * 8) * 2);
#pragma unroll
    for (int d0 = 0; d0 < 8; ++d0) { const char* a = kb[d0 & 3] + (d0 >> 2) * 128;
        bf16x8 b0 = *reinterpret_cast<const bf16x8*>(a);
        bf16x8 b1 = *reinterpret_cast<const bf16x8*>(a + 32 * 256);
        p0 = __builtin_amdgcn_mfma_f32_32x32x16_bf16(b0, qr[d0], p0, 0, 0, 0);
        p1 = __builtin_amdgcn_mfma_f32_32x32x16_bf16(b1, qr[d0], p1, 0, 0, 0); }
}
template <int VB>
__device__ __forceinline__ void pv_tile(f32x16* o, int vb0, bf16x8 pa0, bf16x8 pa1, bf16x8 pa2, bf16x8 pa3) {
#define TRRD(dst, off) asm volatile("ds_read_b64_tr_b16 %0, %1 offset:%2" : "=&v"(dst) : "v"(vb0), "i"(off) : "memory")
#define PV_D0(d0) do { s16x4 l0, l1, l2, l3, h0, h1, h2, h3; constexpr int b_ = VB * SHM_V + v_rd_off(d0, 0, 0); \
        TRRD(l0, b_); TRRD(h0, b_ + 2048); TRRD(l1, b_ + 4096); TRRD(h1, b_ + 6144); TRRD(l2, b_ + 8192); TRRD(h2, b_ + 10240); TRRD(l3, b_ + 12288); TRRD(h3, b_ + 14336); \
        asm volatile("s_waitcnt lgkmcnt(0)" ::: "memory"); SBAR();   \
        o[d0] = __builtin_amdgcn_mfma_f32_32x32x16_bf16(pa0, (bf16x8){l0[0], l0[1], l0[2], l0[3], h0[0], h0[1], h0[2], h0[3]}, o[d0], 0, 0, 0);   \
        o[d0] = __builtin_amdgcn_mfma_f32_32x32x16_bf16(pa1, (bf16x8){l1[0], l1[1], l1[2], l1[3], h1[0], h1[1], h1[2], h1[3]}, o[d0], 0, 0, 0);   \
        o[d0] = __builtin_amdgcn_mfma_f32_32x32x16_bf16(pa2, (bf16x8){l2[0], l2[1], l2[2], l2[3], h2[0], h2[1], h2[2], h2[3]}, o[d0], 0, 0, 0);   \
        o[d0] = __builtin_amdgcn_mfma_f32_32x32x16_bf16(pa3, (bf16x8){l3[0], l3[1], l3[2], l3[3], h3[0], h3[1], h3[2], h3[3]}, o[d0], 0, 0, 0); } while (0)
    PV_D0(0); PV_D0(1); PV_D0(2); PV_D0(3);
#undef PV_D0
#undef TRRD
}
struct BlockRef { const bf16_t* Q; const bf16_t* K; const bf16_t* V; const unsigned* M; bf16_t* O; const bf16_t* Z;
                  bf16_t* OPme; const bf16_t* OPot; f32x2* MLme; const f32x2* MLot; unsigned* cnt; int t_lo, NT; };
struct Seam { bf16x8 qr[8]; bf16x8 st_v0, st_v1, st_k0, st_k1; };
#define ROW(p, k0, rr) ((p) + (size_t)((k0) + (rr)) * D + sc)
#define VMW() asm volatile("s_waitcnt vmcnt(0)" ::: "memory")
#define VMWN(n) asm volatile("s_waitcnt vmcnt(%0)" :: "i"(n) : "memory")
#define SLOAD_H(Kp, Vp, k0) do { S.st_v0 = load8(ROW(Vp, k0, sr)); S.st_v1 = load8(ROW(Vp, k0, 32 + sr));              \
                         S.st_k0 = load8(ROW(Kp, k0, sr)); S.st_k1 = load8(ROW(Kp, k0, 32 + sr)); } while (0)
#define SWRITE_HK(bf) do { *(bf16x8*)(K_lds + (bf) * SHM_K + kws) = S.st_k0; *(bf16x8*)(K_lds + (bf) * SHM_K + kws + 32 * 256) = S.st_k1; } while (0)
#define SWRITE_HV(bf) do { *(bf16x8*)(V_lds + (bf) * SHM_V + vst0) = S.st_v0; *(bf16x8*)(V_lds + (bf) * SHM_V + vst1) = S.st_v1; } while (0)
#define SWRITE_H(bf) do { SWRITE_HV(bf); SWRITE_HK(bf); } while (0)
__device__ __forceinline__ void attn_prime(const BlockRef& cur, char* lds, Seam& S) {
    const int tid = opaque_tid(), wid = __builtin_amdgcn_readfirstlane(tid >> 6), lane = tid & 63, r32 = lane & 31, hi = lane >> 5;
    const int sr = tid >> 4, sc = (tid & 15) * 8, kws = KSWZ(sr, sc * 2); char* K_lds = lds + 2 * SHM_V;
#pragma unroll
    for (int d0 = 0; d0 < 8; ++d0) S.qr[d0] = load8(cur.Q + (size_t)(wid * QBLK + r32) * D + d0 * 16 + hi * 8);
    SLOAD_H(cur.K, cur.V, cur.t_lo * KVBLK); VMW(); SWRITE_HK(0);
    __syncthreads();
}
__device__ __forceinline__ void attn_block(const BlockRef& cur, const BlockRef& nxt, char* lds, Seam& S) {
    const int tid = opaque_tid(), wid = __builtin_amdgcn_readfirstlane(tid >> 6), lane = tid & 63, r32 = lane & 31, hi = lane >> 5;
    const int NT = cur.NT, t_lo = cur.t_lo;
    char* V_lds = lds; char* K_lds = lds + 2 * SHM_V;
    float* wsl = (float*)(lds + 2 * SHM_V + 2 * SHM_K) + wid * 128; float* li_l = wsl, * al_l = wsl + 32, * fb_l = wsl + 64;
    volatile unsigned* flag = (volatile unsigned*)(lds + 2 * SHM_V + 2 * SHM_K + NW * 128 * 4);
    float m_reg = -1e30f, l_reg = 0; f32x16 o[4] = {};
    const int sr = tid >> 4, sc = (tid & 15) * 8, vst0 = v_st(sr, sc), vst1 = v_st(32 + sr, sc), kws = KSWZ(sr, sc * 2);
    const int vb0 = (int)(uintptr_t)V_lds + v_rd_base(lane);
    const bf16_t* Kh = cur.K; const bf16_t* Vh = cur.V;
    const unsigned* mrow = cur.M + (size_t)(wid * QBLK + r32) * 128;
#define RESC(a) do { if (__any((a) < 1.f)) { if (hi == 0) al_l[r32] = (a); asm volatile("s_waitcnt lgkmcnt(0)" ::: "memory");              \
                     for (int d_ = 0; d_ < 4; ++d_) for (int r = 0; r < 16; ++r) o[d_][r] *= al_l[crow(r, hi)]; } } while (0)
#define KBASE(t) ((t_lo + (t)) * KVBLK)
#define MLOAD(t) (*(const u32x2*)(mrow + 2 * (t_lo + (t))))
#define SEAM_K0() do { VMWN(8); SWRITE_HK(0); SBAR(); } while (0)
    f32x16 pA0, pA1, pB0, pB1; float mnA, mnB, alA, alB; bf16x8 pa0, pa1, pa2, pa3;
    u32x2 mwA, mwB;
    SWRITE_HV(0); SBAR();
    mwA = MLOAD(0); mwB = MLOAD(1);
    SLOAD_H(Kh, Vh, KBASE(1));
    SBAR(); qkt<0>(pA0, pA1, K_lds, r32, hi, S.qr);
    mask_bits(pA0, pA1, mwA[0], mwA[1], hi); partialSM(pA0, pA1, m_reg, mnA, alA);
    VMW(); SWRITE_H(1);
    __syncthreads();
#define HALF_STEP(PX0, PX1, mnX, alX, mwX, mwY, PY0, PY1, alY, t, KB, VB, SB) do {                                              \
        SBAR(); mwY = MLOAD(((t) + 1 < NT) ? (t) + 1 : (t)); qkt<KB>(PX0, PX1, K_lds, r32, hi, S.qr);     \
        finishSM(PY0, PY1, alY, l_reg, pa0, pa1, pa2, pa3); SBAR();                                                           \
        if ((t) + 1 < NT) { SLOAD_H(Kh, Vh, KBASE((t) + 1)); SBAR(); }                                                        \
        pv_tile<VB>(o, vb0, pa0, pa1, pa2, pa3); mask_bits(PX0, PX1, mwX[0], mwX[1], hi); partialSM(PX0, PX1, m_reg, mnX, alX); \
        __syncthreads();                                                                                                      \
        if ((t) + 1 < NT) { VMW(); SWRITE_H(SB); }                                                                            \
        RESC(alX); __syncthreads(); } while (0)
    for (int t = 1; t + 1 < NT; t += 2) {
        HALF_STEP(pB0, pB1, mnB, alB, mwB, mwA, pA0, pA1, alA, t, 1, 0, 0);
        HALF_STEP(pA0, pA1, mnA, alA, mwA, mwB, pB0, pB1, alB, t + 1, 0, 1, 1);
    }
    SBAR(); qkt<1>(pB0, pB1, K_lds, r32, hi, S.qr); SBAR();
    SLOAD_H(nxt.K, nxt.V, nxt.t_lo * KVBLK); SBAR();
#pragma unroll
    for (int d0 = 0; d0 < 8; ++d0) S.qr[d0] = load8(nxt.Q + (size_t)(wid * QBLK + r32) * D + d0 * 16 + hi * 8);
    SBAR();
    finishSM(pA0, pA1, alA, l_reg, pa0, pa1, pa2, pa3); SBAR();
    pv_tile<0>(o, vb0, pa0, pa1, pa2, pa3);
    mask_bits(pB0, pB1, mwB[0], mwB[1], hi); partialSM(pB0, pB1, m_reg, mnB, alB); __syncthreads(); RESC(alB);
    finishSM(pB0, pB1, alB, l_reg, pa0, pa1, pa2, pa3); SBAR(); pv_tile<1>(o, vb0, pa0, pa1, pa2, pa3);
    SBAR(); SEAM_K0();
    char* Tl = lds + EPI_T0 + wid * EPI_TW;
    if (hi == 0) { li_l[r32] = l_reg; cur.MLme[wid * QBLK + r32] = (f32x2){m_reg, l_reg}; }
    asm volatile("s_waitcnt lgkmcnt(0)" ::: "memory");
#pragma unroll
    for (int r = 0; r < 16; ++r) { const float lr = li_l[crow(r, hi)]; const float rl = lr > 0.f ? __builtin_amdgcn_rcpf(lr) : 0.f;
#pragma unroll
        for (int d0 = 0; d0 < 4; ++d0) *(bf16_t*)(Tl + crow(r, hi) * 272 + (d0 * 32 + r32) * 2) = f2bf(o[d0][r] * rl); }
    asm volatile("s_waitcnt lgkmcnt(0)" ::: "memory");
    const int crw = lane >> 4, ccol = (lane & 15) * 8;
#pragma unroll
    for (int i = 0; i < 8; ++i) { const int row = crw + 4 * i; *(u32x4*)(cur.OPme + (size_t)(wid * QBLK + row) * D + ccol) = *(const u32x4*)(Tl + row * 272 + ccol * 2); }
    VMW(); __syncthreads();
    if (tid == 0) { __builtin_amdgcn_fence(__ATOMIC_RELEASE, "agent"); asm volatile("s_waitcnt vmcnt(0)" ::: "memory");
        *flag = __hip_atomic_fetch_add(cur.cnt, 1u, __ATOMIC_RELAXED, __HIP_MEMORY_SCOPE_AGENT); }
    __syncthreads();
    if (*flag == 1u) {
        if (tid == 0) { __builtin_amdgcn_fence(__ATOMIC_ACQUIRE, "agent"); asm volatile("s_waitcnt vmcnt(0)" ::: "memory"); }
        __syncthreads();
        u32x4 ot[8], zz[8];
#pragma unroll
        for (int i = 0; i < 8; ++i) { const int row = wid * QBLK + crw + 4 * i; ot[i] = *(const u32x4*)(cur.OPot + (size_t)row * D + ccol); zz[i] = *(const u32x4*)(cur.Z + (size_t)row * 1024 + ccol); }
        constexpr float C2 = 1.4426950408889634f * SCALE;
        if (hi == 0) { const f32x2 om = cur.MLot[wid * QBLK + r32]; const float M = fmaxf(m_reg, om[0]);
            const float wa = __builtin_amdgcn_exp2f((m_reg - M) * C2) * l_reg, wb = __builtin_amdgcn_exp2f((om[0] - M) * C2) * om[1];
            const float inv = __builtin_amdgcn_rcpf(wa + wb); li_l[r32] = wa * inv; fb_l[r32] = wb * inv; }
        asm volatile("s_waitcnt lgkmcnt(0)" ::: "memory");
#pragma unroll
        for (int i = 0; i < 8; ++i) { const int row = crw + 4 * i; const float fa = li_l[row], fb = fb_l[row];
            const u32x4 ow = *(const u32x4*)(Tl + row * 272 + ccol * 2); u32x4 w;
#pragma unroll
            for (int e = 0; e < 4; ++e) w[e] = cvt_pk_bf16((bflo(ow[e]) * fa + bflo(ot[i][e]) * fb) * bflo(zz[i][e]), (bfhi(ow[e]) * fa + bfhi(ot[i][e]) * fb) * bfhi(zz[i][e]));
            *(u32x4*)(cur.O + (size_t)(wid * QBLK + row) * 1024 + ccol) = w; }
    }
    __syncthreads();
#undef RESC
#undef KBASE
#undef MLOAD
#undef SEAM_K0
#undef HALF_STEP
}
#undef ROW
#undef VMW
#undef VMWN
#undef SLOAD_H
#undef SWRITE_HK
#undef SWRITE_HV
#undef SWRITE_H
__device__ __forceinline__ BlockRef make_ref(unsigned char* ws, unsigned* ctl, int item, int pass) {
    const int hf = item & 1, xp = (item >> 1) & 7, bh = item >> 4, qb = pass ? 15 - xp : xp, b = bh >> 3, h = bh & 7, kvh = b * 2 + (h >> 2);
    BlockRef r;
    r.Q = (const bf16_t*)(ws + WS_QN) + ((size_t)bh * SEQ + qb * QB) * D;
    r.K = (const bf16_t*)(ws + WS_KN) + (size_t)kvh * SEQ * D; r.V = (const bf16_t*)(ws + WS_VV) + (size_t)kvh * SEQ * D;
    r.M = (const unsigned*)(ws + WS_MASK) + (size_t)(b * SEQ + qb * QB) * 128;
    r.O = (bf16_t*)(ws + WS_XB) + (size_t)(b * SEQ + qb * QB) * 1024 + h * 128;
    r.Z = (const bf16_t*)(ws + WS_BZ) + (size_t)(b * SEQ + qb * QB) * 1024 + h * 128;
    const size_t prow = (size_t)bh * SEQ + qb * QB, hstr = (size_t)16 * SEQ;
    r.OPme = (bf16_t*)(ws + WS_OPART) + ((size_t)hf * hstr + prow) * D; r.OPot = (const bf16_t*)(ws + WS_OPART) + ((size_t)(hf ^ 1) * hstr + prow) * D;
    r.MLme = (f32x2*)(ws + WS_ML) + (size_t)hf * hstr + prow; r.MLot = (const f32x2*)(ws + WS_ML) + (size_t)(hf ^ 1) * hstr + prow;
    r.cnt = ctl + bh * 16 + qb;
    r.NT = 2 * (qb + 1); r.t_lo = hf * r.NT; return r;
}
}


#define XB_TMO      128
#define XB_XCNT(j)  (256  + 64 * (j))
#define XB_XSUB(j)  (1280 + 64 * (j))
#define XB_XGEN(j)  (2304 + 64 * (j))
#define XB_TOP      3328
#define XB_TOPGEN   3392
#define XCD_BAR_WORDS 3456
#define XB_SPIN_CAP (1u << 22)
__device__ __forceinline__ unsigned xb_ld(unsigned* p)              { return __hip_atomic_load(p, __ATOMIC_RELAXED, __HIP_MEMORY_SCOPE_AGENT); }
__device__ __forceinline__ unsigned xb_add(unsigned* p, unsigned v) { return __hip_atomic_fetch_add(p, v, __ATOMIC_RELAXED, __HIP_MEMORY_SCOPE_AGENT); }
__device__ __forceinline__ unsigned xb_xcc_id() { return (unsigned)__builtin_amdgcn_s_getreg((3 << 11) | 20) & 0xFu; }
#define XB_SPIN(cond, bar) do { unsigned _sp = 0; while (cond) { __builtin_amdgcn_s_sleep(1); \
    if ((++_sp & 255u) == 0u) { if (xb_ld(&(bar)[XB_TMO])) break; if (_sp > XB_SPIN_CAP) { atomicAdd(&(bar)[XB_TMO], 1u); break; } } } } while (0)
struct XcdBarrier { unsigned* bar; unsigned x; volatile LAS unsigned* st; };
__device__ __forceinline__ XcdBarrier xcd_barrier_post(unsigned* bar, volatile LAS unsigned* st) {
    XcdBarrier b; b.bar = bar; b.x = xb_xcc_id(); b.st = st;
    if (threadIdx.x == 0) (void)xb_add(&bar[XB_XCNT(b.x)], 1u);
    return b;
}
__device__ __forceinline__ void xcd_barrier_complete(unsigned* bar, unsigned x, unsigned& nloc, unsigned& nx) {
    const unsigned G = gridDim.x * gridDim.y * gridDim.z;
    unsigned sum, cnt, mine, sp = 0u;
    for (;;) {
        sum = 0u; cnt = 0u; mine = 0u;
#pragma unroll
        for (unsigned j = 0; j < 16; ++j) { const unsigned c = xb_ld(&bar[XB_XCNT(j)]); sum += c; cnt += (c > 0u) ? 1u : 0u; mine = (j == x) ? c : mine; }
        if (sum == G) break;
        __builtin_amdgcn_s_sleep(1);
        if ((++sp & 255u) == 0u) { if (xb_ld(&bar[XB_TMO])) break; if (sp > XB_SPIN_CAP) { atomicAdd(&bar[XB_TMO], 1u); break; } }
    }
    nloc = mine > 0u ? mine : 1u; nx = cnt > 0u ? cnt : 1u;
}
__device__ __forceinline__ void xcd_barrier(const XcdBarrier& b) {
    asm volatile("s_waitcnt vmcnt(0)" ::: "memory");
    __syncthreads();
    if (threadIdx.x == 0) {
        unsigned* bar = b.bar;
        __builtin_amdgcn_s_waitcnt(0);
        unsigned nloc = b.st[0], nx = b.st[1];
        if (nloc == 0u) { xcd_barrier_complete(bar, b.x, nloc, nx); b.st[0] = nloc; b.st[1] = nx; }
        const unsigned old = xb_add(&bar[XB_XSUB(b.x)], 1u);
        const unsigned gen = old / nloc;
        if (old + 1u == (gen + 1u) * nloc) {
            __builtin_amdgcn_fence(__ATOMIC_RELEASE, "agent");
            asm volatile("s_waitcnt vmcnt(0)" ::: "memory");
            const unsigned og = xb_add(&bar[XB_TOP], 1u);
            const unsigned tg = og / nx;
            if (og + 1u == (tg + 1u) * nx) xb_add(&bar[XB_TOPGEN], 1u);
            else XB_SPIN(xb_ld(&bar[XB_TOPGEN]) == tg, bar);
            __builtin_amdgcn_fence(__ATOMIC_ACQUIRE, "agent");
            xb_add(&bar[XB_XGEN(b.x)], 1u);
            asm volatile("s_waitcnt vmcnt(0)" ::: "memory");
        } else {
            XB_SPIN(xb_ld(&bar[XB_XGEN(b.x)]) == gen, bar);
            __builtin_amdgcn_fence(__ATOMIC_ACQUIRE, "agent");
            asm volatile("s_waitcnt vmcnt(0)" ::: "memory");
        }
    }
    __syncthreads();
}

constexpr int CW_EXIT = XCD_BAR_WORDS, CW_ATT = XCD_BAR_WORDS + 64, CW_WORDS = CW_ATT + 256;
__device__ unsigned g_ctl[CW_WORDS];

__global__ void __launch_bounds__(NTHREADS, 2) fwd_mega(Params p) {
    extern __shared__ __attribute__((aligned(16))) unsigned char lds_raw[];
    cg::grid_group grid = cg::this_grid();
    LAS unsigned char* lds = (LAS unsigned char*)lds_raw;
    const int G = gridDim.x, bx = blockIdx.x;
    const int vcu = (G % 8 == 0) ? (bx % 8) * (G / 8) + bx / 8 : bx;
    unsigned char* ws = p.ws;
    volatile LAS unsigned* misc = (volatile LAS unsigned*)(lds + MISC_OFF);
    if (threadIdx.x < 2) misc[threadIdx.x] = 0u;
    __syncthreads();
    if (p.out == nullptr) grid.sync();
    const XcdBarrier gbar = xcd_barrier_post(g_ctl, misc);
#define GRID_SYNC() xcd_barrier(gbar)

#ifndef PHASES
#define PHASES 0xffff
#endif
#ifndef REPMASK
#define REPMASK 0
#endif
#define NREP(bit) ((REPMASK & (bit)) ? 2 : 1)
#ifndef SPAN_A
#define SPAN_A -1
#endif
#ifndef SPAN_B
#define SPAN_B -1
#endif
    volatile LAS unsigned long long* stamps = (volatile LAS unsigned long long*)(lds + MISC_OFF + 16);
#define STAMP(k) do { if (SPAN_A >= 0 && bx == 0 && threadIdx.x == 0) stamps[k] = __builtin_amdgcn_s_memrealtime(); } while (0)
    STAMP(0);
    if (SPAN_A >= 0 && bx == 0 && threadIdx.x == 0) { stamps[16] = 0; stamps[17] = 0; stamps[18] = 0; stamps[19] = 0; }
    for (int rep = 0; rep < NREP(1); ++rep) if (PHASES & 1) p0_prep(p, lds, vcu, G);
    GRID_SYNC(); STAMP(1);
    for (int rep = 0; rep < NREP(2); ++rep) if (PHASES & 2) {
        Sched1 S{G, bx, (const char*)ws};
        Epi1 E{ws, p.ik_g, p.ik_b};
        pg8::gemm_phase<Epi1, Sched1, true, true>(lds, DM, S, E);
    }
    if (PHASES & 1) { constexpr int NU1A = 32 * NT_BF + 16; const int nfull = (NU1A % G == 0) ? 0 : NU1A % G; const int nhelp = G - nfull;
        if (nhelp == G) p0b_gate8(p, lds, bx, G); else if (bx >= nfull) p0b_gate8(p, lds, bx - nfull, nhelp); }
    STAMP(14);
    GRID_SYNC();
    if (PHASES & 2) {
        Sched1b S{G, bx, (const char*)ws}; Epi1b E{ws};
        pg8::gemm_phase<Epi1b, Sched1b, true, true, true>(lds, DM / 2, S, E);
    }
    GRID_SYNC(); STAMP(2);
    for (int rep = 0; rep < NREP(4); ++rep) if (PHASES & 4) p2_qkprep(p, vcu, G);
    STAMP(3);
    for (int rep = 0; rep < NREP(8); ++rep) if (PHASES & 8) for (int u = bx; u < 512; u += G) p2_gmlp_unit(p, lds, u);
    STAMP(4);
    for (int rep = 0; rep < NREP(16); ++rep) if (PHASES & 16) for (int u = bx; u < 256; u += G) p2_mem_unit(p, lds, u);
    STAMP(5);
    for (int rep = 0; rep < NREP(32); ++rep) if (PHASES & 32) p2_idx_all(p, lds, bx, G);
    STAMP(6);
    GRID_SYNC(); STAMP(7);
    for (int rep = 0; rep < NREP(64); ++rep) if (PHASES & 64) {
        const int L0 = (G == 256) ? ((bx & 7) * 32 + (bx >> 3)) : bx;
        if (L0 < 256) {
            int L = L0, pass = 0;
            att::Seam S; att::BlockRef cur = att::make_ref(ws, g_ctl + CW_ATT, L, 0);
            att::attn_prime(cur, (char*)lds_raw, S);
            STAMP(11);
            for (;;) {
                const bool more_pass = pass == 0, more_item = L + G < 256, last = !more_pass && !more_item;
                const int Ln = more_pass ? L : (more_item ? L + G : L), pn = more_pass ? 1 : 0;
                const att::BlockRef nxt = last ? cur : att::make_ref(ws, g_ctl + CW_ATT, Ln, pn);
                att::attn_block(cur, nxt, (char*)lds_raw, S);
                STAMP(12 + pass);
                if (last) break;
                cur = nxt; L = Ln; pass = pn;
            }
        }
    }
    GRID_SYNC(); STAMP(8);
    for (int rep = 0; rep < NREP(128); ++rep) if (PHASES & 128) {
        Sched2 S{G, bx, (const char*)ws};
        Epi2 E{ws};
        pg8::gemm_phase<Epi2, Sched2, true, true>(lds, 1024, S, E);
    }
    GRID_SYNC(); STAMP(9);
    if (REPMASK & 512) { for (int i = 0; i < 10; ++i) GRID_SYNC(); }
    for (int rep = 0; rep < NREP(256); ++rep) if (PHASES & 256) {
        Sched3 S{G, bx, (const char*)(ws + WS_MERGED), (const char*)(ws + WS_WOUT)};
        Epi3 E{p.x, p.out};
        pg8::gemm_phase<Epi3, Sched3, true, true>(lds, DM, S, E);
    }
    STAMP(10);
    if (SPAN_A >= 0 && bx == 0 && threadIdx.x == 0) {
        const unsigned long long dt = (SPAN_A >= 100) ? stamps[SPAN_A - 100 + 16] : (stamps[SPAN_B] - stamps[SPAN_A]), t0 = __builtin_amdgcn_s_memrealtime();
        while (__builtin_amdgcn_s_memrealtime() - t0 < dt) __builtin_amdgcn_s_sleep(8);
    }
    __syncthreads();
    if (threadIdx.x == 0) misc[0] = (xb_add(&g_ctl[CW_EXIT], 1u) == (unsigned)G - 1u) ? 1u : 0u;
    __syncthreads();
    if (misc[0]) { for (int i = threadIdx.x; i < CW_WORDS; i += NTHREADS) __hip_atomic_store(&g_ctl[i], 0u, __ATOMIC_RELAXED, __HIP_MEMORY_SCOPE_AGENT);
                   for (int i = threadIdx.x; i < NGATE; i += NTHREADS) __hip_atomic_store(&g_colmax[i], 0u, __ATOMIC_RELAXED, __HIP_MEMORY_SCOPE_AGENT); }
}

extern "C" void kernel_launch(void* const* d_in, const int* in_sizes, int n_in, void* d_out, int out_size, void* d_ws, size_t ws_size, hipStream_t stream) {
    static int grid_blocks = 0;
    if (!grid_blocks) {
        if (n_in != 21 || out_size != T * DM || ws_size < WS_TOTAL) { fprintf(stderr, "kernel_launch: unexpected shapes (n_in %d out %d ws %zu)\n", n_in, out_size, ws_size); grid_blocks = -1; return; }
        int dev = 0, cus = 0, per_cu = 0;
        (void)hipGetDevice(&dev);
        (void)hipDeviceGetAttribute(&cus, hipDeviceAttributeMultiprocessorCount, dev);
        (void)hipFuncSetAttribute((const void*)fwd_mega, hipFuncAttributeMaxDynamicSharedMemorySize, LDS_BYTES);
        (void)hipOccupancyMaxActiveBlocksPerMultiprocessor(&per_cu, (const void*)fwd_mega, NTHREADS, LDS_BYTES);
        if (per_cu < 1) { fprintf(stderr, "kernel_launch: occupancy query returned %d\n", per_cu); grid_blocks = -1; return; }
        grid_blocks = cus;
        fprintf(stderr, "kernel_launch: cus %d per_cu %d grid %d\n", cus, per_cu, grid_blocks);
    }
    if (grid_blocks < 0) return;
    Params p{};
    p.x = (const float*)d_in[0]; p.mem = (const float*)d_in[1]; p.pos = (const int*)d_in[2]; p.norm_gain = (const float*)d_in[3]; p.w_in = (const float*)d_in[4];
    p.gmlp_g = (const float*)d_in[5]; p.gmlp_b = (const float*)d_in[6]; p.spatial_w = (const float*)d_in[7]; p.spatial_b = (const float*)d_in[8]; p.w_a = (const float*)d_in[9];
    p.q_gain = (const float*)d_in[10]; p.k_gain = (const float*)d_in[11]; p.ik_g = (const float*)d_in[12]; p.ik_b = (const float*)d_in[13]; p.w_b = (const float*)d_in[14];
    p.mem_gain = (const float*)d_in[15]; p.w_mkv = (const float*)d_in[16]; p.mq_gain = (const float*)d_in[17]; p.mk_gain = (const float*)d_in[18]; p.w_m = (const float*)d_in[19];
    p.w_out = (const float*)d_in[20]; p.out = (float*)d_out; p.ws = (unsigned char*)d_ws;
    void* args[] = {&p};
    hipError_t e = hipLaunchCooperativeKernel((const void*)fwd_mega, dim3(grid_blocks), dim3(NTHREADS), args, LDS_BYTES, stream);
    if (e != hipSuccess) fprintf(stderr, "cooperative launch failed: %s (grid %d)\n", hipGetErrorString(e), grid_blocks);
}
```

```cpp
#include <hip/hip_runtime.h>
#include <hip/hip_cooperative_groups.h>
#include <cstdio>
#include <cstdint>
namespace cg = cooperative_groups;

#define LAS __attribute__((address_space(3)))
typedef unsigned short bf16_t;
typedef short bf16x8 __attribute__((ext_vector_type(8)));
typedef short s16x4 __attribute__((ext_vector_type(4)));
typedef float f32x2 __attribute__((ext_vector_type(2)));
typedef float f32x4 __attribute__((ext_vector_type(4)));
typedef float f32x16 __attribute__((ext_vector_type(16)));
typedef unsigned u32x2 __attribute__((ext_vector_type(2)));
typedef unsigned u32x4 __attribute__((ext_vector_type(4)));
typedef int i32x4 __attribute__((ext_vector_type(4)));

constexpr int NB = 2, SEQ = 4096, T = NB * SEQ, DM = 2048, DIN = 14928, NPAD = 15104, MEML = 256;
constexpr int NTHREADS = 512, NWAVES = 8;
constexpr int LDS_BYTES = 147456;
constexpr float EPS = 1e-6f;
constexpr float LOG2E = 1.4426950408889634f;

constexpr size_t MiB = (size_t)1 << 20;
constexpr size_t WS_WIN = 0, WS_WBR = 60 * MiB, WS_WOUT = 72 * MiB, WS_WMKV = 80 * MiB, WS_H = 88 * MiB, WS_MEMN = 120 * MiB;
constexpr size_t WS_AU = 122 * MiB, WS_AV = 138 * MiB, WS_AZ = 154 * MiB, WS_QR = 170 * MiB, WS_BZ = 186 * MiB, WS_MQ = 202 * MiB, WS_MZ = 218 * MiB;
constexpr size_t WS_IQ = 234 * MiB, WS_KR = 250 * MiB, WS_VV = 254 * MiB, WS_SA = 258 * MiB, WS_SB = 290 * MiB, WS_SM = 322 * MiB;
constexpr size_t WS_QN = 354 * MiB, WS_KN = 370 * MiB, WS_XA = 374 * MiB, WS_XM = 390 * MiB, WS_MASK = 406 * MiB, WS_IK = 410 * MiB, WS_IW = 411 * MiB;
constexpr size_t WS_KM = 412 * MiB, WS_VT = 413 * MiB, WS_CSB = 414 * MiB, WS_CSI = 415 * MiB, WS_END = 416 * MiB;
constexpr size_t WS_RKP = WS_IW + 524288;
constexpr size_t WS_OPART = WS_END, WS_ML = WS_END + 32 * MiB, WS_TOTAL = WS_END + 34 * MiB;
constexpr size_t WS_CTL = WS_END, CTL_BYTES = 65536;
constexpr int NGATE = 8192, GATE0 = 6736, NT_BF = 27;
constexpr size_t WS_LNP = 48 * MiB;
constexpr size_t WS_W8 = 27 * MiB, WS_SH = 47 * MiB, WS_SW = 47 * MiB + 65536, WS_CMP = 47 * MiB + 131072, WS_H8 = WS_OPART;
static_assert(WS_W8 + (size_t)NGATE * DM <= WS_SH && WS_CMP + 8 * NGATE * 4 <= WS_WBR && (size_t)NT_BF * 256 * DM * 2 <= WS_W8, "int8 regions inside the WS_WIN slot");
constexpr int CW_BAR = 0;
constexpr int MISC_OFF = 147200;
constexpr size_t WS_XB = WS_QR;
constexpr size_t WS_MERGED = WS_H;

typedef __bf16 bf16x2_t __attribute__((ext_vector_type(2)));
__device__ __forceinline__ unsigned cvt_pk_bf16(float lo, float hi) { const f32x2 v = {lo, hi}; const bf16x2_t b = __builtin_convertvector(v, bf16x2_t); return __builtin_bit_cast(unsigned, b); }
__device__ __forceinline__ bf16_t f2bf(float f) { return (bf16_t)(cvt_pk_bf16(f, 0.f) & 0xffffu); }
__device__ __forceinline__ float bf2f(unsigned short b) { return __uint_as_float(((unsigned)b) << 16); }
__device__ __forceinline__ float bflo(unsigned w) { return __uint_as_float(w << 16); }
__device__ __forceinline__ float bfhi(unsigned w) { return __uint_as_float(w & 0xffff0000u); }
__device__ __forceinline__ float sigm(float x) { return __builtin_amdgcn_rcpf(1.f + __builtin_amdgcn_exp2f(-LOG2E * x)); }
__device__ __forceinline__ float silu_f(float x) { return x * sigm(x); }
__device__ __forceinline__ float gelu_f(float x) { const float u = 0.7978845608028654f * (x + 0.044715f * x * x * x); return x * sigm(2.f * u); }
__device__ __forceinline__ float wave_sum(float v) {
#pragma unroll
    for (int o = 1; o < 64; o <<= 1) v += __shfl_xor(v, o);
    return v;
}
__device__ __forceinline__ unsigned wave_sum_u(unsigned v) {
#pragma unroll
    for (int o = 1; o < 64; o <<= 1) v += (unsigned)__shfl_xor((int)v, o);
    return v;
}
__device__ __forceinline__ bf16x8 pack8(f32x4 a, f32x4 b) {
    u32x4 w = {cvt_pk_bf16(a[0], a[1]), cvt_pk_bf16(a[2], a[3]), cvt_pk_bf16(b[0], b[1]), cvt_pk_bf16(b[2], b[3])};
    return *reinterpret_cast<bf16x8*>(&w);
}
#define LDS_WAIT() asm volatile("s_waitcnt lgkmcnt(0)" ::: "memory")
__device__ __forceinline__ int opaque_tid() { int t = threadIdx.x; asm volatile("" : "+v"(t)); return t; }

namespace pg8 {
constexpr int BM = 256, BK = 64, HALF = 128, HTB = HALF * BK * 2, STAGE_BYTES = 8 * HTB, NXCD = 8, WGM = 8;
__host__ __device__ __forceinline__ int lds_byte(int r, int c) { const int st = (r >> 4) * 2 + (c >> 5), rr = r & 15, cc = c & 31, ob = rr * 64 + cc * 2; return st * 1024 + (ob ^ (((ob >> 9) & 1) << 5)); }
__host__ __device__ __forceinline__ void stage_rc(int b, int& R, int& C) { const int st = b / 1024, sb = b % 1024, swz = sb ^ (((sb >> 9) & 1) << 5); R = (st >> 1) * 16 + swz / 64; C = (st & 1) * 32 + (swz % 64) / 2; }
__host__ __device__ __forceinline__ int perm32(int rho) { const int n = rho >> 4, i = rho & 15; return 8 * (i >> 2) + 4 * n + (i & 3); }

struct Unit { int pm, pn, kind; };

__device__ __forceinline__ void tile_order(int wgid, int nM, int nN, int& pm, int& pn) {
    const int nwg = nM * nN;
    { const int q = nwg / NXCD, r = nwg % NXCD, xcd = wgid % NXCD, off = wgid / NXCD; wgid = (xcd < r ? xcd * (q + 1) : r * (q + 1) + (xcd - r) * q) + off; }
    const int nig = WGM * nN, gid = wgid / nig, fm = gid * WGM, gsz = (nM - fm) < WGM ? (nM - fm) : WGM;
    pm = fm + ((wgid % nig) % gsz); pn = (wgid % nig) / gsz;
}

template <class Epi, class Sched, bool ALIGN_EPI, bool SP2, bool I8 = false>
__device__ __forceinline__ void gemm_phase(LAS unsigned char* lds, const int K, const Sched& S, const Epi& E) {
    const int tid = opaque_tid(), wid = __builtin_amdgcn_readfirstlane(tid >> 6), lane = tid & 63, wr = wid >> 2, wc = wid & 3, fr = lane & 15, fq = lane >> 4;
    const int nt = K / BK;
    unsigned voffA[2], voffB[2];
#pragma unroll
    for (int i = 0; i < 2; ++i) { int R, C; stage_rc(tid * 16 + i * 8192, R, C); const int Rb = Epi::PERM ? ((R & ~31) + perm32(R & 31)) : R;
        voffA[i] = (unsigned)(R * K + C) * 2u; voffB[i] = (unsigned)(Rb * K + C) * 2u; }
    const size_t kstep = (size_t)(BK * 2);
    const size_t hstep = (size_t)HALF * K * 2;
    const unsigned ldsw = (unsigned)wid * 1024u;
    const int aoff = lds_byte(wr * 64 + fr, fq * 8), boff = lds_byte(wc * 32 + fr, fq * 8);
#define PG8_SA(b, h) (((b) * 2 + (h)) * HTB)
#define PG8_SB(b, h) ((4 + (b) * 2 + (h)) * HTB)
#define PG8_STAGE(bufoff, gbase, voff) do { _Pragma("unroll") for (int _i = 0; _i < 2; ++_i) \
        __builtin_amdgcn_global_load_lds((const unsigned*)((const char*)(gbase) + (voff)[_i]), (LAS unsigned*)(lds + (bufoff) + ldsw + _i * 8192), 16, 0, 0); } while (0)
#define PG8_LDA(dst, b, h) do { _Pragma("unroll") for (int m = 0; m < 4; ++m) _Pragma("unroll") for (int k = 0; k < 2; ++k) dst[m][k] = *(const LAS bf16x8*)(lds + PG8_SA(b, h) + aoff + m * 2048 + k * 1024); } while (0)
#define PG8_LDB(dst, b, h) do { _Pragma("unroll") for (int n = 0; n < 2; ++n) _Pragma("unroll") for (int k = 0; k < 2; ++k) dst[n][k] = *(const LAS bf16x8*)(lds + PG8_SB(b, h) + boff + n * 2048 + k * 1024); } while (0)
#define PG8_MMA(ai, bj, At, Bt) do { __builtin_amdgcn_s_setprio(1); _Pragma("unroll") for (int m = 0; m < 4; ++m) _Pragma("unroll") for (int n = 0; n < 2; ++n) _Pragma("unroll") for (int k = 0; k < 2; ++k) \
        { if constexpr (I8) acc[ai][bj][m][n] = __builtin_bit_cast(f32x4, __builtin_amdgcn_mfma_i32_16x16x64_i8(__builtin_bit_cast(i32x4, Bt[n][k]), __builtin_bit_cast(i32x4, At[m][k]), __builtin_bit_cast(i32x4, acc[ai][bj][m][n]), 0, 0, 0)); \
          else acc[ai][bj][m][n] = __builtin_amdgcn_mfma_f32_16x16x32_bf16(Bt[n][k], At[m][k], acc[ai][bj][m][n], 0, 0, 0); } __builtin_amdgcn_s_setprio(0); } while (0)
#define PG8_WAIT_V(n) asm volatile("s_waitcnt vmcnt(" #n ")" ::: "memory")
#define PG8_WAIT_L(n) asm volatile("s_waitcnt lgkmcnt(" #n ")" ::: "memory")
#define PG8_BAR __builtin_amdgcn_s_barrier()
#define PG8_SCHED __builtin_amdgcn_sched_barrier(0)
    Unit cur, nxt; int ui = 0;
    if (!S.next(0, cur)) return;
    f32x4 acc[2][2][4][2];
    if constexpr (Epi::INIT) E.init(acc, cur, wr, wc, fr, fq);
    else {
#pragma unroll
    for (int a = 0; a < 2; ++a)
#pragma unroll
        for (int b = 0; b < 2; ++b)
#pragma unroll
            for (int m = 0; m < 4; ++m)
#pragma unroll
                for (int n = 0; n < 2; ++n) acc[a][b][m][n] = (f32x4){0.f, 0.f, 0.f, 0.f};
    }
    bf16x8 At[4][2], B0[2][2], B1[2][2];
    const char* cA = S.a_base(cur); const char* cB = S.b_base(cur);
    if constexpr (SP2) {
        PG8_STAGE(PG8_SB(0, 0), cB, voffB); PG8_STAGE(PG8_SB(0, 1), cB + hstep, voffB); PG8_STAGE(PG8_SA(0, 0), cA, voffA); PG8_STAGE(PG8_SA(0, 1), cA + hstep, voffA);
        if (wr == 1) PG8_BAR;
        PG8_WAIT_V(2); PG8_BAR;
        PG8_STAGE(PG8_SB(1, 0), cB + kstep, voffB); PG8_STAGE(PG8_SA(1, 0), cA + kstep, voffA); PG8_STAGE(PG8_SB(1, 1), cB + hstep + kstep, voffB);
        PG8_WAIT_V(6); PG8_BAR;
    } else {
        PG8_STAGE(PG8_SB(0, 0), cB, voffB); PG8_STAGE(PG8_SA(0, 0), cA, voffA); PG8_STAGE(PG8_SB(0, 1), cB + hstep, voffB); PG8_STAGE(PG8_SA(0, 1), cA + hstep, voffA);
        if (wr == 1) PG8_BAR;
        PG8_WAIT_V(4); PG8_BAR;
        PG8_STAGE(PG8_SB(1, 0), cB + kstep, voffB); PG8_STAGE(PG8_SA(1, 0), cA + kstep, voffA); PG8_STAGE(PG8_SB(1, 1), cB + hstep + kstep, voffB);
        PG8_WAIT_V(6); PG8_BAR;
    }
    for (;;) {
        const bool has_next = S.next(ui + 1, nxt);
        const char* nA = has_next ? S.a_base(nxt) : cA; const char* nB = has_next ? S.b_base(nxt) : cB;
        for (int t = 0; t < nt; t += 2) {
            const bool last = (t == nt - 2);
            const char* a1 = cA + (size_t)(t + 1) * kstep;
            const char* a2 = last ? nA : cA + (size_t)(t + 2) * kstep; const char* b2 = last ? nB : cB + (size_t)(t + 2) * kstep;
            const char* a3 = a2 + kstep; const char* b3 = b2 + kstep;
            if constexpr (SP2) {
            PG8_LDB(B0, 0, 0); PG8_LDB(B1, 0, 1); PG8_SCHED; PG8_LDA(At, 0, 0); PG8_STAGE(PG8_SA(1, 1), a1 + hstep, voffA);
            PG8_WAIT_V(8); PG8_WAIT_L(0); PG8_BAR; PG8_MMA(0, 0, At, B0); PG8_MMA(0, 1, At, B1); PG8_BAR; PG8_SCHED;
            PG8_LDA(At, 0, 1); PG8_STAGE(PG8_SB(0, 0), b2, voffB); PG8_STAGE(PG8_SB(0, 1), b2 + hstep, voffB); PG8_STAGE(PG8_SA(0, 0), a2, voffA);
            PG8_WAIT_V(8); PG8_WAIT_L(0); PG8_BAR; PG8_MMA(1, 0, At, B0); PG8_MMA(1, 1, At, B1); PG8_BAR; PG8_SCHED;
            PG8_LDB(B0, 1, 0); PG8_LDB(B1, 1, 1); PG8_SCHED; PG8_LDA(At, 1, 0); PG8_STAGE(PG8_SA(0, 1), a2 + hstep, voffA);
            PG8_WAIT_V(8); PG8_WAIT_L(0); PG8_BAR; PG8_MMA(0, 0, At, B0); PG8_MMA(0, 1, At, B1); PG8_BAR; PG8_SCHED;
            PG8_LDA(At, 1, 1); PG8_STAGE(PG8_SB(1, 0), b3, voffB); PG8_STAGE(PG8_SB(1, 1), b3 + hstep, voffB); PG8_STAGE(PG8_SA(1, 0), a3, voffA);
            PG8_WAIT_V(8); PG8_WAIT_L(0); PG8_BAR; PG8_MMA(1, 0, At, B0); PG8_MMA(1, 1, At, B1); PG8_BAR; PG8_SCHED;
            } else {
            PG8_LDB(B0, 0, 0); PG8_SCHED; PG8_LDA(At, 0, 0); PG8_STAGE(PG8_SA(1, 1), a1 + hstep, voffA);
            PG8_WAIT_L(8); PG8_BAR; PG8_WAIT_L(0); PG8_MMA(0, 0, At, B0); PG8_BAR; PG8_SCHED;
            PG8_LDB(B1, 0, 1); PG8_STAGE(PG8_SB(0, 0), b2, voffB);
            PG8_BAR; PG8_WAIT_L(0); PG8_MMA(0, 1, At, B1); PG8_BAR;
            PG8_LDA(At, 0, 1); PG8_STAGE(PG8_SA(0, 0), a2, voffA);
            PG8_BAR; PG8_WAIT_L(0); PG8_MMA(1, 0, At, B0); PG8_BAR; PG8_SCHED;
            PG8_STAGE(PG8_SB(0, 1), b2 + hstep, voffB);
            PG8_WAIT_V(6); PG8_BAR; PG8_MMA(1, 1, At, B1); PG8_BAR;
            PG8_LDB(B0, 1, 0); PG8_SCHED; PG8_LDA(At, 1, 0); PG8_STAGE(PG8_SA(0, 1), a2 + hstep, voffA);
            PG8_WAIT_L(8); PG8_BAR; PG8_WAIT_L(0); PG8_MMA(0, 0, At, B0); PG8_BAR; PG8_SCHED;
            PG8_LDB(B1, 1, 1); PG8_STAGE(PG8_SB(1, 0), b3, voffB);
            PG8_BAR; PG8_WAIT_L(0); PG8_MMA(0, 1, At, B1); PG8_BAR;
            PG8_LDA(At, 1, 1); PG8_STAGE(PG8_SA(1, 0), a3, voffA);
            PG8_BAR; PG8_WAIT_L(0); PG8_MMA(1, 0, At, B0); PG8_BAR; PG8_SCHED;
            PG8_STAGE(PG8_SB(1, 1), b3 + hstep, voffB);
            PG8_WAIT_V(6); PG8_BAR; PG8_MMA(1, 1, At, B1); PG8_BAR;
            }
        }
        if constexpr (ALIGN_EPI) { if (wr == 0) PG8_BAR; }
        const bool zero = E(acc, cur, wr, wc, fr, fq);
        if (!has_next) break;
        if constexpr (Epi::INIT) { E.init(acc, nxt, wr, wc, fr, fq); }
        else if (zero) {
#pragma unroll
        for (int a = 0; a < 2; ++a)
#pragma unroll
            for (int b = 0; b < 2; ++b)
#pragma unroll
                for (int m = 0; m < 4; ++m)
#pragma unroll
                    for (int n = 0; n < 2; ++n) acc[a][b][m][n] = (f32x4){0.f, 0.f, 0.f, 0.f};
        }
        cur = nxt; cA = nA; cB = nB; ++ui;
        if constexpr (ALIGN_EPI) { if (wr == 1) PG8_BAR; }
    }
    PG8_WAIT_V(0);
    if constexpr (!ALIGN_EPI) { if (wr == 0) PG8_BAR; }
    PG8_BAR;
#undef PG8_SA
#undef PG8_SB
#undef PG8_STAGE
#undef PG8_LDA
#undef PG8_LDB
#undef PG8_MMA
#undef PG8_WAIT_V
#undef PG8_WAIT_L
#undef PG8_BAR
#undef PG8_SCHED
}
}

struct Params {
    const float* x; const float* mem; const int* pos; const float* norm_gain; const float* w_in; const float* gmlp_g; const float* gmlp_b;
    const float* spatial_w; const float* spatial_b; const float* w_a; const float* q_gain; const float* k_gain; const float* ik_g; const float* ik_b;
    const float* w_b; const float* mem_gain; const float* w_mkv; const float* mq_gain; const float* mk_gain; const float* w_m; const float* w_out;
    float* out; unsigned char* ws;
};

__device__ unsigned g_colmax[8192];

__device__ __forceinline__ int win_src_col(int np) {
    const int tile = np >> 8, c = np & 255;
    if (tile < 22) return np;
    const int bj = c >> 7, wc = (c >> 5) & 3, fq = (c >> 3) & 3, j = c & 7;
    if (tile < 26) return 5632 + (tile - 22) * 256 + wc * 64 + 8 * (2 * fq + bj) + j;
    if (tile == 26) {
        if (wc == 0) return 6656 + 8 * (2 * fq + bj) + j;
        if (wc == 1 && fq == 0) return 6720 + 8 * bj + j;
        return -1;
    }
    return np - 176;
}
__device__ __forceinline__ void transpose_item(const float* W, int K, int N, bf16_t* WT, int kb, int nb, bool is_win, LAS float* scr, int lane) {
    const int k0 = 64 * kb, n0 = 32 * nb, nl = lane & 31;
    const int src = is_win ? win_src_col(n0 + nl) : (n0 + nl);
    const float* wp = W + (size_t)(k0 + (lane >> 5)) * N + (src >= 0 ? src : 0);
    float tv[32];
#pragma unroll
    for (int i = 0; i < 32; ++i) tv[i] = wp[(size_t)(2 * i) * N];
#pragma unroll
    for (int i = 0; i < 32; ++i) { const int kk = 2 * i + (lane >> 5); scr[kk * 33 + nl] = src >= 0 ? tv[i] : 0.f; }
    LDS_WAIT(); asm volatile("" ::: "memory");
    const int c = lane & 7;
#pragma unroll
    for (int j = 0; j < 4; ++j) { const int n = (lane >> 3) + 8 * j; const LAS float* s = scr + (8 * c) * 33 + n;
        u32x4 o; o.x = cvt_pk_bf16(s[0 * 33], s[1 * 33]); o.y = cvt_pk_bf16(s[2 * 33], s[3 * 33]); o.z = cvt_pk_bf16(s[4 * 33], s[5 * 33]); o.w = cvt_pk_bf16(s[6 * 33], s[7 * 33]);
        *(u32x4*)(WT + (size_t)(n0 + n) * K + k0 + 8 * c) = o; }
    LDS_WAIT(); asm volatile("" ::: "memory");
}
template <bool Q8>
__device__ __forceinline__ void rms_row(const float* xrow, const float* gain, bf16_t* orow, unsigned* q8row, float* q8scale, int lane) {
    f32x4 v[8]; float s = 0.f;
#pragma unroll
    for (int j = 0; j < 8; ++j) { v[j] = ((const f32x4*)xrow)[lane + 64 * j]; s += (v[j][0] * v[j][0] + v[j][1] * v[j][1]) + (v[j][2] * v[j][2] + v[j][3] * v[j][3]); }
    s = wave_sum(s);
    const float r = 1.0f / sqrtf(s * (1.0f / DM) + EPS);
    float am = 0.f;
#pragma unroll
    for (int j = 0; j < 8; ++j) { const f32x4 g = ((const f32x4*)gain)[lane + 64 * j]; v[j] = v[j] * r * g;
        u32x2 w; w.x = cvt_pk_bf16(v[j][0], v[j][1]); w.y = cvt_pk_bf16(v[j][2], v[j][3]); ((u32x2*)orow)[lane + 64 * j] = w;
        if (Q8) am = fmaxf(fmaxf(am, fmaxf(fabsf(v[j][0]), fabsf(v[j][1]))), fmaxf(fabsf(v[j][2]), fabsf(v[j][3]))); }
    if (Q8) {
#pragma unroll
        for (int o = 1; o < 64; o <<= 1) am = fmaxf(am, __shfl_xor(am, o));
        const float inv = am > 0.f ? 127.f / am : 0.f;
#pragma unroll
        for (int j = 0; j < 8; ++j) { const int q0 = (int)rintf(v[j][0] * inv), q1 = (int)rintf(v[j][1] * inv), q2 = (int)rintf(v[j][2] * inv), q3 = (int)rintf(v[j][3] * inv);
            q8row[lane + 64 * j] = (unsigned)(q0 & 0xff) | ((unsigned)(q1 & 0xff) << 8) | ((unsigned)(q2 & 0xff) << 16) | ((unsigned)(q3 & 0xff) << 24); }
        if (lane == 0) *q8scale = am * (1.f / 127.f);
    }
}
__device__ __forceinline__ void p0_prep(const Params& p, LAS unsigned char* lds, int vcu, int G) {
    const int tid = opaque_tid(), lane = tid & 63, wave = tid >> 6;
    LAS float* scr = (LAS float*)(lds + wave * 16384);
    const int gw = vcu * NWAVES + wave, NGW = G * NWAVES;
    unsigned char* ws = p.ws;
    constexpr int I_CM = 32 * 32, I_WIN = 32 * (NT_BF * 8), I_BR = 16 * 64, I_SQ = 32 * 64;
    constexpr int NITEMS = I_CM + I_WIN + 3 * I_BR + 2 * I_SQ;
    for (int it = gw; it < NITEMS; it += NGW) {
        int r = it;
        if (r < I_CM) {
            const int cg = r % 32, kc = r / 32; const float* wp = p.w_in + (size_t)(64 * kc) * DIN + GATE0 + 256 * cg + 4 * lane; f32x4 m = {0.f, 0.f, 0.f, 0.f};
#pragma unroll 32
            for (int k = 0; k < 64; ++k) { const f32x4 w = *(const f32x4*)(wp + (size_t)k * DIN); m[0] = fmaxf(m[0], fabsf(w[0])); m[1] = fmaxf(m[1], fabsf(w[1])); m[2] = fmaxf(m[2], fabsf(w[2])); m[3] = fmaxf(m[3], fabsf(w[3])); }
#pragma unroll
            for (int e = 0; e < 4; ++e) atomicMax(&g_colmax[256 * cg + 4 * lane + e], __float_as_uint(m[e]));
            continue; } r -= I_CM;
        if (r < I_WIN) { const int nb = r % (NT_BF * 8), kb = r / (NT_BF * 8); transpose_item(p.w_in, DM, DIN, (bf16_t*)(ws + WS_WIN), kb, nb, true, scr, lane); continue; } r -= I_WIN;
        if (r < 3 * I_BR) { const int br = r / I_BR, q = r % I_BR; const float* W = br == 0 ? p.w_a : (br == 1 ? p.w_b : p.w_m);
            transpose_item(W, 1024, DM, (bf16_t*)(ws + WS_WBR) + (size_t)br * DM * 1024, q / 64, q % 64, false, scr, lane); continue; } r -= 3 * I_BR;
        if (r < I_SQ) { transpose_item(p.w_out, DM, DM, (bf16_t*)(ws + WS_WOUT), r / 64, r % 64, false, scr, lane); continue; } r -= I_SQ;
        transpose_item(p.w_mkv, DM, DM, (bf16_t*)(ws + WS_WMKV), r / 64, r % 64, false, scr, lane);
    }
    for (int m = gw; m < T + NB * MEML; m += NGW) {
        if (m < T) rms_row<true>(p.x + (size_t)m * DM, p.norm_gain, (bf16_t*)(ws + WS_H) + (size_t)m * DM, (unsigned*)(ws + WS_H8) + (size_t)m * (DM / 4), (float*)(ws + WS_SH) + m, lane);
        else rms_row<false>(p.mem + (size_t)(m - T) * DM, p.mem_gain, (bf16_t*)(ws + WS_MEMN) + (size_t)(m - T) * DM, nullptr, nullptr, lane);
    }
    for (int i = vcu * NTHREADS + tid; i < T * 24; i += G * NTHREADS) {
        const int t = i / 24, j = i % 24; const float ps = (float)p.pos[t];
        float inv; if (j < 16) inv = powf(500000.0f, -(float)j / 16.0f); else inv = powf(500000.0f, -(float)(j - 16) / 8.0f);
        float sn, cs; sincosf(ps * inv, &sn, &cs);
        if (j < 16) ((f32x2*)(ws + WS_CSB))[t * 16 + j] = (f32x2){cs, sn}; else ((f32x2*)(ws + WS_CSI))[t * 8 + (j - 16)] = (f32x2){cs, sn};
    }
}
__device__ __forceinline__ void p0b_gate8(const Params& p, LAS unsigned char* lds, int widx, int nw) {
    const int tid = opaque_tid(), lane = tid & 63, wave = tid >> 6;
    LAS float* scr = (LAS float*)(lds + wave * 16384);
    const int gw = widx * NWAVES + wave, NGW = nw * NWAVES;
    unsigned char* ws = p.ws;
    for (int it = gw; it < 32 * (NGATE / 32); it += NGW) {
        const int nb = it % (NGATE / 32), kb = it / (NGATE / 32), k0 = 64 * kb, n0 = 32 * nb, nl = lane & 31;
        const float cm = __uint_as_float(__hip_atomic_load(&g_colmax[n0 + nl], __ATOMIC_RELAXED, __HIP_MEMORY_SCOPE_AGENT));
        const float inv = cm > 0.f ? 127.f / cm : 0.f;
        if (kb == 0 && lane < 32) ((float*)(ws + WS_SW))[n0 + nl] = cm * (1.f / 127.f);
        const float* wp = p.w_in + (size_t)(k0 + (lane >> 5)) * DIN + GATE0 + n0 + nl;
        float tv[32];
#pragma unroll
        for (int i = 0; i < 32; ++i) tv[i] = wp[(size_t)(2 * i) * DIN];
#pragma unroll
        for (int i = 0; i < 32; ++i) { const int kk = 2 * i + (lane >> 5); scr[kk * 33 + nl] = rintf(tv[i] * inv); }
        LDS_WAIT(); asm volatile("" ::: "memory");
        const int c = lane & 7;
#pragma unroll
        for (int j = 0; j < 4; ++j) { const int n = (lane >> 3) + 8 * j; const LAS float* sp = scr + (8 * c) * 33 + n;
            unsigned lo = 0, hi2 = 0;
#pragma unroll
            for (int e = 0; e < 4; ++e) { lo |= ((unsigned)((int)sp[e * 33]) & 0xffu) << (8 * e); hi2 |= ((unsigned)((int)sp[(4 + e) * 33]) & 0xffu) << (8 * e); }
            *(u32x2*)((unsigned char*)(ws + WS_W8) + (size_t)(n0 + n) * DM + k0 + 8 * c) = (u32x2){lo, hi2}; }
        LDS_WAIT(); asm volatile("" ::: "memory");
    }
}

struct Sched1 {
    int G, c; const char* ws;
    __device__ __forceinline__ bool next(int i, pg8::Unit& u) const {
        int L = i * G + c;
        if (L < 32 * NT_BF) { pg8::tile_order(L, 32, NT_BF, u.pm, u.pn); u.kind = 0; return true; }
        L -= 32 * NT_BF;
        if (L < 8) { u.pm = L & 1; u.pn = L >> 1; u.kind = 1; return true; }
        L -= 8;
        if (L < 8) { u.pm = L & 3; u.pn = L >> 2; u.kind = 2; return true; }
        return false;
    }
    __device__ __forceinline__ const char* a_base(const pg8::Unit& u) const {
        const size_t off = u.kind == 0 ? WS_H : (u.kind == 1 ? WS_MEMN : WS_WMKV + (size_t)1024 * DM * 2);
        return ws + off + (size_t)u.pm * (256 * DM * 2); }
    __device__ __forceinline__ const char* b_base(const pg8::Unit& u) const {
        const size_t off = u.kind == 0 ? WS_WIN : (u.kind == 1 ? WS_WMKV : WS_MEMN);
        return ws + off + (size_t)u.pn * (256 * DM * 2); }
};
struct Epi1 {
    static constexpr bool PERM = true, INIT = false;
    unsigned char* ws; const float* ikg; const float* ikb;
    __device__ __forceinline__ bool operator()(f32x4 (&acc)[2][2][4][2], const pg8::Unit& u, int wr, int wc, int fr, int fq) const {
        const int rowb = u.pm * 256 + wr * 64 + fr, cl = wc * 32 + 8 * fq, pn = u.pn;
#ifndef EX_NOIQ
        if (u.kind == 0 && pn >= 22 && pn < 26) {
            const int head = 4 * (pn - 22) + wc;
#pragma unroll
            for (int ai = 0; ai < 2; ++ai)
#pragma unroll
                for (int m = 0; m < 4; ++m) { const int row = rowb + ai * 128 + m * 16;
                    f32x4 x1a = acc[ai][0][m][0], x1b = acc[ai][0][m][1], x2a = acc[ai][1][m][0], x2b = acc[ai][1][m][1];
                    if (fq == 0) { const f32x4* cs = (const f32x4*)(ws + WS_CSI) + row * 4;
                        const f32x4 c0 = cs[0], c1 = cs[1], c2 = cs[2], c3 = cs[3];
                        const f32x4 co_a = {c0[0], c0[2], c1[0], c1[2]}, si_a = {c0[1], c0[3], c1[1], c1[3]}, co_b = {c2[0], c2[2], c3[0], c3[2]}, si_b = {c2[1], c2[3], c3[1], c3[3]};
                        const f32x4 r1a = x1a * co_a - x2a * si_a, r1b = x1b * co_b - x2b * si_b, r2a = x2a * co_a + x1a * si_a, r2b = x2b * co_b + x1b * si_b;
                        x1a = r1a; x1b = r1b; x2a = r2a; x2b = r2b; }
                    bf16_t* dst = (bf16_t*)(ws + WS_IQ) + (size_t)row * 1024 + head * 64 + 16 * fq;
                    *(bf16x8*)(dst) = pack8(x1a, x1b); *(bf16x8*)(dst + 8) = pack8(x2a, x2b); }
            return true;
        }
#endif
#ifndef EX_NOIK
        if (u.kind == 0 && pn == 26) {
            if (wc == 0) {
                const f32x4 g0 = *(const f32x4*)(ikg + 16 * fq), g1 = *(const f32x4*)(ikg + 16 * fq + 4), g2 = *(const f32x4*)(ikg + 16 * fq + 8), g3 = *(const f32x4*)(ikg + 16 * fq + 12);
                const f32x4 e0 = *(const f32x4*)(ikb + 16 * fq), e1 = *(const f32x4*)(ikb + 16 * fq + 4), e2 = *(const f32x4*)(ikb + 16 * fq + 8), e3 = *(const f32x4*)(ikb + 16 * fq + 12);
#pragma unroll
                for (int ai = 0; ai < 2; ++ai)
#pragma unroll
                    for (int m = 0; m < 4; ++m) { const int row = rowb + ai * 128 + m * 16;
                        f32x4 v0 = acc[ai][0][m][0], v1 = acc[ai][0][m][1], v2 = acc[ai][1][m][0], v3 = acc[ai][1][m][1];
                        const f32x4 sv = (v0 + v1) + (v2 + v3);
                        float sm = (sv[0] + sv[1]) + (sv[2] + sv[3]);
                        sm += __shfl_xor(sm, 16); sm += __shfl_xor(sm, 32);
                        const float mean = sm * (1.f / 64.f);
                        v0 = v0 - mean; v1 = v1 - mean; v2 = v2 - mean; v3 = v3 - mean;
                        const f32x4 qv = (v0 * v0 + v1 * v1) + (v2 * v2 + v3 * v3);
                        float q2 = (qv[0] + qv[1]) + (qv[2] + qv[3]);
                        q2 += __shfl_xor(q2, 16); q2 += __shfl_xor(q2, 32);
                        const float rstd = 1.0f / sqrtf(q2 * (1.f / 64.f) + EPS);
                        v0 = v0 * rstd * g0 + e0; v1 = v1 * rstd * g1 + e1; v2 = v2 * rstd * g2 + e2; v3 = v3 * rstd * g3 + e3;
                        if (fq == 0) { const f32x4* cs = (const f32x4*)(ws + WS_CSI) + row * 4;
                            const f32x4 c0 = cs[0], c1 = cs[1], c2 = cs[2], c3 = cs[3];
                            const f32x4 co_a = {c0[0], c0[2], c1[0], c1[2]}, si_a = {c0[1], c0[3], c1[1], c1[3]}, co_b = {c2[0], c2[2], c3[0], c3[2]}, si_b = {c2[1], c2[3], c3[1], c3[3]};
                            const f32x4 r1a = v0 * co_a - v2 * si_a, r1b = v1 * co_b - v3 * si_b, r2a = v2 * co_a + v0 * si_a, r2b = v3 * co_b + v1 * si_b;
                            v0 = r1a; v1 = r1b; v2 = r2a; v3 = r2b; }
                        bf16_t* dst = (bf16_t*)(ws + WS_IK) + (size_t)row * 64 + 16 * fq;
                        *(bf16x8*)(dst) = pack8(v0, v1); *(bf16x8*)(dst + 8) = pack8(v2, v3); }
            } else if (wc == 1 && fq == 0) {
#pragma unroll
                for (int ai = 0; ai < 2; ++ai)
#pragma unroll
                    for (int m = 0; m < 4; ++m) { const int row = rowb + ai * 128 + m * 16; float* dst = (float*)(ws + WS_IW) + (size_t)row * 16;
                        *(f32x4*)(dst) = acc[ai][0][m][0] * 0.03125f; *(f32x4*)(dst + 4) = acc[ai][0][m][1] * 0.03125f;
                        *(f32x4*)(dst + 8) = acc[ai][1][m][0] * 0.03125f; *(f32x4*)(dst + 12) = acc[ai][1][m][1] * 0.03125f; }
            }
            return true;
        }
#endif
        int act = 0, ld = 1024, co = 0, bjs = 128; size_t off = 0, bex = 0;
        if (u.kind == 1) { off = WS_KM; co = pn * 256; }
        else if (u.kind == 2) { off = WS_VT; ld = 512; co = pn * 256; }
        else if (pn < 4) { act = 1; off = WS_AU; co = pn * 256; }
        else if (pn < 8) { act = 1; off = WS_AV; co = (pn - 4) * 256; }
        else if (pn < 12) { act = 2; off = WS_AZ; co = (pn - 8) * 256; }
        else if (pn < 16) { off = WS_QR; co = (pn - 12) * 256; }
        else if (pn == 16) { off = WS_KR; ld = 256; }
        else if (pn == 17) { off = WS_VV; ld = 128; bjs = SEQ * 128; bex = (size_t)SEQ * 128; }
        else { act = 2; off = WS_BZ; co = (pn - 18) * 256; }
        bf16_t* dst = (bf16_t*)(ws + off) + co + cl;
#pragma unroll
        for (int ai = 0; ai < 2; ++ai)
#pragma unroll
            for (int m = 0; m < 4; ++m) { const int row = rowb + ai * 128 + m * 16; bf16_t* rp = dst + (size_t)row * ld + (size_t)(row >> 12) * bex;
#pragma unroll
                for (int bj = 0; bj < 2; ++bj) { f32x4 v0 = acc[ai][bj][m][0], v1 = acc[ai][bj][m][1];
                    if (act == 1) {
#pragma unroll
                        for (int e = 0; e < 4; ++e) { v0[e] = gelu_f(v0[e]); v1[e] = gelu_f(v1[e]); } }
                    else if (act == 2) {
#pragma unroll
                        for (int e = 0; e < 4; ++e) { v0[e] = silu_f(v0[e]); v1[e] = silu_f(v1[e]); } }
                    *(bf16x8*)(rp + (size_t)bj * bjs) = pack8(v0, v1); }
                if (u.kind == 0 && pn >= 4 && pn < 8) {
                    f32x4 g0 = acc[ai][0][m][0], g1 = acc[ai][0][m][1], g2 = acc[ai][1][m][0], g3 = acc[ai][1][m][1];
#pragma unroll
                    for (int e = 0; e < 4; ++e) { g0[e] = gelu_f(g0[e]); g1[e] = gelu_f(g1[e]); g2[e] = gelu_f(g2[e]); g3[e] = gelu_f(g3[e]); }
                    const f32x4 sv = (g0 + g1) + (g2 + g3), qv = (g0 * g0 + g1 * g1) + (g2 * g2 + g3 * g3);
                    float s1 = (sv[0] + sv[1]) + (sv[2] + sv[3]), s2 = (qv[0] + qv[1]) + (qv[2] + qv[3]);
                    s1 += __shfl_xor(s1, 16); s2 += __shfl_xor(s2, 16); s1 += __shfl_xor(s1, 32); s2 += __shfl_xor(s2, 32);
                    if (fq == 0) ((f32x2*)(ws + WS_LNP))[(size_t)row * 16 + (pn - 4) * 4 + wc] = (f32x2){s1, s2}; }
                if (u.kind == 1) {
                    const f32x4 q = (acc[ai][0][m][0] * acc[ai][0][m][0] + acc[ai][0][m][1] * acc[ai][0][m][1]) + (acc[ai][1][m][0] * acc[ai][1][m][0] + acc[ai][1][m][1] * acc[ai][1][m][1]);
                    float ss = (q[0] + q[1]) + (q[2] + q[3]);
                    ss += __shfl_xor(ss, 16); ss += __shfl_xor(ss, 32);
                    if (fq == 0) ((float*)(ws + WS_RKP))[(size_t)row * 16 + pn * 4 + wc] = ss; } }
        return true;
    }
};

struct Sched1b {
    int G, c; const char* ws;
    __device__ __forceinline__ bool next(int i, pg8::Unit& u) const { const int L = i * G + c; if (L >= 32 * 32) return false; pg8::tile_order(L, 32, 32, u.pm, u.pn); u.kind = 0; return true; }
    __device__ __forceinline__ const char* a_base(const pg8::Unit& u) const { return ws + WS_H8 + (size_t)u.pm * (256 * DM); }
    __device__ __forceinline__ const char* b_base(const pg8::Unit& u) const { return ws + WS_W8 + (size_t)u.pn * (256 * DM); }
};
struct Epi1b {
    static constexpr bool PERM = true, INIT = false;
    unsigned char* ws;
    __device__ __forceinline__ bool operator()(f32x4 (&acc)[2][2][4][2], const pg8::Unit& u, int wr, int wc, int fr, int fq) const {
        const int rowb = u.pm * 256 + wr * 64 + fr, cl = wc * 32 + 8 * fq, pn = u.pn;
        const float* __restrict__ SW = (const float*)(ws + WS_SW) + pn * 256 + cl; const float* __restrict__ SH = (const float*)(ws + WS_SH);
        const f32x4 sw00 = *(const f32x4*)(SW), sw01 = *(const f32x4*)(SW + 4), sw10 = *(const f32x4*)(SW + 128), sw11 = *(const f32x4*)(SW + 132);
        float sh[2][4];
#pragma unroll
        for (int ai = 0; ai < 2; ++ai)
#pragma unroll
            for (int m = 0; m < 4; ++m) sh[ai][m] = SH[rowb + ai * 128 + m * 16];
        if (pn < 8) {
            bf16_t* __restrict__ dst = (bf16_t*)(ws + (pn < 4 ? WS_MQ : WS_MZ)) + (pn & 3) * 256 + cl;
#pragma unroll
            for (int ai = 0; ai < 2; ++ai)
#pragma unroll
                for (int m = 0; m < 4; ++m) { const int row = rowb + ai * 128 + m * 16; const float rs = sh[ai][m];
#pragma unroll
                    for (int bj = 0; bj < 2; ++bj) { f32x4 v0, v1; const f32x4 s0 = bj ? sw10 : sw00, s1 = bj ? sw11 : sw01;
#pragma unroll
                        for (int e = 0; e < 4; ++e) { v0[e] = (float)__float_as_int(acc[ai][bj][m][0][e]) * (rs * s0[e]); v1[e] = (float)__float_as_int(acc[ai][bj][m][1][e]) * (rs * s1[e]); }
                        if (pn >= 4) {
#pragma unroll
                            for (int e = 0; e < 4; ++e) { v0[e] = silu_f(v0[e]); v1[e] = silu_f(v1[e]); } }
                        *(bf16x8*)(dst + (size_t)row * 1024 + bj * 128) = pack8(v0, v1); } }
            return true;
        }
        const int pg = pn - 8;
        unsigned char* __restrict__ dst = (unsigned char*)(ws + WS_SA + (size_t)(pg >> 3) * (WS_SB - WS_SA)) + (pg & 7) * 256 + cl;
#pragma unroll
        for (int ai = 0; ai < 2; ++ai)
#pragma unroll
            for (int m = 0; m < 4; ++m) { const int row = rowb + ai * 128 + m * 16; const float rs = sh[ai][m] * (-LOG2E);
#pragma unroll
                for (int bj = 0; bj < 2; ++bj) { const f32x4 s0 = bj ? sw10 : sw00, s1 = bj ? sw11 : sw01; unsigned lo = 0, hi2 = 0;
#pragma unroll
                    for (int e = 0; e < 4; ++e) {
                        const float q0 = 255.f * __builtin_amdgcn_rcpf(1.f + __builtin_amdgcn_exp2f((float)__float_as_int(acc[ai][bj][m][0][e]) * (rs * s0[e])));
                        const float q1 = 255.f * __builtin_amdgcn_rcpf(1.f + __builtin_amdgcn_exp2f((float)__float_as_int(acc[ai][bj][m][1][e]) * (rs * s1[e])));
                        lo = __builtin_amdgcn_cvt_pk_u8_f32(__builtin_amdgcn_fmed3f(q0, 1.f, 255.f), e, lo); hi2 = __builtin_amdgcn_cvt_pk_u8_f32(__builtin_amdgcn_fmed3f(q1, 1.f, 255.f), e, hi2); }
                    *(u32x2*)(dst + (size_t)row * DM + bj * 128) = (u32x2){lo, hi2}; } }
        return true;
    }
};

struct Sched2 {
    int G, c; const char* ws;
    __device__ __forceinline__ bool next(int i, pg8::Unit& u) const {
        const int L = (i / 3) * G + c; if (L >= 256) return false;
        pg8::tile_order(L, 32, 8, u.pm, u.pn); u.kind = i % 3; return true;
    }
    __device__ __forceinline__ const char* a_base(const pg8::Unit& u) const {
        const size_t off = WS_XA + (u.kind == 1 ? (WS_XB - WS_XA) : (size_t)0) + (u.kind == 2 ? (WS_XM - WS_XA) : (size_t)0);
        return ws + off + (size_t)u.pm * (256 * 1024 * 2); }
    __device__ __forceinline__ const char* b_base(const pg8::Unit& u) const { return ws + WS_WBR + (size_t)u.kind * ((size_t)DM * 1024 * 2) + (size_t)u.pn * (256 * 1024 * 2); }
};
struct Epi2 {
    static constexpr bool PERM = true, INIT = false;
    unsigned char* ws;
    __device__ __forceinline__ bool operator()(f32x4 (&acc)[2][2][4][2], const pg8::Unit& u, int wr, int wc, int fr, int fq) const {
        const int rowb = u.pm * 256 + wr * 64 + fr, colb = u.pn * 256 + wc * 32 + 8 * fq, seg = u.kind;
        constexpr size_t GST = WS_SB - WS_SA;
        static_assert(WS_SM - WS_SB == GST, "gate spacing");
        const unsigned char* __restrict__ NUM = (const unsigned char*)(ws + WS_SA + (size_t)seg * GST);
        const unsigned char* __restrict__ DEN = (const unsigned char*)(ws + WS_SA + (size_t)(seg < 2 ? seg + 1 : 2) * GST);
        bf16_t* __restrict__ MG = (bf16_t*)(ws + WS_MERGED);
#define U8F(w, e) ((float)(((w) >> (8 * (e))) & 0xffu))
#pragma unroll
        for (int ai = 0; ai < 2; ++ai)
#pragma unroll
            for (int m = 0; m < 4; ++m) { const size_t ro = (size_t)(rowb + ai * 128 + m * 16) * DM + colb;
#pragma unroll
                for (int bj = 0; bj < 2; ++bj) {
                    const u32x2 nu = *(const u32x2*)(NUM + ro + bj * 128);
                    f32x4 f0 = {U8F(nu[0], 0), U8F(nu[0], 1), U8F(nu[0], 2), U8F(nu[0], 3)}, f1 = {U8F(nu[1], 0), U8F(nu[1], 1), U8F(nu[1], 2), U8F(nu[1], 3)};
                    if (seg < 2) { const u32x2 de = *(const u32x2*)(DEN + ro + bj * 128);
                        const f32x4 d0 = {U8F(de[0], 0), U8F(de[0], 1), U8F(de[0], 2), U8F(de[0], 3)}, d1 = {U8F(de[1], 0), U8F(de[1], 1), U8F(de[1], 2), U8F(de[1], 3)};
#pragma unroll
                        for (int e = 0; e < 4; ++e) { f0[e] *= __builtin_amdgcn_rcpf(d0[e]); f1[e] *= __builtin_amdgcn_rcpf(d1[e]); }
                        acc[ai][bj][m][0] *= f0; acc[ai][bj][m][1] *= f1;
                    } else { *(bf16x8*)(MG + ro + bj * 128) = pack8(acc[ai][bj][m][0] * f0 * (1.f / 255.f), acc[ai][bj][m][1] * f1 * (1.f / 255.f)); }
                } }
#undef U8F
        return seg == 2;
    }
};
struct Sched3 {
    int G, c; const char* A; const char* B;
    __device__ __forceinline__ bool next(int i, pg8::Unit& u) const { const int L = i * G + c; if (L >= 256) return false; pg8::tile_order(L, 32, 8, u.pm, u.pn); u.kind = 0; return true; }
    __device__ __forceinline__ const char* a_base(const pg8::Unit& u) const { return A + (size_t)u.pm * (256 * DM * 2); }
    __device__ __forceinline__ const char* b_base(const pg8::Unit& u) const { return B + (size_t)u.pn * (256 * DM * 2); }
};
struct Epi3 {
    static constexpr bool PERM = false, INIT = true;
    const float* x; float* out;
    __device__ __forceinline__ void init(f32x4 (&acc)[2][2][4][2], const pg8::Unit& u, int wr, int wc, int fr, int fq) const {
        const int rowb = u.pm * 256 + wr * 64 + fr, colb = u.pn * 256 + wc * 32 + 4 * fq;
#pragma unroll
        for (int ai = 0; ai < 2; ++ai)
#pragma unroll
            for (int m = 0; m < 4; ++m) { const size_t ro = (size_t)(rowb + ai * 128 + m * 16) * DM + colb;
#pragma unroll
                for (int bj = 0; bj < 2; ++bj)
#pragma unroll
                    for (int n = 0; n < 2; ++n) acc[ai][bj][m][n] = *(const f32x4*)(x + ro + bj * 128 + n * 16); }
    }
    __device__ __forceinline__ bool operator()(f32x4 (&acc)[2][2][4][2], const pg8::Unit& u, int wr, int wc, int fr, int fq) const {
        const int rowb = u.pm * 256 + wr * 64 + fr, colb = u.pn * 256 + wc * 32 + 4 * fq;
#pragma unroll
        for (int ai = 0; ai < 2; ++ai)
#pragma unroll
            for (int m = 0; m < 4; ++m) { const size_t ro = (size_t)(rowb + ai * 128 + m * 16) * DM + colb;
#pragma unroll
                for (int bj = 0; bj < 2; ++bj)
#pragma unroll
                    for (int n = 0; n < 2; ++n) *(f32x4*)(out + ro + bj * 128 + n * 16) = acc[ai][bj][m][n]; }
        return true;
    }
};

__device__ __forceinline__ void p2_qkprep(const Params& p, int vcu, int G) {
    const int tid = opaque_tid(), lane = tid & 63, wave = tid >> 6;
    unsigned char* ws = p.ws;
    const bf16_t* QR = (const bf16_t*)(ws + WS_QR); const bf16_t* KR = (const bf16_t*)(ws + WS_KR);
    bf16_t* QN = (bf16_t*)(ws + WS_QN); bf16_t* KN = (bf16_t*)(ws + WS_KN);
    const f32x2* CSB = (const f32x2*)(ws + WS_CSB);
    const float gq0 = p.q_gain[lane], gq1 = p.q_gain[lane + 64], gk0 = p.k_gain[lane], gk1 = p.k_gain[lane + 64];
    const float gA0 = (lane < 64) ? p.q_gain[2 * lane] : 0.f, gA1 = p.q_gain[2 * lane + 1], gB0 = p.k_gain[2 * lane], gB1 = p.k_gain[2 * lane + 1];
    (void)gq0; (void)gq1; (void)gk0; (void)gk1;
    const int NWT = G * NWAVES, w0 = vcu * NWAVES + wave;
#pragma unroll 1
    for (int t = w0; t < T; t += 2 * NWT) {
        const int t1 = (t + NWT < T) ? t + NWT : t;
        unsigned raw[2][10];
#pragma unroll
        for (int u = 0; u < 2; ++u) { const int tt = u ? t1 : t;
#pragma unroll
            for (int r = 0; r < 10; ++r) raw[u][r] = *(const unsigned*)((r < 8 ? QR + (size_t)tt * 1024 + r * 128 : KR + (size_t)tt * 256 + (r - 8) * 128) + 2 * lane); }
        f32x2 cs[2];
        cs[0] = CSB[t * 16 + ((2 * lane) & 15)]; cs[1] = CSB[t1 * 16 + ((2 * lane) & 15)];
        f32x2 cs1[2];
        cs1[0] = CSB[t * 16 + ((2 * lane + 1) & 15)]; cs1[1] = CSB[t1 * 16 + ((2 * lane + 1) & 15)];
        float ss[2][10];
#pragma unroll
        for (int u = 0; u < 2; ++u)
#pragma unroll
            for (int r = 0; r < 10; ++r) { const float x0 = bflo(raw[u][r]), x1 = bfhi(raw[u][r]); ss[u][r] = x0 * x0 + x1 * x1; }
#pragma unroll
        for (int o = 1; o < 64; o <<= 1)
#pragma unroll
            for (int u = 0; u < 2; ++u)
#pragma unroll
                for (int r = 0; r < 10; ++r) ss[u][r] += __shfl_xor(ss[u][r], o);
#pragma unroll
        for (int u = 0; u < 2; ++u) { const int tt = u ? t1 : t; const int b = tt >> 12, sq = tt & (SEQ - 1);
#pragma unroll
            for (int r = 0; r < 10; ++r) {
                const float rs = 1.0f / sqrtf(ss[u][r] * (1.f / 128.f) + EPS);
                float y0 = bflo(raw[u][r]) * rs * (r < 8 ? gA0 : gB0), y1 = bfhi(raw[u][r]) * rs * (r < 8 ? gA1 : gB1);
                const float p0 = __shfl_xor(y0, 8), p1 = __shfl_xor(y1, 8);
                if (lane < 8) { y0 = y0 * cs[u][0] - p0 * cs[u][1]; y1 = y1 * cs1[u][0] - p1 * cs1[u][1]; }
                else if (lane < 16) { y0 = y0 * cs[u][0] + p0 * cs[u][1]; y1 = y1 * cs1[u][0] + p1 * cs1[u][1]; }
                bf16_t* dst = r < 8 ? QN + ((size_t)(b * 8 + r) * SEQ + sq) * 128 : KN + ((size_t)(b * 2 + (r - 8)) * SEQ + sq) * 128;
                *(unsigned*)(dst + 2 * lane) = cvt_pk_bf16(y0, y1);
            } }
    }
}

constexpr int GM_VSTR = 136;
__device__ __forceinline__ void p2_gmlp_unit(const Params& p, LAS unsigned char* lds, int unit) {
    const int tid = opaque_tid(), lane = tid & 63, wave = __builtin_amdgcn_readfirstlane(tid >> 6), r32 = lane & 31, hi = lane >> 5;
    unsigned char* ws = p.ws;
    const int g = unit & 7, ch = unit >> 3, tok0 = ch * 128;
    const bf16_t* AV = (const bf16_t*)(ws + WS_AV); const bf16_t* AU = (const bf16_t*)(ws + WS_AU); const bf16_t* AZ = (const bf16_t*)(ws + WS_AZ);
    bf16_t* XA = (bf16_t*)(ws + WS_XA);
    LAS float* stat = (LAS float*)lds;
    LAS bf16_t* vT = (LAS bf16_t*)(lds + 1024);
    const int tb = wave >> 1, dh = wave & 1, trow = tb * 32 + r32;
    const float* wsp = p.spatial_w + ((size_t)g * 128 + trow) * 128 + 8 * hi;
    f32x4 wf[8][2];
#pragma unroll
    for (int ks = 0; ks < 8; ++ks) { wf[ks][0] = *(const f32x4*)(wsp + 16 * ks); wf[ks][1] = *(const f32x4*)(wsp + 16 * ks + 4); }
    if (tid < 128) { const f32x4* lp = (const f32x4*)((const f32x2*)(ws + WS_LNP) + (size_t)(tok0 + tid) * 16); float s1 = 0.f, s2 = 0.f;
#pragma unroll
        for (int i = 0; i < 8; ++i) { const f32x4 v = lp[i]; s1 += v[0] + v[2]; s2 += v[1] + v[3]; }
        const float mean = s1 * (1.f / 1024.f), var = fmaxf(s2 * (1.f / 1024.f) - mean * mean, 0.f);
        stat[2 * tid] = mean; stat[2 * tid + 1] = 1.0f / sqrtf(var + EPS); }
    __syncthreads();
    {
        u32x4 va[4];
#pragma unroll
        for (int i = 0; i < 4; ++i) { const int it = tid + i * NTHREADS, s_ = it >> 4, d8 = (it & 15) * 8; va[i] = *(const u32x4*)(AV + (size_t)(tok0 + s_) * 1024 + g * 128 + d8); }
        const int d8 = (tid & 15) * 8;
        const f32x4 g0 = *(const f32x4*)(p.gmlp_g + g * 128 + d8), g1 = *(const f32x4*)(p.gmlp_g + g * 128 + d8 + 4), b0 = *(const f32x4*)(p.gmlp_b + g * 128 + d8), b1 = *(const f32x4*)(p.gmlp_b + g * 128 + d8 + 4);
#pragma unroll
        for (int i = 0; i < 4; ++i) { const int it = tid + i * NTHREADS, s_ = it >> 4; const u32x4 a = va[i];
            const float mean = stat[2 * s_], rstd = stat[2 * s_ + 1];
            float f[8] = {bflo(a[0]), bfhi(a[0]), bflo(a[1]), bfhi(a[1]), bflo(a[2]), bfhi(a[2]), bflo(a[3]), bfhi(a[3])};
#pragma unroll
            for (int e = 0; e < 8; ++e) { const float y = (f[e] - mean) * rstd * (e < 4 ? g0[e & 3] : g1[e & 3]) + (e < 4 ? b0[e & 3] : b1[e & 3]); vT[(d8 + e) * GM_VSTR + s_] = f2bf(y); } }
    }
    unsigned short gu[16][2], gz[16][2];
#pragma unroll
    for (int r = 0; r < 16; ++r) { const int tl = tb * 32 + (r & 3) + 8 * (r >> 2) + 4 * hi; const size_t o = (size_t)(tok0 + tl) * 1024 + g * 128 + dh * 64 + r32;
        gu[r][0] = AU[o]; gu[r][1] = AU[o + 32]; gz[r][0] = AZ[o]; gz[r][1] = AZ[o + 32]; }
    __syncthreads();
    f32x16 acc0 = {}, acc1 = {};
#pragma unroll
    for (int ks = 0; ks < 8; ++ks) {
        const int s0 = 16 * ks + 8 * hi;
        f32x4 w0 = wf[ks][0], w1 = wf[ks][1];
#pragma unroll
        for (int e = 0; e < 4; ++e) { if (s0 + e > trow) w0[e] = 0.f; if (s0 + 4 + e > trow) w1[e] = 0.f; }
        const bf16x8 a = pack8(w0, w1);
        const bf16x8 b0 = *(const LAS bf16x8*)(vT + (dh * 64 + r32) * GM_VSTR + s0), b1 = *(const LAS bf16x8*)(vT + (dh * 64 + 32 + r32) * GM_VSTR + s0);
        acc0 = __builtin_amdgcn_mfma_f32_32x32x16_bf16(a, b0, acc0, 0, 0, 0);
        acc1 = __builtin_amdgcn_mfma_f32_32x32x16_bf16(a, b1, acc1, 0, 0, 0);
    }
#pragma unroll
    for (int r = 0; r < 16; ++r) { const int tl = tb * 32 + (r & 3) + 8 * (r >> 2) + 4 * hi; const float bias = p.spatial_b[g * 128 + tl];
        const size_t o = (size_t)(tok0 + tl) * 1024 + g * 128 + dh * 64 + r32;
        XA[o] = f2bf(bf2f(gu[r][0]) * (acc0[r] + bias) * bf2f(gz[r][0]));
        XA[o + 32] = f2bf(bf2f(gu[r][1]) * (acc1[r] + bias) * bf2f(gz[r][1])); }
    __syncthreads();
}

constexpr int MA_KST = 32 * 512, MA_VROW = 72, MA_VST = 256 * MA_VROW;
constexpr int MA_K0 = 2048, MA_V0 = MA_K0 + 2 * MA_KST;
static_assert(MA_V0 + 2 * MA_VST <= MISC_OFF, "mem-attn LDS map");
__device__ __forceinline__ void p2_mem_unit(const Params& p, LAS unsigned char* lds, int unit) {
    const int tid = opaque_tid(), lane = tid & 63, wave = __builtin_amdgcn_readfirstlane(tid >> 6), r32 = lane & 31, hi = lane >> 5;
    unsigned char* ws = p.ws;
    const int qb = unit & 31, h = (unit >> 5) & 3, b = unit >> 7, qg = wave & 3, dhf = wave >> 2;
    const bf16_t* MQ = (const bf16_t*)(ws + WS_MQ); const bf16_t* MZ = (const bf16_t*)(ws + WS_MZ);
    const bf16_t* KM = (const bf16_t*)(ws + WS_KM) + (size_t)(b * 256) * 1024 + h * 256;
    const bf16_t* VT = (const bf16_t*)(ws + WS_VT) + (size_t)(h * 256) * 512 + b * 256;
    bf16_t* XM = (bf16_t*)(ws + WS_XM);
    LAS float* rk = (LAS float*)lds;
    LAS float* gqk = (LAS float*)(lds + 1024);
    u32x4 sk[2], sv[2];
#define MA_LOAD(st) do { _Pragma("unroll") for (int i = 0; i < 2; ++i) { const int q = tid + i * NTHREADS; \
        sk[i] = *(const u32x4*)(KM + (size_t)((st) * 32 + (q >> 5)) * 1024 + (q & 31) * 8); \
        sv[i] = *(const u32x4*)(VT + (size_t)(q >> 2) * 512 + (st) * 32 + (q & 3) * 8); } } while (0)
#define MA_WRITE(bf) do { _Pragma("unroll") for (int i = 0; i < 2; ++i) { const int q = tid + i * NTHREADS; const int key = q >> 5, c = q & 31; \
        *(LAS u32x4*)(lds + MA_K0 + (bf) * MA_KST + key * 512 + ((c ^ (key & 15)) << 4)) = sk[i]; \
        LAS unsigned char* vd = lds + MA_V0 + (bf) * MA_VST + (q >> 2) * MA_VROW + (q & 3) * 16; \
        *(LAS u32x2*)vd = (u32x2){sv[i][0], sv[i][1]}; *(LAS u32x2*)(vd + 8) = (u32x2){sv[i][2], sv[i][3]}; } } while (0)
    if (tid < 256) { const f32x4 pr = *(const f32x4*)((const float*)(ws + WS_RKP) + (size_t)(b * 256 + tid) * 16 + h * 4);
        rk[tid] = 1.0f / sqrtf(((pr[0] + pr[1]) + (pr[2] + pr[3])) * (1.f / 256.f) + EPS); gqk[tid] = p.mq_gain[tid] * p.mk_gain[tid]; }
    __syncthreads();
    const int tq = b * SEQ + qb * 128 + qg * 32 + r32;
    bf16x8 qf[16]; float ssq = 0.f;
#pragma unroll
    for (int ks = 0; ks < 16; ++ks) { const int d0 = 16 * ks + 8 * hi; const u32x4 a = *(const u32x4*)(MQ + (size_t)tq * 1024 + h * 256 + d0);
        f32x4 f0 = {bflo(a[0]), bfhi(a[0]), bflo(a[1]), bfhi(a[1])}, f1 = {bflo(a[2]), bfhi(a[2]), bflo(a[3]), bfhi(a[3])};
        ssq += (f0[0] * f0[0] + f0[1] * f0[1]) + (f0[2] * f0[2] + f0[3] * f0[3]) + (f1[0] * f1[0] + f1[1] * f1[1]) + (f1[2] * f1[2] + f1[3] * f1[3]);
        const f32x4 g0 = *(const LAS f32x4*)(gqk + d0), g1 = *(const LAS f32x4*)(gqk + d0 + 4);
        qf[ks] = pack8(f0 * g0, f1 * g1); }
    ssq += __shfl_xor(ssq, 32);
    const float qs = (1.0f / sqrtf(ssq * (1.f / 256.f) + EPS)) * (0.0625f * LOG2E);
    MA_LOAD(0);
    MA_WRITE(0);
    __syncthreads();
    f32x16 o[4];
#pragma unroll
    for (int db = 0; db < 4; ++db) o[db] = (f32x16){};
    float mrun = -1e30f, l = 0.f;
    const int kx = r32 & 15;
#pragma unroll 1
    for (int st = 0; st < 8; ++st) {
        const int bf = st & 1;
        if (st + 1 < 8) MA_LOAD(st + 1);
        {
            f32x16 a = {};
            const LAS unsigned char* kp = lds + MA_K0 + bf * MA_KST + r32 * 512;
#pragma unroll
            for (int ks = 0; ks < 16; ++ks) { if ((ks & 3) == 0) __builtin_amdgcn_sched_barrier(0); const bf16x8 kf = *(const LAS bf16x8*)(kp + (((2 * ks + hi) ^ kx) << 4)); a = __builtin_amdgcn_mfma_f32_32x32x16_bf16(kf, qf[ks], a, 0, 0, 0); }
            __builtin_amdgcn_sched_barrier(0);
#pragma unroll
            for (int g4 = 0; g4 < 4; ++g4) { const f32x4 rr = *(const LAS f32x4*)(rk + st * 32 + 8 * g4 + 4 * hi);
#pragma unroll
                for (int e = 0; e < 4; ++e) a[4 * g4 + e] *= rr[e] * qs; }
            float bm = a[0];
#pragma unroll
            for (int r = 1; r < 16; ++r) bm = fmaxf(bm, a[r]);
            bm = fmaxf(bm, __shfl_xor(bm, 32));
            if (!__all(bm - mrun <= 8.f)) { const float mn = fmaxf(mrun, bm), al = __builtin_amdgcn_exp2f(mrun - mn); mrun = mn; l *= al;
#pragma unroll
                for (int db = 0; db < 4; ++db) o[db] *= al; }
#pragma unroll
            for (int r = 0; r < 16; ++r) { a[r] = __builtin_amdgcn_exp2f(a[r] - mrun); l += a[r]; }
            u32x4 w0 = {cvt_pk_bf16(a[0], a[1]), cvt_pk_bf16(a[2], a[3]), cvt_pk_bf16(a[4], a[5]), cvt_pk_bf16(a[6], a[7])};
            u32x4 w1 = {cvt_pk_bf16(a[8], a[9]), cvt_pk_bf16(a[10], a[11]), cvt_pk_bf16(a[12], a[13]), cvt_pk_bf16(a[14], a[15])};
            const bf16x8 pf0 = *reinterpret_cast<bf16x8*>(&w0), pf1 = *reinterpret_cast<bf16x8*>(&w1);
            const LAS unsigned char* vp = lds + MA_V0 + bf * MA_VST + (dhf * 128 + r32) * MA_VROW + 8 * hi;
#pragma unroll
            for (int db = 0; db < 4; ++db) {
                const u32x2 lo0 = *(const LAS u32x2*)(vp + db * 32 * MA_VROW), hi0 = *(const LAS u32x2*)(vp + db * 32 * MA_VROW + 16);
                const u32x2 lo1 = *(const LAS u32x2*)(vp + db * 32 * MA_VROW + 32), hi1 = *(const LAS u32x2*)(vp + db * 32 * MA_VROW + 48);
                u32x4 v0 = {lo0[0], lo0[1], hi0[0], hi0[1]}, v1 = {lo1[0], lo1[1], hi1[0], hi1[1]};
                o[db] = __builtin_amdgcn_mfma_f32_32x32x16_bf16(*reinterpret_cast<bf16x8*>(&v0), pf0, o[db], 0, 0, 0);
                o[db] = __builtin_amdgcn_mfma_f32_32x32x16_bf16(*reinterpret_cast<bf16x8*>(&v1), pf1, o[db], 0, 0, 0); }
        }
        if (st + 1 < 8) MA_WRITE(bf ^ 1);
        __syncthreads();
    }
#undef MA_LOAD
#undef MA_WRITE
    l += __shfl_xor(l, 32);
    const float il = __builtin_amdgcn_rcpf(l);
    u32x2 zg[4][4];
#pragma unroll
    for (int db = 0; db < 4; ++db)
#pragma unroll
        for (int g4 = 0; g4 < 4; ++g4) zg[db][g4] = *(const u32x2*)(MZ + (size_t)tq * 1024 + h * 256 + dhf * 128 + db * 32 + 8 * g4 + 4 * hi);
#pragma unroll
    for (int db = 0; db < 4; ++db)
#pragma unroll
        for (int g4 = 0; g4 < 4; ++g4) { const size_t oo = (size_t)tq * 1024 + h * 256 + dhf * 128 + db * 32 + 8 * g4 + 4 * hi;
            const u32x2 z = zg[db][g4];
            u32x2 w; w[0] = cvt_pk_bf16(o[db][4 * g4] * il * bflo(z[0]), o[db][4 * g4 + 1] * il * bfhi(z[0])); w[1] = cvt_pk_bf16(o[db][4 * g4 + 2] * il * bflo(z[1]), o[db][4 * g4 + 3] * il * bfhi(z[1]));
            *(u32x2*)(XM + oo) = w; }
}


__device__ __forceinline__ unsigned wave_sum_dpp(unsigned c) {
    c += (unsigned)__builtin_amdgcn_update_dpp(0, (int)c, 0xB1, 0xF, 0xF, false);
    c += (unsigned)__builtin_amdgcn_update_dpp(0, (int)c, 0x4E, 0xF, 0xF, false);
    c += (unsigned)__builtin_amdgcn_update_dpp(0, (int)c, 0x141, 0xF, 0xF, false);
    c += (unsigned)__builtin_amdgcn_update_dpp(0, (int)c, 0x140, 0xF, 0xF, false);
    { auto r = __builtin_amdgcn_permlane16_swap(c, c, false, false); c = r[0] + r[1]; }
    { auto r = __builtin_amdgcn_permlane32_swap(c, c, false, false); c = r[0] + r[1]; }
    return c;
}
#define CNT4(c0, c1, c2, c3, a, b, c_, d, t) do { unsigned long long m0_, m1_, m2_, m3_; asm volatile( \
    "v_cmp_ge_u32_e64 %[m0], %[va], %[vt]\n\tv_cmp_ge_u32_e64 %[m1], %[vb], %[vt]\n\tv_cmp_ge_u32_e64 %[m2], %[vc], %[vt]\n\tv_cmp_ge_u32_e64 %[m3], %[vd], %[vt]\n\t" \
    "v_addc_co_u32_e64 %[k0], %[m0], %[k0], 0, %[m0]\n\tv_addc_co_u32_e64 %[k1], %[m1], %[k1], 0, %[m1]\n\tv_addc_co_u32_e64 %[k2], %[m2], %[k2], 0, %[m2]\n\tv_addc_co_u32_e64 %[k3], %[m3], %[k3], 0, %[m3]" \
    : [k0] "+v"(c0), [k1] "+v"(c1), [k2] "+v"(c2), [k3] "+v"(c3), [m0] "=&s"(m0_), [m1] "=&s"(m1_), [m2] "=&s"(m2_), [m3] "=&s"(m3_) \
    : [va] "v"(a), [vb] "v"(b), [vc] "v"(c_), [vd] "v"(d), [vt] "v"(t)); } while (0)

__device__ __forceinline__ unsigned sortable(float f) { const unsigned u = __float_as_uint(f); return u ^ ((unsigned)((int)u >> 31) | 0x80000000u); }
#ifndef SPAN_A
#define SPAN_A -1
#endif
#define ACC_T(k, t0v) do { if (SPAN_A >= 100 && blockIdx.x == 0 && threadIdx.x == 0) { volatile LAS unsigned long long* st_ = (volatile LAS unsigned long long*)(lds + MISC_OFF + 16); const unsigned long long n_ = __builtin_amdgcn_s_memrealtime(); st_[16 + (k)] += n_ - (t0v); (t0v) = n_; } } while (0)
__device__ __forceinline__ float relu1(float x) { const int xi = __float_as_int(x); return __int_as_float(xi > 0 ? xi : 0); }
__device__ __forceinline__ void p2_idx_all(const Params& p, LAS unsigned char* lds, int bx, int G, unsigned* qctr) {
    unsigned long long tacc = (SPAN_A >= 100) ? __builtin_amdgcn_s_memrealtime() : 0ull;
    const int tid = opaque_tid(), lane = tid & 63, wave = __builtin_amdgcn_readfirstlane(tid >> 6), r32 = lane & 31, hi = lane >> 5;
    unsigned char* ws = p.ws;
    const bf16_t* IQ = (const bf16_t*)(ws + WS_IQ); const float* IW = (const float*)(ws + WS_IW);
    LAS unsigned* sc = (LAS unsigned*)lds;
    LAS float* iwl0 = (LAS float*)(lds + 131072);
    LAS unsigned* qword = (LAS unsigned*)(lds + 131072 + 1024 + 4096);
#define AF_LOAD(tt0) do { _Pragma("unroll") for (int at = 0; at < 4; ++at) _Pragma("unroll") for (int ks = 0; ks < 4; ++ks) \
        af[at][ks] = *(const bf16x8*)(IQ + (size_t)((tt0) + 2 * at + (r32 >> 4)) * 1024 + (r32 & 15) * 64 + 16 * ks + 8 * hi); } while (0)
    bf16x8 af[4][4];
    int qcur = bx, qnxt = bx + G;
    if (qcur >= 1024) return;
    { const int t0 = (qcur & 1) * SEQ + (511 - (qcur >> 1)) * 8; AF_LOAD(t0); if (tid < 128) iwl0[tid] = IW[(size_t)t0 * 16 + tid]; }
    __syncthreads();
#pragma unroll 1
    for (int k = 0; qcur < 1024; ++k) {
        const int b = qcur & 1, ublk = 511 - (qcur >> 1);
        const int s0 = ublk * 8, t0 = b * SEQ + s0;
        const bf16_t* IK = (const bf16_t*)(ws + WS_IK) + (size_t)(b * SEQ) * 64;
        LAS float* iwl = iwl0 + (k & 1) * 128;
        unsigned qgot = 0u; if (tid == 0) qgot = 2u * (unsigned)G + __hip_atomic_fetch_add(qctr, 1u, __ATOMIC_RELAXED, __HIP_MEMORY_SCOPE_AGENT);
        const int qn_ok = qnxt < 1024 ? qnxt : qcur;
        const int t0n = (qn_ok & 1) * SEQ + (511 - (qn_ok >> 1)) * 8;
        float iwn = 0.f; if (tid < 128) iwn = IW[(size_t)t0n * 16 + tid];
        ACC_T(0, tacc);
        const int ntiles = (s0 + 8 + 31) >> 5;
        bf16x8 kb0[4], kb1[4], kb2[4];
#define IK_LOAD(dst, jj) do { const int jc_ = (jj) < ntiles ? (jj) : 0; _Pragma("unroll") for (int ks = 0; ks < 4; ++ks) dst[ks] = *(const bf16x8*)(IK + (size_t)(32 * jc_ + r32) * 64 + 16 * ks + 8 * hi); } while (0)
#define SCORE_TILE(KB, jj) do { const int k0 = 32 * (jj); \
        _Pragma("unroll") for (int at = 0; at < 4; ++at) { f32x16 a = {}; \
            _Pragma("unroll") for (int ks = 0; ks < 4; ++ks) a = __builtin_amdgcn_mfma_f32_32x32x16_bf16(af[at][ks], KB[ks], a, 0, 0, 0); \
            const f32x4 wa0 = *(const LAS f32x4*)(iwl + (2 * at) * 16 + 4 * hi), wa1 = *(const LAS f32x4*)(iwl + (2 * at) * 16 + 8 + 4 * hi); \
            const f32x4 wb0 = *(const LAS f32x4*)(iwl + (2 * at + 1) * 16 + 4 * hi), wb1 = *(const LAS f32x4*)(iwl + (2 * at + 1) * 16 + 8 + 4 * hi); \
            float pa = 0.f, pb = 0.f; \
            _Pragma("unroll") for (int e = 0; e < 4; ++e) { pa += wa0[e] * relu1(a[e]); pa += wa1[e] * relu1(a[4 + e]); pb += wb0[e] * relu1(a[8 + e]); pb += wb1[e] * relu1(a[12 + e]); } \
            auto rr = __builtin_amdgcn_permlane32_swap(__float_as_uint(pa), __float_as_uint(pb), false, false); \
            const float score = __uint_as_float(rr[0]) + __uint_as_float(rr[1]); \
            const int qi = 2 * at + hi, key = k0 + r32; \
            sc[qi * 4096 + key] = (key <= s0 + qi) ? sortable(score) : 0u; } } while (0)
#ifndef IDX_SCORE_REP
#define IDX_SCORE_REP 1
#endif
#pragma unroll 1
        for (int rep_ = 0; rep_ < IDX_SCORE_REP; ++rep_) {
        IK_LOAD(kb0, wave); IK_LOAD(kb1, wave + NWAVES);
#pragma unroll 1
        for (int j = wave; j < ntiles; j += 3 * NWAVES) {
            IK_LOAD(kb2, j + 2 * NWAVES); SCORE_TILE(kb0, j);
            if (j + NWAVES >= ntiles) break;
            IK_LOAD(kb0, j + 3 * NWAVES); SCORE_TILE(kb1, j + NWAVES);
            if (j + 2 * NWAVES >= ntiles) break;
            IK_LOAD(kb1, j + 4 * NWAVES); SCORE_TILE(kb2, j + 2 * NWAVES);
        }
        }
#undef IK_LOAD
#undef SCORE_TILE
        if (tid == 0) *qword = qgot;
        __syncthreads();
        ACC_T(1, tacc);
        const int s = s0 + wave, n = s + 1;
        unsigned kv[64];
#pragma unroll
        for (int i = 0; i < 64; ++i) { const int key = 64 * i + lane; kv[i] = (key <= s) ? sc[wave * 4096 + key] : 0u; }
        if (tid < 128) iwl0[((k + 1) & 1) * 128 + tid] = iwn;
        const int qnn = (int)*qword;
        AF_LOAD(t0n);
        LDS_WAIT();
        __syncthreads();
        unsigned Tt = 1u; bool exact = true;
        if (n > 256) {
            Tt = 0u; exact = false;
            for (int bit = 31; bit >= 0; --bit) {
                const unsigned cand = Tt | (1u << bit); unsigned c0 = 0, c1 = 0, c2 = 0, c3 = 0;
#pragma unroll
                for (int i = 0; i < 64; i += 4) CNT4(c0, c1, c2, c3, kv[i], kv[i + 1], kv[i + 2], kv[i + 3], cand);
                const unsigned c = wave_sum_dpp((c0 + c1) + (c2 + c3));
                if (c >= 256u) { Tt = cand; if (c == 256u) { exact = true; break; } }
            }
        }
        ACC_T(2, tacc);
        LAS unsigned long long* lm = (LAS unsigned long long*)(lds + 131072 + 1024) + wave * 64;
        if (exact) {
#pragma unroll
            for (int i = 0; i < 64; ++i) { const unsigned long long bal = __ballot(kv[i] >= Tt); if (lane == 0) lm[i] = bal; }
        } else {
            unsigned cg_ = 0;
#pragma unroll
            for (int i = 0; i < 64; ++i) cg_ += (kv[i] > Tt) ? 1u : 0u;
            cg_ = wave_sum_u(cg_);
            const unsigned need = 256u - cg_; unsigned seen = 0u;
#pragma unroll
            for (int i = 0; i < 64; ++i) {
                const unsigned kk = kv[i];
                const unsigned long long eq = __ballot(kk == Tt), gt = __ballot(kk > Tt);
                const unsigned below = (unsigned)__popcll(eq & ((1ull << lane) - 1ull));
                const bool take = (kk == Tt) && (seen + below < need);
                const unsigned long long bal = gt | __ballot(take);
                seen += (unsigned)__popcll(eq);
                if (lane == 0) lm[i] = bal;
            }
        }
        LDS_WAIT(); asm volatile("" ::: "memory");
        const unsigned long long mine = lm[lane];
        ((unsigned long long*)(ws + WS_MASK))[(size_t)(t0 + wave) * 64 + lane] = mine;
        ACC_T(3, tacc);
        qcur = qnxt; qnxt = qnn;
    }
#undef AF_LOAD
    __syncthreads();
}

namespace att {
constexpr int D = 128, NW = 8, QBLK = 32, KVBLK = 64, QB = 256;
constexpr int SHM_V = KVBLK * D * 2, SHM_K = KVBLK * D * 2;
constexpr int EPI_T0 = 2 * SHM_V + 2 * SHM_K + NW * 128 * 4 + 16, EPI_TW = 32 * 272;
constexpr int LDS_NEED = EPI_T0 + NW * EPI_TW;
static_assert(LDS_NEED <= MISC_OFF, "attention LDS map");
constexpr float SCALE = 0.08838834764831845f, THR = 8.f;
#define KSWZ(row, colB) ((row) * 256 + ((colB) ^ (((row) & 7) << 4)))
#define SBAR() __builtin_amdgcn_sched_barrier(0)
__device__ __forceinline__ int v_st(int k, int c) { const int kk = (k & ~0xC) | ((k & 4) << 1) | ((k & 8) >> 1); return ((kk >> 3) * 4 + (c >> 5)) * 512 + ((kk & 7) * 32 + (c & 31)) * 2; }
__device__ __forceinline__ int v_rd_base(int lane) { return ((lane & 3) << 3) | (((lane >> 2) & 3) << 6) | (((lane >> 4) & 1) << 5) | (((lane >> 5) & 1) << 8); }
constexpr int v_rd_off(int d0, int ks, int half) { return d0 * 512 + ks * 4096 + half * 2048; }
__device__ __forceinline__ int crow(int r, int hi) { return (r & 3) + 8 * (r >> 2) + 4 * hi; }
__device__ __forceinline__ bf16x8 load8(const bf16_t* p) { return *reinterpret_cast<const bf16x8*>(p); }
__device__ __forceinline__ void mask_bits(f32x16& p0, f32x16& p1, unsigned w0, unsigned w1, int hi) {
    w0 >>= 4 * hi; w1 >>= 4 * hi;
#pragma unroll
    for (int r = 0; r < 16; ++r) { const int c = (r & 3) + 8 * (r >> 2);
        const unsigned t0 = (unsigned)(((int)(w0 << (31 - c))) >> 31), t1 = (unsigned)(((int)(w1 << (31 - c))) >> 31);
        p0[r] = __uint_as_float((__float_as_uint(p0[r]) & t0) | (0xff800000u & ~t0));
        p1[r] = __uint_as_float((__float_as_uint(p1[r]) & t1) | (0xff800000u & ~t1)); }
}
__device__ __forceinline__ void partialSM(f32x16& p0, f32x16& p1, float& m_reg, float& mn, float& alpha) {
    float pmax = p0[0];
#pragma unroll
    for (int r = 1; r < 16; ++r) pmax = fmaxf(pmax, p0[r]);
#pragma unroll
    for (int r = 0; r < 16; ++r) pmax = fmaxf(pmax, p1[r]);
    { auto rr = __builtin_amdgcn_permlane32_swap(__float_as_uint(pmax), __float_as_uint(pmax), false, false);
      pmax = fmaxf(__uint_as_float(rr[0]), __uint_as_float(rr[1])); }
    constexpr float C2 = 1.4426950408889634f * SCALE;
    if (__builtin_expect(__all((pmax - m_reg) * SCALE <= THR), 1)) { mn = m_reg; alpha = 1.f; }
    else { mn = fmaxf(m_reg, pmax); alpha = __builtin_amdgcn_exp2f((m_reg - mn) * C2); m_reg = mn; }
    const float mnL = -mn * C2;
#pragma unroll
    for (int r = 0; r < 16; ++r) p0[r] = fmaf(p0[r], C2, mnL);
#pragma unroll
    for (int r = 0; r < 16; ++r) p1[r] = fmaf(p1[r], C2, mnL);
#pragma unroll
    for (int r = 0; r < 16; ++r) p0[r] = __builtin_amdgcn_exp2f(p0[r]);
}
__device__ __forceinline__ void finishSM(f32x16& p0, f32x16& p1, float alpha, float& l_reg, bf16x8& pa0, bf16x8& pa1, bf16x8& pa2, bf16x8& pa3) {
#pragma unroll
    for (int r = 0; r < 16; ++r) p1[r] = __builtin_amdgcn_exp2f(p1[r]);
    float ps = 0;
#pragma unroll
    for (int r = 0; r < 16; ++r) ps += p0[r];
#pragma unroll
    for (int r = 0; r < 16; ++r) ps += p1[r];
    { auto rr = __builtin_amdgcn_permlane32_swap(__float_as_uint(ps), __float_as_uint(ps), false, false);
      ps = __uint_as_float(rr[0]) + __uint_as_float(rr[1]); }
    l_reg = l_reg * alpha + ps;
#define PK4(P, B_, OUT) do { unsigned a0 = cvt_pk_bf16(P[B_+0], P[B_+1]), a1 = cvt_pk_bf16(P[B_+2], P[B_+3]);                          \
        unsigned b0 = cvt_pk_bf16(P[B_+4], P[B_+5]), b1 = cvt_pk_bf16(P[B_+6], P[B_+7]);                                             \
        auto r0 = __builtin_amdgcn_permlane32_swap(a0, b0, false, false); auto r1 = __builtin_amdgcn_permlane32_swap(a1, b1, false, false); \
        u32x4 w = {r0[0], r1[0], r0[1], r1[1]}; OUT = *reinterpret_cast<bf16x8*>(&w); } while (0)
    PK4(p0, 0, pa0); PK4(p0, 8, pa1); PK4(p1, 0, pa2); PK4(p1, 8, pa3);
#undef PK4
}
template <int KB>
__device__ __forceinline__ void qkt(f32x16& p0, f32x16& p1, const char* K_lds, int r32, int hi, const bf16x8* qr) {
    p0 = f32x16{}; p1 = f32x16{};
    const char* kb[4];
#pragma unroll
    for (int dd = 0; dd < 4; ++dd) kb[dd] = K_lds + KB * SHM_K + KSWZ(r32, (dd * 16 + hi * 8) * 2);
#pragma unroll
    for (int d0 = 0; d0 < 8; ++d0) { const char* a = kb[d0 & 3] + (d0 >> 2) * 128;
        bf16x8 b0 = *reinterpret_cast<const bf16x8*>(a);
        bf16x8 b1 = *reinterpret_cast<const bf16x8*>(a + 32 * 256);
        p0 = __builtin_amdgcn_mfma_f32_32x32x16_bf16(b0, qr[d0], p0, 0, 0, 0);
        p1 = __builtin_amdgcn_mfma_f32_32x32x16_bf16(b1, qr[d0], p1, 0, 0, 0); }
}
template <int VB>
__device__ __forceinline__ void pv_tile(f32x16* o, int vb0, bf16x8 pa0, bf16x8 pa1, bf16x8 pa2, bf16x8 pa3) {
#define TRRD(dst, off) asm volatile("ds_read_b64_tr_b16 %0, %1 offset:%2" : "=&v"(dst) : "v"(vb0), "i"(off) : "memory")
#define PV_D0(d0) do { s16x4 l0, l1, l2, l3, h0, h1, h2, h3; constexpr int b_ = VB * SHM_V + v_rd_off(d0, 0, 0); \
        TRRD(l0, b_); TRRD(h0, b_ + 2048); TRRD(l1, b_ + 4096); TRRD(h1, b_ + 6144); TRRD(l2, b_ + 8192); TRRD(h2, b_ + 10240); TRRD(l3, b_ + 12288); TRRD(h3, b_ + 14336); \
        asm volatile("s_waitcnt lgkmcnt(0)" ::: "memory"); SBAR();   \
        o[d0] = __builtin_amdgcn_mfma_f32_32x32x16_bf16(pa0, (bf16x8){l0[0], l0[1], l0[2], l0[3], h0[0], h0[1], h0[2], h0[3]}, o[d0], 0, 0, 0);   \
        o[d0] = __builtin_amdgcn_mfma_f32_32x32x16_bf16(pa1, (bf16x8){l1[0], l1[1], l1[2], l1[3], h1[0], h1[1], h1[2], h1[3]}, o[d0], 0, 0, 0);   \
        o[d0] = __builtin_amdgcn_mfma_f32_32x32x16_bf16(pa2, (bf16x8){l2[0], l2[1], l2[2], l2[3], h2[0], h2[1], h2[2], h2[3]}, o[d0], 0, 0, 0);   \
        o[d0] = __builtin_amdgcn_mfma_f32_32x32x16_bf16(pa3, (bf16x8){l3[0], l3[1], l3[2], l3[3], h3[0], h3[1], h3[2], h3[3]}, o[d0], 0, 0, 0); } while (0)
    PV_D0(0); PV_D0(1); PV_D0(2); PV_D0(3);
#undef PV_D0
#undef TRRD
}
struct BlockRef { const bf16_t* Q; const bf16_t* K; const bf16_t* V; const unsigned* M; bf16_t* O; const bf16_t* Z;
                  bf16_t* OPme; const bf16_t* OPot; f32x2* MLme; const f32x2* MLot; unsigned* cnt; int t_lo, NT; };
struct Seam { bf16x8 qr[8]; bf16x8 st_v0, st_v1, st_k0, st_k1; };
#define ROW(p, k0, rr) ((p) + (size_t)((k0) + (rr)) * D + sc)
#define VMW() asm volatile("s_waitcnt vmcnt(0)" ::: "memory")
#define VMWN(n) asm volatile("s_waitcnt vmcnt(%0)" :: "i"(n) : "memory")
#define SLOAD_H(Kp, Vp, k0) do { S.st_v0 = load8(ROW(Vp, k0, sr)); S.st_v1 = load8(ROW(Vp, k0, 32 + sr));              \
                         S.st_k0 = load8(ROW(Kp, k0, sr)); S.st_k1 = load8(ROW(Kp, k0, 32 + sr)); } while (0)
#define SWRITE_HK(bf) do { *(bf16x8*)(K_lds + (bf) * SHM_K + kws) = S.st_k0; *(bf16x8*)(K_lds + (bf) * SHM_K + kws + 32 * 256) = S.st_k1; } while (0)
#define SWRITE_HV(bf) do { *(bf16x8*)(V_lds + (bf) * SHM_V + vst0) = S.st_v0; *(bf16x8*)(V_lds + (bf) * SHM_V + vst1) = S.st_v1; } while (0)
#define SWRITE_H(bf) do { SWRITE_HV(bf); SWRITE_HK(bf); } while (0)
__device__ __forceinline__ void attn_prime(const BlockRef& cur, char* lds, Seam& S) {
    const int tid = opaque_tid(), wid = __builtin_amdgcn_readfirstlane(tid >> 6), lane = tid & 63, r32 = lane & 31, hi = lane >> 5;
    const int sr = tid >> 4, sc = (tid & 15) * 8, kws = KSWZ(sr, sc * 2); char* K_lds = lds + 2 * SHM_V;
#pragma unroll
    for (int d0 = 0; d0 < 8; ++d0) S.qr[d0] = load8(cur.Q + (size_t)(wid * QBLK + r32) * D + d0 * 16 + hi * 8);
    SLOAD_H(cur.K, cur.V, cur.t_lo * KVBLK); VMW(); SWRITE_HK(0);
    __syncthreads();
}
__device__ __forceinline__ void attn_block(const BlockRef& cur, const BlockRef& nxt, char* lds, Seam& S) {
    const int tid = opaque_tid(), wid = __builtin_amdgcn_readfirstlane(tid >> 6), lane = tid & 63, r32 = lane & 31, hi = lane >> 5;
    const int NT = cur.NT, t_lo = cur.t_lo;
    char* V_lds = lds; char* K_lds = lds + 2 * SHM_V;
    float* wsl = (float*)(lds + 2 * SHM_V + 2 * SHM_K) + wid * 128; float* li_l = wsl, * al_l = wsl + 32, * fb_l = wsl + 64;
    volatile unsigned* flag = (volatile unsigned*)(lds + 2 * SHM_V + 2 * SHM_K + NW * 128 * 4);
    float m_reg = -1e30f, l_reg = 0; f32x16 o[4] = {};
    const int sr = tid >> 4, sc = (tid & 15) * 8, vst0 = v_st(sr, sc), vst1 = v_st(32 + sr, sc), kws = KSWZ(sr, sc * 2);
    const int vb0 = (int)(uintptr_t)V_lds + v_rd_base(lane);
    const bf16_t* Kh = cur.K; const bf16_t* Vh = cur.V;
    const unsigned* mrow = cur.M + (size_t)(wid * QBLK + r32) * 128;
#define RESC(a) do { if (__any((a) < 1.f)) { if (hi == 0) al_l[r32] = (a); asm volatile("s_waitcnt lgkmcnt(0)" ::: "memory");              \
                     for (int d_ = 0; d_ < 4; ++d_) for (int r = 0; r < 16; ++r) o[d_][r] *= al_l[crow(r, hi)]; } } while (0)
#define KBASE(t) ((t_lo + (t)) * KVBLK)
#define MLOAD(t) (*(const u32x2*)(mrow + 2 * (t_lo + (t))))
#define SEAM_K0() do { VMWN(8); SWRITE_HK(0); SBAR(); } while (0)
    f32x16 pA0, pA1, pB0, pB1; float mnA, mnB, alA, alB; bf16x8 pa0, pa1, pa2, pa3;
    u32x2 mwA, mwB;
    SWRITE_HV(0); SBAR();
    mwA = MLOAD(0); mwB = MLOAD(1);
    SLOAD_H(Kh, Vh, KBASE(1));
    SBAR(); qkt<0>(pA0, pA1, K_lds, r32, hi, S.qr);
    mask_bits(pA0, pA1, mwA[0], mwA[1], hi); partialSM(pA0, pA1, m_reg, mnA, alA);
    VMW(); SWRITE_H(1);
    __syncthreads();
#define HALF_STEP(PX0, PX1, mnX, alX, mwX, mwY, PY0, PY1, alY, t, KB, VB, SB) do {                                              \
        SBAR(); mwY = MLOAD(((t) + 1 < NT) ? (t) + 1 : (t)); qkt<KB>(PX0, PX1, K_lds, r32, hi, S.qr);     \
        finishSM(PY0, PY1, alY, l_reg, pa0, pa1, pa2, pa3); SBAR();                                                           \
        if ((t) + 1 < NT) { SLOAD_H(Kh, Vh, KBASE((t) + 1)); SBAR(); }                                                        \
        pv_tile<VB>(o, vb0, pa0, pa1, pa2, pa3); mask_bits(PX0, PX1, mwX[0], mwX[1], hi); partialSM(PX0, PX1, m_reg, mnX, alX); \
        __syncthreads();                                                                                                      \
        if ((t) + 1 < NT) { VMW(); SWRITE_H(SB); }                                                                            \
        RESC(alX); __syncthreads(); } while (0)
    for (int t = 1; t + 1 < NT; t += 2) {
        HALF_STEP(pB0, pB1, mnB, alB, mwB, mwA, pA0, pA1, alA, t, 1, 0, 0);
        HALF_STEP(pA0, pA1, mnA, alA, mwA, mwB, pB0, pB1, alB, t + 1, 0, 1, 1);
    }
    SBAR(); qkt<1>(pB0, pB1, K_lds, r32, hi, S.qr); SBAR();
    SLOAD_H(nxt.K, nxt.V, nxt.t_lo * KVBLK); SBAR();
#pragma unroll
    for (int d0 = 0; d0 < 8; ++d0) S.qr[d0] = load8(nxt.Q + (size_t)(wid * QBLK + r32) * D + d0 * 16 + hi * 8);
    SBAR();
    finishSM(pA0, pA1, alA, l_reg, pa0, pa1, pa2, pa3); SBAR();
    pv_tile<0>(o, vb0, pa0, pa1, pa2, pa3);
    mask_bits(pB0, pB1, mwB[0], mwB[1], hi); partialSM(pB0, pB1, m_reg, mnB, alB); __syncthreads(); RESC(alB);
    finishSM(pB0, pB1, alB, l_reg, pa0, pa1, pa2, pa3); SBAR(); pv_tile<1>(o, vb0, pa0, pa1, pa2, pa3);
    SBAR(); SEAM_K0();
    char* Tl = lds + EPI_T0 + wid * EPI_TW;
    if (hi == 0) { li_l[r32] = l_reg; cur.MLme[wid * QBLK + r32] = (f32x2){m_reg, l_reg}; }
    asm volatile("s_waitcnt lgkmcnt(0)" ::: "memory");
#pragma unroll
    for (int r = 0; r < 16; ++r) { const float lr = li_l[crow(r, hi)]; const float rl = lr > 0.f ? __builtin_amdgcn_rcpf(lr) : 0.f;
#pragma unroll
        for (int d0 = 0; d0 < 4; ++d0) *(bf16_t*)(Tl + crow(r, hi) * 272 + (d0 * 32 + r32) * 2) = f2bf(o[d0][r] * rl); }
    asm volatile("s_waitcnt lgkmcnt(0)" ::: "memory");
    const int crw = lane >> 4, ccol = (lane & 15) * 8;
#pragma unroll
    for (int i = 0; i < 8; ++i) { const int row = crw + 4 * i; *(u32x4*)(cur.OPme + (size_t)(wid * QBLK + row) * D + ccol) = *(const u32x4*)(Tl + row * 272 + ccol * 2); }
    VMW(); __syncthreads();
    if (tid == 0) { __builtin_amdgcn_fence(__ATOMIC_RELEASE, "agent"); asm volatile("s_waitcnt vmcnt(0)" ::: "memory");
        *flag = __hip_atomic_fetch_add(cur.cnt, 1u, __ATOMIC_RELAXED, __HIP_MEMORY_SCOPE_AGENT); }
    __syncthreads();
    if (*flag == 1u) {
        if (tid == 0) { __builtin_amdgcn_fence(__ATOMIC_ACQUIRE, "agent"); asm volatile("s_waitcnt vmcnt(0)" ::: "memory"); }
        __syncthreads();
        u32x4 ot[8], zz[8];
#pragma unroll
        for (int i = 0; i < 8; ++i) { const int row = wid * QBLK + crw + 4 * i; ot[i] = *(const u32x4*)(cur.OPot + (size_t)row * D + ccol); zz[i] = *(const u32x4*)(cur.Z + (size_t)row * 1024 + ccol); }
        constexpr float C2 = 1.4426950408889634f * SCALE;
        if (hi == 0) { const f32x2 om = cur.MLot[wid * QBLK + r32]; const float M = fmaxf(m_reg, om[0]);
            const float wa = __builtin_amdgcn_exp2f((m_reg - M) * C2) * l_reg, wb = __builtin_amdgcn_exp2f((om[0] - M) * C2) * om[1];
            const float inv = __builtin_amdgcn_rcpf(wa + wb); li_l[r32] = wa * inv; fb_l[r32] = wb * inv; }
        asm volatile("s_waitcnt lgkmcnt(0)" ::: "memory");
#pragma unroll
        for (int i = 0; i < 8; ++i) { const int row = crw + 4 * i; const float fa = li_l[row], fb = fb_l[row];
            const u32x4 ow = *(const u32x4*)(Tl + row * 272 + ccol * 2); u32x4 w;
#pragma unroll
            for (int e = 0; e < 4; ++e) w[e] = cvt_pk_bf16((bflo(ow[e]) * fa + bflo(ot[i][e]) * fb) * bflo(zz[i][e]), (bfhi(ow[e]) * fa + bfhi(ot[i][e]) * fb) * bfhi(zz[i][e]));
            *(u32x4*)(cur.O + (size_t)(wid * QBLK + row) * 1024 + ccol) = w; }
    }
    __syncthreads();
#undef RESC
#undef KBASE
#undef MLOAD
#undef SEAM_K0
#undef HALF_STEP
}
#undef ROW
#undef VMW
#undef VMWN
#undef SLOAD_H
#undef SWRITE_HK
#undef SWRITE_HV
#undef SWRITE_H
__device__ __forceinline__ BlockRef make_ref(unsigned char* ws, unsigned* ctl, int item, int pass) {
    const int hf = item & 1, xp = (item >> 1) & 7, bh = item >> 4, qb = pass ? 15 - xp : xp, b = bh >> 3, h = bh & 7, kvh = b * 2 + (h >> 2);
    BlockRef r;
    r.Q = (const bf16_t*)(ws + WS_QN) + ((size_t)bh * SEQ + qb * QB) * D;
    r.K = (const bf16_t*)(ws + WS_KN) + (size_t)kvh * SEQ * D; r.V = (const bf16_t*)(ws + WS_VV) + (size_t)kvh * SEQ * D;
    r.M = (const unsigned*)(ws + WS_MASK) + (size_t)(b * SEQ + qb * QB) * 128;
    r.O = (bf16_t*)(ws + WS_XB) + (size_t)(b * SEQ + qb * QB) * 1024 + h * 128;
    r.Z = (const bf16_t*)(ws + WS_BZ) + (size_t)(b * SEQ + qb * QB) * 1024 + h * 128;
    const size_t prow = (size_t)bh * SEQ + qb * QB, hstr = (size_t)16 * SEQ;
    r.OPme = (bf16_t*)(ws + WS_OPART) + ((size_t)hf * hstr + prow) * D; r.OPot = (const bf16_t*)(ws + WS_OPART) + ((size_t)(hf ^ 1) * hstr + prow) * D;
    r.MLme = (f32x2*)(ws + WS_ML) + (size_t)hf * hstr + prow; r.MLot = (const f32x2*)(ws + WS_ML) + (size_t)(hf ^ 1) * hstr + prow;
    r.cnt = ctl + bh * 16 + qb;
    r.NT = 2 * (qb + 1); r.t_lo = hf * r.NT; return r;
}
}


#define XB_TMO      128
#define XB_XCNT(j)  (256  + 64 * (j))
#define XB_XSUB(j)  (1280 + 64 * (j))
#define XB_XGEN(j)  (2304 + 64 * (j))
#define XB_TOP      3328
#define XB_TOPGEN   3392
#define XCD_BAR_WORDS 3456
#define XB_SPIN_CAP (1u << 22)
__device__ __forceinline__ unsigned xb_ld(unsigned* p)              { return __hip_atomic_load(p, __ATOMIC_RELAXED, __HIP_MEMORY_SCOPE_AGENT); }
__device__ __forceinline__ unsigned xb_add(unsigned* p, unsigned v) { return __hip_atomic_fetch_add(p, v, __ATOMIC_RELAXED, __HIP_MEMORY_SCOPE_AGENT); }
__device__ __forceinline__ unsigned xb_xcc_id() { return (unsigned)__builtin_amdgcn_s_getreg((3 << 11) | 20) & 0xFu; }
#define XB_SPIN(cond, bar) do { unsigned _sp = 0; while (cond) { __builtin_amdgcn_s_sleep(1); \
    if ((++_sp & 255u) == 0u) { if (xb_ld(&(bar)[XB_TMO])) break; if (_sp > XB_SPIN_CAP) { atomicAdd(&(bar)[XB_TMO], 1u); break; } } } } while (0)
struct XcdBarrier { unsigned* bar; unsigned x; volatile LAS unsigned* st; };
__device__ __forceinline__ XcdBarrier xcd_barrier_post(unsigned* bar, volatile LAS unsigned* st) {
    XcdBarrier b; b.bar = bar; b.x = xb_xcc_id(); b.st = st;
    if (threadIdx.x == 0) (void)xb_add(&bar[XB_XCNT(b.x)], 1u);
    return b;
}
__device__ __forceinline__ void xcd_barrier_complete(unsigned* bar, unsigned x, unsigned& nloc, unsigned& nx) {
    const unsigned G = gridDim.x * gridDim.y * gridDim.z;
    unsigned sum, cnt, mine, sp = 0u;
    for (;;) {
        sum = 0u; cnt = 0u; mine = 0u;
#pragma unroll
        for (unsigned j = 0; j < 16; ++j) { const unsigned c = xb_ld(&bar[XB_XCNT(j)]); sum += c; cnt += (c > 0u) ? 1u : 0u; mine = (j == x) ? c : mine; }
        if (sum == G) break;
        __builtin_amdgcn_s_sleep(1);
        if ((++sp & 255u) == 0u) { if (xb_ld(&bar[XB_TMO])) break; if (sp > XB_SPIN_CAP) { atomicAdd(&bar[XB_TMO], 1u); break; } }
    }
    nloc = mine > 0u ? mine : 1u; nx = cnt > 0u ? cnt : 1u;
}
__device__ __forceinline__ void xcd_barrier(const XcdBarrier& b) {
    asm volatile("s_waitcnt vmcnt(0)" ::: "memory");
    __syncthreads();
    if (threadIdx.x == 0) {
        unsigned* bar = b.bar;
        __builtin_amdgcn_s_waitcnt(0);
        unsigned nloc = b.st[0], nx = b.st[1];
        if (nloc == 0u) { xcd_barrier_complete(bar, b.x, nloc, nx); b.st[0] = nloc; b.st[1] = nx; }
        const unsigned old = xb_add(&bar[XB_XSUB(b.x)], 1u);
        const unsigned gen = old / nloc;
        if (old + 1u == (gen + 1u) * nloc) {
            __builtin_amdgcn_fence(__ATOMIC_RELEASE, "agent");
            asm volatile("s_waitcnt vmcnt(0)" ::: "memory");
            const unsigned og = xb_add(&bar[XB_TOP], 1u);
            const unsigned tg = og / nx;
            if (og + 1u == (tg + 1u) * nx) xb_add(&bar[XB_TOPGEN], 1u);
            else XB_SPIN(xb_ld(&bar[XB_TOPGEN]) == tg, bar);
            __builtin_amdgcn_fence(__ATOMIC_ACQUIRE, "agent");
            xb_add(&bar[XB_XGEN(b.x)], 1u);
            asm volatile("s_waitcnt vmcnt(0)" ::: "memory");
        } else {
            XB_SPIN(xb_ld(&bar[XB_XGEN(b.x)]) == gen, bar);
            __builtin_amdgcn_fence(__ATOMIC_ACQUIRE, "agent");
            asm volatile("s_waitcnt vmcnt(0)" ::: "memory");
        }
    }
    __syncthreads();
}

constexpr int CW_EXIT = XCD_BAR_WORDS, CW_ATT = XCD_BAR_WORDS + 64, CW_IDXQ = CW_ATT + 256, CW_WORDS = CW_IDXQ + 64;
__device__ unsigned g_ctl[CW_WORDS];

__global__ void __launch_bounds__(NTHREADS, 2) fwd_mega(Params p) {
    extern __shared__ __attribute__((aligned(16))) unsigned char lds_raw[];
    cg::grid_group grid = cg::this_grid();
    LAS unsigned char* lds = (LAS unsigned char*)lds_raw;
    const int G = gridDim.x, bx = blockIdx.x;
    const int vcu = (G % 8 == 0) ? (bx % 8) * (G / 8) + bx / 8 : bx;
    unsigned char* ws = p.ws;
    volatile LAS unsigned* misc = (volatile LAS unsigned*)(lds + MISC_OFF);
    if (threadIdx.x < 2) misc[threadIdx.x] = 0u;
    __syncthreads();
    if (p.out == nullptr) grid.sync();
    const XcdBarrier gbar = xcd_barrier_post(g_ctl, misc);
#define GRID_SYNC() xcd_barrier(gbar)

#ifndef PHASES
#define PHASES 0xffff
#endif
#ifndef REPMASK
#define REPMASK 0
#endif
#define NREP(bit) ((REPMASK & (bit)) ? 2 : 1)
#ifndef SPAN_A
#define SPAN_A -1
#endif
#ifndef SPAN_B
#define SPAN_B -1
#endif
    volatile LAS unsigned long long* stamps = (volatile LAS unsigned long long*)(lds + MISC_OFF + 16);
#define STAMP(k) do { if (SPAN_A >= 0 && bx == 0 && threadIdx.x == 0) stamps[k] = __builtin_amdgcn_s_memrealtime(); } while (0)
    STAMP(0);
    if (SPAN_A >= 0 && bx == 0 && threadIdx.x == 0) { stamps[16] = 0; stamps[17] = 0; stamps[18] = 0; stamps[19] = 0; }
    for (int rep = 0; rep < NREP(1); ++rep) if (PHASES & 1) p0_prep(p, lds, vcu, G);
    GRID_SYNC(); STAMP(1);
    for (int rep = 0; rep < NREP(2); ++rep) if (PHASES & 2) {
        Sched1 S{G, bx, (const char*)ws};
        Epi1 E{ws, p.ik_g, p.ik_b};
        pg8::gemm_phase<Epi1, Sched1, true, true>(lds, DM, S, E);
    }
    if (PHASES & 1) { constexpr int NU1A = 32 * NT_BF + 16; const int nfull = (NU1A % G == 0) ? 0 : NU1A % G; const int nhelp = G - nfull;
        if (nhelp == G) p0b_gate8(p, lds, bx, G); else if (bx >= nfull) p0b_gate8(p, lds, bx - nfull, nhelp); }
    STAMP(14);
    GRID_SYNC();
    if (PHASES & 2) {
        Sched1b S{G, bx, (const char*)ws}; Epi1b E{ws};
        pg8::gemm_phase<Epi1b, Sched1b, true, true, true>(lds, DM / 2, S, E);
    }
    GRID_SYNC(); STAMP(2);
    for (int rep = 0; rep < NREP(4); ++rep) if (PHASES & 4) p2_qkprep(p, vcu, G);
    STAMP(3);
    for (int rep = 0; rep < NREP(8); ++rep) if (PHASES & 8) for (int u = bx; u < 512; u += G) p2_gmlp_unit(p, lds, u);
    STAMP(4);
    for (int rep = 0; rep < NREP(16); ++rep) if (PHASES & 16) for (int u = bx; u < 256; u += G) p2_mem_unit(p, lds, u);
    STAMP(5);
    for (int rep = 0; rep < NREP(32); ++rep) if (PHASES & 32) p2_idx_all(p, lds, bx, G, g_ctl + CW_IDXQ);
    STAMP(6);
    GRID_SYNC(); STAMP(7);
    for (int rep = 0; rep < NREP(64); ++rep) if (PHASES & 64) {
        const int L0 = (G == 256) ? ((bx & 7) * 32 + (bx >> 3)) : bx;
        if (L0 < 256) {
            int L = L0, pass = 0;
            att::Seam S; att::BlockRef cur = att::make_ref(ws, g_ctl + CW_ATT, L, 0);
            att::attn_prime(cur, (char*)lds_raw, S);
            STAMP(11);
            for (;;) {
                const bool more_pass = pass == 0, more_item = L + G < 256, last = !more_pass && !more_item;
                const int Ln = more_pass ? L : (more_item ? L + G : L), pn = more_pass ? 1 : 0;
                const att::BlockRef nxt = last ? cur : att::make_ref(ws, g_ctl + CW_ATT, Ln, pn);
                att::attn_block(cur, nxt, (char*)lds_raw, S);
                STAMP(12 + pass);
                if (last) break;
                cur = nxt; L = Ln; pass = pn;
            }
        }
    }
    GRID_SYNC(); STAMP(8);
    for (int rep = 0; rep < NREP(128); ++rep) if (PHASES & 128) {
        Sched2 S{G, bx, (const char*)ws};
        Epi2 E{ws};
        pg8::gemm_phase<Epi2, Sched2, true, true>(lds, 1024, S, E);
    }
    GRID_SYNC(); STAMP(9);
    if (REPMASK & 512) { for (int i = 0; i < 10; ++i) GRID_SYNC(); }
    for (int rep = 0; rep < NREP(256); ++rep) if (PHASES & 256) {
        Sched3 S{G, bx, (const char*)(ws + WS_MERGED), (const char*)(ws + WS_WOUT)};
        Epi3 E{p.x, p.out};
        pg8::gemm_phase<Epi3, Sched3, true, true>(lds, DM, S, E);
    }
    STAMP(10);
    if (SPAN_A >= 0 && bx == 0 && threadIdx.x == 0) {
        const unsigned long long dt = (SPAN_A >= 100) ? stamps[SPAN_A - 100 + 16] : (stamps[SPAN_B] - stamps[SPAN_A]), t0 = __builtin_amdgcn_s_memrealtime();
        while (__builtin_amdgcn_s_memrealtime() - t0 < dt) __builtin_amdgcn_s_sleep(8);
    }
    __syncthreads();
    if (threadIdx.x == 0) misc[0] = (xb_add(&g_ctl[CW_EXIT], 1u) == (unsigned)G - 1u) ? 1u : 0u;
    __syncthreads();
    if (misc[0]) { for (int i = threadIdx.x; i < CW_WORDS; i += NTHREADS) __hip_atomic_store(&g_ctl[i], 0u, __ATOMIC_RELAXED, __HIP_MEMORY_SCOPE_AGENT);
                   for (int i = threadIdx.x; i < NGATE; i += NTHREADS) __hip_atomic_store(&g_colmax[i], 0u, __ATOMIC_RELAXED, __HIP_MEMORY_SCOPE_AGENT); }
}

extern "C" void kernel_launch(void* const* d_in, const int* in_sizes, int n_in, void* d_out, int out_size, void* d_ws, size_t ws_size, hipStream_t stream) {
    static int grid_blocks = 0;
    if (!grid_blocks) {
        if (n_in != 21 || out_size != T * DM || ws_size < WS_TOTAL) { fprintf(stderr, "kernel_launch: unexpected shapes (n_in %d out %d ws %zu)\n", n_in, out_size, ws_size); grid_blocks = -1; return; }
        int dev = 0, cus = 0, per_cu = 0;
        (void)hipGetDevice(&dev);
        (void)hipDeviceGetAttribute(&cus, hipDeviceAttributeMultiprocessorCount, dev);
        (void)hipFuncSetAttribute((const void*)fwd_mega, hipFuncAttributeMaxDynamicSharedMemorySize, LDS_BYTES);
        (void)hipOccupancyMaxActiveBlocksPerMultiprocessor(&per_cu, (const void*)fwd_mega, NTHREADS, LDS_BYTES);
        if (per_cu < 1) { fprintf(stderr, "kernel_launch: occupancy query returned %d\n", per_cu); grid_blocks = -1; return; }
        grid_blocks = cus;
        fprintf(stderr, "kernel_launch: cus %d per_cu %d grid %d\n", cus, per_cu, grid_blocks);
    }
    if (grid_blocks < 0) return;
    Params p{};
    p.x = (const float*)d_in[0]; p.mem = (const float*)d_in[1]; p.pos = (const int*)d_in[2]; p.norm_gain = (const float*)d_in[3]; p.w_in = (const float*)d_in[4];
    p.gmlp_g = (const float*)d_in[5]; p.gmlp_b = (const float*)d_in[6]; p.spatial_w = (const float*)d_in[7]; p.spatial_b = (const float*)d_in[8]; p.w_a = (const float*)d_in[9];
    p.q_gain = (const float*)d_in[10]; p.k_gain = (const float*)d_in[11]; p.ik_g = (const float*)d_in[12]; p.ik_b = (const float*)d_in[13]; p.w_b = (const float*)d_in[14];
    p.mem_gain = (const float*)d_in[15]; p.w_mkv = (const float*)d_in[16]; p.mq_gain = (const float*)d_in[17]; p.mk_gain = (const float*)d_in[18]; p.w_m = (const float*)d_in[19];
    p.w_out = (const float*)d_in[20]; p.out = (float*)d_out; p.ws = (unsigned char*)d_ws;
    void* args[] = {&p};
    hipError_t e = hipLaunchCooperativeKernel((const void*)fwd_mega, dim3(grid_blocks), dim3(NTHREADS), args, LDS_BYTES, stream);
    if (e != hipSuccess) fprintf(stderr, "cooperative launch failed: %s (grid %d)\n", hipGetErrorString(e), grid_blocks);
}
```

```cpp
#include <hip/hip_runtime.h>
#include <hip/hip_cooperative_groups.h>
#include <cstdio>
#include <cstdint>
namespace cg = cooperative_groups;

#define LAS __attribute__((address_space(3)))
typedef unsigned short bf16_t;
typedef short bf16x8 __attribute__((ext_vector_type(8)));
typedef short s16x4 __attribute__((ext_vector_type(4)));
typedef float f32x2 __attribute__((ext_vector_type(2)));
typedef float f32x4 __attribute__((ext_vector_type(4)));
typedef float f32x16 __attribute__((ext_vector_type(16)));
typedef unsigned u32x2 __attribute__((ext_vector_type(2)));
typedef unsigned u32x4 __attribute__((ext_vector_type(4)));
typedef int i32x4 __attribute__((ext_vector_type(4)));

constexpr int NB = 2, SEQ = 4096, T = NB * SEQ, DM = 2048, DIN = 14928, NPAD = 15104, MEML = 256;
constexpr int NTHREADS = 512, NWAVES = 8;
constexpr int LDS_BYTES = 147456;
constexpr float EPS = 1e-6f;
constexpr float LOG2E = 1.4426950408889634f;

constexpr size_t MiB = (size_t)1 << 20;
constexpr size_t WS_WIN = 0, WS_WBR = 60 * MiB, WS_WOUT = 72 * MiB, WS_WMKV = 80 * MiB, WS_H = 88 * MiB, WS_MEMN = 120 * MiB;
constexpr size_t WS_AU = 122 * MiB, WS_AV = 138 * MiB, WS_AZ = 154 * MiB, WS_QR = 170 * MiB, WS_BZ = 186 * MiB, WS_MQ = 202 * MiB, WS_MZ = 218 * MiB;
constexpr size_t WS_IQ = 234 * MiB, WS_KR = 250 * MiB, WS_VV = 254 * MiB, WS_SA = 258 * MiB, WS_SB = 290 * MiB, WS_SM = 322 * MiB;
constexpr size_t WS_QN = 354 * MiB, WS_KN = 370 * MiB, WS_XA = 374 * MiB, WS_XM = 390 * MiB, WS_MASK = 406 * MiB, WS_IK = 410 * MiB, WS_IW = 411 * MiB;
constexpr size_t WS_KM = 412 * MiB, WS_VT = 413 * MiB, WS_CSB = 414 * MiB, WS_CSI = 415 * MiB, WS_END = 416 * MiB;
constexpr size_t WS_RKP = WS_IW + 524288;
constexpr size_t WS_OPART = WS_END, WS_ML = WS_END + 32 * MiB, WS_TOTAL = WS_END + 34 * MiB;
constexpr size_t WS_CTL = WS_END, CTL_BYTES = 65536;
constexpr int NGATE = 8192, GATE0 = 6736, NT_BF = 27;
constexpr size_t WS_LNP = 48 * MiB;
constexpr size_t WS_W8 = 27 * MiB, WS_SH = 47 * MiB, WS_SW = 47 * MiB + 65536, WS_CMP = 47 * MiB + 131072, WS_H8 = WS_OPART;
static_assert(WS_W8 + (size_t)NGATE * DM <= WS_SH && WS_CMP + 8 * NGATE * 4 <= WS_WBR && (size_t)NT_BF * 256 * DM * 2 <= WS_W8, "int8 regions inside the WS_WIN slot");
constexpr int CW_BAR = 0;
constexpr int MISC_OFF = 147200;
constexpr size_t WS_XB = WS_QR;
constexpr size_t WS_MERGED = WS_H;

typedef __bf16 bf16x2_t __attribute__((ext_vector_type(2)));
__device__ __forceinline__ unsigned cvt_pk_bf16(float lo, float hi) { const f32x2 v = {lo, hi}; const bf16x2_t b = __builtin_convertvector(v, bf16x2_t); return __builtin_bit_cast(unsigned, b); }
__device__ __forceinline__ bf16_t f2bf(float f) { return (bf16_t)(cvt_pk_bf16(f, 0.f) & 0xffffu); }
__device__ __forceinline__ float bf2f(unsigned short b) { return __uint_as_float(((unsigned)b) << 16); }
__device__ __forceinline__ float bflo(unsigned w) { return __uint_as_float(w << 16); }
__device__ __forceinline__ float bfhi(unsigned w) { return __uint_as_float(w & 0xffff0000u); }
__device__ __forceinline__ float sigm(float x) { return __builtin_amdgcn_rcpf(1.f + __builtin_amdgcn_exp2f(-LOG2E * x)); }
__device__ __forceinline__ float silu_f(float x) { return x * sigm(x); }
__device__ __forceinline__ float gelu_f(float x) { const float u = 0.7978845608028654f * (x + 0.044715f * x * x * x); return x * sigm(2.f * u); }
__device__ __forceinline__ float wave_sum(float v) {
#pragma unroll
    for (int o = 1; o < 64; o <<= 1) v += __shfl_xor(v, o);
    return v;
}
__device__ __forceinline__ unsigned wave_sum_u(unsigned v) {
#pragma unroll
    for (int o = 1; o < 64; o <<= 1) v += (unsigned)__shfl_xor((int)v, o);
    return v;
}
__device__ __forceinline__ bf16x8 pack8(f32x4 a, f32x4 b) {
    u32x4 w = {cvt_pk_bf16(a[0], a[1]), cvt_pk_bf16(a[2], a[3]), cvt_pk_bf16(b[0], b[1]), cvt_pk_bf16(b[2], b[3])};
    return *reinterpret_cast<bf16x8*>(&w);
}
#define LDS_WAIT() asm volatile("s_waitcnt lgkmcnt(0)" ::: "memory")
__device__ __forceinline__ int opaque_tid() { int t = threadIdx.x; asm volatile("" : "+v"(t)); return t; }

namespace pg8 {
constexpr int BM = 256, BK = 64, HALF = 128, HTB = HALF * BK * 2, STAGE_BYTES = 8 * HTB, NXCD = 8, WGM = 8;
__host__ __device__ __forceinline__ int lds_byte(int r, int c) { const int st = (r >> 4) * 2 + (c >> 5), rr = r & 15, cc = c & 31, ob = rr * 64 + cc * 2; return st * 1024 + (ob ^ (((ob >> 9) & 1) << 5)); }
__host__ __device__ __forceinline__ void stage_rc(int b, int& R, int& C) { const int st = b / 1024, sb = b % 1024, swz = sb ^ (((sb >> 9) & 1) << 5); R = (st >> 1) * 16 + swz / 64; C = (st & 1) * 32 + (swz % 64) / 2; }
__host__ __device__ __forceinline__ int perm32(int rho) { const int n = rho >> 4, i = rho & 15; return 8 * (i >> 2) + 4 * n + (i & 3); }

struct Unit { int pm, pn, kind; };

__device__ __forceinline__ void tile_order(int wgid, int nM, int nN, int& pm, int& pn) {
    const int nwg = nM * nN;
    { const int q = nwg / NXCD, r = nwg % NXCD, xcd = wgid % NXCD, off = wgid / NXCD; wgid = (xcd < r ? xcd * (q + 1) : r * (q + 1) + (xcd - r) * q) + off; }
    const int nig = WGM * nN, gid = wgid / nig, fm = gid * WGM, gsz = (nM - fm) < WGM ? (nM - fm) : WGM;
    pm = fm + ((wgid % nig) % gsz); pn = (wgid % nig) / gsz;
}

template <class Epi, class Sched, bool ALIGN_EPI, bool SP2, bool I8 = false>
__device__ __forceinline__ void gemm_phase(LAS unsigned char* lds, const int K, const Sched& S, const Epi& E) {
    const int tid = opaque_tid(), wid = __builtin_amdgcn_readfirstlane(tid >> 6), lane = tid & 63, wr = wid >> 2, wc = wid & 3, fr = lane & 15, fq = lane >> 4;
    const int nt = K / BK;
    unsigned voffA[2], voffB[2];
#pragma unroll
    for (int i = 0; i < 2; ++i) { int R, C; stage_rc(tid * 16 + i * 8192, R, C); const int Rb = Epi::PERM ? ((R & ~31) + perm32(R & 31)) : R;
        voffA[i] = (unsigned)(R * K + C) * 2u; voffB[i] = (unsigned)(Rb * K + C) * 2u; }
    const size_t kstep = (size_t)(BK * 2);
    const size_t hstep = (size_t)HALF * K * 2;
    const unsigned ldsw = (unsigned)wid * 1024u;
    const int aoff = lds_byte(wr * 64 + fr, fq * 8), boff = lds_byte(wc * 32 + fr, fq * 8);
#define PG8_SA(b, h) (((b) * 2 + (h)) * HTB)
#define PG8_SB(b, h) ((4 + (b) * 2 + (h)) * HTB)
#define PG8_STAGE(bufoff, gbase, voff) do { _Pragma("unroll") for (int _i = 0; _i < 2; ++_i) \
        __builtin_amdgcn_global_load_lds((const unsigned*)((const char*)(gbase) + (voff)[_i]), (LAS unsigned*)(lds + (bufoff) + ldsw + _i * 8192), 16, 0, 0); } while (0)
#define PG8_LDA(dst, b, h) do { _Pragma("unroll") for (int m = 0; m < 4; ++m) _Pragma("unroll") for (int k = 0; k < 2; ++k) dst[m][k] = *(const LAS bf16x8*)(lds + PG8_SA(b, h) + aoff + m * 2048 + k * 1024); } while (0)
#define PG8_LDB(dst, b, h) do { _Pragma("unroll") for (int n = 0; n < 2; ++n) _Pragma("unroll") for (int k = 0; k < 2; ++k) dst[n][k] = *(const LAS bf16x8*)(lds + PG8_SB(b, h) + boff + n * 2048 + k * 1024); } while (0)
#define PG8_MMA(ai, bj, At, Bt) do { __builtin_amdgcn_s_setprio(1); _Pragma("unroll") for (int m = 0; m < 4; ++m) _Pragma("unroll") for (int n = 0; n < 2; ++n) _Pragma("unroll") for (int k = 0; k < 2; ++k) \
        { if constexpr (I8) acc[ai][bj][m][n] = __builtin_bit_cast(f32x4, __builtin_amdgcn_mfma_i32_16x16x64_i8(__builtin_bit_cast(i32x4, Bt[n][k]), __builtin_bit_cast(i32x4, At[m][k]), __builtin_bit_cast(i32x4, acc[ai][bj][m][n]), 0, 0, 0)); \
          else acc[ai][bj][m][n] = __builtin_amdgcn_mfma_f32_16x16x32_bf16(Bt[n][k], At[m][k], acc[ai][bj][m][n], 0, 0, 0); } __builtin_amdgcn_s_setprio(0); } while (0)
#define PG8_WAIT_V(n) asm volatile("s_waitcnt vmcnt(" #n ")" ::: "memory")
#define PG8_WAIT_L(n) asm volatile("s_waitcnt lgkmcnt(" #n ")" ::: "memory")
#define PG8_BAR __builtin_amdgcn_s_barrier()
#define PG8_SCHED __builtin_amdgcn_sched_barrier(0)
    Unit cur, nxt; int ui = 0;
    if (!S.next(0, cur)) return;
    f32x4 acc[2][2][4][2];
    if constexpr (Epi::INIT) E.init(acc, cur, wr, wc, fr, fq);
    else {
#pragma unroll
    for (int a = 0; a < 2; ++a)
#pragma unroll
        for (int b = 0; b < 2; ++b)
#pragma unroll
            for (int m = 0; m < 4; ++m)
#pragma unroll
                for (int n = 0; n < 2; ++n) acc[a][b][m][n] = (f32x4){0.f, 0.f, 0.f, 0.f};
    }
    bf16x8 At[4][2], B0[2][2], B1[2][2];
    const char* cA = S.a_base(cur); const char* cB = S.b_base(cur);
    if constexpr (SP2) {
        PG8_STAGE(PG8_SB(0, 0), cB, voffB); PG8_STAGE(PG8_SB(0, 1), cB + hstep, voffB); PG8_STAGE(PG8_SA(0, 0), cA, voffA); PG8_STAGE(PG8_SA(0, 1), cA + hstep, voffA);
        if (wr == 1) PG8_BAR;
        PG8_WAIT_V(2); PG8_BAR;
        PG8_STAGE(PG8_SB(1, 0), cB + kstep, voffB); PG8_STAGE(PG8_SA(1, 0), cA + kstep, voffA); PG8_STAGE(PG8_SB(1, 1), cB + hstep + kstep, voffB);
        PG8_WAIT_V(6); PG8_BAR;
    } else {
        PG8_STAGE(PG8_SB(0, 0), cB, voffB); PG8_STAGE(PG8_SA(0, 0), cA, voffA); PG8_STAGE(PG8_SB(0, 1), cB + hstep, voffB); PG8_STAGE(PG8_SA(0, 1), cA + hstep, voffA);
        if (wr == 1) PG8_BAR;
        PG8_WAIT_V(4); PG8_BAR;
        PG8_STAGE(PG8_SB(1, 0), cB + kstep, voffB); PG8_STAGE(PG8_SA(1, 0), cA + kstep, voffA); PG8_STAGE(PG8_SB(1, 1), cB + hstep + kstep, voffB);
        PG8_WAIT_V(6); PG8_BAR;
    }
    for (;;) {
        const bool has_next = S.next(ui + 1, nxt);
        const char* nA = has_next ? S.a_base(nxt) : cA; const char* nB = has_next ? S.b_base(nxt) : cB;
        for (int t = 0; t < nt; t += 2) {
            const bool last = (t == nt - 2);
            const char* a1 = cA + (size_t)(t + 1) * kstep;
            const char* a2 = last ? nA : cA + (size_t)(t + 2) * kstep; const char* b2 = last ? nB : cB + (size_t)(t + 2) * kstep;
            const char* a3 = a2 + kstep; const char* b3 = b2 + kstep;
            if constexpr (SP2) {
            PG8_LDB(B0, 0, 0); PG8_LDB(B1, 0, 1); PG8_SCHED; PG8_LDA(At, 0, 0); PG8_STAGE(PG8_SA(1, 1), a1 + hstep, voffA);
            PG8_WAIT_V(8); PG8_WAIT_L(0); PG8_BAR; PG8_MMA(0, 0, At, B0); PG8_MMA(0, 1, At, B1); PG8_BAR; PG8_SCHED;
            PG8_LDA(At, 0, 1); PG8_STAGE(PG8_SB(0, 0), b2, voffB); PG8_STAGE(PG8_SB(0, 1), b2 + hstep, voffB); PG8_STAGE(PG8_SA(0, 0), a2, voffA);
            PG8_WAIT_V(8); PG8_WAIT_L(0); PG8_BAR; PG8_MMA(1, 0, At, B0); PG8_MMA(1, 1, At, B1); PG8_BAR; PG8_SCHED;
            PG8_LDB(B0, 1, 0); PG8_LDB(B1, 1, 1); PG8_SCHED; PG8_LDA(At, 1, 0); PG8_STAGE(PG8_SA(0, 1), a2 + hstep, voffA);
            PG8_WAIT_V(8); PG8_WAIT_L(0); PG8_BAR; PG8_MMA(0, 0, At, B0); PG8_MMA(0, 1, At, B1); PG8_BAR; PG8_SCHED;
            PG8_LDA(At, 1, 1); PG8_STAGE(PG8_SB(1, 0), b3, voffB); PG8_STAGE(PG8_SB(1, 1), b3 + hstep, voffB); PG8_STAGE(PG8_SA(1, 0), a3, voffA);
            PG8_WAIT_V(8); PG8_WAIT_L(0); PG8_BAR; PG8_MMA(1, 0, At, B0); PG8_MMA(1, 1, At, B1); PG8_BAR; PG8_SCHED;
            } else {
            PG8_LDB(B0, 0, 0); PG8_SCHED; PG8_LDA(At, 0, 0); PG8_STAGE(PG8_SA(1, 1), a1 + hstep, voffA);
            PG8_WAIT_L(8); PG8_BAR; PG8_WAIT_L(0); PG8_MMA(0, 0, At, B0); PG8_BAR; PG8_SCHED;
            PG8_LDB(B1, 0, 1); PG8_STAGE(PG8_SB(0, 0), b2, voffB);
            PG8_BAR; PG8_WAIT_L(0); PG8_MMA(0, 1, At, B1); PG8_BAR;
            PG8_LDA(At, 0, 1); PG8_STAGE(PG8_SA(0, 0), a2, voffA);
            PG8_BAR; PG8_WAIT_L(0); PG8_MMA(1, 0, At, B0); PG8_BAR; PG8_SCHED;
            PG8_STAGE(PG8_SB(0, 1), b2 + hstep, voffB);
            PG8_WAIT_V(6); PG8_BAR; PG8_MMA(1, 1, At, B1); PG8_BAR;
            PG8_LDB(B0, 1, 0); PG8_SCHED; PG8_LDA(At, 1, 0); PG8_STAGE(PG8_SA(0, 1), a2 + hstep, voffA);
            PG8_WAIT_L(8); PG8_BAR; PG8_WAIT_L(0); PG8_MMA(0, 0, At, B0); PG8_BAR; PG8_SCHED;
            PG8_LDB(B1, 1, 1); PG8_STAGE(PG8_SB(1, 0), b3, voffB);
            PG8_BAR; PG8_WAIT_L(0); PG8_MMA(0, 1, At, B1); PG8_BAR;
            PG8_LDA(At, 1, 1); PG8_STAGE(PG8_SA(1, 0), a3, voffA);
            PG8_BAR; PG8_WAIT_L(0); PG8_MMA(1, 0, At, B0); PG8_BAR; PG8_SCHED;
            PG8_STAGE(PG8_SB(1, 1), b3 + hstep, voffB);
            PG8_WAIT_V(6); PG8_BAR; PG8_MMA(1, 1, At, B1); PG8_BAR;
            }
        }
        if constexpr (ALIGN_EPI) { if (wr == 0) PG8_BAR; }
        const bool zero = E(acc, cur, wr, wc, fr, fq);
        if (!has_next) break;
        if constexpr (Epi::INIT) { E.init(acc, nxt, wr, wc, fr, fq); }
        else if (zero) {
#pragma unroll
        for (int a = 0; a < 2; ++a)
#pragma unroll
            for (int b = 0; b < 2; ++b)
#pragma unroll
                for (int m = 0; m < 4; ++m)
#pragma unroll
                    for (int n = 0; n < 2; ++n) acc[a][b][m][n] = (f32x4){0.f, 0.f, 0.f, 0.f};
        }
        cur = nxt; cA = nA; cB = nB; ++ui;
        if constexpr (ALIGN_EPI) { if (wr == 1) PG8_BAR; }
    }
    PG8_WAIT_V(0);
    if constexpr (!ALIGN_EPI) { if (wr == 0) PG8_BAR; }
    PG8_BAR;
#undef PG8_SA
#undef PG8_SB
#undef PG8_STAGE
#undef PG8_LDA
#undef PG8_LDB
#undef PG8_MMA
#undef PG8_WAIT_V
#undef PG8_WAIT_L
#undef PG8_BAR
#undef PG8_SCHED
}
}

struct Params {
    const float* x; const float* mem; const int* pos; const float* norm_gain; const float* w_in; const float* gmlp_g; const float* gmlp_b;
    const float* spatial_w; const float* spatial_b; const float* w_a; const float* q_gain; const float* k_gain; const float* ik_g; const float* ik_b;
    const float* w_b; const float* mem_gain; const float* w_mkv; const float* mq_gain; const float* mk_gain; const float* w_m; const float* w_out;
    float* out; unsigned char* ws;
};

__device__ unsigned g_colmax[8192];

__device__ __forceinline__ int win_src_col(int np) {
    const int tile = np >> 8, c = np & 255;
    if (tile < 22) return np;
    const int bj = c >> 7, wc = (c >> 5) & 3, fq = (c >> 3) & 3, j = c & 7;
    if (tile < 26) return 5632 + (tile - 22) * 256 + wc * 64 + 8 * (2 * fq + bj) + j;
    if (tile == 26) {
        if (wc == 0) return 6656 + 8 * (2 * fq + bj) + j;
        if (wc == 1 && fq == 0) return 6720 + 8 * bj + j;
        return -1;
    }
    return np - 176;
}
__device__ __forceinline__ void transpose_item(const float* W, int K, int N, bf16_t* WT, int kb, int nb, bool is_win, LAS float* scr, int lane) {
    const int k0 = 64 * kb, n0 = 32 * nb, nl = lane & 31;
    const int src = is_win ? win_src_col(n0 + nl) : (n0 + nl);
    const float* wp = W + (size_t)(k0 + (lane >> 5)) * N + (src >= 0 ? src : 0);
    float tv[32];
#pragma unroll
    for (int i = 0; i < 32; ++i) tv[i] = wp[(size_t)(2 * i) * N];
#pragma unroll
    for (int i = 0; i < 32; ++i) { const int kk = 2 * i + (lane >> 5); scr[kk * 33 + nl] = src >= 0 ? tv[i] : 0.f; }
    LDS_WAIT(); asm volatile("" ::: "memory");
    const int c = lane & 7;
#pragma unroll
    for (int j = 0; j < 4; ++j) { const int n = (lane >> 3) + 8 * j; const LAS float* s = scr + (8 * c) * 33 + n;
        u32x4 o; o.x = cvt_pk_bf16(s[0 * 33], s[1 * 33]); o.y = cvt_pk_bf16(s[2 * 33], s[3 * 33]); o.z = cvt_pk_bf16(s[4 * 33], s[5 * 33]); o.w = cvt_pk_bf16(s[6 * 33], s[7 * 33]);
        *(u32x4*)(WT + (size_t)(n0 + n) * K + k0 + 8 * c) = o; }
    LDS_WAIT(); asm volatile("" ::: "memory");
}
template <bool Q8>
__device__ __forceinline__ void rms_row(const float* xrow, const float* gain, bf16_t* orow, unsigned* q8row, float* q8scale, int lane) {
    f32x4 v[8]; float s = 0.f;
#pragma unroll
    for (int j = 0; j < 8; ++j) { v[j] = ((const f32x4*)xrow)[lane + 64 * j]; s += (v[j][0] * v[j][0] + v[j][1] * v[j][1]) + (v[j][2] * v[j][2] + v[j][3] * v[j][3]); }
    s = wave_sum(s);
    const float r = 1.0f / sqrtf(s * (1.0f / DM) + EPS);
    float am = 0.f;
#pragma unroll
    for (int j = 0; j < 8; ++j) { const f32x4 g = ((const f32x4*)gain)[lane + 64 * j]; v[j] = v[j] * r * g;
        u32x2 w; w.x = cvt_pk_bf16(v[j][0], v[j][1]); w.y = cvt_pk_bf16(v[j][2], v[j][3]); ((u32x2*)orow)[lane + 64 * j] = w;
        if (Q8) am = fmaxf(fmaxf(am, fmaxf(fabsf(v[j][0]), fabsf(v[j][1]))), fmaxf(fabsf(v[j][2]), fabsf(v[j][3]))); }
    if (Q8) {
#pragma unroll
        for (int o = 1; o < 64; o <<= 1) am = fmaxf(am, __shfl_xor(am, o));
        const float inv = am > 0.f ? 127.f / am : 0.f;
#pragma unroll
        for (int j = 0; j < 8; ++j) { const int q0 = (int)rintf(v[j][0] * inv), q1 = (int)rintf(v[j][1] * inv), q2 = (int)rintf(v[j][2] * inv), q3 = (int)rintf(v[j][3] * inv);
            q8row[lane + 64 * j] = (unsigned)(q0 & 0xff) | ((unsigned)(q1 & 0xff) << 8) | ((unsigned)(q2 & 0xff) << 16) | ((unsigned)(q3 & 0xff) << 24); }
        if (lane == 0) *q8scale = am * (1.f / 127.f);
    }
}
__device__ __forceinline__ void p0_prep(const Params& p, LAS unsigned char* lds, int vcu, int G) {
    const int tid = opaque_tid(), lane = tid & 63, wave = tid >> 6;
    LAS float* scr = (LAS float*)(lds + wave * 16384);
    const int gw = vcu * NWAVES + wave, NGW = G * NWAVES;
    unsigned char* ws = p.ws;
    constexpr int I_CM = 32 * 32, I_WIN = 32 * (NT_BF * 8), I_BR = 16 * 64, I_SQ = 32 * 64;
    constexpr int NITEMS = I_CM + I_WIN + 3 * I_BR + 2 * I_SQ;
    for (int it = gw; it < NITEMS; it += NGW) {
        int r = it;
        if (r < I_CM) {
            const int cg = r % 32, kc = r / 32; const float* wp = p.w_in + (size_t)(64 * kc) * DIN + GATE0 + 256 * cg + 4 * lane; f32x4 m = {0.f, 0.f, 0.f, 0.f};
#pragma unroll 32
            for (int k = 0; k < 64; ++k) { const f32x4 w = *(const f32x4*)(wp + (size_t)k * DIN); m[0] = fmaxf(m[0], fabsf(w[0])); m[1] = fmaxf(m[1], fabsf(w[1])); m[2] = fmaxf(m[2], fabsf(w[2])); m[3] = fmaxf(m[3], fabsf(w[3])); }
#pragma unroll
            for (int e = 0; e < 4; ++e) atomicMax(&g_colmax[256 * cg + 4 * lane + e], __float_as_uint(m[e]));
            continue; } r -= I_CM;
        if (r < I_WIN) { const int nb = r % (NT_BF * 8), kb = r / (NT_BF * 8); transpose_item(p.w_in, DM, DIN, (bf16_t*)(ws + WS_WIN), kb, nb, true, scr, lane); continue; } r -= I_WIN;
        if (r < 3 * I_BR) { const int br = r / I_BR, q = r % I_BR; const float* W = br == 0 ? p.w_a : (br == 1 ? p.w_b : p.w_m);
            transpose_item(W, 1024, DM, (bf16_t*)(ws + WS_WBR) + (size_t)br * DM * 1024, q / 64, q % 64, false, scr, lane); continue; } r -= 3 * I_BR;
        if (r < I_SQ) { transpose_item(p.w_out, DM, DM, (bf16_t*)(ws + WS_WOUT), r / 64, r % 64, false, scr, lane); continue; } r -= I_SQ;
        transpose_item(p.w_mkv, DM, DM, (bf16_t*)(ws + WS_WMKV), r / 64, r % 64, false, scr, lane);
    }
    for (int m = gw; m < T + NB * MEML; m += NGW) {
        if (m < T) rms_row<true>(p.x + (size_t)m * DM, p.norm_gain, (bf16_t*)(ws + WS_H) + (size_t)m * DM, (unsigned*)(ws + WS_H8) + (size_t)m * (DM / 4), (float*)(ws + WS_SH) + m, lane);
        else rms_row<false>(p.mem + (size_t)(m - T) * DM, p.mem_gain, (bf16_t*)(ws + WS_MEMN) + (size_t)(m - T) * DM, nullptr, nullptr, lane);
    }
    for (int i = vcu * NTHREADS + tid; i < T * 24; i += G * NTHREADS) {
        const int t = i / 24, j = i % 24; const float ps = (float)p.pos[t];
        float inv; if (j < 16) inv = powf(500000.0f, -(float)j / 16.0f); else inv = powf(500000.0f, -(float)(j - 16) / 8.0f);
        float sn, cs; sincosf(ps * inv, &sn, &cs);
        if (j < 16) ((f32x2*)(ws + WS_CSB))[t * 16 + j] = (f32x2){cs, sn}; else ((f32x2*)(ws + WS_CSI))[t * 8 + (j - 16)] = (f32x2){cs, sn};
    }
}
__device__ __forceinline__ void p0b_gate8(const Params& p, LAS unsigned char* lds, int widx, int nw) {
    const int tid = opaque_tid(), lane = tid & 63, wave = tid >> 6;
    LAS float* scr = (LAS float*)(lds + wave * 16384);
    const int gw = widx * NWAVES + wave, NGW = nw * NWAVES;
    unsigned char* ws = p.ws;
    for (int it = gw; it < 32 * (NGATE / 32); it += NGW) {
        const int nb = it % (NGATE / 32), kb = it / (NGATE / 32), k0 = 64 * kb, n0 = 32 * nb, nl = lane & 31;
        const float cm = __uint_as_float(__hip_atomic_load(&g_colmax[n0 + nl], __ATOMIC_RELAXED, __HIP_MEMORY_SCOPE_AGENT));
        const float inv = cm > 0.f ? 127.f / cm : 0.f;
        if (kb == 0 && lane < 32) ((float*)(ws + WS_SW))[n0 + nl] = cm * (1.f / 127.f);
        const float* wp = p.w_in + (size_t)(k0 + (lane >> 5)) * DIN + GATE0 + n0 + nl;
        float tv[32];
#pragma unroll
        for (int i = 0; i < 32; ++i) tv[i] = wp[(size_t)(2 * i) * DIN];
#pragma unroll
        for (int i = 0; i < 32; ++i) { const int kk = 2 * i + (lane >> 5); scr[kk * 33 + nl] = rintf(tv[i] * inv); }
        LDS_WAIT(); asm volatile("" ::: "memory");
        const int c = lane & 7;
#pragma unroll
        for (int j = 0; j < 4; ++j) { const int n = (lane >> 3) + 8 * j; const LAS float* sp = scr + (8 * c) * 33 + n;
            unsigned lo = 0, hi2 = 0;
#pragma unroll
            for (int e = 0; e < 4; ++e) { lo |= ((unsigned)((int)sp[e * 33]) & 0xffu) << (8 * e); hi2 |= ((unsigned)((int)sp[(4 + e) * 33]) & 0xffu) << (8 * e); }
            *(u32x2*)((unsigned char*)(ws + WS_W8) + (size_t)(n0 + n) * DM + k0 + 8 * c) = (u32x2){lo, hi2}; }
        LDS_WAIT(); asm volatile("" ::: "memory");
    }
}

struct Sched1 {
    int G, c; const char* ws;
    __device__ __forceinline__ bool next(int i, pg8::Unit& u) const {
        int L = i * G + c;
        if (L < 32 * NT_BF) { pg8::tile_order(L, 32, NT_BF, u.pm, u.pn); u.kind = 0; return true; }
        L -= 32 * NT_BF;
        if (L < 8) { u.pm = L & 1; u.pn = L >> 1; u.kind = 1; return true; }
        L -= 8;
        if (L < 8) { u.pm = L & 3; u.pn = L >> 2; u.kind = 2; return true; }
        return false;
    }
    __device__ __forceinline__ const char* a_base(const pg8::Unit& u) const {
        const size_t off = u.kind == 0 ? WS_H : (u.kind == 1 ? WS_MEMN : WS_WMKV + (size_t)1024 * DM * 2);
        return ws + off + (size_t)u.pm * (256 * DM * 2); }
    __device__ __forceinline__ const char* b_base(const pg8::Unit& u) const {
        const size_t off = u.kind == 0 ? WS_WIN : (u.kind == 1 ? WS_WMKV : WS_MEMN);
        return ws + off + (size_t)u.pn * (256 * DM * 2); }
};
struct Epi1 {
    static constexpr bool PERM = true, INIT = false;
    unsigned char* ws; const float* ikg; const float* ikb;
    __device__ __forceinline__ bool operator()(f32x4 (&acc)[2][2][4][2], const pg8::Unit& u, int wr, int wc, int fr, int fq) const {
        const int rowb = u.pm * 256 + wr * 64 + fr, cl = wc * 32 + 8 * fq, pn = u.pn;
#ifndef EX_NOIQ
        if (u.kind == 0 && pn >= 22 && pn < 26) {
            const int head = 4 * (pn - 22) + wc;
#pragma unroll
            for (int ai = 0; ai < 2; ++ai)
#pragma unroll
                for (int m = 0; m < 4; ++m) { const int row = rowb + ai * 128 + m * 16;
                    f32x4 x1a = acc[ai][0][m][0], x1b = acc[ai][0][m][1], x2a = acc[ai][1][m][0], x2b = acc[ai][1][m][1];
                    if (fq == 0) { const f32x4* cs = (const f32x4*)(ws + WS_CSI) + row * 4;
                        const f32x4 c0 = cs[0], c1 = cs[1], c2 = cs[2], c3 = cs[3];
                        const f32x4 co_a = {c0[0], c0[2], c1[0], c1[2]}, si_a = {c0[1], c0[3], c1[1], c1[3]}, co_b = {c2[0], c2[2], c3[0], c3[2]}, si_b = {c2[1], c2[3], c3[1], c3[3]};
                        const f32x4 r1a = x1a * co_a - x2a * si_a, r1b = x1b * co_b - x2b * si_b, r2a = x2a * co_a + x1a * si_a, r2b = x2b * co_b + x1b * si_b;
                        x1a = r1a; x1b = r1b; x2a = r2a; x2b = r2b; }
                    bf16_t* dst = (bf16_t*)(ws + WS_IQ) + (size_t)row * 1024 + head * 64 + 16 * fq;
                    *(bf16x8*)(dst) = pack8(x1a, x1b); *(bf16x8*)(dst + 8) = pack8(x2a, x2b); }
            return true;
        }
#endif
#ifndef EX_NOIK
        if (u.kind == 0 && pn == 26) {
            if (wc == 0) {
                const f32x4 g0 = *(const f32x4*)(ikg + 16 * fq), g1 = *(const f32x4*)(ikg + 16 * fq + 4), g2 = *(const f32x4*)(ikg + 16 * fq + 8), g3 = *(const f32x4*)(ikg + 16 * fq + 12);
                const f32x4 e0 = *(const f32x4*)(ikb + 16 * fq), e1 = *(const f32x4*)(ikb + 16 * fq + 4), e2 = *(const f32x4*)(ikb + 16 * fq + 8), e3 = *(const f32x4*)(ikb + 16 * fq + 12);
#pragma unroll
                for (int ai = 0; ai < 2; ++ai)
#pragma unroll
                    for (int m = 0; m < 4; ++m) { const int row = rowb + ai * 128 + m * 16;
                        f32x4 v0 = acc[ai][0][m][0], v1 = acc[ai][0][m][1], v2 = acc[ai][1][m][0], v3 = acc[ai][1][m][1];
                        const f32x4 sv = (v0 + v1) + (v2 + v3);
                        float sm = (sv[0] + sv[1]) + (sv[2] + sv[3]);
                        sm += __shfl_xor(sm, 16); sm += __shfl_xor(sm, 32);
                        const float mean = sm * (1.f / 64.f);
                        v0 = v0 - mean; v1 = v1 - mean; v2 = v2 - mean; v3 = v3 - mean;
                        const f32x4 qv = (v0 * v0 + v1 * v1) + (v2 * v2 + v3 * v3);
                        float q2 = (qv[0] + qv[1]) + (qv[2] + qv[3]);
                        q2 += __shfl_xor(q2, 16); q2 += __shfl_xor(q2, 32);
                        const float rstd = 1.0f / sqrtf(q2 * (1.f / 64.f) + EPS);
                        v0 = v0 * rstd * g0 + e0; v1 = v1 * rstd * g1 + e1; v2 = v2 * rstd * g2 + e2; v3 = v3 * rstd * g3 + e3;
                        if (fq == 0) { const f32x4* cs = (const f32x4*)(ws + WS_CSI) + row * 4;
                            const f32x4 c0 = cs[0], c1 = cs[1], c2 = cs[2], c3 = cs[3];
                            const f32x4 co_a = {c0[0], c0[2], c1[0], c1[2]}, si_a = {c0[1], c0[3], c1[1], c1[3]}, co_b = {c2[0], c2[2], c3[0], c3[2]}, si_b = {c2[1], c2[3], c3[1], c3[3]};
                            const f32x4 r1a = v0 * co_a - v2 * si_a, r1b = v1 * co_b - v3 * si_b, r2a = v2 * co_a + v0 * si_a, r2b = v3 * co_b + v1 * si_b;
                            v0 = r1a; v1 = r1b; v2 = r2a; v3 = r2b; }
                        bf16_t* dst = (bf16_t*)(ws + WS_IK) + (size_t)row * 64 + 16 * fq;
                        *(bf16x8*)(dst) = pack8(v0, v1); *(bf16x8*)(dst + 8) = pack8(v2, v3); }
            } else if (wc == 1 && fq == 0) {
#pragma unroll
                for (int ai = 0; ai < 2; ++ai)
#pragma unroll
                    for (int m = 0; m < 4; ++m) { const int row = rowb + ai * 128 + m * 16; float* dst = (float*)(ws + WS_IW) + (size_t)row * 16;
                        *(f32x4*)(dst) = acc[ai][0][m][0] * 0.03125f; *(f32x4*)(dst + 4) = acc[ai][0][m][1] * 0.03125f;
                        *(f32x4*)(dst + 8) = acc[ai][1][m][0] * 0.03125f; *(f32x4*)(dst + 12) = acc[ai][1][m][1] * 0.03125f; }
            }
            return true;
        }
#endif
        int act = 0, ld = 1024, co = 0, bjs = 128; size_t off = 0, bex = 0;
        if (u.kind == 1) { off = WS_KM; co = pn * 256; }
        else if (u.kind == 2) { off = WS_VT; ld = 512; co = pn * 256; }
        else if (pn < 4) { act = 1; off = WS_AU; co = pn * 256; }
        else if (pn < 8) { act = 1; off = WS_AV; co = (pn - 4) * 256; }
        else if (pn < 12) { act = 2; off = WS_AZ; co = (pn - 8) * 256; }
        else if (pn < 16) { off = WS_QR; co = (pn - 12) * 256; }
        else if (pn == 16) { off = WS_KR; ld = 256; }
        else if (pn == 17) { off = WS_VV; ld = 128; bjs = SEQ * 128; bex = (size_t)SEQ * 128; }
        else { act = 2; off = WS_BZ; co = (pn - 18) * 256; }
        bf16_t* dst = (bf16_t*)(ws + off) + co + cl;
#pragma unroll
        for (int ai = 0; ai < 2; ++ai)
#pragma unroll
            for (int m = 0; m < 4; ++m) { const int row = rowb + ai * 128 + m * 16; bf16_t* rp = dst + (size_t)row * ld + (size_t)(row >> 12) * bex;
#pragma unroll
                for (int bj = 0; bj < 2; ++bj) { f32x4 v0 = acc[ai][bj][m][0], v1 = acc[ai][bj][m][1];
                    if (act == 1) {
#pragma unroll
                        for (int e = 0; e < 4; ++e) { v0[e] = gelu_f(v0[e]); v1[e] = gelu_f(v1[e]); } }
                    else if (act == 2) {
#pragma unroll
                        for (int e = 0; e < 4; ++e) { v0[e] = silu_f(v0[e]); v1[e] = silu_f(v1[e]); } }
                    *(bf16x8*)(rp + (size_t)bj * bjs) = pack8(v0, v1); }
                if (u.kind == 0 && pn >= 4 && pn < 8) {
                    f32x4 g0 = acc[ai][0][m][0], g1 = acc[ai][0][m][1], g2 = acc[ai][1][m][0], g3 = acc[ai][1][m][1];
#pragma unroll
                    for (int e = 0; e < 4; ++e) { g0[e] = gelu_f(g0[e]); g1[e] = gelu_f(g1[e]); g2[e] = gelu_f(g2[e]); g3[e] = gelu_f(g3[e]); }
                    const f32x4 sv = (g0 + g1) + (g2 + g3), qv = (g0 * g0 + g1 * g1) + (g2 * g2 + g3 * g3);
                    float s1 = (sv[0] + sv[1]) + (sv[2] + sv[3]), s2 = (qv[0] + qv[1]) + (qv[2] + qv[3]);
                    s1 += __shfl_xor(s1, 16); s2 += __shfl_xor(s2, 16); s1 += __shfl_xor(s1, 32); s2 += __shfl_xor(s2, 32);
                    if (fq == 0) ((f32x2*)(ws + WS_LNP))[(size_t)row * 16 + (pn - 4) * 4 + wc] = (f32x2){s1, s2}; }
                if (u.kind == 1) {
                    const f32x4 q = (acc[ai][0][m][0] * acc[ai][0][m][0] + acc[ai][0][m][1] * acc[ai][0][m][1]) + (acc[ai][1][m][0] * acc[ai][1][m][0] + acc[ai][1][m][1] * acc[ai][1][m][1]);
                    float ss = (q[0] + q[1]) + (q[2] + q[3]);
                    ss += __shfl_xor(ss, 16); ss += __shfl_xor(ss, 32);
                    if (fq == 0) ((float*)(ws + WS_RKP))[(size_t)row * 16 + pn * 4 + wc] = ss; } }
        return true;
    }
};

struct Sched1b {
    int G, c; const char* ws;
    __device__ __forceinline__ bool next(int i, pg8::Unit& u) const { const int L = i * G + c; if (L >= 32 * 32) return false; pg8::tile_order(L, 32, 32, u.pm, u.pn); u.kind = 0; return true; }
    __device__ __forceinline__ const char* a_base(const pg8::Unit& u) const { return ws + WS_H8 + (size_t)u.pm * (256 * DM); }
    __device__ __forceinline__ const char* b_base(const pg8::Unit& u) const { return ws + WS_W8 + (size_t)u.pn * (256 * DM); }
};
struct Epi1b {
    static constexpr bool PERM = true, INIT = false;
    unsigned char* ws;
    __device__ __forceinline__ bool operator()(f32x4 (&acc)[2][2][4][2], const pg8::Unit& u, int wr, int wc, int fr, int fq) const {
        const int rowb = u.pm * 256 + wr * 64 + fr, cl = wc * 32 + 8 * fq, pn = u.pn;
        const float* __restrict__ SW = (const float*)(ws + WS_SW) + pn * 256 + cl; const float* __restrict__ SH = (const float*)(ws + WS_SH);
        const f32x4 sw00 = *(const f32x4*)(SW), sw01 = *(const f32x4*)(SW + 4), sw10 = *(const f32x4*)(SW + 128), sw11 = *(const f32x4*)(SW + 132);
        float sh[2][4];
#pragma unroll
        for (int ai = 0; ai < 2; ++ai)
#pragma unroll
            for (int m = 0; m < 4; ++m) sh[ai][m] = SH[rowb + ai * 128 + m * 16];
        if (pn < 8) {
            bf16_t* __restrict__ dst = (bf16_t*)(ws + (pn < 4 ? WS_MQ : WS_MZ)) + (pn & 3) * 256 + cl;
#pragma unroll
            for (int ai = 0; ai < 2; ++ai)
#pragma unroll
                for (int m = 0; m < 4; ++m) { const int row = rowb + ai * 128 + m * 16; const float rs = sh[ai][m];
#pragma unroll
                    for (int bj = 0; bj < 2; ++bj) { f32x4 v0, v1; const f32x4 s0 = bj ? sw10 : sw00, s1 = bj ? sw11 : sw01;
#pragma unroll
                        for (int e = 0; e < 4; ++e) { v0[e] = (float)__float_as_int(acc[ai][bj][m][0][e]) * (rs * s0[e]); v1[e] = (float)__float_as_int(acc[ai][bj][m][1][e]) * (rs * s1[e]); }
                        if (pn >= 4) {
#pragma unroll
                            for (int e = 0; e < 4; ++e) { v0[e] = silu_f(v0[e]); v1[e] = silu_f(v1[e]); } }
                        *(bf16x8*)(dst + (size_t)row * 1024 + bj * 128) = pack8(v0, v1); } }
            return true;
        }
        const int pg = pn - 8;
        unsigned char* __restrict__ dst = (unsigned char*)(ws + WS_SA + (size_t)(pg >> 3) * (WS_SB - WS_SA)) + (pg & 7) * 256 + cl;
#pragma unroll
        for (int ai = 0; ai < 2; ++ai)
#pragma unroll
            for (int m = 0; m < 4; ++m) { const int row = rowb + ai * 128 + m * 16; const float rs = sh[ai][m] * (-LOG2E);
#pragma unroll
                for (int bj = 0; bj < 2; ++bj) { const f32x4 s0 = bj ? sw10 : sw00, s1 = bj ? sw11 : sw01; unsigned lo = 0, hi2 = 0;
#pragma unroll
                    for (int e = 0; e < 4; ++e) {
                        const float q0 = 255.f * __builtin_amdgcn_rcpf(1.f + __builtin_amdgcn_exp2f((float)__float_as_int(acc[ai][bj][m][0][e]) * (rs * s0[e])));
                        const float q1 = 255.f * __builtin_amdgcn_rcpf(1.f + __builtin_amdgcn_exp2f((float)__float_as_int(acc[ai][bj][m][1][e]) * (rs * s1[e])));
                        lo = __builtin_amdgcn_cvt_pk_u8_f32(__builtin_amdgcn_fmed3f(q0, 1.f, 255.f), e, lo); hi2 = __builtin_amdgcn_cvt_pk_u8_f32(__builtin_amdgcn_fmed3f(q1, 1.f, 255.f), e, hi2); }
                    *(u32x2*)(dst + (size_t)row * DM + bj * 128) = (u32x2){lo, hi2}; } }
        return true;
    }
};

struct Sched2 {
    int G, c; const char* ws;
    __device__ __forceinline__ bool next(int i, pg8::Unit& u) const {
        const int L = (i / 3) * G + c; if (L >= 256) return false;
        pg8::tile_order(L, 32, 8, u.pm, u.pn); u.kind = i % 3; return true;
    }
    __device__ __forceinline__ const char* a_base(const pg8::Unit& u) const {
        const size_t off = WS_XA + (u.kind == 1 ? (WS_XB - WS_XA) : (size_t)0) + (u.kind == 2 ? (WS_XM - WS_XA) : (size_t)0);
        return ws + off + (size_t)u.pm * (256 * 1024 * 2); }
    __device__ __forceinline__ const char* b_base(const pg8::Unit& u) const { return ws + WS_WBR + (size_t)u.kind * ((size_t)DM * 1024 * 2) + (size_t)u.pn * (256 * 1024 * 2); }
};
struct Epi2 {
    static constexpr bool PERM = true, INIT = false;
    unsigned char* ws;
    __device__ __forceinline__ bool operator()(f32x4 (&acc)[2][2][4][2], const pg8::Unit& u, int wr, int wc, int fr, int fq) const {
        const int rowb = u.pm * 256 + wr * 64 + fr, colb = u.pn * 256 + wc * 32 + 8 * fq, seg = u.kind;
        constexpr size_t GST = WS_SB - WS_SA;
        static_assert(WS_SM - WS_SB == GST, "gate spacing");
        const unsigned char* __restrict__ NUM = (const unsigned char*)(ws + WS_SA + (size_t)seg * GST);
        const unsigned char* __restrict__ DEN = (const unsigned char*)(ws + WS_SA + (size_t)(seg < 2 ? seg + 1 : 2) * GST);
        bf16_t* __restrict__ MG = (bf16_t*)(ws + WS_MERGED);
#define U8F(w, e) ((float)(((w) >> (8 * (e))) & 0xffu))
#pragma unroll
        for (int ai = 0; ai < 2; ++ai)
#pragma unroll
            for (int m = 0; m < 4; ++m) { const size_t ro = (size_t)(rowb + ai * 128 + m * 16) * DM + colb;
#pragma unroll
                for (int bj = 0; bj < 2; ++bj) {
                    const u32x2 nu = *(const u32x2*)(NUM + ro + bj * 128);
                    f32x4 f0 = {U8F(nu[0], 0), U8F(nu[0], 1), U8F(nu[0], 2), U8F(nu[0], 3)}, f1 = {U8F(nu[1], 0), U8F(nu[1], 1), U8F(nu[1], 2), U8F(nu[1], 3)};
                    if (seg < 2) { const u32x2 de = *(const u32x2*)(DEN + ro + bj * 128);
                        const f32x4 d0 = {U8F(de[0], 0), U8F(de[0], 1), U8F(de[0], 2), U8F(de[0], 3)}, d1 = {U8F(de[1], 0), U8F(de[1], 1), U8F(de[1], 2), U8F(de[1], 3)};
#pragma unroll
                        for (int e = 0; e < 4; ++e) { f0[e] *= __builtin_amdgcn_rcpf(d0[e]); f1[e] *= __builtin_amdgcn_rcpf(d1[e]); }
                        acc[ai][bj][m][0] *= f0; acc[ai][bj][m][1] *= f1;
                    } else { *(bf16x8*)(MG + ro + bj * 128) = pack8(acc[ai][bj][m][0] * f0 * (1.f / 255.f), acc[ai][bj][m][1] * f1 * (1.f / 255.f)); }
                } }
#undef U8F
        return seg == 2;
    }
};
struct Sched3 {
    int G, c; const char* A; const char* B;
    __device__ __forceinline__ bool next(int i, pg8::Unit& u) const { const int L = i * G + c; if (L >= 256) return false; pg8::tile_order(L, 32, 8, u.pm, u.pn); u.kind = 0; return true; }
    __device__ __forceinline__ const char* a_base(const pg8::Unit& u) const { return A + (size_t)u.pm * (256 * DM * 2); }
    __device__ __forceinline__ const char* b_base(const pg8::Unit& u) const { return B + (size_t)u.pn * (256 * DM * 2); }
};
struct Epi3 {
    static constexpr bool PERM = false, INIT = true;
    const float* x; float* out;
    __device__ __forceinline__ void init(f32x4 (&acc)[2][2][4][2], const pg8::Unit& u, int wr, int wc, int fr, int fq) const {
        const int rowb = u.pm * 256 + wr * 64 + fr, colb = u.pn * 256 + wc * 32 + 4 * fq;
#pragma unroll
        for (int ai = 0; ai < 2; ++ai)
#pragma unroll
            for (int m = 0; m < 4; ++m) { const size_t ro = (size_t)(rowb + ai * 128 + m * 16) * DM + colb;
#pragma unroll
                for (int bj = 0; bj < 2; ++bj)
#pragma unroll
                    for (int n = 0; n < 2; ++n) acc[ai][bj][m][n] = *(const f32x4*)(x + ro + bj * 128 + n * 16); }
    }
    __device__ __forceinline__ bool operator()(f32x4 (&acc)[2][2][4][2], const pg8::Unit& u, int wr, int wc, int fr, int fq) const {
        const int rowb = u.pm * 256 + wr * 64 + fr, colb = u.pn * 256 + wc * 32 + 4 * fq;
#pragma unroll
        for (int ai = 0; ai < 2; ++ai)
#pragma unroll
            for (int m = 0; m < 4; ++m) { const size_t ro = (size_t)(rowb + ai * 128 + m * 16) * DM + colb;
#pragma unroll
                for (int bj = 0; bj < 2; ++bj)
#pragma unroll
                    for (int n = 0; n < 2; ++n) *(f32x4*)(out + ro + bj * 128 + n * 16) = acc[ai][bj][m][n]; }
        return true;
    }
};

__device__ __forceinline__ void p2_qkprep(const Params& p, int vcu, int G) {
    const int tid = opaque_tid(), lane = tid & 63, wave = tid >> 6;
    unsigned char* ws = p.ws;
    const bf16_t* QR = (const bf16_t*)(ws + WS_QR); const bf16_t* KR = (const bf16_t*)(ws + WS_KR);
    bf16_t* QN = (bf16_t*)(ws + WS_QN); bf16_t* KN = (bf16_t*)(ws + WS_KN);
    const f32x2* CSB = (const f32x2*)(ws + WS_CSB);
    const float gq0 = p.q_gain[lane], gq1 = p.q_gain[lane + 64], gk0 = p.k_gain[lane], gk1 = p.k_gain[lane + 64];
    const float gA0 = (lane < 64) ? p.q_gain[2 * lane] : 0.f, gA1 = p.q_gain[2 * lane + 1], gB0 = p.k_gain[2 * lane], gB1 = p.k_gain[2 * lane + 1];
    (void)gq0; (void)gq1; (void)gk0; (void)gk1;
    const int NWT = G * NWAVES, w0 = vcu * NWAVES + wave;
#pragma unroll 1
    for (int t = w0; t < T; t += 2 * NWT) {
        const int t1 = (t + NWT < T) ? t + NWT : t;
        unsigned raw[2][10];
#pragma unroll
        for (int u = 0; u < 2; ++u) { const int tt = u ? t1 : t;
#pragma unroll
            for (int r = 0; r < 10; ++r) raw[u][r] = *(const unsigned*)((r < 8 ? QR + (size_t)tt * 1024 + r * 128 : KR + (size_t)tt * 256 + (r - 8) * 128) + 2 * lane); }
        f32x2 cs[2];
        cs[0] = CSB[t * 16 + ((2 * lane) & 15)]; cs[1] = CSB[t1 * 16 + ((2 * lane) & 15)];
        f32x2 cs1[2];
        cs1[0] = CSB[t * 16 + ((2 * lane + 1) & 15)]; cs1[1] = CSB[t1 * 16 + ((2 * lane + 1) & 15)];
        float ss[2][10];
#pragma unroll
        for (int u = 0; u < 2; ++u)
#pragma unroll
            for (int r = 0; r < 10; ++r) { const float x0 = bflo(raw[u][r]), x1 = bfhi(raw[u][r]); ss[u][r] = x0 * x0 + x1 * x1; }
#pragma unroll
        for (int o = 1; o < 64; o <<= 1)
#pragma unroll
            for (int u = 0; u < 2; ++u)
#pragma unroll
                for (int r = 0; r < 10; ++r) ss[u][r] += __shfl_xor(ss[u][r], o);
#pragma unroll
        for (int u = 0; u < 2; ++u) { const int tt = u ? t1 : t; const int b = tt >> 12, sq = tt & (SEQ - 1);
#pragma unroll
            for (int r = 0; r < 10; ++r) {
                const float rs = 1.0f / sqrtf(ss[u][r] * (1.f / 128.f) + EPS);
                float y0 = bflo(raw[u][r]) * rs * (r < 8 ? gA0 : gB0), y1 = bfhi(raw[u][r]) * rs * (r < 8 ? gA1 : gB1);
                const float p0 = __shfl_xor(y0, 8), p1 = __shfl_xor(y1, 8);
                if (lane < 8) { y0 = y0 * cs[u][0] - p0 * cs[u][1]; y1 = y1 * cs1[u][0] - p1 * cs1[u][1]; }
                else if (lane < 16) { y0 = y0 * cs[u][0] + p0 * cs[u][1]; y1 = y1 * cs1[u][0] + p1 * cs1[u][1]; }
                bf16_t* dst = r < 8 ? QN + ((size_t)(b * 8 + r) * SEQ + sq) * 128 : KN + ((size_t)(b * 2 + (r - 8)) * SEQ + sq) * 128;
                *(unsigned*)(dst + 2 * lane) = cvt_pk_bf16(y0, y1);
            } }
    }
}

constexpr int GM_VSTR = 136;
__device__ __forceinline__ void p2_gmlp_unit(const Params& p, LAS unsigned char* lds, int unit) {
    const int tid = opaque_tid(), lane = tid & 63, wave = __builtin_amdgcn_readfirstlane(tid >> 6), r32 = lane & 31, hi = lane >> 5;
    unsigned char* ws = p.ws;
    const int g = unit & 7, ch = unit >> 3, tok0 = ch * 128;
    const bf16_t* AV = (const bf16_t*)(ws + WS_AV); const bf16_t* AU = (const bf16_t*)(ws + WS_AU); const bf16_t* AZ = (const bf16_t*)(ws + WS_AZ);
    bf16_t* XA = (bf16_t*)(ws + WS_XA);
    LAS float* stat = (LAS float*)lds;
    LAS bf16_t* vT = (LAS bf16_t*)(lds + 1024);
    const int tb = wave >> 1, dh = wave & 1, trow = tb * 32 + r32;
    const float* wsp = p.spatial_w + ((size_t)g * 128 + trow) * 128 + 8 * hi;
    f32x4 wf[8][2];
#pragma unroll
    for (int ks = 0; ks < 8; ++ks) { wf[ks][0] = *(const f32x4*)(wsp + 16 * ks); wf[ks][1] = *(const f32x4*)(wsp + 16 * ks + 4); }
    if (tid < 128) { const f32x4* lp = (const f32x4*)((const f32x2*)(ws + WS_LNP) + (size_t)(tok0 + tid) * 16); float s1 = 0.f, s2 = 0.f;
#pragma unroll
        for (int i = 0; i < 8; ++i) { const f32x4 v = lp[i]; s1 += v[0] + v[2]; s2 += v[1] + v[3]; }
        const float mean = s1 * (1.f / 1024.f), var = fmaxf(s2 * (1.f / 1024.f) - mean * mean, 0.f);
        stat[2 * tid] = mean; stat[2 * tid + 1] = 1.0f / sqrtf(var + EPS); }
    __syncthreads();
    {
        u32x4 va[4];
#pragma unroll
        for (int i = 0; i < 4; ++i) { const int it = tid + i * NTHREADS, s_ = it >> 4, d8 = (it & 15) * 8; va[i] = *(const u32x4*)(AV + (size_t)(tok0 + s_) * 1024 + g * 128 + d8); }
        const int d8 = (tid & 15) * 8;
        const f32x4 g0 = *(const f32x4*)(p.gmlp_g + g * 128 + d8), g1 = *(const f32x4*)(p.gmlp_g + g * 128 + d8 + 4), b0 = *(const f32x4*)(p.gmlp_b + g * 128 + d8), b1 = *(const f32x4*)(p.gmlp_b + g * 128 + d8 + 4);
#pragma unroll
        for (int i = 0; i < 4; ++i) { const int it = tid + i * NTHREADS, s_ = it >> 4; const u32x4 a = va[i];
            const float mean = stat[2 * s_], rstd = stat[2 * s_ + 1];
            float f[8] = {bflo(a[0]), bfhi(a[0]), bflo(a[1]), bfhi(a[1]), bflo(a[2]), bfhi(a[2]), bflo(a[3]), bfhi(a[3])};
#pragma unroll
            for (int e = 0; e < 8; ++e) { const float y = (f[e] - mean) * rstd * (e < 4 ? g0[e & 3] : g1[e & 3]) + (e < 4 ? b0[e & 3] : b1[e & 3]); vT[(d8 + e) * GM_VSTR + s_] = f2bf(y); } }
    }
    unsigned short gu[16][2], gz[16][2];
#pragma unroll
    for (int r = 0; r < 16; ++r) { const int tl = tb * 32 + (r & 3) + 8 * (r >> 2) + 4 * hi; const size_t o = (size_t)(tok0 + tl) * 1024 + g * 128 + dh * 64 + r32;
        gu[r][0] = AU[o]; gu[r][1] = AU[o + 32]; gz[r][0] = AZ[o]; gz[r][1] = AZ[o + 32]; }
    __syncthreads();
    f32x16 acc0 = {}, acc1 = {};
#pragma unroll
    for (int ks = 0; ks < 8; ++ks) {
        const int s0 = 16 * ks + 8 * hi;
        f32x4 w0 = wf[ks][0], w1 = wf[ks][1];
#pragma unroll
        for (int e = 0; e < 4; ++e) { if (s0 + e > trow) w0[e] = 0.f; if (s0 + 4 + e > trow) w1[e] = 0.f; }
        const bf16x8 a = pack8(w0, w1);
        const bf16x8 b0 = *(const LAS bf16x8*)(vT + (dh * 64 + r32) * GM_VSTR + s0), b1 = *(const LAS bf16x8*)(vT + (dh * 64 + 32 + r32) * GM_VSTR + s0);
        acc0 = __builtin_amdgcn_mfma_f32_32x32x16_bf16(a, b0, acc0, 0, 0, 0);
        acc1 = __builtin_amdgcn_mfma_f32_32x32x16_bf16(a, b1, acc1, 0, 0, 0);
    }
#pragma unroll
    for (int r = 0; r < 16; ++r) { const int tl = tb * 32 + (r & 3) + 8 * (r >> 2) + 4 * hi; const float bias = p.spatial_b[g * 128 + tl];
        const size_t o = (size_t)(tok0 + tl) * 1024 + g * 128 + dh * 64 + r32;
        XA[o] = f2bf(bf2f(gu[r][0]) * (acc0[r] + bias) * bf2f(gz[r][0]));
        XA[o + 32] = f2bf(bf2f(gu[r][1]) * (acc1[r] + bias) * bf2f(gz[r][1])); }
    __syncthreads();
}

constexpr int MA_KST = 32 * 512, MA_VROW = 72, MA_VST = 256 * MA_VROW;
constexpr int MA_K0 = 2048, MA_V0 = MA_K0 + 2 * MA_KST;
static_assert(MA_V0 + 2 * MA_VST <= MISC_OFF, "mem-attn LDS map");
__device__ __forceinline__ void p2_mem_unit(const Params& p, LAS unsigned char* lds, int unit) {
    const int tid = opaque_tid(), lane = tid & 63, wave = __builtin_amdgcn_readfirstlane(tid >> 6), r32 = lane & 31, hi = lane >> 5;
    unsigned char* ws = p.ws;
    const int qb = unit & 31, h = (unit >> 5) & 3, b = unit >> 7, qg = wave & 3, dhf = wave >> 2;
    const bf16_t* MQ = (const bf16_t*)(ws + WS_MQ); const bf16_t* MZ = (const bf16_t*)(ws + WS_MZ);
    const bf16_t* KM = (const bf16_t*)(ws + WS_KM) + (size_t)(b * 256) * 1024 + h * 256;
    const bf16_t* VT = (const bf16_t*)(ws + WS_VT) + (size_t)(h * 256) * 512 + b * 256;
    bf16_t* XM = (bf16_t*)(ws + WS_XM);
    LAS float* rk = (LAS float*)lds;
    LAS float* gqk = (LAS float*)(lds + 1024);
    u32x4 sk[2], sv[2];
#define MA_LOAD(st) do { _Pragma("unroll") for (int i = 0; i < 2; ++i) { const int q = tid + i * NTHREADS; \
        sk[i] = *(const u32x4*)(KM + (size_t)((st) * 32 + (q >> 5)) * 1024 + (q & 31) * 8); \
        sv[i] = *(const u32x4*)(VT + (size_t)(q >> 2) * 512 + (st) * 32 + (q & 3) * 8); } } while (0)
#define MA_WRITE(bf) do { _Pragma("unroll") for (int i = 0; i < 2; ++i) { const int q = tid + i * NTHREADS; const int key = q >> 5, c = q & 31; \
        *(LAS u32x4*)(lds + MA_K0 + (bf) * MA_KST + key * 512 + ((c ^ (key & 15)) << 4)) = sk[i]; \
        LAS unsigned char* vd = lds + MA_V0 + (bf) * MA_VST + (q >> 2) * MA_VROW + (q & 3) * 16; \
        *(LAS u32x2*)vd = (u32x2){sv[i][0], sv[i][1]}; *(LAS u32x2*)(vd + 8) = (u32x2){sv[i][2], sv[i][3]}; } } while (0)
    if (tid < 256) { const f32x4 pr = *(const f32x4*)((const float*)(ws + WS_RKP) + (size_t)(b * 256 + tid) * 16 + h * 4);
        rk[tid] = 1.0f / sqrtf(((pr[0] + pr[1]) + (pr[2] + pr[3])) * (1.f / 256.f) + EPS); gqk[tid] = p.mq_gain[tid] * p.mk_gain[tid]; }
    __syncthreads();
    const int tq = b * SEQ + qb * 128 + qg * 32 + r32;
    bf16x8 qf[16]; float ssq = 0.f;
#pragma unroll
    for (int ks = 0; ks < 16; ++ks) { const int d0 = 16 * ks + 8 * hi; const u32x4 a = *(const u32x4*)(MQ + (size_t)tq * 1024 + h * 256 + d0);
        f32x4 f0 = {bflo(a[0]), bfhi(a[0]), bflo(a[1]), bfhi(a[1])}, f1 = {bflo(a[2]), bfhi(a[2]), bflo(a[3]), bfhi(a[3])};
        ssq += (f0[0] * f0[0] + f0[1] * f0[1]) + (f0[2] * f0[2] + f0[3] * f0[3]) + (f1[0] * f1[0] + f1[1] * f1[1]) + (f1[2] * f1[2] + f1[3] * f1[3]);
        const f32x4 g0 = *(const LAS f32x4*)(gqk + d0), g1 = *(const LAS f32x4*)(gqk + d0 + 4);
        qf[ks] = pack8(f0 * g0, f1 * g1); }
    ssq += __shfl_xor(ssq, 32);
    const float qs = (1.0f / sqrtf(ssq * (1.f / 256.f) + EPS)) * (0.0625f * LOG2E);
    MA_LOAD(0);
    MA_WRITE(0);
    __syncthreads();
    f32x16 o[4];
#pragma unroll
    for (int db = 0; db < 4; ++db) o[db] = (f32x16){};
    float mrun = -1e30f, l = 0.f;
    const int kx = r32 & 15;
#pragma unroll 1
    for (int st = 0; st < 8; ++st) {
        const int bf = st & 1;
        if (st + 1 < 8) MA_LOAD(st + 1);
        {
            f32x16 a = {};
            const LAS unsigned char* kp = lds + MA_K0 + bf * MA_KST + r32 * 512;
#pragma unroll
            for (int ks = 0; ks < 16; ++ks) { if ((ks & 3) == 0) __builtin_amdgcn_sched_barrier(0); const bf16x8 kf = *(const LAS bf16x8*)(kp + (((2 * ks + hi) ^ kx) << 4)); a = __builtin_amdgcn_mfma_f32_32x32x16_bf16(kf, qf[ks], a, 0, 0, 0); }
            __builtin_amdgcn_sched_barrier(0);
#pragma unroll
            for (int g4 = 0; g4 < 4; ++g4) { const f32x4 rr = *(const LAS f32x4*)(rk + st * 32 + 8 * g4 + 4 * hi);
#pragma unroll
                for (int e = 0; e < 4; ++e) a[4 * g4 + e] *= rr[e] * qs; }
            float bm = a[0];
#pragma unroll
            for (int r = 1; r < 16; ++r) bm = fmaxf(bm, a[r]);
            bm = fmaxf(bm, __shfl_xor(bm, 32));
            if (!__all(bm - mrun <= 8.f)) { const float mn = fmaxf(mrun, bm), al = __builtin_amdgcn_exp2f(mrun - mn); mrun = mn; l *= al;
#pragma unroll
                for (int db = 0; db < 4; ++db) o[db] *= al; }
#pragma unroll
            for (int r = 0; r < 16; ++r) { a[r] = __builtin_amdgcn_exp2f(a[r] - mrun); l += a[r]; }
            u32x4 w0 = {cvt_pk_bf16(a[0], a[1]), cvt_pk_bf16(a[2], a[3]), cvt_pk_bf16(a[4], a[5]), cvt_pk_bf16(a[6], a[7])};
            u32x4 w1 = {cvt_pk_bf16(a[8], a[9]), cvt_pk_bf16(a[10], a[11]), cvt_pk_bf16(a[12], a[13]), cvt_pk_bf16(a[14], a[15])};
            const bf16x8 pf0 = *reinterpret_cast<bf16x8*>(&w0), pf1 = *reinterpret_cast<bf16x8*>(&w1);
            const LAS unsigned char* vp = lds + MA_V0 + bf * MA_VST + (dhf * 128 + r32) * MA_VROW + 8 * hi;
#pragma unroll
            for (int db = 0; db < 4; ++db) {
                const u32x2 lo0 = *(const LAS u32x2*)(vp + db * 32 * MA_VROW), hi0 = *(const LAS u32x2*)(vp + db * 32 * MA_VROW + 16);
                const u32x2 lo1 = *(const LAS u32x2*)(vp + db * 32 * MA_VROW + 32), hi1 = *(const LAS u32x2*)(vp + db * 32 * MA_VROW + 48);
                u32x4 v0 = {lo0[0], lo0[1], hi0[0], hi0[1]}, v1 = {lo1[0], lo1[1], hi1[0], hi1[1]};
                o[db] = __builtin_amdgcn_mfma_f32_32x32x16_bf16(*reinterpret_cast<bf16x8*>(&v0), pf0, o[db], 0, 0, 0);
                o[db] = __builtin_amdgcn_mfma_f32_32x32x16_bf16(*reinterpret_cast<bf16x8*>(&v1), pf1, o[db], 0, 0, 0); }
        }
        if (st + 1 < 8) MA_WRITE(bf ^ 1);
        __syncthreads();
    }
#undef MA_LOAD
#undef MA_WRITE
    l += __shfl_xor(l, 32);
    const float il = __builtin_amdgcn_rcpf(l);
    u32x2 zg[4][4];
#pragma unroll
    for (int db = 0; db < 4; ++db)
#pragma unroll
        for (int g4 = 0; g4 < 4; ++g4) zg[db][g4] = *(const u32x2*)(MZ + (size_t)tq * 1024 + h * 256 + dhf * 128 + db * 32 + 8 * g4 + 4 * hi);
#pragma unroll
    for (int db = 0; db < 4; ++db)
#pragma unroll
        for (int g4 = 0; g4 < 4; ++g4) { const size_t oo = (size_t)tq * 1024 + h * 256 + dhf * 128 + db * 32 + 8 * g4 + 4 * hi;
            const u32x2 z = zg[db][g4];
            u32x2 w; w[0] = cvt_pk_bf16(o[db][4 * g4] * il * bflo(z[0]), o[db][4 * g4 + 1] * il * bfhi(z[0])); w[1] = cvt_pk_bf16(o[db][4 * g4 + 2] * il * bflo(z[1]), o[db][4 * g4 + 3] * il * bfhi(z[1]));
            *(u32x2*)(XM + oo) = w; }
}


__device__ __forceinline__ unsigned wave_sum_dpp(unsigned c) {
    c += (unsigned)__builtin_amdgcn_update_dpp(0, (int)c, 0xB1, 0xF, 0xF, false);
    c += (unsigned)__builtin_amdgcn_update_dpp(0, (int)c, 0x4E, 0xF, 0xF, false);
    c += (unsigned)__builtin_amdgcn_update_dpp(0, (int)c, 0x141, 0xF, 0xF, false);
    c += (unsigned)__builtin_amdgcn_update_dpp(0, (int)c, 0x140, 0xF, 0xF, false);
    { auto r = __builtin_amdgcn_permlane16_swap(c, c, false, false); c = r[0] + r[1]; }
    { auto r = __builtin_amdgcn_permlane32_swap(c, c, false, false); c = r[0] + r[1]; }
    return c;
}
#define CNT4(c0, c1, c2, c3, a, b, c_, d, t) do { unsigned long long m0_, m1_, m2_, m3_; asm volatile( \
    "v_cmp_ge_u32_e64 %[m0], %[va], %[vt]\n\tv_cmp_ge_u32_e64 %[m1], %[vb], %[vt]\n\tv_cmp_ge_u32_e64 %[m2], %[vc], %[vt]\n\tv_cmp_ge_u32_e64 %[m3], %[vd], %[vt]\n\t" \
    "v_addc_co_u32_e64 %[k0], %[m0], %[k0], 0, %[m0]\n\tv_addc_co_u32_e64 %[k1], %[m1], %[k1], 0, %[m1]\n\tv_addc_co_u32_e64 %[k2], %[m2], %[k2], 0, %[m2]\n\tv_addc_co_u32_e64 %[k3], %[m3], %[k3], 0, %[m3]" \
    : [k0] "+v"(c0), [k1] "+v"(c1), [k2] "+v"(c2), [k3] "+v"(c3), [m0] "=&s"(m0_), [m1] "=&s"(m1_), [m2] "=&s"(m2_), [m3] "=&s"(m3_) \
    : [va] "v"(a), [vb] "v"(b), [vc] "v"(c_), [vd] "v"(d), [vt] "v"(t)); } while (0)

__device__ __forceinline__ unsigned sortable(float f) { const unsigned u = __float_as_uint(f); return u ^ ((unsigned)((int)u >> 31) | 0x80000000u); }
#ifndef SPAN_A
#define SPAN_A -1
#endif
#define ACC_T(k, t0v) do { if (SPAN_A >= 100 && blockIdx.x == 0 && threadIdx.x == 0) { volatile LAS unsigned long long* st_ = (volatile LAS unsigned long long*)(lds + MISC_OFF + 16); const unsigned long long n_ = __builtin_amdgcn_s_memrealtime(); st_[16 + (k)] += n_ - (t0v); (t0v) = n_; } } while (0)
__device__ __forceinline__ float relu1(float x) { const int xi = __float_as_int(x); return __int_as_float(xi > 0 ? xi : 0); }
__device__ __forceinline__ void p2_idx_all(const Params& p, LAS unsigned char* lds, int bx, int G, unsigned* qctr) {
    unsigned long long tacc = (SPAN_A >= 100) ? __builtin_amdgcn_s_memrealtime() : 0ull;
    const int tid = opaque_tid(), lane = tid & 63, wave = __builtin_amdgcn_readfirstlane(tid >> 6), r32 = lane & 31, hi = lane >> 5;
    unsigned char* ws = p.ws;
    const bf16_t* IQ = (const bf16_t*)(ws + WS_IQ); const float* IW = (const float*)(ws + WS_IW);
    LAS unsigned* sc = (LAS unsigned*)lds;
    LAS float* iwl0 = (LAS float*)(lds + 131072);
    LAS unsigned* qword = (LAS unsigned*)(lds + 131072 + 1024 + 4096);
#define AF_LOAD(tt0) do { _Pragma("unroll") for (int at = 0; at < 4; ++at) _Pragma("unroll") for (int ks = 0; ks < 4; ++ks) \
        af[at][ks] = *(const bf16x8*)(IQ + (size_t)((tt0) + 2 * at + (r32 >> 4)) * 1024 + (r32 & 15) * 64 + 16 * ks + 8 * hi); } while (0)
    bf16x8 af[4][4];
    int qcur = bx, qnxt = bx + G;
    if (qcur >= 1024) return;
    { const int t0 = (qcur & 1) * SEQ + (511 - (qcur >> 1)) * 8; AF_LOAD(t0); if (tid < 128) iwl0[tid] = IW[(size_t)t0 * 16 + tid]; }
    __syncthreads();
#pragma unroll 1
    for (int k = 0; qcur < 1024; ++k) {
        const int b = qcur & 1, ublk = 511 - (qcur >> 1);
        const int s0 = ublk * 8, t0 = b * SEQ + s0;
        const bf16_t* IK = (const bf16_t*)(ws + WS_IK) + (size_t)(b * SEQ) * 64;
        LAS float* iwl = iwl0 + (k & 1) * 128;
        unsigned qgot = 0u; if (tid == 0) qgot = 2u * (unsigned)G + __hip_atomic_fetch_add(qctr, 1u, __ATOMIC_RELAXED, __HIP_MEMORY_SCOPE_AGENT);
        const int qn_ok = qnxt < 1024 ? qnxt : qcur;
        const int t0n = (qn_ok & 1) * SEQ + (511 - (qn_ok >> 1)) * 8;
        float iwn = 0.f; if (tid < 128) iwn = IW[(size_t)t0n * 16 + tid];
        ACC_T(0, tacc);
        const int ntiles = (s0 + 8 + 31) >> 5;
        bf16x8 kb0[4], kb1[4], kb2[4];
#define IK_LOAD(dst, jj) do { const int jc_ = (jj) < ntiles ? (jj) : 0; _Pragma("unroll") for (int ks = 0; ks < 4; ++ks) dst[ks] = *(const bf16x8*)(IK + (size_t)(32 * jc_ + r32) * 64 + 16 * ks + 8 * hi); } while (0)
#define SCORE_TILE(KB, jj) do { const int k0 = 32 * (jj); \
        _Pragma("unroll") for (int at = 0; at < 4; ++at) { f32x16 a = {}; \
            _Pragma("unroll") for (int ks = 0; ks < 4; ++ks) a = __builtin_amdgcn_mfma_f32_32x32x16_bf16(af[at][ks], KB[ks], a, 0, 0, 0); \
            const f32x4 wa0 = *(const LAS f32x4*)(iwl + (2 * at) * 16 + 4 * hi), wa1 = *(const LAS f32x4*)(iwl + (2 * at) * 16 + 8 + 4 * hi); \
            const f32x4 wb0 = *(const LAS f32x4*)(iwl + (2 * at + 1) * 16 + 4 * hi), wb1 = *(const LAS f32x4*)(iwl + (2 * at + 1) * 16 + 8 + 4 * hi); \
            float pa = 0.f, pb = 0.f; \
            _Pragma("unroll") for (int e = 0; e < 4; ++e) { pa += wa0[e] * relu1(a[e]); pa += wa1[e] * relu1(a[4 + e]); pb += wb0[e] * relu1(a[8 + e]); pb += wb1[e] * relu1(a[12 + e]); } \
            auto rr = __builtin_amdgcn_permlane32_swap(__float_as_uint(pa), __float_as_uint(pb), false, false); \
            const float score = __uint_as_float(rr[0]) + __uint_as_float(rr[1]); \
            const int qi = 2 * at + hi, key = k0 + r32; \
            sc[qi * 4096 + key] = (key <= s0 + qi) ? sortable(score) : 0u; } } while (0)
#ifndef IDX_SCORE_REP
#define IDX_SCORE_REP 1
#endif
#pragma unroll 1
        for (int rep_ = 0; rep_ < IDX_SCORE_REP; ++rep_) {
        IK_LOAD(kb0, wave); IK_LOAD(kb1, wave + NWAVES);
#pragma unroll 1
        for (int j = wave; j < ntiles; j += 3 * NWAVES) {
            IK_LOAD(kb2, j + 2 * NWAVES); SCORE_TILE(kb0, j);
            if (j + NWAVES >= ntiles) break;
            IK_LOAD(kb0, j + 3 * NWAVES); SCORE_TILE(kb1, j + NWAVES);
            if (j + 2 * NWAVES >= ntiles) break;
            IK_LOAD(kb1, j + 4 * NWAVES); SCORE_TILE(kb2, j + 2 * NWAVES);
        }
        }
#undef IK_LOAD
#undef SCORE_TILE
        if (tid == 0) *qword = qgot;
        __syncthreads();
        ACC_T(1, tacc);
        const int s = s0 + wave, n = s + 1;
        unsigned kv[64];
#pragma unroll
        for (int i = 0; i < 64; ++i) { const int key = 64 * i + lane; kv[i] = (key <= s) ? sc[wave * 4096 + key] : 0u; }
        if (tid < 128) iwl0[((k + 1) & 1) * 128 + tid] = iwn;
        const int qnn = (int)*qword;
        AF_LOAD(t0n);
        LDS_WAIT();
        __syncthreads();
        unsigned Tt = 1u; bool exact = true;
        if (n > 256) {
            Tt = 0u; exact = false;
            for (int bit = 31; bit >= 0; --bit) {
                const unsigned cand = Tt | (1u << bit); unsigned c0 = 0, c1 = 0, c2 = 0, c3 = 0;
#pragma unroll
                for (int i = 0; i < 64; i += 4) CNT4(c0, c1, c2, c3, kv[i], kv[i + 1], kv[i + 2], kv[i + 3], cand);
                const unsigned c = wave_sum_dpp((c0 + c1) + (c2 + c3));
                if (c >= 256u) { Tt = cand; if (c == 256u) { exact = true; break; } }
            }
        }
        ACC_T(2, tacc);
#define WRLANE2(lo_, hi_, bal_, i_) do { const unsigned bl_ = (unsigned)(bal_), bh_ = (unsigned)((bal_) >> 32); \
        asm volatile("s_nop 3\n\tv_writelane_b32 %0, %2, %4\n\tv_writelane_b32 %1, %3, %4" : "+v"(lo_), "+v"(hi_) : "s"(bl_), "s"(bh_), "n"(i_)); } while (0)
        unsigned mlo = 0u, mhi = 0u;
        if (exact) {
#pragma unroll
            for (int i = 0; i < 64; ++i) { const unsigned long long bal = __ballot(kv[i] >= Tt);
                WRLANE2(mlo, mhi, bal, i); }
        } else {
            unsigned cg_ = 0;
#pragma unroll
            for (int i = 0; i < 64; ++i) cg_ += (kv[i] > Tt) ? 1u : 0u;
            cg_ = wave_sum_u(cg_);
            const unsigned need = 256u - cg_; unsigned seen = 0u;
#pragma unroll
            for (int i = 0; i < 64; ++i) {
                const unsigned kk = kv[i];
                const unsigned long long eq = __ballot(kk == Tt), gt = __ballot(kk > Tt);
                const unsigned below = (unsigned)__popcll(eq & ((1ull << lane) - 1ull));
                const bool take = (kk == Tt) && (seen + below < need);
                const unsigned long long bal = gt | __ballot(take);
                seen += (unsigned)__popcll(eq);
                WRLANE2(mlo, mhi, bal, i);
            }
        }
        const unsigned long long mine = ((unsigned long long)mhi << 32) | mlo;
        ((unsigned long long*)(ws + WS_MASK))[(size_t)(t0 + wave) * 64 + lane] = mine;
        ACC_T(3, tacc);
        qcur = qnxt; qnxt = qnn;
    }
#undef AF_LOAD
    __syncthreads();
}

namespace att {
constexpr int D = 128, NW = 8, QBLK = 32, KVBLK = 64, QB = 256;
constexpr int SHM_V = KVBLK * D * 2, SHM_K = KVBLK * D * 2;
constexpr int EPI_T0 = 2 * SHM_V + 2 * SHM_K + NW * 128 * 4 + 16, EPI_TW = 32 * 272;
constexpr int LDS_NEED = EPI_T0 + NW * EPI_TW;
static_assert(LDS_NEED <= MISC_OFF, "attention LDS map");
constexpr float SCALE = 0.08838834764831845f, THR = 8.f;
#define KSWZ(row, colB) ((row) * 256 + ((colB) ^ (((row) & 7) << 4)))
#define SBAR() __builtin_amdgcn_sched_barrier(0)
__device__ __forceinline__ int v_st(int k, int c) { const int kk = (k & ~0xC) | ((k & 4) << 1) | ((k & 8) >> 1); return ((kk >> 3) * 4 + (c >> 5)) * 512 + ((kk & 7) * 32 + (c & 31)) * 2; }
__device__ __forceinline__ int v_rd_base(int lane) { return ((lane & 3) << 3) | (((lane >> 2) & 3) << 6) | (((lane >> 4) & 1) << 5) | (((lane >> 5) & 1) << 8); }
constexpr int v_rd_off(int d0, int ks, int half) { return d0 * 512 + ks * 4096 + half * 2048; }
__device__ __forceinline__ int crow(int r, int hi) { return (r & 3) + 8 * (r >> 2) + 4 * hi; }
__device__ __forceinline__ bf16x8 load8(const bf16_t* p) { return *reinterpret_cast<const bf16x8*>(p); }
__device__ __forceinline__ void mask_bits(f32x16& p0, f32x16& p1, unsigned w0, unsigned w1, int hi) {
    w0 >>= 4 * hi; w1 >>= 4 * hi;
#pragma unroll
    for (int r = 0; r < 16; ++r) { const int c = (r & 3) + 8 * (r >> 2);
        const unsigned t0 = (unsigned)(((int)(w0 << (31 - c))) >> 31), t1 = (unsigned)(((int)(w1 << (31 - c))) >> 31);
        p0[r] = __uint_as_float((__float_as_uint(p0[r]) & t0) | (0xff800000u & ~t0));
        p1[r] = __uint_as_float((__float_as_uint(p1[r]) & t1) | (0xff800000u & ~t1)); }
}
__device__ __forceinline__ void partialSM(f32x16& p0, f32x16& p1, float& m_reg, float& mn, float& alpha) {
    float pmax = p0[0];
#pragma unroll
    for (int r = 1; r < 16; ++r) pmax = fmaxf(pmax, p0[r]);
#pragma unroll
    for (int r = 0; r < 16; ++r) pmax = fmaxf(pmax, p1[r]);
    { auto rr = __builtin_amdgcn_permlane32_swap(__float_as_uint(pmax), __float_as_uint(pmax), false, false);
      pmax = fmaxf(__uint_as_float(rr[0]), __uint_as_float(rr[1])); }
    constexpr float C2 = 1.4426950408889634f * SCALE;
    if (__builtin_expect(__all((pmax - m_reg) * SCALE <= THR), 1)) { mn = m_reg; alpha = 1.f; }
    else { mn = fmaxf(m_reg, pmax); alpha = __builtin_amdgcn_exp2f((m_reg - mn) * C2); m_reg = mn; }
    const float mnL = -mn * C2;
#pragma unroll
    for (int r = 0; r < 16; ++r) p0[r] = fmaf(p0[r], C2, mnL);
#pragma unroll
    for (int r = 0; r < 16; ++r) p1[r] = fmaf(p1[r], C2, mnL);
#pragma unroll
    for (int r = 0; r < 16; ++r) p0[r] = __builtin_amdgcn_exp2f(p0[r]);
}
__device__ __forceinline__ void finishSM(f32x16& p0, f32x16& p1, float alpha, float& l_reg, bf16x8& pa0, bf16x8& pa1, bf16x8& pa2, bf16x8& pa3) {
#pragma unroll
    for (int r = 0; r < 16; ++r) p1[r] = __builtin_amdgcn_exp2f(p1[r]);
    float ps = 0;
#pragma unroll
    for (int r = 0; r < 16; ++r) ps += p0[r];
#pragma unroll
    for (int r = 0; r < 16; ++r) ps += p1[r];
    { auto rr = __builtin_amdgcn_permlane32_swap(__float_as_uint(ps), __float_as_uint(ps), false, false);
      ps = __uint_as_float(rr[0]) + __uint_as_float(rr[1]); }
    l_reg = l_reg * alpha + ps;
#define PK4(P, B_, OUT) do { unsigned a0 = cvt_pk_bf16(P[B_+0], P[B_+1]), a1 = cvt_pk_bf16(P[B_+2], P[B_+3]);                          \
        unsigned b0 = cvt_pk_bf16(P[B_+4], P[B_+5]), b1 = cvt_pk_bf16(P[B_+6], P[B_+7]);                                             \
        auto r0 = __builtin_amdgcn_permlane32_swap(a0, b0, false, false); auto r1 = __builtin_amdgcn_permlane32_swap(a1, b1, false, false); \
        u32x4 w = {r0[0], r1[0], r0[1], r1[1]}; OUT = *reinterpret_cast<bf16x8*>(&w); } while (0)
    PK4(p0, 0, pa0); PK4(p0, 8, pa1); PK4(p1, 0, pa2); PK4(p1, 8, pa3);
#undef PK4
}
template <int KB>
__device__ __forceinline__ void qkt(f32x16& p0, f32x16& p1, const char* K_lds, int r32, int hi, const bf16x8* qr) {
    p0 = f32x16{}; p1 = f32x16{};
    const char* kb[4];
#pragma unroll
    for (int dd = 0; dd < 4; ++dd) kb[dd] = K_lds + KB * SHM_K + KSWZ(r32, (dd * 16 + hi * 8) * 2);
#pragma unroll
    for (int d0 = 0; d0 < 8; ++d0) { const char* a = kb[d0 & 3] + (d0 >> 2) * 128;
        bf16x8 b0 = *reinterpret_cast<const bf16x8*>(a);
        bf16x8 b1 = *reinterpret_cast<const bf16x8*>(a + 32 * 256);
        p0 = __builtin_amdgcn_mfma_f32_32x32x16_bf16(b0, qr[d0], p0, 0, 0, 0);
        p1 = __builtin_amdgcn_mfma_f32_32x32x16_bf16(b1, qr[d0], p1, 0, 0, 0); }
}
template <int VB>
__device__ __forceinline__ void pv_tile(f32x16* o, int vb0, bf16x8 pa0, bf16x8 pa1, bf16x8 pa2, bf16x8 pa3) {
#define TRRD(dst, off) asm volatile("ds_read_b64_tr_b16 %0, %1 offset:%2" : "=&v"(dst) : "v"(vb0), "i"(off) : "memory")
#define PV_D0(d0) do { s16x4 l0, l1, l2, l3, h0, h1, h2, h3; constexpr int b_ = VB * SHM_V + v_rd_off(d0, 0, 0); \
        TRRD(l0, b_); TRRD(h0, b_ + 2048); TRRD(l1, b_ + 4096); TRRD(h1, b_ + 6144); TRRD(l2, b_ + 8192); TRRD(h2, b_ + 10240); TRRD(l3, b_ + 12288); TRRD(h3, b_ + 14336); \
        asm volatile("s_waitcnt lgkmcnt(0)" ::: "memory"); SBAR();   \
        o[d0] = __builtin_amdgcn_mfma_f32_32x32x16_bf16(pa0, (bf16x8){l0[0], l0[1], l0[2], l0[3], h0[0], h0[1], h0[2], h0[3]}, o[d0], 0, 0, 0);   \
        o[d0] = __builtin_amdgcn_mfma_f32_32x32x16_bf16(pa1, (bf16x8){l1[0], l1[1], l1[2], l1[3], h1[0], h1[1], h1[2], h1[3]}, o[d0], 0, 0, 0);   \
        o[d0] = __builtin_amdgcn_mfma_f32_32x32x16_bf16(pa2, (bf16x8){l2[0], l2[1], l2[2], l2[3], h2[0], h2[1], h2[2], h2[3]}, o[d0], 0, 0, 0);   \
        o[d0] = __builtin_amdgcn_mfma_f32_32x32x16_bf16(pa3, (bf16x8){l3[0], l3[1], l3[2], l3[3], h3[0], h3[1], h3[2], h3[3]}, o[d0], 0, 0, 0); } while (0)
    PV_D0(0); PV_D0(1); PV_D0(2); PV_D0(3);
#undef PV_D0
#undef TRRD
}
struct BlockRef { const bf16_t* Q; const bf16_t* K; const bf16_t* V; const unsigned* M; bf16_t* O; const bf16_t* Z;
                  bf16_t* OPme; const bf16_t* OPot; f32x2* MLme; const f32x2* MLot; unsigned* cnt; int t_lo, NT; };
struct Seam { bf16x8 qr[8]; bf16x8 st_v0, st_v1, st_k0, st_k1; };
#define ROW(p, k0, rr) ((p) + (size_t)((k0) + (rr)) * D + sc)
#define VMW() asm volatile("s_waitcnt vmcnt(0)" ::: "memory")
#define VMWN(n) asm volatile("s_waitcnt vmcnt(%0)" :: "i"(n) : "memory")
#define SLOAD_H(Kp, Vp, k0) do { S.st_v0 = load8(ROW(Vp, k0, sr)); S.st_v1 = load8(ROW(Vp, k0, 32 + sr));              \
                         S.st_k0 = load8(ROW(Kp, k0, sr)); S.st_k1 = load8(ROW(Kp, k0, 32 + sr)); } while (0)
#define SWRITE_HK(bf) do { *(bf16x8*)(K_lds + (bf) * SHM_K + kws) = S.st_k0; *(bf16x8*)(K_lds + (bf) * SHM_K + kws + 32 * 256) = S.st_k1; } while (0)
#define SWRITE_HV(bf) do { *(bf16x8*)(V_lds + (bf) * SHM_V + vst0) = S.st_v0; *(bf16x8*)(V_lds + (bf) * SHM_V + vst1) = S.st_v1; } while (0)
#define SWRITE_H(bf) do { SWRITE_HV(bf); SWRITE_HK(bf); } while (0)
__device__ __forceinline__ void attn_prime(const BlockRef& cur, char* lds, Seam& S) {
    const int tid = opaque_tid(), wid = __builtin_amdgcn_readfirstlane(tid >> 6), lane = tid & 63, r32 = lane & 31, hi = lane >> 5;
    const int sr = tid >> 4, sc = (tid & 15) * 8, kws = KSWZ(sr, sc * 2); char* K_lds = lds + 2 * SHM_V;
#pragma unroll
    for (int d0 = 0; d0 < 8; ++d0) S.qr[d0] = load8(cur.Q + (size_t)(wid * QBLK + r32) * D + d0 * 16 + hi * 8);
    SLOAD_H(cur.K, cur.V, cur.t_lo * KVBLK); VMW(); SWRITE_HK(0);
    __syncthreads();
}
__device__ __forceinline__ void attn_block(const BlockRef& cur, const BlockRef& nxt, char* lds, Seam& S) {
    const int tid = opaque_tid(), wid = __builtin_amdgcn_readfirstlane(tid >> 6), lane = tid & 63, r32 = lane & 31, hi = lane >> 5;
    const int NT = cur.NT, t_lo = cur.t_lo;
    char* V_lds = lds; char* K_lds = lds + 2 * SHM_V;
    float* wsl = (float*)(lds + 2 * SHM_V + 2 * SHM_K) + wid * 128; float* li_l = wsl, * al_l = wsl + 32, * fb_l = wsl + 64;
    volatile unsigned* flag = (volatile unsigned*)(lds + 2 * SHM_V + 2 * SHM_K + NW * 128 * 4);
    float m_reg = -1e30f, l_reg = 0; f32x16 o[4] = {};
    const int sr = tid >> 4, sc = (tid & 15) * 8, vst0 = v_st(sr, sc), vst1 = v_st(32 + sr, sc), kws = KSWZ(sr, sc * 2);
    const int vb0 = (int)(uintptr_t)V_lds + v_rd_base(lane);
    const bf16_t* Kh = cur.K; const bf16_t* Vh = cur.V;
    const unsigned* mrow = cur.M + (size_t)(wid * QBLK + r32) * 128;
#define RESC(a) do { if (__any((a) < 1.f)) { if (hi == 0) al_l[r32] = (a); asm volatile("s_waitcnt lgkmcnt(0)" ::: "memory");              \
                     for (int d_ = 0; d_ < 4; ++d_) for (int r = 0; r < 16; ++r) o[d_][r] *= al_l[crow(r, hi)]; } } while (0)
#define KBASE(t) ((t_lo + (t)) * KVBLK)
#define MLOAD(t) (*(const u32x2*)(mrow + 2 * (t_lo + (t))))
#define SEAM_K0() do { VMWN(8); SWRITE_HK(0); SBAR(); } while (0)
    f32x16 pA0, pA1, pB0, pB1; float mnA, mnB, alA, alB; bf16x8 pa0, pa1, pa2, pa3;
    u32x2 mwA, mwB;
    SWRITE_HV(0); SBAR();
    mwA = MLOAD(0); mwB = MLOAD(1);
    SLOAD_H(Kh, Vh, KBASE(1));
    SBAR(); qkt<0>(pA0, pA1, K_lds, r32, hi, S.qr);
    mask_bits(pA0, pA1, mwA[0], mwA[1], hi); partialSM(pA0, pA1, m_reg, mnA, alA);
    VMW(); SWRITE_H(1);
    __syncthreads();
#define HALF_STEP(PX0, PX1, mnX, alX, mwX, mwY, PY0, PY1, alY, t, KB, VB, SB) do {                                              \
        SBAR(); mwY = MLOAD(((t) + 1 < NT) ? (t) + 1 : (t)); qkt<KB>(PX0, PX1, K_lds, r32, hi, S.qr);     \
        finishSM(PY0, PY1, alY, l_reg, pa0, pa1, pa2, pa3); SBAR();                                                           \
        if ((t) + 1 < NT) { SLOAD_H(Kh, Vh, KBASE((t) + 1)); SBAR(); }                                                        \
        pv_tile<VB>(o, vb0, pa0, pa1, pa2, pa3); mask_bits(PX0, PX1, mwX[0], mwX[1], hi); partialSM(PX0, PX1, m_reg, mnX, alX); \
        __syncthreads();                                                                                                      \
        if ((t) + 1 < NT) { VMW(); SWRITE_H(SB); }                                                                            \
        RESC(alX); __syncthreads(); } while (0)
    for (int t = 1; t + 1 < NT; t += 2) {
        HALF_STEP(pB0, pB1, mnB, alB, mwB, mwA, pA0, pA1, alA, t, 1, 0, 0);
        HALF_STEP(pA0, pA1, mnA, alA, mwA, mwB, pB0, pB1, alB, t + 1, 0, 1, 1);
    }
    SBAR(); qkt<1>(pB0, pB1, K_lds, r32, hi, S.qr); SBAR();
    SLOAD_H(nxt.K, nxt.V, nxt.t_lo * KVBLK); SBAR();
#pragma unroll
    for (int d0 = 0; d0 < 8; ++d0) S.qr[d0] = load8(nxt.Q + (size_t)(wid * QBLK + r32) * D + d0 * 16 + hi * 8);
    SBAR();
    finishSM(pA0, pA1, alA, l_reg, pa0, pa1, pa2, pa3); SBAR();
    pv_tile<0>(o, vb0, pa0, pa1, pa2, pa3);
    mask_bits(pB0, pB1, mwB[0], mwB[1], hi); partialSM(pB0, pB1, m_reg, mnB, alB); __syncthreads(); RESC(alB);
    finishSM(pB0, pB1, alB, l_reg, pa0, pa1, pa2, pa3); SBAR(); pv_tile<1>(o, vb0, pa0, pa1, pa2, pa3);
    SBAR(); SEAM_K0();
    char* Tl = lds + EPI_T0 + wid * EPI_TW;
    if (hi == 0) { li_l[r32] = l_reg; cur.MLme[wid * QBLK + r32] = (f32x2){m_reg, l_reg}; }
    asm volatile("s_waitcnt lgkmcnt(0)" ::: "memory");
#pragma unroll
    for (int r = 0; r < 16; ++r) { const float lr = li_l[crow(r, hi)]; const float rl = lr > 0.f ? __builtin_amdgcn_rcpf(lr) : 0.f;
#pragma unroll
        for (int d0 = 0; d0 < 4; ++d0) *(bf16_t*)(Tl + crow(r, hi) * 272 + (d0 * 32 + r32) * 2) = f2bf(o[d0][r] * rl); }
    asm volatile("s_waitcnt lgkmcnt(0)" ::: "memory");
    const int crw = lane >> 4, ccol = (lane & 15) * 8;
#pragma unroll
    for (int i = 0; i < 8; ++i) { const int row = crw + 4 * i; *(u32x4*)(cur.OPme + (size_t)(wid * QBLK + row) * D + ccol) = *(const u32x4*)(Tl + row * 272 + ccol * 2); }
    VMW(); __syncthreads();
    if (tid == 0) { __builtin_amdgcn_fence(__ATOMIC_RELEASE, "agent"); asm volatile("s_waitcnt vmcnt(0)" ::: "memory");
        *flag = __hip_atomic_fetch_add(cur.cnt, 1u, __ATOMIC_RELAXED, __HIP_MEMORY_SCOPE_AGENT); }
    __syncthreads();
    if (*flag == 1u) {
        if (tid == 0) { __builtin_amdgcn_fence(__ATOMIC_ACQUIRE, "agent"); asm volatile("s_waitcnt vmcnt(0)" ::: "memory"); }
        __syncthreads();
        u32x4 ot[8], zz[8];
#pragma unroll
        for (int i = 0; i < 8; ++i) { const int row = wid * QBLK + crw + 4 * i; ot[i] = *(const u32x4*)(cur.OPot + (size_t)row * D + ccol); zz[i] = *(const u32x4*)(cur.Z + (size_t)row * 1024 + ccol); }
        constexpr float C2 = 1.4426950408889634f * SCALE;
        if (hi == 0) { const f32x2 om = cur.MLot[wid * QBLK + r32]; const float M = fmaxf(m_reg, om[0]);
            const float wa = __builtin_amdgcn_exp2f((m_reg - M) * C2) * l_reg, wb = __builtin_amdgcn_exp2f((om[0] - M) * C2) * om[1];
            const float inv = __builtin_amdgcn_rcpf(wa + wb); li_l[r32] = wa * inv; fb_l[r32] = wb * inv; }
        asm volatile("s_waitcnt lgkmcnt(0)" ::: "memory");
#pragma unroll
        for (int i = 0; i < 8; ++i) { const int row = crw + 4 * i; const float fa = li_l[row], fb = fb_l[row];
            const u32x4 ow = *(const u32x4*)(Tl + row * 272 + ccol * 2); u32x4 w;
#pragma unroll
            for (int e = 0; e < 4; ++e) w[e] = cvt_pk_bf16((bflo(ow[e]) * fa + bflo(ot[i][e]) * fb) * bflo(zz[i][e]), (bfhi(ow[e]) * fa + bfhi(ot[i][e]) * fb) * bfhi(zz[i][e]));
            *(u32x4*)(cur.O + (size_t)(wid * QBLK + row) * 1024 + ccol) = w; }
    }
    __syncthreads();
#undef RESC
#undef KBASE
#undef MLOAD
#undef SEAM_K0
#undef HALF_STEP
}
#undef ROW
#undef VMW
#undef VMWN
#undef SLOAD_H
#undef SWRITE_HK
#undef SWRITE_HV
#undef SWRITE_H
__device__ __forceinline__ BlockRef make_ref(unsigned char* ws, unsigned* ctl, int item, int pass) {
    const int hf = item & 1, xp = (item >> 1) & 7, bh = item >> 4, qb = pass ? 15 - xp : xp, b = bh >> 3, h = bh & 7, kvh = b * 2 + (h >> 2);
    BlockRef r;
    r.Q = (const bf16_t*)(ws + WS_QN) + ((size_t)bh * SEQ + qb * QB) * D;
    r.K = (const bf16_t*)(ws + WS_KN) + (size_t)kvh * SEQ * D; r.V = (const bf16_t*)(ws + WS_VV) + (size_t)kvh * SEQ * D;
    r.M = (const unsigned*)(ws + WS_MASK) + (size_t)(b * SEQ + qb * QB) * 128;
    r.O = (bf16_t*)(ws + WS_XB) + (size_t)(b * SEQ + qb * QB) * 1024 + h * 128;
    r.Z = (const bf16_t*)(ws + WS_BZ) + (size_t)(b * SEQ + qb * QB) * 1024 + h * 128;
    const size_t prow = (size_t)bh * SEQ + qb * QB, hstr = (size_t)16 * SEQ;
    r.OPme = (bf16_t*)(ws + WS_OPART) + ((size_t)hf * hstr + prow) * D; r.OPot = (const bf16_t*)(ws + WS_OPART) + ((size_t)(hf ^ 1) * hstr + prow) * D;
    r.MLme = (f32x2*)(ws + WS_ML) + (size_t)hf * hstr + prow; r.MLot = (const f32x2*)(ws + WS_ML) + (size_t)(hf ^ 1) * hstr + prow;
    r.cnt = ctl + bh * 16 + qb;
    r.NT = 2 * (qb + 1); r.t_lo = hf * r.NT; return r;
}
}


#define XB_TMO      128
#define XB_XCNT(j)  (256  + 64 * (j))
#define XB_XSUB(j)  (1280 + 64 * (j))
#define XB_XGEN(j)  (2304 + 64 * (j))
#define XB_TOP      3328
#define XB_TOPGEN   3392
#define XCD_BAR_WORDS 3456
#define XB_SPIN_CAP (1u << 22)
__device__ __forceinline__ unsigned xb_ld(unsigned* p)              { return __hip_atomic_load(p, __ATOMIC_RELAXED, __HIP_MEMORY_SCOPE_AGENT); }
__device__ __forceinline__ unsigned xb_add(unsigned* p, unsigned v) { return __hip_atomic_fetch_add(p, v, __ATOMIC_RELAXED, __HIP_MEMORY_SCOPE_AGENT); }
__device__ __forceinline__ unsigned xb_xcc_id() { return (unsigned)__builtin_amdgcn_s_getreg((3 << 11) | 20) & 0xFu; }
#define XB_SPIN(cond, bar) do { unsigned _sp = 0; while (cond) { __builtin_amdgcn_s_sleep(1); \
    if ((++_sp & 255u) == 0u) { if (xb_ld(&(bar)[XB_TMO])) break; if (_sp > XB_SPIN_CAP) { atomicAdd(&(bar)[XB_TMO], 1u); break; } } } } while (0)
struct XcdBarrier { unsigned* bar; unsigned x; volatile LAS unsigned* st; };
__device__ __forceinline__ XcdBarrier xcd_barrier_post(unsigned* bar, volatile LAS unsigned* st) {
    XcdBarrier b; b.bar = bar; b.x = xb_xcc_id(); b.st = st;
    if (threadIdx.x == 0) (void)xb_add(&bar[XB_XCNT(b.x)], 1u);
    return b;
}
__device__ __forceinline__ void xcd_barrier_complete(unsigned* bar, unsigned x, unsigned& nloc, unsigned& nx) {
    const unsigned G = gridDim.x * gridDim.y * gridDim.z;
    unsigned sum, cnt, mine, sp = 0u;
    for (;;) {
        sum = 0u; cnt = 0u; mine = 0u;
#pragma unroll
        for (unsigned j = 0; j < 16; ++j) { const unsigned c = xb_ld(&bar[XB_XCNT(j)]); sum += c; cnt += (c > 0u) ? 1u : 0u; mine = (j == x) ? c : mine; }
        if (sum == G) break;
        __builtin_amdgcn_s_sleep(1);
        if ((++sp & 255u) == 0u) { if (xb_ld(&bar[XB_TMO])) break; if (sp > XB_SPIN_CAP) { atomicAdd(&bar[XB_TMO], 1u); break; } }
    }
    nloc = mine > 0u ? mine : 1u; nx = cnt > 0u ? cnt : 1u;
}
__device__ __forceinline__ void xcd_barrier(const XcdBarrier& b) {
    asm volatile("s_waitcnt vmcnt(0)" ::: "memory");
    __syncthreads();
    if (threadIdx.x == 0) {
        unsigned* bar = b.bar;
        __builtin_amdgcn_s_waitcnt(0);
        unsigned nloc = b.st[0], nx = b.st[1];
        if (nloc == 0u) { xcd_barrier_complete(bar, b.x, nloc, nx); b.st[0] = nloc; b.st[1] = nx; }
        const unsigned old = xb_add(&bar[XB_XSUB(b.x)], 1u);
        const unsigned gen = old / nloc;
        if (old + 1u == (gen + 1u) * nloc) {
            __builtin_amdgcn_fence(__ATOMIC_RELEASE, "agent");
            asm volatile("s_waitcnt vmcnt(0)" ::: "memory");
            const unsigned og = xb_add(&bar[XB_TOP], 1u);
            const unsigned tg = og / nx;
            if (og + 1u == (tg + 1u) * nx) xb_add(&bar[XB_TOPGEN], 1u);
            else XB_SPIN(xb_ld(&bar[XB_TOPGEN]) == tg, bar);
            __builtin_amdgcn_fence(__ATOMIC_ACQUIRE, "agent");
            xb_add(&bar[XB_XGEN(b.x)], 1u);
            asm volatile("s_waitcnt vmcnt(0)" ::: "memory");
        } else {
            XB_SPIN(xb_ld(&bar[XB_XGEN(b.x)]) == gen, bar);
            __builtin_amdgcn_fence(__ATOMIC_ACQUIRE, "agent");
            asm volatile("s_waitcnt vmcnt(0)" ::: "memory");
        }
    }
    __syncthreads();
}

constexpr int CW_EXIT = XCD_BAR_WORDS, CW_ATT = XCD_BAR_WORDS + 64, CW_IDXQ = CW_ATT + 256, CW_WORDS = CW_IDXQ + 64;
__device__ unsigned g_ctl[CW_WORDS];

__global__ void __launch_bounds__(NTHREADS, 2) fwd_mega(Params p) {
    extern __shared__ __attribute__((aligned(16))) unsigned char lds_raw[];
    cg::grid_group grid = cg::this_grid();
    LAS unsigned char* lds = (LAS unsigned char*)lds_raw;
    const int G = gridDim.x, bx = blockIdx.x;
    const int vcu = (G % 8 == 0) ? (bx % 8) * (G / 8) + bx / 8 : bx;
    unsigned char* ws = p.ws;
    volatile LAS unsigned* misc = (volatile LAS unsigned*)(lds + MISC_OFF);
    if (threadIdx.x < 2) misc[threadIdx.x] = 0u;
    __syncthreads();
    if (p.out == nullptr) grid.sync();
    const XcdBarrier gbar = xcd_barrier_post(g_ctl, misc);
#define GRID_SYNC() xcd_barrier(gbar)

#ifndef PHASES
#define PHASES 0xffff
#endif
#ifndef REPMASK
#define REPMASK 0
#endif
#define NREP(bit) ((REPMASK & (bit)) ? 2 : 1)
#ifndef SPAN_A
#define SPAN_A -1
#endif
#ifndef SPAN_B
#define SPAN_B -1
#endif
    volatile LAS unsigned long long* stamps = (volatile LAS unsigned long long*)(lds + MISC_OFF + 16);
#define STAMP(k) do { if (SPAN_A >= 0 && bx == 0 && threadIdx.x == 0) stamps[k] = __builtin_amdgcn_s_memrealtime(); } while (0)
    STAMP(0);
    if (SPAN_A >= 0 && bx == 0 && threadIdx.x == 0) { stamps[16] = 0; stamps[17] = 0; stamps[18] = 0; stamps[19] = 0; }
    for (int rep = 0; rep < NREP(1); ++rep) if (PHASES & 1) p0_prep(p, lds, vcu, G);
    GRID_SYNC(); STAMP(1);
    for (int rep = 0; rep < NREP(2); ++rep) if (PHASES & 2) {
        Sched1 S{G, bx, (const char*)ws};
        Epi1 E{ws, p.ik_g, p.ik_b};
        pg8::gemm_phase<Epi1, Sched1, true, true>(lds, DM, S, E);
    }
    if (PHASES & 1) { constexpr int NU1A = 32 * NT_BF + 16; const int nfull = (NU1A % G == 0) ? 0 : NU1A % G; const int nhelp = G - nfull;
        if (nhelp == G) p0b_gate8(p, lds, bx, G); else if (bx >= nfull) p0b_gate8(p, lds, bx - nfull, nhelp); }
    STAMP(14);
    GRID_SYNC();
    if (PHASES & 2) {
        Sched1b S{G, bx, (const char*)ws}; Epi1b E{ws};
        pg8::gemm_phase<Epi1b, Sched1b, true, true, true>(lds, DM / 2, S, E);
    }
    GRID_SYNC(); STAMP(2);
    for (int rep = 0; rep < NREP(4); ++rep) if (PHASES & 4) p2_qkprep(p, vcu, G);
    STAMP(3);
    for (int rep = 0; rep < NREP(8); ++rep) if (PHASES & 8) for (int u = bx; u < 512; u += G) p2_gmlp_unit(p, lds, u);
    STAMP(4);
    for (int rep = 0; rep < NREP(16); ++rep) if (PHASES & 16) for (int u = bx; u < 256; u += G) p2_mem_unit(p, lds, u);
    STAMP(5);
    for (int rep = 0; rep < NREP(32); ++rep) if (PHASES & 32) p2_idx_all(p, lds, bx, G, g_ctl + CW_IDXQ);
    STAMP(6);
    GRID_SYNC(); STAMP(7);
    for (int rep = 0; rep < NREP(64); ++rep) if (PHASES & 64) {
        const int L0 = (G == 256) ? ((bx & 7) * 32 + (bx >> 3)) : bx;
        if (L0 < 256) {
            int L = L0, pass = 0;
            att::Seam S; att::BlockRef cur = att::make_ref(ws, g_ctl + CW_ATT, L, 0);
            att::attn_prime(cur, (char*)lds_raw, S);
            STAMP(11);
            for (;;) {
                const bool more_pass = pass == 0, more_item = L + G < 256, last = !more_pass && !more_item;
                const int Ln = more_pass ? L : (more_item ? L + G : L), pn = more_pass ? 1 : 0;
                const att::BlockRef nxt = last ? cur : att::make_ref(ws, g_ctl + CW_ATT, Ln, pn);
                att::attn_block(cur, nxt, (char*)lds_raw, S);
                STAMP(12 + pass);
                if (last) break;
                cur = nxt; L = Ln; pass = pn;
            }
        }
    }
    GRID_SYNC(); STAMP(8);
    for (int rep = 0; rep < NREP(128); ++rep) if (PHASES & 128) {
        Sched2 S{G, bx, (const char*)ws};
        Epi2 E{ws};
        pg8::gemm_phase<Epi2, Sched2, true, true>(lds, 1024, S, E);
    }
    GRID_SYNC(); STAMP(9);
    if (REPMASK & 512) { for (int i = 0; i < 10; ++i) GRID_SYNC(); }
    for (int rep = 0; rep < NREP(256); ++rep) if (PHASES & 256) {
        Sched3 S{G, bx, (const char*)(ws + WS_MERGED), (const char*)(ws + WS_WOUT)};
        Epi3 E{p.x, p.out};
        pg8::gemm_phase<Epi3, Sched3, true, true>(lds, DM, S, E);
    }
    STAMP(10);
    if (SPAN_A >= 0 && bx == 0 && threadIdx.x == 0) {
        const unsigned long long dt = (SPAN_A >= 100) ? stamps[SPAN_A - 100 + 16] : (stamps[SPAN_B] - stamps[SPAN_A]), t0 = __builtin_amdgcn_s_memrealtime();
        while (__builtin_amdgcn_s_memrealtime() - t0 < dt) __builtin_amdgcn_s_sleep(8);
    }
    __syncthreads();
    if (threadIdx.x == 0) misc[0] = (xb_add(&g_ctl[CW_EXIT], 1u) == (unsigned)G - 1u) ? 1u : 0u;
    __syncthreads();
    if (misc[0]) { for (int i = threadIdx.x; i < CW_WORDS; i += NTHREADS) __hip_atomic_store(&g_ctl[i], 0u, __ATOMIC_RELAXED, __HIP_MEMORY_SCOPE_AGENT);
                   for (int i = threadIdx.x; i < NGATE; i += NTHREADS) __hip_atomic_store(&g_colmax[i], 0u, __ATOMIC_RELAXED, __HIP_MEMORY_SCOPE_AGENT); }
}

extern "C" void kernel_launch(void* const* d_in, const int* in_sizes, int n_in, void* d_out, int out_size, void* d_ws, size_t ws_size, hipStream_t stream) {
    static int grid_blocks = 0;
    if (!grid_blocks) {
        if (n_in != 21 || out_size != T * DM || ws_size < WS_TOTAL) { fprintf(stderr, "kernel_launch: unexpected shapes (n_in %d out %d ws %zu)\n", n_in, out_size, ws_size); grid_blocks = -1; return; }
        int dev = 0, cus = 0, per_cu = 0;
        (void)hipGetDevice(&dev);
        (void)hipDeviceGetAttribute(&cus, hipDeviceAttributeMultiprocessorCount, dev);
        (void)hipFuncSetAttribute((const void*)fwd_mega, hipFuncAttributeMaxDynamicSharedMemorySize, LDS_BYTES);
        (void)hipOccupancyMaxActiveBlocksPerMultiprocessor(&per_cu, (const void*)fwd_mega, NTHREADS, LDS_BYTES);
        if (per_cu < 1) { fprintf(stderr, "kernel_launch: occupancy query returned %d\n", per_cu); grid_blocks = -1; return; }
        grid_blocks = cus;
        fprintf(stderr, "kernel_launch: cus %d per_cu %d grid %d\n", cus, per_cu, grid_blocks);
    }
    if (grid_blocks < 0) return;
    Params p{};
    p.x = (const float*)d_in[0]; p.mem = (const float*)d_in[1]; p.pos = (const int*)d_in[2]; p.norm_gain = (const float*)d_in[3]; p.w_in = (const float*)d_in[4];
    p.gmlp_g = (const float*)d_in[5]; p.gmlp_b = (const float*)d_in[6]; p.spatial_w = (const float*)d_in[7]; p.spatial_b = (const float*)d_in[8]; p.w_a = (const float*)d_in[9];
    p.q_gain = (const float*)d_in[10]; p.k_gain = (const float*)d_in[11]; p.ik_g = (const float*)d_in[12]; p.ik_b = (const float*)d_in[13]; p.w_b = (const float*)d_in[14];
    p.mem_gain = (const float*)d_in[15]; p.w_mkv = (const float*)d_in[16]; p.mq_gain = (const float*)d_in[17]; p.mk_gain = (const float*)d_in[18]; p.w_m = (const float*)d_in[19];
    p.w_out = (const float*)d_in[20]; p.out = (float*)d_out; p.ws = (unsigned char*)d_ws;
    void* args[] = {&p};
    hipError_t e = hipLaunchCooperativeKernel((const void*)fwd_mega, dim3(grid_blocks), dim3(NTHREADS), args, LDS_BYTES, stream);
    if (e != hipSuccess) fprintf(stderr, "cooperative launch failed: %s (grid %d)\n", hipGetErrorString(e), grid_blocks);
}
```

```cpp
#include <hip/hip_runtime.h>
#include <hip/hip_cooperative_groups.h>
#include <cstdio>
#include <cstdint>
namespace cg = cooperative_groups;

#define LAS __attribute__((address_space(3)))
typedef unsigned short bf16_t;
typedef short bf16x8 __attribute__((ext_vector_type(8)));
typedef short s16x4 __attribute__((ext_vector_type(4)));
typedef float f32x2 __attribute__((ext_vector_type(2)));
typedef float f32x4 __attribute__((ext_vector_type(4)));
typedef float f32x16 __attribute__((ext_vector_type(16)));
typedef unsigned u32x2 __attribute__((ext_vector_type(2)));
typedef unsigned u32x4 __attribute__((ext_vector_type(4)));
typedef int i32x4 __attribute__((ext_vector_type(4)));

constexpr int NB = 2, SEQ = 4096, T = NB * SEQ, DM = 2048, DIN = 14928, NPAD = 15104, MEML = 256;
constexpr int NTHREADS = 512, NWAVES = 8;
constexpr int LDS_BYTES = 147456;
constexpr float EPS = 1e-6f;
constexpr float LOG2E = 1.4426950408889634f;

constexpr size_t MiB = (size_t)1 << 20;
constexpr size_t WS_WIN = 0, WS_WBR = 60 * MiB, WS_WOUT = 72 * MiB, WS_WMKV = 80 * MiB, WS_H = 88 * MiB, WS_MEMN = 120 * MiB;
constexpr size_t WS_AU = 122 * MiB, WS_AV = 138 * MiB, WS_AZ = 154 * MiB, WS_QR = 170 * MiB, WS_BZ = 186 * MiB, WS_MQ = 202 * MiB, WS_MZ = 218 * MiB;
constexpr size_t WS_IQ = 234 * MiB, WS_KR = 250 * MiB, WS_VV = 254 * MiB, WS_SA = 258 * MiB, WS_SB = 290 * MiB, WS_SM = 322 * MiB;
constexpr size_t WS_QN = 354 * MiB, WS_KN = 370 * MiB, WS_XA = 374 * MiB, WS_XM = 390 * MiB, WS_MASK = 406 * MiB, WS_IK = 410 * MiB, WS_IW = 411 * MiB;
constexpr size_t WS_KM = 412 * MiB, WS_VT = 413 * MiB, WS_CSB = 414 * MiB, WS_CSI = 415 * MiB, WS_END = 416 * MiB;
constexpr size_t WS_RKP = WS_IW + 524288;
constexpr size_t WS_OPART = WS_END, WS_ML = WS_END + 32 * MiB, WS_TOTAL = WS_END + 34 * MiB;
constexpr size_t WS_CTL = WS_END, CTL_BYTES = 65536;
constexpr int NGATE = 8192, GATE0 = 6736, NT_BF = 27;
constexpr size_t WS_LNP = 48 * MiB;
constexpr size_t WS_W8 = 27 * MiB, WS_SH = 47 * MiB, WS_SW = 47 * MiB + 65536, WS_CMP = 47 * MiB + 131072, WS_H8 = WS_OPART;
static_assert(WS_W8 + (size_t)NGATE * DM <= WS_SH && WS_CMP + 8 * NGATE * 4 <= WS_WBR && (size_t)NT_BF * 256 * DM * 2 <= WS_W8, "int8 regions inside the WS_WIN slot");
constexpr int CW_BAR = 0;
constexpr int MISC_OFF = 147200;
constexpr size_t WS_XB = WS_QR;
constexpr size_t WS_MERGED = WS_H;

typedef __bf16 bf16x2_t __attribute__((ext_vector_type(2)));
__device__ __forceinline__ unsigned cvt_pk_bf16(float lo, float hi) { const f32x2 v = {lo, hi}; const bf16x2_t b = __builtin_convertvector(v, bf16x2_t); return __builtin_bit_cast(unsigned, b); }
__device__ __forceinline__ bf16_t f2bf(float f) { return (bf16_t)(cvt_pk_bf16(f, 0.f) & 0xffffu); }
__device__ __forceinline__ float bf2f(unsigned short b) { return __uint_as_float(((unsigned)b) << 16); }
__device__ __forceinline__ float bflo(unsigned w) { return __uint_as_float(w << 16); }
__device__ __forceinline__ float bfhi(unsigned w) { return __uint_as_float(w & 0xffff0000u); }
__device__ __forceinline__ float sigm(float x) { return __builtin_amdgcn_rcpf(1.f + __builtin_amdgcn_exp2f(-LOG2E * x)); }
__device__ __forceinline__ float silu_f(float x) { return x * sigm(x); }
__device__ __forceinline__ float gelu_f(float x) { const float u = 0.7978845608028654f * (x + 0.044715f * x * x * x); return x * sigm(2.f * u); }
__device__ __forceinline__ float wave_sum(float v) {
#pragma unroll
    for (int o = 1; o < 64; o <<= 1) v += __shfl_xor(v, o);
    return v;
}
__device__ __forceinline__ unsigned wave_sum_u(unsigned v) {
#pragma unroll
    for (int o = 1; o < 64; o <<= 1) v += (unsigned)__shfl_xor((int)v, o);
    return v;
}
__device__ __forceinline__ bf16x8 pack8(f32x4 a, f32x4 b) {
    u32x4 w = {cvt_pk_bf16(a[0], a[1]), cvt_pk_bf16(a[2], a[3]), cvt_pk_bf16(b[0], b[1]), cvt_pk_bf16(b[2], b[3])};
    return *reinterpret_cast<bf16x8*>(&w);
}
#define LDS_WAIT() asm volatile("s_waitcnt lgkmcnt(0)" ::: "memory")
__device__ __forceinline__ int opaque_tid() { int t = threadIdx.x; asm volatile("" : "+v"(t)); return t; }

namespace pg8 {
constexpr int BM = 256, BK = 64, HALF = 128, HTB = HALF * BK * 2, STAGE_BYTES = 8 * HTB, NXCD = 8, WGM = 8;
__host__ __device__ __forceinline__ int lds_byte(int r, int c) { const int st = (r >> 4) * 2 + (c >> 5), rr = r & 15, cc = c & 31, ob = rr * 64 + cc * 2; return st * 1024 + (ob ^ (((ob >> 9) & 1) << 5)); }
__host__ __device__ __forceinline__ void stage_rc(int b, int& R, int& C) { const int st = b / 1024, sb = b % 1024, swz = sb ^ (((sb >> 9) & 1) << 5); R = (st >> 1) * 16 + swz / 64; C = (st & 1) * 32 + (swz % 64) / 2; }
__host__ __device__ __forceinline__ int perm32(int rho) { const int n = rho >> 4, i = rho & 15; return 8 * (i >> 2) + 4 * n + (i & 3); }

struct Unit { int pm, pn, kind; };

__device__ __forceinline__ void tile_order(int wgid, int nM, int nN, int& pm, int& pn) {
    const int nwg = nM * nN;
    { const int q = nwg / NXCD, r = nwg % NXCD, xcd = wgid % NXCD, off = wgid / NXCD; wgid = (xcd < r ? xcd * (q + 1) : r * (q + 1) + (xcd - r) * q) + off; }
    const int nig = WGM * nN, gid = wgid / nig, fm = gid * WGM, gsz = (nM - fm) < WGM ? (nM - fm) : WGM;
    pm = fm + ((wgid % nig) % gsz); pn = (wgid % nig) / gsz;
}

template <class Epi, class Sched, bool ALIGN_EPI, bool SP2, bool I8 = false>
__device__ __forceinline__ void gemm_phase(LAS unsigned char* lds, const int K, const Sched& S, const Epi& E) {
    const int tid = opaque_tid(), wid = __builtin_amdgcn_readfirstlane(tid >> 6), lane = tid & 63, wr = wid >> 2, wc = wid & 3, fr = lane & 15, fq = lane >> 4;
    const int nt = K / BK;
    unsigned voffA[2], voffB[2];
#pragma unroll
    for (int i = 0; i < 2; ++i) { int R, C; stage_rc(tid * 16 + i * 8192, R, C); const int Rb = Epi::PERM ? ((R & ~31) + perm32(R & 31)) : R;
        voffA[i] = (unsigned)(R * K + C) * 2u; voffB[i] = (unsigned)(Rb * K + C) * 2u; }
    const size_t kstep = (size_t)(BK * 2);
    const size_t hstep = (size_t)HALF * K * 2;
    const unsigned ldsw = (unsigned)wid * 1024u;
    const int aoff = lds_byte(wr * 64 + fr, fq * 8), boff = lds_byte(wc * 32 + fr, fq * 8);
#define PG8_SA(b, h) (((b) * 2 + (h)) * HTB)
#define PG8_SB(b, h) ((4 + (b) * 2 + (h)) * HTB)
#define PG8_STAGE(bufoff, gbase, voff) do { _Pragma("unroll") for (int _i = 0; _i < 2; ++_i) \
        __builtin_amdgcn_global_load_lds((const unsigned*)((const char*)(gbase) + (voff)[_i]), (LAS unsigned*)(lds + (bufoff) + ldsw + _i * 8192), 16, 0, 0); } while (0)
#define PG8_LDA(dst, b, h) do { _Pragma("unroll") for (int m = 0; m < 4; ++m) _Pragma("unroll") for (int k = 0; k < 2; ++k) dst[m][k] = *(const LAS bf16x8*)(lds + PG8_SA(b, h) + aoff + m * 2048 + k * 1024); } while (0)
#define PG8_LDB(dst, b, h) do { _Pragma("unroll") for (int n = 0; n < 2; ++n) _Pragma("unroll") for (int k = 0; k < 2; ++k) dst[n][k] = *(const LAS bf16x8*)(lds + PG8_SB(b, h) + boff + n * 2048 + k * 1024); } while (0)
#define PG8_MMA(ai, bj, At, Bt) do { __builtin_amdgcn_s_setprio(1); _Pragma("unroll") for (int m = 0; m < 4; ++m) _Pragma("unroll") for (int n = 0; n < 2; ++n) _Pragma("unroll") for (int k = 0; k < 2; ++k) \
        { if constexpr (I8) acc[ai][bj][m][n] = __builtin_bit_cast(f32x4, __builtin_amdgcn_mfma_i32_16x16x64_i8(__builtin_bit_cast(i32x4, Bt[n][k]), __builtin_bit_cast(i32x4, At[m][k]), __builtin_bit_cast(i32x4, acc[ai][bj][m][n]), 0, 0, 0)); \
          else acc[ai][bj][m][n] = __builtin_amdgcn_mfma_f32_16x16x32_bf16(Bt[n][k], At[m][k], acc[ai][bj][m][n], 0, 0, 0); } __builtin_amdgcn_s_setprio(0); } while (0)
#define PG8_WAIT_V(n) asm volatile("s_waitcnt vmcnt(" #n ")" ::: "memory")
#define PG8_WAIT_L(n) asm volatile("s_waitcnt lgkmcnt(" #n ")" ::: "memory")
#define PG8_BAR __builtin_amdgcn_s_barrier()
#define PG8_SCHED __builtin_amdgcn_sched_barrier(0)
    Unit cur, nxt; int ui = 0;
    if (!S.next(0, cur)) return;
    f32x4 acc[2][2][4][2];
    if constexpr (Epi::INIT) E.init(acc, cur, wr, wc, fr, fq);
    else {
#pragma unroll
    for (int a = 0; a < 2; ++a)
#pragma unroll
        for (int b = 0; b < 2; ++b)
#pragma unroll
            for (int m = 0; m < 4; ++m)
#pragma unroll
                for (int n = 0; n < 2; ++n) acc[a][b][m][n] = (f32x4){0.f, 0.f, 0.f, 0.f};
    }
    bf16x8 At[4][2], B0[2][2], B1[2][2];
    const char* cA = S.a_base(cur); const char* cB = S.b_base(cur);
    if constexpr (SP2) {
        PG8_STAGE(PG8_SB(0, 0), cB, voffB); PG8_STAGE(PG8_SB(0, 1), cB + hstep, voffB); PG8_STAGE(PG8_SA(0, 0), cA, voffA); PG8_STAGE(PG8_SA(0, 1), cA + hstep, voffA);
        if (wr == 1) PG8_BAR;
        PG8_WAIT_V(2); PG8_BAR;
        PG8_STAGE(PG8_SB(1, 0), cB + kstep, voffB); PG8_STAGE(PG8_SA(1, 0), cA + kstep, voffA); PG8_STAGE(PG8_SB(1, 1), cB + hstep + kstep, voffB);
        PG8_WAIT_V(6); PG8_BAR;
    } else {
        PG8_STAGE(PG8_SB(0, 0), cB, voffB); PG8_STAGE(PG8_SA(0, 0), cA, voffA); PG8_STAGE(PG8_SB(0, 1), cB + hstep, voffB); PG8_STAGE(PG8_SA(0, 1), cA + hstep, voffA);
        if (wr == 1) PG8_BAR;
        PG8_WAIT_V(4); PG8_BAR;
        PG8_STAGE(PG8_SB(1, 0), cB + kstep, voffB); PG8_STAGE(PG8_SA(1, 0), cA + kstep, voffA); PG8_STAGE(PG8_SB(1, 1), cB + hstep + kstep, voffB);
        PG8_WAIT_V(6); PG8_BAR;
    }
    for (;;) {
        const bool has_next = S.next(ui + 1, nxt);
        const char* nA = has_next ? S.a_base(nxt) : cA; const char* nB = has_next ? S.b_base(nxt) : cB;
        for (int t = 0; t < nt; t += 2) {
            const bool last = (t == nt - 2);
            const char* a1 = cA + (size_t)(t + 1) * kstep;
            const char* a2 = last ? nA : cA + (size_t)(t + 2) * kstep; const char* b2 = last ? nB : cB + (size_t)(t + 2) * kstep;
            const char* a3 = a2 + kstep; const char* b3 = b2 + kstep;
            if constexpr (SP2) {
            PG8_LDB(B0, 0, 0); PG8_LDB(B1, 0, 1); PG8_SCHED; PG8_LDA(At, 0, 0); PG8_STAGE(PG8_SA(1, 1), a1 + hstep, voffA);
            PG8_WAIT_V(8); PG8_WAIT_L(0); PG8_BAR; PG8_MMA(0, 0, At, B0); PG8_MMA(0, 1, At, B1); PG8_BAR; PG8_SCHED;
            PG8_LDA(At, 0, 1); PG8_STAGE(PG8_SB(0, 0), b2, voffB); PG8_STAGE(PG8_SB(0, 1), b2 + hstep, voffB); PG8_STAGE(PG8_SA(0, 0), a2, voffA);
            PG8_WAIT_V(8); PG8_WAIT_L(0); PG8_BAR; PG8_MMA(1, 0, At, B0); PG8_MMA(1, 1, At, B1); PG8_BAR; PG8_SCHED;
            PG8_LDB(B0, 1, 0); PG8_LDB(B1, 1, 1); PG8_SCHED; PG8_LDA(At, 1, 0); PG8_STAGE(PG8_SA(0, 1), a2 + hstep, voffA);
            PG8_WAIT_V(8); PG8_WAIT_L(0); PG8_BAR; PG8_MMA(0, 0, At, B0); PG8_MMA(0, 1, At, B1); PG8_BAR; PG8_SCHED;
            PG8_LDA(At, 1, 1); PG8_STAGE(PG8_SB(1, 0), b3, voffB); PG8_STAGE(PG8_SB(1, 1), b3 + hstep, voffB); PG8_STAGE(PG8_SA(1, 0), a3, voffA);
            PG8_WAIT_V(8); PG8_WAIT_L(0); PG8_BAR; PG8_MMA(1, 0, At, B0); PG8_MMA(1, 1, At, B1); PG8_BAR; PG8_SCHED;
            } else {
            PG8_LDB(B0, 0, 0); PG8_SCHED; PG8_LDA(At, 0, 0); PG8_STAGE(PG8_SA(1, 1), a1 + hstep, voffA);
            PG8_WAIT_L(8); PG8_BAR; PG8_WAIT_L(0); PG8_MMA(0, 0, At, B0); PG8_BAR; PG8_SCHED;
            PG8_LDB(B1, 0, 1); PG8_STAGE(PG8_SB(0, 0), b2, voffB);
            PG8_BAR; PG8_WAIT_L(0); PG8_MMA(0, 1, At, B1); PG8_BAR;
            PG8_LDA(At, 0, 1); PG8_STAGE(PG8_SA(0, 0), a2, voffA);
            PG8_BAR; PG8_WAIT_L(0); PG8_MMA(1, 0, At, B0); PG8_BAR; PG8_SCHED;
            PG8_STAGE(PG8_SB(0, 1), b2 + hstep, voffB);
            PG8_WAIT_V(6); PG8_BAR; PG8_MMA(1, 1, At, B1); PG8_BAR;
            PG8_LDB(B0, 1, 0); PG8_SCHED; PG8_LDA(At, 1, 0); PG8_STAGE(PG8_SA(0, 1), a2 + hstep, voffA);
            PG8_WAIT_L(8); PG8_BAR; PG8_WAIT_L(0); PG8_MMA(0, 0, At, B0); PG8_BAR; PG8_SCHED;
            PG8_LDB(B1, 1, 1); PG8_STAGE(PG8_SB(1, 0), b3, voffB);
            PG8_BAR; PG8_WAIT_L(0); PG8_MMA(0, 1, At, B1); PG8_BAR;
            PG8_LDA(At, 1, 1); PG8_STAGE(PG8_SA(1, 0), a3, voffA);
            PG8_BAR; PG8_WAIT_L(0); PG8_MMA(1, 0, At, B0); PG8_BAR; PG8_SCHED;
            PG8_STAGE(PG8_SB(1, 1), b3 + hstep, voffB);
            PG8_WAIT_V(6); PG8_BAR; PG8_MMA(1, 1, At, B1); PG8_BAR;
            }
        }
        if constexpr (ALIGN_EPI) { if (wr == 0) PG8_BAR; }
        const bool zero = E(acc, cur, wr, wc, fr, fq);
        if (!has_next) break;
        if constexpr (Epi::INIT) { E.init(acc, nxt, wr, wc, fr, fq); }
        else if (zero) {
#pragma unroll
        for (int a = 0; a < 2; ++a)
#pragma unroll
            for (int b = 0; b < 2; ++b)
#pragma unroll
                for (int m = 0; m < 4; ++m)
#pragma unroll
                    for (int n = 0; n < 2; ++n) acc[a][b][m][n] = (f32x4){0.f, 0.f, 0.f, 0.f};
        }
        cur = nxt; cA = nA; cB = nB; ++ui;
        if constexpr (ALIGN_EPI) { if (wr == 1) PG8_BAR; }
    }
    PG8_WAIT_V(0);
    if constexpr (!ALIGN_EPI) { if (wr == 0) PG8_BAR; }
    PG8_BAR;
#undef PG8_SA
#undef PG8_SB
#undef PG8_STAGE
#undef PG8_LDA
#undef PG8_LDB
#undef PG8_MMA
#undef PG8_WAIT_V
#undef PG8_WAIT_L
#undef PG8_BAR
#undef PG8_SCHED
}
}

struct Params {
    const float* x; const float* mem; const int* pos; const float* norm_gain; const float* w_in; const float* gmlp_g; const float* gmlp_b;
    const float* spatial_w; const float* spatial_b; const float* w_a; const float* q_gain; const float* k_gain; const float* ik_g; const float* ik_b;
    const float* w_b; const float* mem_gain; const float* w_mkv; const float* mq_gain; const float* mk_gain; const float* w_m; const float* w_out;
    float* out; unsigned char* ws;
};

__device__ unsigned g_colmax[8192];

__device__ __forceinline__ int win_src_col(int np) {
    const int tile = np >> 8, c = np & 255;
    if (tile < 22) return np;
    const int bj = c >> 7, wc = (c >> 5) & 3, fq = (c >> 3) & 3, j = c & 7;
    if (tile < 26) return 5632 + (tile - 22) * 256 + wc * 64 + 8 * (2 * fq + bj) + j;
    if (tile == 26) {
        if (wc == 0) return 6656 + 8 * (2 * fq + bj) + j;
        if (wc == 1 && fq == 0) return 6720 + 8 * bj + j;
        return -1;
    }
    return np - 176;
}
__device__ __forceinline__ void transpose_item(const float* W, int K, int N, bf16_t* WT, int kb, int nb, bool is_win, LAS float* scr, int lane) {
    const int k0 = 64 * kb, n0 = 32 * nb, nl = lane & 31;
    const int src = is_win ? win_src_col(n0 + nl) : (n0 + nl);
    const float* wp = W + (size_t)(k0 + (lane >> 5)) * N + (src >= 0 ? src : 0);
    float tv[32];
#pragma unroll
    for (int i = 0; i < 32; ++i) tv[i] = wp[(size_t)(2 * i) * N];
#pragma unroll
    for (int i = 0; i < 32; ++i) { const int kk = 2 * i + (lane >> 5); scr[kk * 33 + nl] = src >= 0 ? tv[i] : 0.f; }
    LDS_WAIT(); asm volatile("" ::: "memory");
    const int c = lane & 7;
#pragma unroll
    for (int j = 0; j < 4; ++j) { const int n = (lane >> 3) + 8 * j; const LAS float* s = scr + (8 * c) * 33 + n;
        u32x4 o; o.x = cvt_pk_bf16(s[0 * 33], s[1 * 33]); o.y = cvt_pk_bf16(s[2 * 33], s[3 * 33]); o.z = cvt_pk_bf16(s[4 * 33], s[5 * 33]); o.w = cvt_pk_bf16(s[6 * 33], s[7 * 33]);
        *(u32x4*)(WT + (size_t)(n0 + n) * K + k0 + 8 * c) = o; }
    LDS_WAIT(); asm volatile("" ::: "memory");
}
template <bool Q8>
__device__ __forceinline__ void rms_row(const float* xrow, const float* gain, bf16_t* orow, unsigned* q8row, float* q8scale, int lane) {
    f32x4 v[8]; float s = 0.f;
#pragma unroll
    for (int j = 0; j < 8; ++j) { v[j] = ((const f32x4*)xrow)[lane + 64 * j]; s += (v[j][0] * v[j][0] + v[j][1] * v[j][1]) + (v[j][2] * v[j][2] + v[j][3] * v[j][3]); }
    s = wave_sum(s);
    const float r = 1.0f / sqrtf(s * (1.0f / DM) + EPS);
    float am = 0.f;
#pragma unroll
    for (int j = 0; j < 8; ++j) { const f32x4 g = ((const f32x4*)gain)[lane + 64 * j]; v[j] = v[j] * r * g;
        u32x2 w; w.x = cvt_pk_bf16(v[j][0], v[j][1]); w.y = cvt_pk_bf16(v[j][2], v[j][3]); ((u32x2*)orow)[lane + 64 * j] = w;
        if (Q8) am = fmaxf(fmaxf(am, fmaxf(fabsf(v[j][0]), fabsf(v[j][1]))), fmaxf(fabsf(v[j][2]), fabsf(v[j][3]))); }
    if (Q8) {
#pragma unroll
        for (int o = 1; o < 64; o <<= 1) am = fmaxf(am, __shfl_xor(am, o));
        const float inv = am > 0.f ? 127.f / am : 0.f;
#pragma unroll
        for (int j = 0; j < 8; ++j) { const int q0 = (int)rintf(v[j][0] * inv), q1 = (int)rintf(v[j][1] * inv), q2 = (int)rintf(v[j][2] * inv), q3 = (int)rintf(v[j][3] * inv);
            q8row[lane + 64 * j] = (unsigned)(q0 & 0xff) | ((unsigned)(q1 & 0xff) << 8) | ((unsigned)(q2 & 0xff) << 16) | ((unsigned)(q3 & 0xff) << 24); }
        if (lane == 0) *q8scale = am * (1.f / 127.f);
    }
}
__device__ __forceinline__ void p0_prep(const Params& p, LAS unsigned char* lds, int vcu, int G) {
    const int tid = opaque_tid(), lane = tid & 63, wave = tid >> 6;
    LAS float* scr = (LAS float*)(lds + wave * 16384);
    const int gw = vcu * NWAVES + wave, NGW = G * NWAVES;
    unsigned char* ws = p.ws;
    constexpr int I_CM = 32 * 32, I_WIN = 32 * (NT_BF * 8), I_BR = 16 * 64, I_SQ = 32 * 64;
    constexpr int NITEMS = I_CM + I_WIN + 3 * I_BR + 2 * I_SQ;
    for (int it = gw; it < NITEMS; it += NGW) {
        int r = it;
        if (r < I_CM) {
            const int cg = r % 32, kc = r / 32; const float* wp = p.w_in + (size_t)(64 * kc) * DIN + GATE0 + 256 * cg + 4 * lane; f32x4 m = {0.f, 0.f, 0.f, 0.f};
#pragma unroll 32
            for (int k = 0; k < 64; ++k) { const f32x4 w = *(const f32x4*)(wp + (size_t)k * DIN); m[0] = fmaxf(m[0], fabsf(w[0])); m[1] = fmaxf(m[1], fabsf(w[1])); m[2] = fmaxf(m[2], fabsf(w[2])); m[3] = fmaxf(m[3], fabsf(w[3])); }
#pragma unroll
            for (int e = 0; e < 4; ++e) atomicMax(&g_colmax[256 * cg + 4 * lane + e], __float_as_uint(m[e]));
            continue; } r -= I_CM;
        if (r < I_WIN) { const int nb = r % (NT_BF * 8), kb = r / (NT_BF * 8); transpose_item(p.w_in, DM, DIN, (bf16_t*)(ws + WS_WIN), kb, nb, true, scr, lane); continue; } r -= I_WIN;
        if (r < 3 * I_BR) { const int br = r / I_BR, q = r % I_BR; const float* W = br == 0 ? p.w_a : (br == 1 ? p.w_b : p.w_m);
            transpose_item(W, 1024, DM, (bf16_t*)(ws + WS_WBR) + (size_t)br * DM * 1024, q / 64, q % 64, false, scr, lane); continue; } r -= 3 * I_BR;
        if (r < I_SQ) { transpose_item(p.w_out, DM, DM, (bf16_t*)(ws + WS_WOUT), r / 64, r % 64, false, scr, lane); continue; } r -= I_SQ;
        transpose_item(p.w_mkv, DM, DM, (bf16_t*)(ws + WS_WMKV), r / 64, r % 64, false, scr, lane);
    }
    for (int m = gw; m < T + NB * MEML; m += NGW) {
        if (m < T) rms_row<true>(p.x + (size_t)m * DM, p.norm_gain, (bf16_t*)(ws + WS_H) + (size_t)m * DM, (unsigned*)(ws + WS_H8) + (size_t)m * (DM / 4), (float*)(ws + WS_SH) + m, lane);
        else rms_row<false>(p.mem + (size_t)(m - T) * DM, p.mem_gain, (bf16_t*)(ws + WS_MEMN) + (size_t)(m - T) * DM, nullptr, nullptr, lane);
    }
    for (int i = vcu * NTHREADS + tid; i < T * 24; i += G * NTHREADS) {
        const int t = i / 24, j = i % 24; const float ps = (float)p.pos[t];
        float inv; if (j < 16) inv = powf(500000.0f, -(float)j / 16.0f); else inv = powf(500000.0f, -(float)(j - 16) / 8.0f);
        float sn, cs; sincosf(ps * inv, &sn, &cs);
        if (j < 16) ((f32x2*)(ws + WS_CSB))[t * 16 + j] = (f32x2){cs, sn}; else ((f32x2*)(ws + WS_CSI))[t * 8 + (j - 16)] = (f32x2){cs, sn};
    }
}
__device__ __forceinline__ void p0b_gate8(const Params& p, LAS unsigned char* lds, int widx, int nw) {
    const int tid = opaque_tid(), lane = tid & 63, wave = tid >> 6;
    LAS float* scr = (LAS float*)(lds + wave * 16384);
    const int gw = widx * NWAVES + wave, NGW = nw * NWAVES;
    unsigned char* ws = p.ws;
    for (int it = gw; it < 32 * (NGATE / 32); it += NGW) {
        const int nb = it % (NGATE / 32), kb = it / (NGATE / 32), k0 = 64 * kb, n0 = 32 * nb, nl = lane & 31;
        const float cm = __uint_as_float(__hip_atomic_load(&g_colmax[n0 + nl], __ATOMIC_RELAXED, __HIP_MEMORY_SCOPE_AGENT));
        const float inv = cm > 0.f ? 127.f / cm : 0.f;
        if (kb == 0 && lane < 32) ((float*)(ws + WS_SW))[n0 + nl] = cm * (1.f / 127.f);
        const float* wp = p.w_in + (size_t)(k0 + (lane >> 5)) * DIN + GATE0 + n0 + nl;
        float tv[32];
#pragma unroll
        for (int i = 0; i < 32; ++i) tv[i] = wp[(size_t)(2 * i) * DIN];
#pragma unroll
        for (int i = 0; i < 32; ++i) { const int kk = 2 * i + (lane >> 5); scr[kk * 33 + nl] = rintf(tv[i] * inv); }
        LDS_WAIT(); asm volatile("" ::: "memory");
        const int c = lane & 7;
#pragma unroll
        for (int j = 0; j < 4; ++j) { const int n = (lane >> 3) + 8 * j; const LAS float* sp = scr + (8 * c) * 33 + n;
            unsigned lo = 0, hi2 = 0;
#pragma unroll
            for (int e = 0; e < 4; ++e) { lo |= ((unsigned)((int)sp[e * 33]) & 0xffu) << (8 * e); hi2 |= ((unsigned)((int)sp[(4 + e) * 33]) & 0xffu) << (8 * e); }
            *(u32x2*)((unsigned char*)(ws + WS_W8) + (size_t)(n0 + n) * DM + k0 + 8 * c) = (u32x2){lo, hi2}; }
        LDS_WAIT(); asm volatile("" ::: "memory");
    }
}

struct Sched1 {
    int G, c; const char* ws;
    __device__ __forceinline__ bool next(int i, pg8::Unit& u) const {
        int L = i * G + c;
        if (L < 32 * NT_BF) { pg8::tile_order(L, 32, NT_BF, u.pm, u.pn); u.kind = 0; return true; }
        L -= 32 * NT_BF;
        if (L < 8) { u.pm = L & 1; u.pn = L >> 1; u.kind = 1; return true; }
        L -= 8;
        if (L < 8) { u.pm = L & 3; u.pn = L >> 2; u.kind = 2; return true; }
        return false;
    }
    __device__ __forceinline__ const char* a_base(const pg8::Unit& u) const {
        const size_t off = u.kind == 0 ? WS_H : (u.kind == 1 ? WS_MEMN : WS_WMKV + (size_t)1024 * DM * 2);
        return ws + off + (size_t)u.pm * (256 * DM * 2); }
    __device__ __forceinline__ const char* b_base(const pg8::Unit& u) const {
        const size_t off = u.kind == 0 ? WS_WIN : (u.kind == 1 ? WS_WMKV : WS_MEMN);
        return ws + off + (size_t)u.pn * (256 * DM * 2); }
};
struct Epi1 {
    static constexpr bool PERM = true, INIT = false;
    unsigned char* ws; const float* ikg; const float* ikb;
    __device__ __forceinline__ bool operator()(f32x4 (&acc)[2][2][4][2], const pg8::Unit& u, int wr, int wc, int fr, int fq) const {
        const int rowb = u.pm * 256 + wr * 64 + fr, cl = wc * 32 + 8 * fq, pn = u.pn;
#ifndef EX_NOIQ
        if (u.kind == 0 && pn >= 22 && pn < 26) {
            const int head = 4 * (pn - 22) + wc;
#pragma unroll
            for (int ai = 0; ai < 2; ++ai)
#pragma unroll
                for (int m = 0; m < 4; ++m) { const int row = rowb + ai * 128 + m * 16;
                    f32x4 x1a = acc[ai][0][m][0], x1b = acc[ai][0][m][1], x2a = acc[ai][1][m][0], x2b = acc[ai][1][m][1];
                    if (fq == 0) { const f32x4* cs = (const f32x4*)(ws + WS_CSI) + row * 4;
                        const f32x4 c0 = cs[0], c1 = cs[1], c2 = cs[2], c3 = cs[3];
                        const f32x4 co_a = {c0[0], c0[2], c1[0], c1[2]}, si_a = {c0[1], c0[3], c1[1], c1[3]}, co_b = {c2[0], c2[2], c3[0], c3[2]}, si_b = {c2[1], c2[3], c3[1], c3[3]};
                        const f32x4 r1a = x1a * co_a - x2a * si_a, r1b = x1b * co_b - x2b * si_b, r2a = x2a * co_a + x1a * si_a, r2b = x2b * co_b + x1b * si_b;
                        x1a = r1a; x1b = r1b; x2a = r2a; x2b = r2b; }
                    bf16_t* dst = (bf16_t*)(ws + WS_IQ) + (size_t)row * 1024 + head * 64 + 16 * fq;
                    *(bf16x8*)(dst) = pack8(x1a, x1b); *(bf16x8*)(dst + 8) = pack8(x2a, x2b); }
            return true;
        }
#endif
#ifndef EX_NOIK
        if (u.kind == 0 && pn == 26) {
            if (wc == 0) {
                const f32x4 g0 = *(const f32x4*)(ikg + 16 * fq), g1 = *(const f32x4*)(ikg + 16 * fq + 4), g2 = *(const f32x4*)(ikg + 16 * fq + 8), g3 = *(const f32x4*)(ikg + 16 * fq + 12);
                const f32x4 e0 = *(const f32x4*)(ikb + 16 * fq), e1 = *(const f32x4*)(ikb + 16 * fq + 4), e2 = *(const f32x4*)(ikb + 16 * fq + 8), e3 = *(const f32x4*)(ikb + 16 * fq + 12);
#pragma unroll
                for (int ai = 0; ai < 2; ++ai)
#pragma unroll
                    for (int m = 0; m < 4; ++m) { const int row = rowb + ai * 128 + m * 16;
                        f32x4 v0 = acc[ai][0][m][0], v1 = acc[ai][0][m][1], v2 = acc[ai][1][m][0], v3 = acc[ai][1][m][1];
                        const f32x4 sv = (v0 + v1) + (v2 + v3);
                        float sm = (sv[0] + sv[1]) + (sv[2] + sv[3]);
                        sm += __shfl_xor(sm, 16); sm += __shfl_xor(sm, 32);
                        const float mean = sm * (1.f / 64.f);
                        v0 = v0 - mean; v1 = v1 - mean; v2 = v2 - mean; v3 = v3 - mean;
                        const f32x4 qv = (v0 * v0 + v1 * v1) + (v2 * v2 + v3 * v3);
                        float q2 = (qv[0] + qv[1]) + (qv[2] + qv[3]);
                        q2 += __shfl_xor(q2, 16); q2 += __shfl_xor(q2, 32);
                        const float rstd = 1.0f / sqrtf(q2 * (1.f / 64.f) + EPS);
                        v0 = v0 * rstd * g0 + e0; v1 = v1 * rstd * g1 + e1; v2 = v2 * rstd * g2 + e2; v3 = v3 * rstd * g3 + e3;
                        if (fq == 0) { const f32x4* cs = (const f32x4*)(ws + WS_CSI) + row * 4;
                            const f32x4 c0 = cs[0], c1 = cs[1], c2 = cs[2], c3 = cs[3];
                            const f32x4 co_a = {c0[0], c0[2], c1[0], c1[2]}, si_a = {c0[1], c0[3], c1[1], c1[3]}, co_b = {c2[0], c2[2], c3[0], c3[2]}, si_b = {c2[1], c2[3], c3[1], c3[3]};
                            const f32x4 r1a = v0 * co_a - v2 * si_a, r1b = v1 * co_b - v3 * si_b, r2a = v2 * co_a + v0 * si_a, r2b = v3 * co_b + v1 * si_b;
                            v0 = r1a; v1 = r1b; v2 = r2a; v3 = r2b; }
                        bf16_t* dst = (bf16_t*)(ws + WS_IK) + (size_t)row * 64 + 16 * fq;
                        *(bf16x8*)(dst) = pack8(v0, v1); *(bf16x8*)(dst + 8) = pack8(v2, v3); }
            } else if (wc == 1 && fq == 0) {
#pragma unroll
                for (int ai = 0; ai < 2; ++ai)
#pragma unroll
                    for (int m = 0; m < 4; ++m) { const int row = rowb + ai * 128 + m * 16; float* dst = (float*)(ws + WS_IW) + (size_t)row * 16;
                        *(f32x4*)(dst) = acc[ai][0][m][0] * 0.03125f; *(f32x4*)(dst + 4) = acc[ai][0][m][1] * 0.03125f;
                        *(f32x4*)(dst + 8) = acc[ai][1][m][0] * 0.03125f; *(f32x4*)(dst + 12) = acc[ai][1][m][1] * 0.03125f; }
            }
            return true;
        }
#endif
        int act = 0, ld = 1024, co = 0, bjs = 128; size_t off = 0, bex = 0;
        if (u.kind == 1) { off = WS_KM; co = pn * 256; }
        else if (u.kind == 2) { off = WS_VT; ld = 512; co = pn * 256; }
        else if (pn < 4) { act = 1; off = WS_AU; co = pn * 256; }
        else if (pn < 8) { act = 1; off = WS_AV; co = (pn - 4) * 256; }
        else if (pn < 12) { act = 2; off = WS_AZ; co = (pn - 8) * 256; }
        else if (pn < 16) { off = WS_QR; co = (pn - 12) * 256; }
        else if (pn == 16) { off = WS_KR; ld = 256; }
        else if (pn == 17) { off = WS_VV; ld = 128; bjs = SEQ * 128; bex = (size_t)SEQ * 128; }
        else { act = 2; off = WS_BZ; co = (pn - 18) * 256; }
        bf16_t* dst = (bf16_t*)(ws + off) + co + cl;
#pragma unroll
        for (int ai = 0; ai < 2; ++ai)
#pragma unroll
            for (int m = 0; m < 4; ++m) { const int row = rowb + ai * 128 + m * 16; bf16_t* rp = dst + (size_t)row * ld + (size_t)(row >> 12) * bex;
#pragma unroll
                for (int bj = 0; bj < 2; ++bj) { f32x4 v0 = acc[ai][bj][m][0], v1 = acc[ai][bj][m][1];
                    if (act == 1) {
#pragma unroll
                        for (int e = 0; e < 4; ++e) { v0[e] = gelu_f(v0[e]); v1[e] = gelu_f(v1[e]); } }
                    else if (act == 2) {
#pragma unroll
                        for (int e = 0; e < 4; ++e) { v0[e] = silu_f(v0[e]); v1[e] = silu_f(v1[e]); } }
                    *(bf16x8*)(rp + (size_t)bj * bjs) = pack8(v0, v1); }
                if (u.kind == 0 && pn >= 4 && pn < 8) {
                    f32x4 g0 = acc[ai][0][m][0], g1 = acc[ai][0][m][1], g2 = acc[ai][1][m][0], g3 = acc[ai][1][m][1];
#pragma unroll
                    for (int e = 0; e < 4; ++e) { g0[e] = gelu_f(g0[e]); g1[e] = gelu_f(g1[e]); g2[e] = gelu_f(g2[e]); g3[e] = gelu_f(g3[e]); }
                    const f32x4 sv = (g0 + g1) + (g2 + g3), qv = (g0 * g0 + g1 * g1) + (g2 * g2 + g3 * g3);
                    float s1 = (sv[0] + sv[1]) + (sv[2] + sv[3]), s2 = (qv[0] + qv[1]) + (qv[2] + qv[3]);
                    s1 += __shfl_xor(s1, 16); s2 += __shfl_xor(s2, 16); s1 += __shfl_xor(s1, 32); s2 += __shfl_xor(s2, 32);
                    if (fq == 0) ((f32x2*)(ws + WS_LNP))[(size_t)row * 16 + (pn - 4) * 4 + wc] = (f32x2){s1, s2}; }
                if (u.kind == 1) {
                    const f32x4 q = (acc[ai][0][m][0] * acc[ai][0][m][0] + acc[ai][0][m][1] * acc[ai][0][m][1]) + (acc[ai][1][m][0] * acc[ai][1][m][0] + acc[ai][1][m][1] * acc[ai][1][m][1]);
                    float ss = (q[0] + q[1]) + (q[2] + q[3]);
                    ss += __shfl_xor(ss, 16); ss += __shfl_xor(ss, 32);
                    if (fq == 0) ((float*)(ws + WS_RKP))[(size_t)row * 16 + pn * 4 + wc] = ss; } }
        return true;
    }
};

struct Sched1b {
    int G, c; const char* ws;
    __device__ __forceinline__ bool next(int i, pg8::Unit& u) const { const int L = i * G + c; if (L >= 32 * 32) return false; pg8::tile_order(L, 32, 32, u.pm, u.pn); u.kind = 0; return true; }
    __device__ __forceinline__ const char* a_base(const pg8::Unit& u) const { return ws + WS_H8 + (size_t)u.pm * (256 * DM); }
    __device__ __forceinline__ const char* b_base(const pg8::Unit& u) const { return ws + WS_W8 + (size_t)u.pn * (256 * DM); }
};
struct Epi1b {
    static constexpr bool PERM = true, INIT = false;
    unsigned char* ws;
    __device__ __forceinline__ bool operator()(f32x4 (&acc)[2][2][4][2], const pg8::Unit& u, int wr, int wc, int fr, int fq) const {
        const int rowb = u.pm * 256 + wr * 64 + fr, cl = wc * 32 + 8 * fq, pn = u.pn;
        const float* __restrict__ SW = (const float*)(ws + WS_SW) + pn * 256 + cl; const float* __restrict__ SH = (const float*)(ws + WS_SH);
        const f32x4 sw00 = *(const f32x4*)(SW), sw01 = *(const f32x4*)(SW + 4), sw10 = *(const f32x4*)(SW + 128), sw11 = *(const f32x4*)(SW + 132);
        float sh[2][4];
#pragma unroll
        for (int ai = 0; ai < 2; ++ai)
#pragma unroll
            for (int m = 0; m < 4; ++m) sh[ai][m] = SH[rowb + ai * 128 + m * 16];
        if (pn < 8) {
            bf16_t* __restrict__ dst = (bf16_t*)(ws + (pn < 4 ? WS_MQ : WS_MZ)) + (pn & 3) * 256 + cl;
#pragma unroll
            for (int ai = 0; ai < 2; ++ai)
#pragma unroll
                for (int m = 0; m < 4; ++m) { const int row = rowb + ai * 128 + m * 16; const float rs = sh[ai][m];
#pragma unroll
                    for (int bj = 0; bj < 2; ++bj) { f32x4 v0, v1; const f32x4 s0 = bj ? sw10 : sw00, s1 = bj ? sw11 : sw01;
#pragma unroll
                        for (int e = 0; e < 4; ++e) { v0[e] = (float)__float_as_int(acc[ai][bj][m][0][e]) * (rs * s0[e]); v1[e] = (float)__float_as_int(acc[ai][bj][m][1][e]) * (rs * s1[e]); }
                        if (pn >= 4) {
#pragma unroll
                            for (int e = 0; e < 4; ++e) { v0[e] = silu_f(v0[e]); v1[e] = silu_f(v1[e]); } }
                        *(bf16x8*)(dst + (size_t)row * 1024 + bj * 128) = pack8(v0, v1); } }
            return true;
        }
        const int pg = pn - 8;
        unsigned char* __restrict__ dst = (unsigned char*)(ws + WS_SA + (size_t)(pg >> 3) * (WS_SB - WS_SA)) + (pg & 7) * 256 + cl;
#pragma unroll
        for (int ai = 0; ai < 2; ++ai)
#pragma unroll
            for (int m = 0; m < 4; ++m) { const int row = rowb + ai * 128 + m * 16; const float rs = sh[ai][m] * (-LOG2E);
#pragma unroll
                for (int bj = 0; bj < 2; ++bj) { const f32x4 s0 = bj ? sw10 : sw00, s1 = bj ? sw11 : sw01; unsigned lo = 0, hi2 = 0;
#pragma unroll
                    for (int e = 0; e < 4; ++e) {
                        const float q0 = 255.f * __builtin_amdgcn_rcpf(1.f + __builtin_amdgcn_exp2f((float)__float_as_int(acc[ai][bj][m][0][e]) * (rs * s0[e])));
                        const float q1 = 255.f * __builtin_amdgcn_rcpf(1.f + __builtin_amdgcn_exp2f((float)__float_as_int(acc[ai][bj][m][1][e]) * (rs * s1[e])));
                        lo = __builtin_amdgcn_cvt_pk_u8_f32(__builtin_amdgcn_fmed3f(q0, 1.f, 255.f), e, lo); hi2 = __builtin_amdgcn_cvt_pk_u8_f32(__builtin_amdgcn_fmed3f(q1, 1.f, 255.f), e, hi2); }
                    *(u32x2*)(dst + (size_t)row * DM + bj * 128) = (u32x2){lo, hi2}; } }
        return true;
    }
};

struct Sched2 {
    int G, c; const char* ws;
    __device__ __forceinline__ bool next(int i, pg8::Unit& u) const {
        const int L = (i / 3) * G + c; if (L >= 256) return false;
        pg8::tile_order(L, 32, 8, u.pm, u.pn); u.kind = i % 3; return true;
    }
    __device__ __forceinline__ const char* a_base(const pg8::Unit& u) const {
        const size_t off = WS_XA + (u.kind == 1 ? (WS_XB - WS_XA) : (size_t)0) + (u.kind == 2 ? (WS_XM - WS_XA) : (size_t)0);
        return ws + off + (size_t)u.pm * (256 * 1024 * 2); }
    __device__ __forceinline__ const char* b_base(const pg8::Unit& u) const { return ws + WS_WBR + (size_t)u.kind * ((size_t)DM * 1024 * 2) + (size_t)u.pn * (256 * 1024 * 2); }
};
struct Epi2 {
    static constexpr bool PERM = true, INIT = false;
    unsigned char* ws;
    __device__ __forceinline__ bool operator()(f32x4 (&acc)[2][2][4][2], const pg8::Unit& u, int wr, int wc, int fr, int fq) const {
        const int rowb = u.pm * 256 + wr * 64 + fr, colb = u.pn * 256 + wc * 32 + 8 * fq, seg = u.kind;
        constexpr size_t GST = WS_SB - WS_SA;
        static_assert(WS_SM - WS_SB == GST, "gate spacing");
        const unsigned char* __restrict__ NUM = (const unsigned char*)(ws + WS_SA + (size_t)seg * GST);
        const unsigned char* __restrict__ DEN = (const unsigned char*)(ws + WS_SA + (size_t)(seg < 2 ? seg + 1 : 2) * GST);
        bf16_t* __restrict__ MG = (bf16_t*)(ws + WS_MERGED);
#define U8F(w, e) ((float)(((w) >> (8 * (e))) & 0xffu))
#pragma unroll
        for (int ai = 0; ai < 2; ++ai)
#pragma unroll
            for (int m = 0; m < 4; ++m) { const size_t ro = (size_t)(rowb + ai * 128 + m * 16) * DM + colb;
#pragma unroll
                for (int bj = 0; bj < 2; ++bj) {
                    const u32x2 nu = *(const u32x2*)(NUM + ro + bj * 128);
                    f32x4 f0 = {U8F(nu[0], 0), U8F(nu[0], 1), U8F(nu[0], 2), U8F(nu[0], 3)}, f1 = {U8F(nu[1], 0), U8F(nu[1], 1), U8F(nu[1], 2), U8F(nu[1], 3)};
                    if (seg < 2) { const u32x2 de = *(const u32x2*)(DEN + ro + bj * 128);
                        const f32x4 d0 = {U8F(de[0], 0), U8F(de[0], 1), U8F(de[0], 2), U8F(de[0], 3)}, d1 = {U8F(de[1], 0), U8F(de[1], 1), U8F(de[1], 2), U8F(de[1], 3)};
#pragma unroll
                        for (int e = 0; e < 4; ++e) { f0[e] *= __builtin_amdgcn_rcpf(d0[e]); f1[e] *= __builtin_amdgcn_rcpf(d1[e]); }
                        acc[ai][bj][m][0] *= f0; acc[ai][bj][m][1] *= f1;
                    } else { *(bf16x8*)(MG + ro + bj * 128) = pack8(acc[ai][bj][m][0] * f0 * (1.f / 255.f), acc[ai][bj][m][1] * f1 * (1.f / 255.f)); }
                } }
#undef U8F
        return seg == 2;
    }
};
struct Sched3 {
    int G, c; const char* A; const char* B;
    __device__ __forceinline__ bool next(int i, pg8::Unit& u) const { const int L = i * G + c; if (L >= 256) return false; pg8::tile_order(L, 32, 8, u.pm, u.pn); u.kind = 0; return true; }
    __device__ __forceinline__ const char* a_base(const pg8::Unit& u) const { return A + (size_t)u.pm * (256 * DM * 2); }
    __device__ __forceinline__ const char* b_base(const pg8::Unit& u) const { return B + (size_t)u.pn * (256 * DM * 2); }
};
struct Epi3 {
    static constexpr bool PERM = false, INIT = true;
    const float* x; float* out;
    __device__ __forceinline__ void init(f32x4 (&acc)[2][2][4][2], const pg8::Unit& u, int wr, int wc, int fr, int fq) const {
        const int rowb = u.pm * 256 + wr * 64 + fr, colb = u.pn * 256 + wc * 32 + 4 * fq;
#pragma unroll
        for (int ai = 0; ai < 2; ++ai)
#pragma unroll
            for (int m = 0; m < 4; ++m) { const size_t ro = (size_t)(rowb + ai * 128 + m * 16) * DM + colb;
#pragma unroll
                for (int bj = 0; bj < 2; ++bj)
#pragma unroll
                    for (int n = 0; n < 2; ++n) acc[ai][bj][m][n] = *(const f32x4*)(x + ro + bj * 128 + n * 16); }
    }
    __device__ __forceinline__ bool operator()(f32x4 (&acc)[2][2][4][2], const pg8::Unit& u, int wr, int wc, int fr, int fq) const {
        const int rowb = u.pm * 256 + wr * 64 + fr, colb = u.pn * 256 + wc * 32 + 4 * fq;
#pragma unroll
        for (int ai = 0; ai < 2; ++ai)
#pragma unroll
            for (int m = 0; m < 4; ++m) { const size_t ro = (size_t)(rowb + ai * 128 + m * 16) * DM + colb;
#pragma unroll
                for (int bj = 0; bj < 2; ++bj)
#pragma unroll
                    for (int n = 0; n < 2; ++n) *(f32x4*)(out + ro + bj * 128 + n * 16) = acc[ai][bj][m][n]; }
        return true;
    }
};

__device__ __forceinline__ void p2_qkprep(const Params& p, int vcu, int G) {
    const int tid = opaque_tid(), lane = tid & 63, wave = tid >> 6;
    unsigned char* ws = p.ws;
    const bf16_t* QR = (const bf16_t*)(ws + WS_QR); const bf16_t* KR = (const bf16_t*)(ws + WS_KR);
    bf16_t* QN = (bf16_t*)(ws + WS_QN); bf16_t* KN = (bf16_t*)(ws + WS_KN);
    const f32x2* CSB = (const f32x2*)(ws + WS_CSB);
    const float gq0 = p.q_gain[lane], gq1 = p.q_gain[lane + 64], gk0 = p.k_gain[lane], gk1 = p.k_gain[lane + 64];
    const float gA0 = (lane < 64) ? p.q_gain[2 * lane] : 0.f, gA1 = p.q_gain[2 * lane + 1], gB0 = p.k_gain[2 * lane], gB1 = p.k_gain[2 * lane + 1];
    (void)gq0; (void)gq1; (void)gk0; (void)gk1;
    const int NWT = G * NWAVES, w0 = vcu * NWAVES + wave;
#pragma unroll 1
    for (int t = w0; t < T; t += 2 * NWT) {
        const int t1 = (t + NWT < T) ? t + NWT : t;
        unsigned raw[2][10];
#pragma unroll
        for (int u = 0; u < 2; ++u) { const int tt = u ? t1 : t;
#pragma unroll
            for (int r = 0; r < 10; ++r) raw[u][r] = *(const unsigned*)((r < 8 ? QR + (size_t)tt * 1024 + r * 128 : KR + (size_t)tt * 256 + (r - 8) * 128) + 2 * lane); }
        f32x2 cs[2];
        cs[0] = CSB[t * 16 + ((2 * lane) & 15)]; cs[1] = CSB[t1 * 16 + ((2 * lane) & 15)];
        f32x2 cs1[2];
        cs1[0] = CSB[t * 16 + ((2 * lane + 1) & 15)]; cs1[1] = CSB[t1 * 16 + ((2 * lane + 1) & 15)];
        float ss[2][10];
#pragma unroll
        for (int u = 0; u < 2; ++u)
#pragma unroll
            for (int r = 0; r < 10; ++r) { const float x0 = bflo(raw[u][r]), x1 = bfhi(raw[u][r]); ss[u][r] = x0 * x0 + x1 * x1; }
#pragma unroll
        for (int o = 1; o < 64; o <<= 1)
#pragma unroll
            for (int u = 0; u < 2; ++u)
#pragma unroll
                for (int r = 0; r < 10; ++r) ss[u][r] += __shfl_xor(ss[u][r], o);
#pragma unroll
        for (int u = 0; u < 2; ++u) { const int tt = u ? t1 : t; const int b = tt >> 12, sq = tt & (SEQ - 1);
#pragma unroll
            for (int r = 0; r < 10; ++r) {
                const float rs = 1.0f / sqrtf(ss[u][r] * (1.f / 128.f) + EPS);
                float y0 = bflo(raw[u][r]) * rs * (r < 8 ? gA0 : gB0), y1 = bfhi(raw[u][r]) * rs * (r < 8 ? gA1 : gB1);
                const float p0 = __shfl_xor(y0, 8), p1 = __shfl_xor(y1, 8);
                if (lane < 8) { y0 = y0 * cs[u][0] - p0 * cs[u][1]; y1 = y1 * cs1[u][0] - p1 * cs1[u][1]; }
                else if (lane < 16) { y0 = y0 * cs[u][0] + p0 * cs[u][1]; y1 = y1 * cs1[u][0] + p1 * cs1[u][1]; }
                bf16_t* dst = r < 8 ? QN + ((size_t)(b * 8 + r) * SEQ + sq) * 128 : KN + ((size_t)(b * 2 + (r - 8)) * SEQ + sq) * 128;
                *(unsigned*)(dst + 2 * lane) = cvt_pk_bf16(y0, y1);
            } }
    }
}

constexpr int GM_VSTR = 136;
__device__ __forceinline__ void p2_gmlp_unit(const Params& p, LAS unsigned char* lds, int unit) {
    const int tid = opaque_tid(), lane = tid & 63, wave = __builtin_amdgcn_readfirstlane(tid >> 6), r32 = lane & 31, hi = lane >> 5;
    unsigned char* ws = p.ws;
    const int g = unit & 7, ch = unit >> 3, tok0 = ch * 128;
    const bf16_t* AV = (const bf16_t*)(ws + WS_AV); const bf16_t* AU = (const bf16_t*)(ws + WS_AU); const bf16_t* AZ = (const bf16_t*)(ws + WS_AZ);
    bf16_t* XA = (bf16_t*)(ws + WS_XA);
    LAS float* stat = (LAS float*)lds;
    LAS bf16_t* vT = (LAS bf16_t*)(lds + 1024);
    const int tb = wave >> 1, dh = wave & 1, trow = tb * 32 + r32;
    const float* wsp = p.spatial_w + ((size_t)g * 128 + trow) * 128 + 8 * hi;
    f32x4 wf[8][2];
#pragma unroll
    for (int ks = 0; ks < 8; ++ks) { wf[ks][0] = *(const f32x4*)(wsp + 16 * ks); wf[ks][1] = *(const f32x4*)(wsp + 16 * ks + 4); }
    if (tid < 128) { const f32x4* lp = (const f32x4*)((const f32x2*)(ws + WS_LNP) + (size_t)(tok0 + tid) * 16); float s1 = 0.f, s2 = 0.f;
#pragma unroll
        for (int i = 0; i < 8; ++i) { const f32x4 v = lp[i]; s1 += v[0] + v[2]; s2 += v[1] + v[3]; }
        const float mean = s1 * (1.f / 1024.f), var = fmaxf(s2 * (1.f / 1024.f) - mean * mean, 0.f);
        stat[2 * tid] = mean; stat[2 * tid + 1] = 1.0f / sqrtf(var + EPS); }
    __syncthreads();
    {
        u32x4 va[4];
#pragma unroll
        for (int i = 0; i < 4; ++i) { const int it = tid + i * NTHREADS, s_ = it >> 4, d8 = (it & 15) * 8; va[i] = *(const u32x4*)(AV + (size_t)(tok0 + s_) * 1024 + g * 128 + d8); }
        const int d8 = (tid & 15) * 8;
        const f32x4 g0 = *(const f32x4*)(p.gmlp_g + g * 128 + d8), g1 = *(const f32x4*)(p.gmlp_g + g * 128 + d8 + 4), b0 = *(const f32x4*)(p.gmlp_b + g * 128 + d8), b1 = *(const f32x4*)(p.gmlp_b + g * 128 + d8 + 4);
#pragma unroll
        for (int i = 0; i < 4; ++i) { const int it = tid + i * NTHREADS, s_ = it >> 4; const u32x4 a = va[i];
            const float mean = stat[2 * s_], rstd = stat[2 * s_ + 1];
            float f[8] = {bflo(a[0]), bfhi(a[0]), bflo(a[1]), bfhi(a[1]), bflo(a[2]), bfhi(a[2]), bflo(a[3]), bfhi(a[3])};
#pragma unroll
            for (int e = 0; e < 8; ++e) { const float y = (f[e] - mean) * rstd * (e < 4 ? g0[e & 3] : g1[e & 3]) + (e < 4 ? b0[e & 3] : b1[e & 3]); vT[(d8 + e) * GM_VSTR + s_] = f2bf(y); } }
    }
    const int prw = lane >> 3, pcl = (lane & 7) * 8;
    u32x4 gu[4], gz[4];
#pragma unroll
    for (int i = 0; i < 4; ++i) { const size_t o = (size_t)(tok0 + tb * 32 + prw + 8 * i) * 1024 + g * 128 + dh * 64 + pcl; gu[i] = *(const u32x4*)(AU + o); gz[i] = *(const u32x4*)(AZ + o); }
    __syncthreads();
    f32x16 acc0 = {}, acc1 = {};
#pragma unroll
    for (int ks = 0; ks < 8; ++ks) {
        const int s0 = 16 * ks + 8 * hi;
        f32x4 w0 = wf[ks][0], w1 = wf[ks][1];
#pragma unroll
        for (int e = 0; e < 4; ++e) { if (s0 + e > trow) w0[e] = 0.f; if (s0 + 4 + e > trow) w1[e] = 0.f; }
        const bf16x8 a = pack8(w0, w1);
        const bf16x8 b0 = *(const LAS bf16x8*)(vT + (dh * 64 + r32) * GM_VSTR + s0), b1 = *(const LAS bf16x8*)(vT + (dh * 64 + 32 + r32) * GM_VSTR + s0);
        acc0 = __builtin_amdgcn_mfma_f32_32x32x16_bf16(a, b0, acc0, 0, 0, 0);
        acc1 = __builtin_amdgcn_mfma_f32_32x32x16_bf16(a, b1, acc1, 0, 0, 0);
    }
    LAS float* ot = (LAS float*)(lds + 36864 + wave * (32 * 272));
#pragma unroll
    for (int r = 0; r < 16; ++r) { const int rl = (r & 3) + 8 * (r >> 2) + 4 * hi; const float bias = p.spatial_b[g * 128 + tb * 32 + rl];
        ot[rl * 68 + r32] = acc0[r] + bias; ot[rl * 68 + 32 + r32] = acc1[r] + bias; }
    LDS_WAIT(); asm volatile("" ::: "memory");
#pragma unroll
    for (int i = 0; i < 4; ++i) { const int rl = prw + 8 * i; const f32x4 s0 = *(const LAS f32x4*)(ot + rl * 68 + pcl), s1 = *(const LAS f32x4*)(ot + rl * 68 + pcl + 4);
        u32x4 w;
        w[0] = cvt_pk_bf16(bflo(gu[i][0]) * s0[0] * bflo(gz[i][0]), bfhi(gu[i][0]) * s0[1] * bfhi(gz[i][0])); w[1] = cvt_pk_bf16(bflo(gu[i][1]) * s0[2] * bflo(gz[i][1]), bfhi(gu[i][1]) * s0[3] * bfhi(gz[i][1]));
        w[2] = cvt_pk_bf16(bflo(gu[i][2]) * s1[0] * bflo(gz[i][2]), bfhi(gu[i][2]) * s1[1] * bfhi(gz[i][2])); w[3] = cvt_pk_bf16(bflo(gu[i][3]) * s1[2] * bflo(gz[i][3]), bfhi(gu[i][3]) * s1[3] * bfhi(gz[i][3]));
        *(u32x4*)(XA + (size_t)(tok0 + tb * 32 + rl) * 1024 + g * 128 + dh * 64 + pcl) = w; }
    __syncthreads();
}

constexpr int MA_KST = 32 * 512, MA_VROW = 72, MA_VST = 256 * MA_VROW;
constexpr int MA_K0 = 2048, MA_V0 = MA_K0 + 2 * MA_KST;
static_assert(MA_V0 + 2 * MA_VST <= MISC_OFF, "mem-attn LDS map");
__device__ __forceinline__ void p2_mem_unit(const Params& p, LAS unsigned char* lds, int unit) {
    const int tid = opaque_tid(), lane = tid & 63, wave = __builtin_amdgcn_readfirstlane(tid >> 6), r32 = lane & 31, hi = lane >> 5;
    unsigned char* ws = p.ws;
    const int qb = unit & 31, h = (unit >> 5) & 3, b = unit >> 7, qg = wave & 3, dhf = wave >> 2;
    const bf16_t* MQ = (const bf16_t*)(ws + WS_MQ); const bf16_t* MZ = (const bf16_t*)(ws + WS_MZ);
    const bf16_t* KM = (const bf16_t*)(ws + WS_KM) + (size_t)(b * 256) * 1024 + h * 256;
    const bf16_t* VT = (const bf16_t*)(ws + WS_VT) + (size_t)(h * 256) * 512 + b * 256;
    bf16_t* XM = (bf16_t*)(ws + WS_XM);
    LAS float* rk = (LAS float*)lds;
    LAS float* gqk = (LAS float*)(lds + 1024);
    u32x4 sk[2], sv[2];
#define MA_LOAD(st) do { _Pragma("unroll") for (int i = 0; i < 2; ++i) { const int q = tid + i * NTHREADS; \
        sk[i] = *(const u32x4*)(KM + (size_t)((st) * 32 + (q >> 5)) * 1024 + (q & 31) * 8); \
        sv[i] = *(const u32x4*)(VT + (size_t)(q >> 2) * 512 + (st) * 32 + (q & 3) * 8); } } while (0)
#define MA_WRITE(bf) do { _Pragma("unroll") for (int i = 0; i < 2; ++i) { const int q = tid + i * NTHREADS; const int key = q >> 5, c = q & 31; \
        *(LAS u32x4*)(lds + MA_K0 + (bf) * MA_KST + key * 512 + ((c ^ (key & 15)) << 4)) = sk[i]; \
        LAS unsigned char* vd = lds + MA_V0 + (bf) * MA_VST + (q >> 2) * MA_VROW + (q & 3) * 16; \
        *(LAS u32x2*)vd = (u32x2){sv[i][0], sv[i][1]}; *(LAS u32x2*)(vd + 8) = (u32x2){sv[i][2], sv[i][3]}; } } while (0)
    if (tid < 256) { const f32x4 pr = *(const f32x4*)((const float*)(ws + WS_RKP) + (size_t)(b * 256 + tid) * 16 + h * 4);
        rk[tid] = 1.0f / sqrtf(((pr[0] + pr[1]) + (pr[2] + pr[3])) * (1.f / 256.f) + EPS); gqk[tid] = p.mq_gain[tid] * p.mk_gain[tid]; }
    __syncthreads();
    const int tq = b * SEQ + qb * 128 + qg * 32 + r32;
    bf16x8 qf[16]; float ssq = 0.f;
#pragma unroll
    for (int ks = 0; ks < 16; ++ks) { const int d0 = 16 * ks + 8 * hi; const u32x4 a = *(const u32x4*)(MQ + (size_t)tq * 1024 + h * 256 + d0);
        f32x4 f0 = {bflo(a[0]), bfhi(a[0]), bflo(a[1]), bfhi(a[1])}, f1 = {bflo(a[2]), bfhi(a[2]), bflo(a[3]), bfhi(a[3])};
        ssq += (f0[0] * f0[0] + f0[1] * f0[1]) + (f0[2] * f0[2] + f0[3] * f0[3]) + (f1[0] * f1[0] + f1[1] * f1[1]) + (f1[2] * f1[2] + f1[3] * f1[3]);
        const f32x4 g0 = *(const LAS f32x4*)(gqk + d0), g1 = *(const LAS f32x4*)(gqk + d0 + 4);
        qf[ks] = pack8(f0 * g0, f1 * g1); }
    ssq += __shfl_xor(ssq, 32);
    const float qs = (1.0f / sqrtf(ssq * (1.f / 256.f) + EPS)) * (0.0625f * LOG2E);
    MA_LOAD(0);
    MA_WRITE(0);
    __syncthreads();
    f32x16 o[4];
#pragma unroll
    for (int db = 0; db < 4; ++db) o[db] = (f32x16){};
    float mrun = -1e30f, l = 0.f;
    const int kx = r32 & 15;
#pragma unroll 1
    for (int st = 0; st < 8; ++st) {
        const int bf = st & 1;
        if (st + 1 < 8) MA_LOAD(st + 1);
        {
            f32x16 a = {};
            const LAS unsigned char* kp = lds + MA_K0 + bf * MA_KST + r32 * 512;
#pragma unroll
            for (int ks = 0; ks < 16; ++ks) { if ((ks & 3) == 0) __builtin_amdgcn_sched_barrier(0); const bf16x8 kf = *(const LAS bf16x8*)(kp + (((2 * ks + hi) ^ kx) << 4)); a = __builtin_amdgcn_mfma_f32_32x32x16_bf16(kf, qf[ks], a, 0, 0, 0); }
            __builtin_amdgcn_sched_barrier(0);
#pragma unroll
            for (int g4 = 0; g4 < 4; ++g4) { const f32x4 rr = *(const LAS f32x4*)(rk + st * 32 + 8 * g4 + 4 * hi);
#pragma unroll
                for (int e = 0; e < 4; ++e) a[4 * g4 + e] *= rr[e] * qs; }
            float bm = a[0];
#pragma unroll
            for (int r = 1; r < 16; ++r) bm = fmaxf(bm, a[r]);
            bm = fmaxf(bm, __shfl_xor(bm, 32));
            if (!__all(bm - mrun <= 8.f)) { const float mn = fmaxf(mrun, bm), al = __builtin_amdgcn_exp2f(mrun - mn); mrun = mn; l *= al;
#pragma unroll
                for (int db = 0; db < 4; ++db) o[db] *= al; }
#pragma unroll
            for (int r = 0; r < 16; ++r) { a[r] = __builtin_amdgcn_exp2f(a[r] - mrun); l += a[r]; }
            u32x4 w0 = {cvt_pk_bf16(a[0], a[1]), cvt_pk_bf16(a[2], a[3]), cvt_pk_bf16(a[4], a[5]), cvt_pk_bf16(a[6], a[7])};
            u32x4 w1 = {cvt_pk_bf16(a[8], a[9]), cvt_pk_bf16(a[10], a[11]), cvt_pk_bf16(a[12], a[13]), cvt_pk_bf16(a[14], a[15])};
            const bf16x8 pf0 = *reinterpret_cast<bf16x8*>(&w0), pf1 = *reinterpret_cast<bf16x8*>(&w1);
            const LAS unsigned char* vp = lds + MA_V0 + bf * MA_VST + (dhf * 128 + r32) * MA_VROW + 8 * hi;
#pragma unroll
            for (int db = 0; db < 4; ++db) {
                const u32x2 lo0 = *(const LAS u32x2*)(vp + db * 32 * MA_VROW), hi0 = *(const LAS u32x2*)(vp + db * 32 * MA_VROW + 16);
                const u32x2 lo1 = *(const LAS u32x2*)(vp + db * 32 * MA_VROW + 32), hi1 = *(const LAS u32x2*)(vp + db * 32 * MA_VROW + 48);
                u32x4 v0 = {lo0[0], lo0[1], hi0[0], hi0[1]}, v1 = {lo1[0], lo1[1], hi1[0], hi1[1]};
                o[db] = __builtin_amdgcn_mfma_f32_32x32x16_bf16(*reinterpret_cast<bf16x8*>(&v0), pf0, o[db], 0, 0, 0);
                o[db] = __builtin_amdgcn_mfma_f32_32x32x16_bf16(*reinterpret_cast<bf16x8*>(&v1), pf1, o[db], 0, 0, 0); }
        }
        if (st + 1 < 8) MA_WRITE(bf ^ 1);
        __syncthreads();
    }
#undef MA_LOAD
#undef MA_WRITE
    l += __shfl_xor(l, 32);
    const float il = __builtin_amdgcn_rcpf(l);
    u32x2 zg[4][4];
#pragma unroll
    for (int db = 0; db < 4; ++db)
#pragma unroll
        for (int g4 = 0; g4 < 4; ++g4) zg[db][g4] = *(const u32x2*)(MZ + (size_t)tq * 1024 + h * 256 + dhf * 128 + db * 32 + 8 * g4 + 4 * hi);
#pragma unroll
    for (int db = 0; db < 4; ++db)
#pragma unroll
        for (int g4 = 0; g4 < 4; ++g4) { const size_t oo = (size_t)tq * 1024 + h * 256 + dhf * 128 + db * 32 + 8 * g4 + 4 * hi;
            const u32x2 z = zg[db][g4];
            u32x2 w; w[0] = cvt_pk_bf16(o[db][4 * g4] * il * bflo(z[0]), o[db][4 * g4 + 1] * il * bfhi(z[0])); w[1] = cvt_pk_bf16(o[db][4 * g4 + 2] * il * bflo(z[1]), o[db][4 * g4 + 3] * il * bfhi(z[1]));
            *(u32x2*)(XM + oo) = w; }
}


__device__ __forceinline__ unsigned wave_sum_dpp(unsigned c) {
    c += (unsigned)__builtin_amdgcn_update_dpp(0, (int)c, 0xB1, 0xF, 0xF, false);
    c += (unsigned)__builtin_amdgcn_update_dpp(0, (int)c, 0x4E, 0xF, 0xF, false);
    c += (unsigned)__builtin_amdgcn_update_dpp(0, (int)c, 0x141, 0xF, 0xF, false);
    c += (unsigned)__builtin_amdgcn_update_dpp(0, (int)c, 0x140, 0xF, 0xF, false);
    { auto r = __builtin_amdgcn_permlane16_swap(c, c, false, false); c = r[0] + r[1]; }
    { auto r = __builtin_amdgcn_permlane32_swap(c, c, false, false); c = r[0] + r[1]; }
    return c;
}
#define CNT4(c0, c1, c2, c3, a, b, c_, d, t) do { unsigned long long m0_, m1_, m2_, m3_; asm volatile( \
    "v_cmp_ge_u32_e64 %[m0], %[va], %[vt]\n\tv_cmp_ge_u32_e64 %[m1], %[vb], %[vt]\n\tv_cmp_ge_u32_e64 %[m2], %[vc], %[vt]\n\tv_cmp_ge_u32_e64 %[m3], %[vd], %[vt]\n\t" \
    "v_addc_co_u32_e64 %[k0], %[m0], %[k0], 0, %[m0]\n\tv_addc_co_u32_e64 %[k1], %[m1], %[k1], 0, %[m1]\n\tv_addc_co_u32_e64 %[k2], %[m2], %[k2], 0, %[m2]\n\tv_addc_co_u32_e64 %[k3], %[m3], %[k3], 0, %[m3]" \
    : [k0] "+v"(c0), [k1] "+v"(c1), [k2] "+v"(c2), [k3] "+v"(c3), [m0] "=&s"(m0_), [m1] "=&s"(m1_), [m2] "=&s"(m2_), [m3] "=&s"(m3_) \
    : [va] "v"(a), [vb] "v"(b), [vc] "v"(c_), [vd] "v"(d), [vt] "v"(t)); } while (0)

__device__ __forceinline__ unsigned sortable(float f) { const unsigned u = __float_as_uint(f); return u ^ ((unsigned)((int)u >> 31) | 0x80000000u); }
#ifndef SPAN_A
#define SPAN_A -1
#endif
#define ACC_T(k, t0v) do { if (SPAN_A >= 100 && blockIdx.x == 0 && threadIdx.x == 0) { volatile LAS unsigned long long* st_ = (volatile LAS unsigned long long*)(lds + MISC_OFF + 16); const unsigned long long n_ = __builtin_amdgcn_s_memrealtime(); st_[16 + (k)] += n_ - (t0v); (t0v) = n_; } } while (0)
__device__ __forceinline__ float relu1(float x) { const int xi = __float_as_int(x); return __int_as_float(xi > 0 ? xi : 0); }
__device__ __forceinline__ void p2_idx_all(const Params& p, LAS unsigned char* lds, int bx, int G, unsigned* qctr) {
    unsigned long long tacc = (SPAN_A >= 100) ? __builtin_amdgcn_s_memrealtime() : 0ull;
    const int tid = opaque_tid(), lane = tid & 63, wave = __builtin_amdgcn_readfirstlane(tid >> 6), r32 = lane & 31, hi = lane >> 5;
    unsigned char* ws = p.ws;
    const bf16_t* IQ = (const bf16_t*)(ws + WS_IQ); const float* IW = (const float*)(ws + WS_IW);
    LAS unsigned* sc = (LAS unsigned*)lds;
    LAS float* iwl0 = (LAS float*)(lds + 131072);
    LAS unsigned* qword = (LAS unsigned*)(lds + 131072 + 1024 + 4096);
#define AF_LOAD(tt0) do { _Pragma("unroll") for (int at = 0; at < 4; ++at) _Pragma("unroll") for (int ks = 0; ks < 4; ++ks) \
        af[at][ks] = *(const bf16x8*)(IQ + (size_t)((tt0) + 2 * at + (r32 >> 4)) * 1024 + (r32 & 15) * 64 + 16 * ks + 8 * hi); } while (0)
    bf16x8 af[4][4];
    int qcur = bx, qnxt = bx + G;
    if (qcur >= 1024) return;
    { const int t0 = (qcur & 1) * SEQ + (511 - (qcur >> 1)) * 8; AF_LOAD(t0); if (tid < 128) iwl0[tid] = IW[(size_t)t0 * 16 + tid]; }
    __syncthreads();
#pragma unroll 1
    for (int k = 0; qcur < 1024; ++k) {
        const int b = qcur & 1, ublk = 511 - (qcur >> 1);
        const int s0 = ublk * 8, t0 = b * SEQ + s0;
        const bf16_t* IK = (const bf16_t*)(ws + WS_IK) + (size_t)(b * SEQ) * 64;
        LAS float* iwl = iwl0 + (k & 1) * 128;
        unsigned qgot = 0u; if (tid == 0) qgot = 2u * (unsigned)G + __hip_atomic_fetch_add(qctr, 1u, __ATOMIC_RELAXED, __HIP_MEMORY_SCOPE_AGENT);
        const int qn_ok = qnxt < 1024 ? qnxt : qcur;
        const int t0n = (qn_ok & 1) * SEQ + (511 - (qn_ok >> 1)) * 8;
        float iwn = 0.f; if (tid < 128) iwn = IW[(size_t)t0n * 16 + tid];
        ACC_T(0, tacc);
        const int ntiles = (s0 + 8 + 31) >> 5;
        bf16x8 kb0[4], kb1[4], kb2[4];
#define IK_LOAD(dst, jj) do { const int jc_ = (jj) < ntiles ? (jj) : 0; _Pragma("unroll") for (int ks = 0; ks < 4; ++ks) dst[ks] = *(const bf16x8*)(IK + (size_t)(32 * jc_ + r32) * 64 + 16 * ks + 8 * hi); } while (0)
#define SCORE_TILE(KB, jj) do { const int k0 = 32 * (jj); \
        _Pragma("unroll") for (int at = 0; at < 4; ++at) { f32x16 a = {}; \
            _Pragma("unroll") for (int ks = 0; ks < 4; ++ks) a = __builtin_amdgcn_mfma_f32_32x32x16_bf16(af[at][ks], KB[ks], a, 0, 0, 0); \
            const f32x4 wa0 = *(const LAS f32x4*)(iwl + (2 * at) * 16 + 4 * hi), wa1 = *(const LAS f32x4*)(iwl + (2 * at) * 16 + 8 + 4 * hi); \
            const f32x4 wb0 = *(const LAS f32x4*)(iwl + (2 * at + 1) * 16 + 4 * hi), wb1 = *(const LAS f32x4*)(iwl + (2 * at + 1) * 16 + 8 + 4 * hi); \
            float pa = 0.f, pb = 0.f; \
            _Pragma("unroll") for (int e = 0; e < 4; ++e) { pa += wa0[e] * relu1(a[e]); pa += wa1[e] * relu1(a[4 + e]); pb += wb0[e] * relu1(a[8 + e]); pb += wb1[e] * relu1(a[12 + e]); } \
            auto rr = __builtin_amdgcn_permlane32_swap(__float_as_uint(pa), __float_as_uint(pb), false, false); \
            const float score = __uint_as_float(rr[0]) + __uint_as_float(rr[1]); \
            const int qi = 2 * at + hi, key = k0 + r32; \
            sc[qi * 4096 + key] = (key <= s0 + qi) ? sortable(score) : 0u; } } while (0)
#ifndef IDX_SCORE_REP
#define IDX_SCORE_REP 1
#endif
#pragma unroll 1
        for (int rep_ = 0; rep_ < IDX_SCORE_REP; ++rep_) {
        IK_LOAD(kb0, wave); IK_LOAD(kb1, wave + NWAVES);
#pragma unroll 1
        for (int j = wave; j < ntiles; j += 3 * NWAVES) {
            IK_LOAD(kb2, j + 2 * NWAVES); SCORE_TILE(kb0, j);
            if (j + NWAVES >= ntiles) break;
            IK_LOAD(kb0, j + 3 * NWAVES); SCORE_TILE(kb1, j + NWAVES);
            if (j + 2 * NWAVES >= ntiles) break;
            IK_LOAD(kb1, j + 4 * NWAVES); SCORE_TILE(kb2, j + 2 * NWAVES);
        }
        }
#undef IK_LOAD
#undef SCORE_TILE
        if (tid == 0) *qword = qgot;
        __syncthreads();
        ACC_T(1, tacc);
        const int s = s0 + wave, n = s + 1;
        unsigned kv[64];
#pragma unroll
        for (int i = 0; i < 64; ++i) { const int key = 64 * i + lane; kv[i] = (key <= s) ? sc[wave * 4096 + key] : 0u; }
        if (tid < 128) iwl0[((k + 1) & 1) * 128 + tid] = iwn;
        const int qnn = (int)*qword;
        AF_LOAD(t0n);
        LDS_WAIT();
        __syncthreads();
        unsigned Tt = 1u; bool exact = true;
        if (n > 256) {
            Tt = 0u; exact = false;
            for (int bit = 31; bit >= 0; --bit) {
                const unsigned cand = Tt | (1u << bit); unsigned c0 = 0, c1 = 0, c2 = 0, c3 = 0;
#pragma unroll
                for (int i = 0; i < 64; i += 4) CNT4(c0, c1, c2, c3, kv[i], kv[i + 1], kv[i + 2], kv[i + 3], cand);
                const unsigned c = wave_sum_dpp((c0 + c1) + (c2 + c3));
                if (c >= 256u) { Tt = cand; if (c == 256u) { exact = true; break; } }
            }
        }
        ACC_T(2, tacc);
#define WRLANE2(lo_, hi_, bal_, i_) do { const unsigned bl_ = (unsigned)(bal_), bh_ = (unsigned)((bal_) >> 32); \
        asm volatile("s_nop 3\n\tv_writelane_b32 %0, %2, %4\n\tv_writelane_b32 %1, %3, %4" : "+v"(lo_), "+v"(hi_) : "s"(bl_), "s"(bh_), "n"(i_)); } while (0)
        unsigned mlo = 0u, mhi = 0u;
        if (exact) {
#pragma unroll
            for (int i = 0; i < 64; ++i) { const unsigned long long bal = __ballot(kv[i] >= Tt);
                WRLANE2(mlo, mhi, bal, i); }
        } else {
            unsigned cg_ = 0;
#pragma unroll
            for (int i = 0; i < 64; ++i) cg_ += (kv[i] > Tt) ? 1u : 0u;
            cg_ = wave_sum_u(cg_);
            const unsigned need = 256u - cg_; unsigned seen = 0u;
#pragma unroll
            for (int i = 0; i < 64; ++i) {
                const unsigned kk = kv[i];
                const unsigned long long eq = __ballot(kk == Tt), gt = __ballot(kk > Tt);
                const unsigned below = (unsigned)__popcll(eq & ((1ull << lane) - 1ull));
                const bool take = (kk == Tt) && (seen + below < need);
                const unsigned long long bal = gt | __ballot(take);
                seen += (unsigned)__popcll(eq);
                WRLANE2(mlo, mhi, bal, i);
            }
        }
        const unsigned long long mine = ((unsigned long long)mhi << 32) | mlo;
        ((unsigned long long*)(ws + WS_MASK))[(size_t)(t0 + wave) * 64 + lane] = mine;
        ACC_T(3, tacc);
        qcur = qnxt; qnxt = qnn;
    }
#undef AF_LOAD
    __syncthreads();
}

namespace att {
constexpr int D = 128, NW = 8, QBLK = 32, KVBLK = 64, QB = 256;
constexpr int SHM_V = KVBLK * D * 2, SHM_K = KVBLK * D * 2;
constexpr int EPI_T0 = 2 * SHM_V + 2 * SHM_K + NW * 128 * 4 + 16, EPI_TW = 32 * 272;
constexpr int LDS_NEED = EPI_T0 + NW * EPI_TW;
static_assert(LDS_NEED <= MISC_OFF, "attention LDS map");
constexpr float SCALE = 0.08838834764831845f, THR = 8.f;
#define KSWZ(row, colB) ((row) * 256 + ((colB) ^ (((row) & 7) << 4)))
#define SBAR() __builtin_amdgcn_sched_barrier(0)
__device__ __forceinline__ int v_st(int k, int c) { const int kk = (k & ~0xC) | ((k & 4) << 1) | ((k & 8) >> 1); return ((kk >> 3) * 4 + (c >> 5)) * 512 + ((kk & 7) * 32 + (c & 31)) * 2; }
__device__ __forceinline__ int v_rd_base(int lane) { return ((lane & 3) << 3) | (((lane >> 2) & 3) << 6) | (((lane >> 4) & 1) << 5) | (((lane >> 5) & 1) << 8); }
constexpr int v_rd_off(int d0, int ks, int half) { return d0 * 512 + ks * 4096 + half * 2048; }
__device__ __forceinline__ int crow(int r, int hi) { return (r & 3) + 8 * (r >> 2) + 4 * hi; }
__device__ __forceinline__ bf16x8 load8(const bf16_t* p) { return *reinterpret_cast<const bf16x8*>(p); }
__device__ __forceinline__ void mask_bits(f32x16& p0, f32x16& p1, unsigned w0, unsigned w1, int hi) {
    w0 >>= 4 * hi; w1 >>= 4 * hi;
#pragma unroll
    for (int r = 0; r < 16; ++r) { const int c = (r & 3) + 8 * (r >> 2);
        const unsigned t0 = (unsigned)(((int)(w0 << (31 - c))) >> 31), t1 = (unsigned)(((int)(w1 << (31 - c))) >> 31);
        p0[r] = __uint_as_float((__float_as_uint(p0[r]) & t0) | (0xff800000u & ~t0));
        p1[r] = __uint_as_float((__float_as_uint(p1[r]) & t1) | (0xff800000u & ~t1)); }
}
__device__ __forceinline__ void partialSM(f32x16& p0, f32x16& p1, float& m_reg, float& mn, float& alpha) {
    float pmax = p0[0];
#pragma unroll
    for (int r = 1; r < 16; ++r) pmax = fmaxf(pmax, p0[r]);
#pragma unroll
    for (int r = 0; r < 16; ++r) pmax = fmaxf(pmax, p1[r]);
    { auto rr = __builtin_amdgcn_permlane32_swap(__float_as_uint(pmax), __float_as_uint(pmax), false, false);
      pmax = fmaxf(__uint_as_float(rr[0]), __uint_as_float(rr[1])); }
    constexpr float C2 = 1.4426950408889634f * SCALE;
    if (__builtin_expect(__all((pmax - m_reg) * SCALE <= THR), 1)) { mn = m_reg; alpha = 1.f; }
    else { mn = fmaxf(m_reg, pmax); alpha = __builtin_amdgcn_exp2f((m_reg - mn) * C2); m_reg = mn; }
    const float mnL = -mn * C2;
#pragma unroll
    for (int r = 0; r < 16; ++r) p0[r] = fmaf(p0[r], C2, mnL);
#pragma unroll
    for (int r = 0; r < 16; ++r) p1[r] = fmaf(p1[r], C2, mnL);
#pragma unroll
    for (int r = 0; r < 16; ++r) p0[r] = __builtin_amdgcn_exp2f(p0[r]);
}
__device__ __forceinline__ void finishSM(f32x16& p0, f32x16& p1, float alpha, float& l_reg, bf16x8& pa0, bf16x8& pa1, bf16x8& pa2, bf16x8& pa3) {
#pragma unroll
    for (int r = 0; r < 16; ++r) p1[r] = __builtin_amdgcn_exp2f(p1[r]);
    float ps = 0;
#pragma unroll
    for (int r = 0; r < 16; ++r) ps += p0[r];
#pragma unroll
    for (int r = 0; r < 16; ++r) ps += p1[r];
    { auto rr = __builtin_amdgcn_permlane32_swap(__float_as_uint(ps), __float_as_uint(ps), false, false);
      ps = __uint_as_float(rr[0]) + __uint_as_float(rr[1]); }
    l_reg = l_reg * alpha + ps;
#define PK4(P, B_, OUT) do { unsigned a0 = cvt_pk_bf16(P[B_+0], P[B_+1]), a1 = cvt_pk_bf16(P[B_+2], P[B_+3]);                          \
        unsigned b0 = cvt_pk_bf16(P[B_+4], P[B_+5]), b1 = cvt_pk_bf16(P[B_+6], P[B_+7]);                                             \
        auto r0 = __builtin_amdgcn_permlane32_swap(a0, b0, false, false); auto r1 = __builtin_amdgcn_permlane32_swap(a1, b1, false, false); \
        u32x4 w = {r0[0], r1[0], r0[1], r1[1]}; OUT = *reinterpret_cast<bf16x8*>(&w); } while (0)
    PK4(p0, 0, pa0); PK4(p0, 8, pa1); PK4(p1, 0, pa2); PK4(p1, 8, pa3);
#undef PK4
}
template <int KB>
__device__ __forceinline__ void qkt(f32x16& p0, f32x16& p1, const char* K_lds, int r32, int hi, const bf16x8* qr) {
    p0 = f32x16{}; p1 = f32x16{};
    const char* kb[4];
#pragma unroll
    for (int dd = 0; dd < 4; ++dd) kb[dd] = K_lds + KB * SHM_K + KSWZ(r32, (dd * 16 + hi * 8) * 2);
#pragma unroll
    for (int d0 = 0; d0 < 8; ++d0) { const char* a = kb[d0 & 3] + (d0 >> 2) * 128;
        bf16x8 b0 = *reinterpret_cast<const bf16x8*>(a);
        bf16x8 b1 = *reinterpret_cast<const bf16x8*>(a + 32 * 256);
        p0 = __builtin_amdgcn_mfma_f32_32x32x16_bf16(b0, qr[d0], p0, 0, 0, 0);
        p1 = __builtin_amdgcn_mfma_f32_32x32x16_bf16(b1, qr[d0], p1, 0, 0, 0); }
}
template <int VB>
__device__ __forceinline__ void pv_tile(f32x16* o, int vb0, bf16x8 pa0, bf16x8 pa1, bf16x8 pa2, bf16x8 pa3) {
#define TRRD(dst, off) asm volatile("ds_read_b64_tr_b16 %0, %1 offset:%2" : "=&v"(dst) : "v"(vb0), "i"(off) : "memory")
#define PV_D0(d0) do { s16x4 l0, l1, l2, l3, h0, h1, h2, h3; constexpr int b_ = VB * SHM_V + v_rd_off(d0, 0, 0); \
        TRRD(l0, b_); TRRD(h0, b_ + 2048); TRRD(l1, b_ + 4096); TRRD(h1, b_ + 6144); TRRD(l2, b_ + 8192); TRRD(h2, b_ + 10240); TRRD(l3, b_ + 12288); TRRD(h3, b_ + 14336); \
        asm volatile("s_waitcnt lgkmcnt(0)" ::: "memory"); SBAR();   \
        o[d0] = __builtin_amdgcn_mfma_f32_32x32x16_bf16(pa0, (bf16x8){l0[0], l0[1], l0[2], l0[3], h0[0], h0[1], h0[2], h0[3]}, o[d0], 0, 0, 0);   \
        o[d0] = __builtin_amdgcn_mfma_f32_32x32x16_bf16(pa1, (bf16x8){l1[0], l1[1], l1[2], l1[3], h1[0], h1[1], h1[2], h1[3]}, o[d0], 0, 0, 0);   \
        o[d0] = __builtin_amdgcn_mfma_f32_32x32x16_bf16(pa2, (bf16x8){l2[0], l2[1], l2[2], l2[3], h2[0], h2[1], h2[2], h2[3]}, o[d0], 0, 0, 0);   \
        o[d0] = __builtin_amdgcn_mfma_f32_32x32x16_bf16(pa3, (bf16x8){l3[0], l3[1], l3[2], l3[3], h3[0], h3[1], h3[2], h3[3]}, o[d0], 0, 0, 0); } while (0)
    PV_D0(0); PV_D0(1); PV_D0(2); PV_D0(3);
#undef PV_D0
#undef TRRD
}
struct BlockRef { const bf16_t* Q; const bf16_t* K; const bf16_t* V; const unsigned* M; bf16_t* O; const bf16_t* Z;
                  bf16_t* OPme; const bf16_t* OPot; f32x2* MLme; const f32x2* MLot; unsigned* cnt; int t_lo, NT; };
struct Seam { bf16x8 qr[8]; bf16x8 st_v0, st_v1, st_k0, st_k1; };
#define ROW(p, k0, rr) ((p) + (size_t)((k0) + (rr)) * D + sc)
#define VMW() asm volatile("s_waitcnt vmcnt(0)" ::: "memory")
#define VMWN(n) asm volatile("s_waitcnt vmcnt(%0)" :: "i"(n) : "memory")
#define SLOAD_H(Kp, Vp, k0) do { S.st_v0 = load8(ROW(Vp, k0, sr)); S.st_v1 = load8(ROW(Vp, k0, 32 + sr));              \
                         S.st_k0 = load8(ROW(Kp, k0, sr)); S.st_k1 = load8(ROW(Kp, k0, 32 + sr)); } while (0)
#define SWRITE_HK(bf) do { *(bf16x8*)(K_lds + (bf) * SHM_K + kws) = S.st_k0; *(bf16x8*)(K_lds + (bf) * SHM_K + kws + 32 * 256) = S.st_k1; } while (0)
#define SWRITE_HV(bf) do { *(bf16x8*)(V_lds + (bf) * SHM_V + vst0) = S.st_v0; *(bf16x8*)(V_lds + (bf) * SHM_V + vst1) = S.st_v1; } while (0)
#define SWRITE_H(bf) do { SWRITE_HV(bf); SWRITE_HK(bf); } while (0)
__device__ __forceinline__ void attn_prime(const BlockRef& cur, char* lds, Seam& S) {
    const int tid = opaque_tid(), wid = __builtin_amdgcn_readfirstlane(tid >> 6), lane = tid & 63, r32 = lane & 31, hi = lane >> 5;
    const int sr = tid >> 4, sc = (tid & 15) * 8, kws = KSWZ(sr, sc * 2); char* K_lds = lds + 2 * SHM_V;
#pragma unroll
    for (int d0 = 0; d0 < 8; ++d0) S.qr[d0] = load8(cur.Q + (size_t)(wid * QBLK + r32) * D + d0 * 16 + hi * 8);
    SLOAD_H(cur.K, cur.V, cur.t_lo * KVBLK); VMW(); SWRITE_HK(0);
    __syncthreads();
}
__device__ __forceinline__ void attn_block(const BlockRef& cur, const BlockRef& nxt, char* lds, Seam& S) {
    const int tid = opaque_tid(), wid = __builtin_amdgcn_readfirstlane(tid >> 6), lane = tid & 63, r32 = lane & 31, hi = lane >> 5;
    const int NT = cur.NT, t_lo = cur.t_lo;
    char* V_lds = lds; char* K_lds = lds + 2 * SHM_V;
    float* wsl = (float*)(lds + 2 * SHM_V + 2 * SHM_K) + wid * 128; float* li_l = wsl, * al_l = wsl + 32, * fb_l = wsl + 64;
    volatile unsigned* flag = (volatile unsigned*)(lds + 2 * SHM_V + 2 * SHM_K + NW * 128 * 4);
    float m_reg = -1e30f, l_reg = 0; f32x16 o[4] = {};
    const int sr = tid >> 4, sc = (tid & 15) * 8, vst0 = v_st(sr, sc), vst1 = v_st(32 + sr, sc), kws = KSWZ(sr, sc * 2);
    const int vb0 = (int)(uintptr_t)V_lds + v_rd_base(lane);
    const bf16_t* Kh = cur.K; const bf16_t* Vh = cur.V;
    const unsigned* mrow = cur.M + (size_t)(wid * QBLK + r32) * 128;
#define RESC(a) do { if (__any((a) < 1.f)) { if (hi == 0) al_l[r32] = (a); asm volatile("s_waitcnt lgkmcnt(0)" ::: "memory");              \
                     for (int d_ = 0; d_ < 4; ++d_) for (int r = 0; r < 16; ++r) o[d_][r] *= al_l[crow(r, hi)]; } } while (0)
#define KBASE(t) ((t_lo + (t)) * KVBLK)
#define MLOAD(t) (*(const u32x2*)(mrow + 2 * (t_lo + (t))))
#define SEAM_K0() do { VMWN(8); SWRITE_HK(0); SBAR(); } while (0)
    f32x16 pA0, pA1, pB0, pB1; float mnA, mnB, alA, alB; bf16x8 pa0, pa1, pa2, pa3;
    u32x2 mwA, mwB;
    SWRITE_HV(0); SBAR();
    mwA = MLOAD(0); mwB = MLOAD(1);
    SLOAD_H(Kh, Vh, KBASE(1));
    SBAR(); qkt<0>(pA0, pA1, K_lds, r32, hi, S.qr);
    mask_bits(pA0, pA1, mwA[0], mwA[1], hi); partialSM(pA0, pA1, m_reg, mnA, alA);
    VMW(); SWRITE_H(1);
    __syncthreads();
#define HALF_STEP(PX0, PX1, mnX, alX, mwX, mwY, PY0, PY1, alY, t, KB, VB, SB) do {                                              \
        SBAR(); mwY = MLOAD(((t) + 1 < NT) ? (t) + 1 : (t)); qkt<KB>(PX0, PX1, K_lds, r32, hi, S.qr);     \
        finishSM(PY0, PY1, alY, l_reg, pa0, pa1, pa2, pa3); SBAR();                                                           \
        if ((t) + 1 < NT) { SLOAD_H(Kh, Vh, KBASE((t) + 1)); SBAR(); }                                                        \
        pv_tile<VB>(o, vb0, pa0, pa1, pa2, pa3); mask_bits(PX0, PX1, mwX[0], mwX[1], hi); partialSM(PX0, PX1, m_reg, mnX, alX); \
        __syncthreads();                                                                                                      \
        if ((t) + 1 < NT) { VMW(); SWRITE_H(SB); }                                                                            \
        RESC(alX); __syncthreads(); } while (0)
    for (int t = 1; t + 1 < NT; t += 2) {
        HALF_STEP(pB0, pB1, mnB, alB, mwB, mwA, pA0, pA1, alA, t, 1, 0, 0);
        HALF_STEP(pA0, pA1, mnA, alA, mwA, mwB, pB0, pB1, alB, t + 1, 0, 1, 1);
    }
    SBAR(); qkt<1>(pB0, pB1, K_lds, r32, hi, S.qr); SBAR();
    SLOAD_H(nxt.K, nxt.V, nxt.t_lo * KVBLK); SBAR();
#pragma unroll
    for (int d0 = 0; d0 < 8; ++d0) S.qr[d0] = load8(nxt.Q + (size_t)(wid * QBLK + r32) * D + d0 * 16 + hi * 8);
    SBAR();
    finishSM(pA0, pA1, alA, l_reg, pa0, pa1, pa2, pa3); SBAR();
    pv_tile<0>(o, vb0, pa0, pa1, pa2, pa3);
    mask_bits(pB0, pB1, mwB[0], mwB[1], hi); partialSM(pB0, pB1, m_reg, mnB, alB); __syncthreads(); RESC(alB);
    finishSM(pB0, pB1, alB, l_reg, pa0, pa1, pa2, pa3); SBAR(); pv_tile<1>(o, vb0, pa0, pa1, pa2, pa3);
    SBAR(); SEAM_K0();
    char* Tl = lds + EPI_T0 + wid * EPI_TW;
    if (hi == 0) { li_l[r32] = l_reg; cur.MLme[wid * QBLK + r32] = (f32x2){m_reg, l_reg}; }
    asm volatile("s_waitcnt lgkmcnt(0)" ::: "memory");
#pragma unroll
    for (int r = 0; r < 16; ++r) { const float lr = li_l[crow(r, hi)]; const float rl = lr > 0.f ? __builtin_amdgcn_rcpf(lr) : 0.f;
#pragma unroll
        for (int d0 = 0; d0 < 4; ++d0) *(bf16_t*)(Tl + crow(r, hi) * 272 + (d0 * 32 + r32) * 2) = f2bf(o[d0][r] * rl); }
    asm volatile("s_waitcnt lgkmcnt(0)" ::: "memory");
    const int crw = lane >> 4, ccol = (lane & 15) * 8;
#pragma unroll
    for (int i = 0; i < 8; ++i) { const int row = crw + 4 * i; *(u32x4*)(cur.OPme + (size_t)(wid * QBLK + row) * D + ccol) = *(const u32x4*)(Tl + row * 272 + ccol * 2); }
    VMW(); __syncthreads();
    if (tid == 0) { __builtin_amdgcn_fence(__ATOMIC_RELEASE, "agent"); asm volatile("s_waitcnt vmcnt(0)" ::: "memory");
        *flag = __hip_atomic_fetch_add(cur.cnt, 1u, __ATOMIC_RELAXED, __HIP_MEMORY_SCOPE_AGENT); }
    __syncthreads();
    if (*flag == 1u) {
        if (tid == 0) { __builtin_amdgcn_fence(__ATOMIC_ACQUIRE, "agent"); asm volatile("s_waitcnt vmcnt(0)" ::: "memory"); }
        __syncthreads();
        u32x4 ot[8], zz[8];
#pragma unroll
        for (int i = 0; i < 8; ++i) { const int row = wid * QBLK + crw + 4 * i; ot[i] = *(const u32x4*)(cur.OPot + (size_t)row * D + ccol); zz[i] = *(const u32x4*)(cur.Z + (size_t)row * 1024 + ccol); }
        constexpr float C2 = 1.4426950408889634f * SCALE;
        if (hi == 0) { const f32x2 om = cur.MLot[wid * QBLK + r32]; const float M = fmaxf(m_reg, om[0]);
            const float wa = __builtin_amdgcn_exp2f((m_reg - M) * C2) * l_reg, wb = __builtin_amdgcn_exp2f((om[0] - M) * C2) * om[1];
            const float inv = __builtin_amdgcn_rcpf(wa + wb); li_l[r32] = wa * inv; fb_l[r32] = wb * inv; }
        asm volatile("s_waitcnt lgkmcnt(0)" ::: "memory");
#pragma unroll
        for (int i = 0; i < 8; ++i) { const int row = crw + 4 * i; const float fa = li_l[row], fb = fb_l[row];
            const u32x4 ow = *(const u32x4*)(Tl + row * 272 + ccol * 2); u32x4 w;
#pragma unroll
            for (int e = 0; e < 4; ++e) w[e] = cvt_pk_bf16((bflo(ow[e]) * fa + bflo(ot[i][e]) * fb) * bflo(zz[i][e]), (bfhi(ow[e]) * fa + bfhi(ot[i][e]) * fb) * bfhi(zz[i][e]));
            *(u32x4*)(cur.O + (size_t)(wid * QBLK + row) * 1024 + ccol) = w; }
    }
    __syncthreads();
#undef RESC
#undef KBASE
#undef MLOAD
#undef SEAM_K0
#undef HALF_STEP
}
#undef ROW
#undef VMW
#undef VMWN
#undef SLOAD_H
#undef SWRITE_HK
#undef SWRITE_HV
#undef SWRITE_H
__device__ __forceinline__ BlockRef make_ref(unsigned char* ws, unsigned* ctl, int item, int pass) {
    const int hf = item & 1, xp = (item >> 1) & 7, bh = item >> 4, qb = pass ? 15 - xp : xp, b = bh >> 3, h = bh & 7, kvh = b * 2 + (h >> 2);
    BlockRef r;
    r.Q = (const bf16_t*)(ws + WS_QN) + ((size_t)bh * SEQ + qb * QB) * D;
    r.K = (const bf16_t*)(ws + WS_KN) + (size_t)kvh * SEQ * D; r.V = (const bf16_t*)(ws + WS_VV) + (size_t)kvh * SEQ * D;
    r.M = (const unsigned*)(ws + WS_MASK) + (size_t)(b * SEQ + qb * QB) * 128;
    r.O = (bf16_t*)(ws + WS_XB) + (size_t)(b * SEQ + qb * QB) * 1024 + h * 128;
    r.Z = (const bf16_t*)(ws + WS_BZ) + (size_t)(b * SEQ + qb * QB) * 1024 + h * 128;
    const size_t prow = (size_t)bh * SEQ + qb * QB, hstr = (size_t)16 * SEQ;
    r.OPme = (bf16_t*)(ws + WS_OPART) + ((size_t)hf * hstr + prow) * D; r.OPot = (const bf16_t*)(ws + WS_OPART) + ((size_t)(hf ^ 1) * hstr + prow) * D;
    r.MLme = (f32x2*)(ws + WS_ML) + (size_t)hf * hstr + prow; r.MLot = (const f32x2*)(ws + WS_ML) + (size_t)(hf ^ 1) * hstr + prow;
    r.cnt = ctl + bh * 16 + qb;
    r.NT = 2 * (qb + 1); r.t_lo = hf * r.NT; return r;
}
}


#define XB_TMO      128
#define XB_XCNT(j)  (256  + 64 * (j))
#define XB_XSUB(j)  (1280 + 64 * (j))
#define XB_XGEN(j)  (2304 + 64 * (j))
#define XB_TOP      3328
#define XB_TOPGEN   3392
#define XCD_BAR_WORDS 3456
#define XB_SPIN_CAP (1u << 22)
__device__ __forceinline__ unsigned xb_ld(unsigned* p)              { return __hip_atomic_load(p, __ATOMIC_RELAXED, __HIP_MEMORY_SCOPE_AGENT); }
__device__ __forceinline__ unsigned xb_add(unsigned* p, unsigned v) { return __hip_atomic_fetch_add(p, v, __ATOMIC_RELAXED, __HIP_MEMORY_SCOPE_AGENT); }
__device__ __forceinline__ unsigned xb_xcc_id() { return (unsigned)__builtin_amdgcn_s_getreg((3 << 11) | 20) & 0xFu; }
#define XB_SPIN(cond, bar) do { unsigned _sp = 0; while (cond) { __builtin_amdgcn_s_sleep(1); \
    if ((++_sp & 255u) == 0u) { if (xb_ld(&(bar)[XB_TMO])) break; if (_sp > XB_SPIN_CAP) { atomicAdd(&(bar)[XB_TMO], 1u); break; } } } } while (0)
struct XcdBarrier { unsigned* bar; unsigned x; volatile LAS unsigned* st; };
__device__ __forceinline__ XcdBarrier xcd_barrier_post(unsigned* bar, volatile LAS unsigned* st) {
    XcdBarrier b; b.bar = bar; b.x = xb_xcc_id(); b.st = st;
    if (threadIdx.x == 0) (void)xb_add(&bar[XB_XCNT(b.x)], 1u);
    return b;
}
__device__ __forceinline__ void xcd_barrier_complete(unsigned* bar, unsigned x, unsigned& nloc, unsigned& nx) {
    const unsigned G = gridDim.x * gridDim.y * gridDim.z;
    unsigned sum, cnt, mine, sp = 0u;
    for (;;) {
        sum = 0u; cnt = 0u; mine = 0u;
#pragma unroll
        for (unsigned j = 0; j < 16; ++j) { const unsigned c = xb_ld(&bar[XB_XCNT(j)]); sum += c; cnt += (c > 0u) ? 1u : 0u; mine = (j == x) ? c : mine; }
        if (sum == G) break;
        __builtin_amdgcn_s_sleep(1);
        if ((++sp & 255u) == 0u) { if (xb_ld(&bar[XB_TMO])) break; if (sp > XB_SPIN_CAP) { atomicAdd(&bar[XB_TMO], 1u); break; } }
    }
    nloc = mine > 0u ? mine : 1u; nx = cnt > 0u ? cnt : 1u;
}
__device__ __forceinline__ void xcd_barrier(const XcdBarrier& b) {
    asm volatile("s_waitcnt vmcnt(0)" ::: "memory");
    __syncthreads();
    if (threadIdx.x == 0) {
        unsigned* bar = b.bar;
        __builtin_amdgcn_s_waitcnt(0);
        unsigned nloc = b.st[0], nx = b.st[1];
        if (nloc == 0u) { xcd_barrier_complete(bar, b.x, nloc, nx); b.st[0] = nloc; b.st[1] = nx; }
        const unsigned old = xb_add(&bar[XB_XSUB(b.x)], 1u);
        const unsigned gen = old / nloc;
        if (old + 1u == (gen + 1u) * nloc) {
            __builtin_amdgcn_fence(__ATOMIC_RELEASE, "agent");
            asm volatile("s_waitcnt vmcnt(0)" ::: "memory");
            const unsigned og = xb_add(&bar[XB_TOP], 1u);
            const unsigned tg = og / nx;
            if (og + 1u == (tg + 1u) * nx) xb_add(&bar[XB_TOPGEN], 1u);
            else XB_SPIN(xb_ld(&bar[XB_TOPGEN]) == tg, bar);
            __builtin_amdgcn_fence(__ATOMIC_ACQUIRE, "agent");
            xb_add(&bar[XB_XGEN(b.x)], 1u);
            asm volatile("s_waitcnt vmcnt(0)" ::: "memory");
        } else {
            XB_SPIN(xb_ld(&bar[XB_XGEN(b.x)]) == gen, bar);
            __builtin_amdgcn_fence(__ATOMIC_ACQUIRE, "agent");
            asm volatile("s_waitcnt vmcnt(0)" ::: "memory");
        }
    }
    __syncthreads();
}

constexpr int CW_EXIT = XCD_BAR_WORDS, CW_ATT = XCD_BAR_WORDS + 64, CW_IDXQ = CW_ATT + 256, CW_WORDS = CW_IDXQ + 64;
__device__ unsigned g_ctl[CW_WORDS];

__global__ void __launch_bounds__(NTHREADS, 2) fwd_mega(Params p) {
    extern __shared__ __attribute__((aligned(16))) unsigned char lds_raw[];
    cg::grid_group grid = cg::this_grid();
    LAS unsigned char* lds = (LAS unsigned char*)lds_raw;
    const int G = gridDim.x, bx = blockIdx.x;
    const int vcu = (G % 8 == 0) ? (bx % 8) * (G / 8) + bx / 8 : bx;
    unsigned char* ws = p.ws;
    volatile LAS unsigned* misc = (volatile LAS unsigned*)(lds + MISC_OFF);
    if (threadIdx.x < 2) misc[threadIdx.x] = 0u;
    __syncthreads();
    if (p.out == nullptr) grid.sync();
    const XcdBarrier gbar = xcd_barrier_post(g_ctl, misc);
#define GRID_SYNC() xcd_barrier(gbar)

#ifndef PHASES
#define PHASES 0xffff
#endif
#ifndef REPMASK
#define REPMASK 0
#endif
#define NREP(bit) ((REPMASK & (bit)) ? 2 : 1)
#ifndef SPAN_A
#define SPAN_A -1
#endif
#ifndef SPAN_B
#define SPAN_B -1
#endif
    volatile LAS unsigned long long* stamps = (volatile LAS unsigned long long*)(lds + MISC_OFF + 16);
#define STAMP(k) do { if (SPAN_A >= 0 && bx == 0 && threadIdx.x == 0) stamps[k] = __builtin_amdgcn_s_memrealtime(); } while (0)
    STAMP(0);
    if (SPAN_A >= 0 && bx == 0 && threadIdx.x == 0) { stamps[16] = 0; stamps[17] = 0; stamps[18] = 0; stamps[19] = 0; }
    for (int rep = 0; rep < NREP(1); ++rep) if (PHASES & 1) p0_prep(p, lds, vcu, G);
    GRID_SYNC(); STAMP(1);
    for (int rep = 0; rep < NREP(2); ++rep) if (PHASES & 2) {
        Sched1 S{G, bx, (const char*)ws};
        Epi1 E{ws, p.ik_g, p.ik_b};
        pg8::gemm_phase<Epi1, Sched1, true, true>(lds, DM, S, E);
    }
    if (PHASES & 1) { constexpr int NU1A = 32 * NT_BF + 16; const int nfull = (NU1A % G == 0) ? 0 : NU1A % G; const int nhelp = G - nfull;
        if (nhelp == G) p0b_gate8(p, lds, bx, G); else if (bx >= nfull) p0b_gate8(p, lds, bx - nfull, nhelp); }
    STAMP(14);
    GRID_SYNC();
    if (PHASES & 2) {
        Sched1b S{G, bx, (const char*)ws}; Epi1b E{ws};
        pg8::gemm_phase<Epi1b, Sched1b, true, true, true>(lds, DM / 2, S, E);
    }
    GRID_SYNC(); STAMP(2);
    for (int rep = 0; rep < NREP(4); ++rep) if (PHASES & 4) p2_qkprep(p, vcu, G);
    STAMP(3);
    for (int rep = 0; rep < NREP(8); ++rep) if (PHASES & 8) for (int u = bx; u < 512; u += G) p2_gmlp_unit(p, lds, u);
    STAMP(4);
    for (int rep = 0; rep < NREP(16); ++rep) if (PHASES & 16) for (int u = bx; u < 256; u += G) p2_mem_unit(p, lds, u);
    STAMP(5);
    for (int rep = 0; rep < NREP(32); ++rep) if (PHASES & 32) p2_idx_all(p, lds, bx, G, g_ctl + CW_IDXQ);
    STAMP(6);
    GRID_SYNC(); STAMP(7);
    for (int rep = 0; rep < NREP(64); ++rep) if (PHASES & 64) {
        const int L0 = (G == 256) ? ((bx & 7) * 32 + (bx >> 3)) : bx;
        if (L0 < 256) {
            int L = L0, pass = 0;
            att::Seam S; att::BlockRef cur = att::make_ref(ws, g_ctl + CW_ATT, L, 0);
            att::attn_prime(cur, (char*)lds_raw, S);
            STAMP(11);
            for (;;) {
                const bool more_pass = pass == 0, more_item = L + G < 256, last = !more_pass && !more_item;
                const int Ln = more_pass ? L : (more_item ? L + G : L), pn = more_pass ? 1 : 0;
                const att::BlockRef nxt = last ? cur : att::make_ref(ws, g_ctl + CW_ATT, Ln, pn);
                att::attn_block(cur, nxt, (char*)lds_raw, S);
                STAMP(12 + pass);
                if (last) break;
                cur = nxt; L = Ln; pass = pn;
            }
        }
    }
    GRID_SYNC(); STAMP(8);
    for (int rep = 0; rep < NREP(128); ++rep) if (PHASES & 128) {
        Sched2 S{G, bx, (const char*)ws};
        Epi2 E{ws};
        pg8::gemm_phase<Epi2, Sched2, true, true>(lds, 1024, S, E);
    }
    GRID_SYNC(); STAMP(9);
    if (REPMASK & 512) { for (int i = 0; i < 10; ++i) GRID_SYNC(); }
    for (int rep = 0; rep < NREP(256); ++rep) if (PHASES & 256) {
        Sched3 S{G, bx, (const char*)(ws + WS_MERGED), (const char*)(ws + WS_WOUT)};
        Epi3 E{p.x, p.out};
        pg8::gemm_phase<Epi3, Sched3, true, true>(lds, DM, S, E);
    }
    STAMP(10);
    if (SPAN_A >= 0 && bx == 0 && threadIdx.x == 0) {
        const unsigned long long dt = (SPAN_A >= 100) ? stamps[SPAN_A - 100 + 16] : (stamps[SPAN_B] - stamps[SPAN_A]), t0 = __builtin_amdgcn_s_memrealtime();
        while (__builtin_amdgcn_s_memrealtime() - t0 < dt) __builtin_amdgcn_s_sleep(8);
    }
    __syncthreads();
    if (threadIdx.x == 0) misc[0] = (xb_add(&g_ctl[CW_EXIT], 1u) == (unsigned)G - 1u) ? 1u : 0u;
    __syncthreads();
    if (misc[0]) { for (int i = threadIdx.x; i < CW_WORDS; i += NTHREADS) __hip_atomic_store(&g_ctl[i], 0u, __ATOMIC_RELAXED, __HIP_MEMORY_SCOPE_AGENT);
                   for (int i = threadIdx.x; i < NGATE; i += NTHREADS) __hip_atomic_store(&g_colmax[i], 0u, __ATOMIC_RELAXED, __HIP_MEMORY_SCOPE_AGENT); }
}

extern "C" void kernel_launch(void* const* d_in, const int* in_sizes, int n_in, void* d_out, int out_size, void* d_ws, size_t ws_size, hipStream_t stream) {
    static int grid_blocks = 0;
    if (!grid_blocks) {
        if (n_in != 21 || out_size != T * DM || ws_size < WS_TOTAL) { fprintf(stderr, "kernel_launch: unexpected shapes (n_in %d out %d ws %zu)\n", n_in, out_size, ws_size); grid_blocks = -1; return; }
        int dev = 0, cus = 0, per_cu = 0;
        (void)hipGetDevice(&dev);
        (void)hipDeviceGetAttribute(&cus, hipDeviceAttributeMultiprocessorCount, dev);
        (void)hipFuncSetAttribute((const void*)fwd_mega, hipFuncAttributeMaxDynamicSharedMemorySize, LDS_BYTES);
        (void)hipOccupancyMaxActiveBlocksPerMultiprocessor(&per_cu, (const void*)fwd_mega, NTHREADS, LDS_BYTES);
        if (per_cu < 1) { fprintf(stderr, "kernel_launch: occupancy query returned %d\n", per_cu); grid_blocks = -1; return; }
        grid_blocks = cus;
        fprintf(stderr, "kernel_launch: cus %d per_cu %d grid %d\n", cus, per_cu, grid_blocks);
    }
    if (grid_blocks < 0) return;
    Params p{};
    p.x = (const float*)d_in[0]; p.mem = (const float*)d_in[1]; p.pos = (const int*)d_in[2]; p.norm_gain = (const float*)d_in[3]; p.w_in = (const float*)d_in[4];
    p.gmlp_g = (const float*)d_in[5]; p.gmlp_b = (const float*)d_in[6]; p.spatial_w = (const float*)d_in[7]; p.spatial_b = (const float*)d_in[8]; p.w_a = (const float*)d_in[9];
    p.q_gain = (const float*)d_in[10]; p.k_gain = (const float*)d_in[11]; p.ik_g = (const float*)d_in[12]; p.ik_b = (const float*)d_in[13]; p.w_b = (const float*)d_in[14];
    p.mem_gain = (const float*)d_in[15]; p.w_mkv = (const float*)d_in[16]; p.mq_gain = (const float*)d_in[17]; p.mk_gain = (const float*)d_in[18]; p.w_m = (const float*)d_in[19];
    p.w_out = (const float*)d_in[20]; p.out = (float*)d_out; p.ws = (unsigned char*)d_ws;
    void* args[] = {&p};
    hipError_t e = hipLaunchCooperativeKernel((const void*)fwd_mega, dim3(grid_blocks), dim3(NTHREADS), args, LDS_BYTES, stream);
    if (e != hipSuccess) fprintf(stderr, "cooperative launch failed: %s (grid %d)\n", hipGetErrorString(e), grid_blocks);
}
```
